# Optimizing an MI355X kernel written in HIP

```python
import math
import jax, jax.numpy as jnp
from jax import lax
import numpy as np

D_MODEL = 2048
BATCH = 4
SEQ = 4096
DEPTH = 2

SSM_WIDTH = D_MODEL // 4
SSM_CH = 16
SSM_GROUPS = SSM_WIDTH // SSM_CH
SSM_STATE = 64
DIFF_WIDTH = 3 * D_MODEL // 8
DIFF_V_DIM = 128
DIFF_HEADS = DIFF_WIDTH // DIFF_V_DIM
DIFF_QK_DIM = DIFF_V_DIM // 2
GDN_WIDTH = D_MODEL - SSM_WIDTH - DIFF_WIDTH
GDN_HEAD_DIM = 128
GDN_HEADS = GDN_WIDTH // GDN_HEAD_DIM
CONV_WIDTH = 4
GDN_CHUNK = 64
ROPE_THETA = 500000.0
ROPE_DIM = DIFF_QK_DIM // 4
Q_BLOCK = 128
D_FF = 5632
N_EXPERTS = 8
TOP_K = 2
D_FF_EXPERT = 7168
N_DENSE = (DEPTH + 1) // 2
N_MOE = DEPTH // 2
IN_PROJ_WIDTH = SSM_WIDTH + 3 * DIFF_WIDTH + 4 * GDN_WIDTH + 2 * GDN_HEADS
EPS = 1e-6
F32 = jnp.float32

kernel_name = 'hybrid_s5_diffattn_gdn_moe_block'


def rmsnorm(x, w):
    xf = x.astype(F32)
    return xf * lax.rsqrt(jnp.mean(xf * xf, axis=-1, keepdims=True) + EPS) * w.astype(F32)


def l2norm(t):
    return t * lax.rsqrt(jnp.sum(t * t, axis=-1, keepdims=True) + EPS)


def s5_mixer(u, a_re, a_im, log_dt, b_re, b_im, c_re, c_im, d_skip, w_glu):
    bsz, seq, _ = u.shape
    ug = u.astype(F32).reshape(bsz, seq, SSM_GROUPS, SSM_CH)
    lam = lax.complex(a_re.astype(F32), a_im.astype(F32))
    dt = jnp.exp(log_dt.astype(F32))[:, None]
    lam_bar = jnp.exp(lam * dt)
    b_mat = lax.complex(b_re.astype(F32), b_im.astype(F32))
    b_bar = ((lam_bar - 1.0) / lam)[:, :, None] * b_mat
    bu = jnp.einsum('gph,bsgh->bsgp', b_bar, ug.astype(jnp.complex64))
    lam_seq = jnp.broadcast_to(lam_bar, bu.shape)

    def combine(e1, e2):
        a1, s1 = e1
        a2, s2 = e2
        return a1 * a2, a2 * s1 + s2

    _, states = lax.associative_scan(combine, (lam_seq, bu), axis=1)
    c_mat = lax.complex(c_re.astype(F32), c_im.astype(F32))
    y = jnp.real(jnp.einsum('ghp,bsgp->bsgh', c_mat, states))
    y = y + d_skip.astype(F32).reshape(SSM_GROUPS, SSM_CH) * ug
    y = jax.nn.gelu(y.reshape(bsz, seq, SSM_WIDTH))
    return y * jax.nn.sigmoid(y @ w_glu.astype(F32))


def partial_rope(t, cos, sin):
    half = ROPE_DIM // 2
    t1, t2, rest = t[..., :half], t[..., half:ROPE_DIM], t[..., ROPE_DIM:]
    return jnp.concatenate([t1 * cos - t2 * sin, t2 * cos + t1 * sin, rest], axis=-1)


def diff_attention(q, k, v, positions, lam_q1, lam_k1, lam_q2, lam_k2, subln_w, lambda_init):
    bsz, seq = q.shape[:2]
    inv_freq = ROPE_THETA ** (-jnp.arange(0, ROPE_DIM, 2, dtype=F32) / ROPE_DIM)
    ang = positions.astype(F32)[:, :, None] * inv_freq
    cos = jnp.cos(ang)[:, :, None, None, :]
    sin = jnp.sin(ang)[:, :, None, None, :]
    q = partial_rope(q, cos, sin) * (DIFF_QK_DIM ** -0.5)
    k = partial_rope(k, cos, sin)
    lam = (jnp.exp(jnp.sum(lam_q1.astype(F32) * lam_k1.astype(F32)))
           - jnp.exp(jnp.sum(lam_q2.astype(F32) * lam_k2.astype(F32))) + lambda_init)
    n_blocks = seq // Q_BLOCK
    q_blocks = jnp.moveaxis(q.reshape(bsz, n_blocks, Q_BLOCK, DIFF_HEADS, 2, DIFF_QK_DIM), 1, 0)
    key_idx = jnp.arange(seq)

    def attend(args):
        q_blk, blk = args
        s = jnp.einsum('bqhmd,bkhmd->bhmqk', q_blk, k)
        q_idx = blk * Q_BLOCK + jnp.arange(Q_BLOCK)
        s = jnp.where(key_idx[None, :] <= q_idx[:, None], s, -jnp.inf)
        p = jax.nn.softmax(s, axis=-1)
        w = p[:, :, 0] - lam * p[:, :, 1]
        return jnp.einsum('bhqk,bkhd->bqhd', w, v)

    o = lax.map(attend, (q_blocks, jnp.arange(n_blocks)))
    o = jnp.moveaxis(o, 0, 1).reshape(bsz, seq, DIFF_HEADS, DIFF_V_DIM)
    o = rmsnorm(o, subln_w) * (1.0 - lambda_init)
    return o.reshape(bsz, seq, DIFF_WIDTH)


def causal_short_conv(t, w):
    ch = t.shape[-1]
    y = lax.conv_general_dilated(t, w.astype(t.dtype)[:, None, :], window_strides=(1,),
                                 padding=[(CONV_WIDTH - 1, 0)],
                                 dimension_numbers=('NWC', 'WIO', 'NWC'),
                                 feature_group_count=ch)
    return jax.nn.silu(y)


def gated_delta_net(q, k, v, a, b, z, a_log, dt_bias, gnorm_w):
    bsz, seq = q.shape[:2]
    n_chunks = seq // GDN_CHUNK
    q = l2norm(q) * (GDN_HEAD_DIM ** -0.5)
    k = l2norm(k)
    beta = jax.nn.sigmoid(b)
    g = -jnp.exp(a_log.astype(F32)) * jax.nn.softplus(a + dt_bias.astype(F32))

    def chunks(t):
        t = t.reshape((bsz, n_chunks, GDN_CHUNK) + t.shape[2:])
        return jnp.moveaxis(t, 3, 1)

    qc, kc, vc = chunks(q), chunks(k), chunks(v)
    bc, gc = chunks(beta), chunks(g)
    g_cum = jnp.cumsum(gc, axis=-1)
    idx = jnp.arange(GDN_CHUNK)
    incl = idx[:, None] >= idx[None, :]
    strict = idx[:, None] > idx[None, :]
    decay = jnp.exp(jnp.where(incl, g_cum[..., :, None] - g_cum[..., None, :], -jnp.inf))
    k_beta = kc * bc[..., None]
    v_beta = vc * bc[..., None]
    lower = jnp.where(strict, jnp.einsum('bhncd,bhned->bhnce', k_beta, kc) * decay, 0.0)
    eye = jnp.eye(GDN_CHUNK, dtype=F32)
    t_mat = lax.linalg.triangular_solve(eye + lower, jnp.broadcast_to(eye, lower.shape),
                                        left_side=True, lower=True, unit_diagonal=True)
    u = t_mat @ v_beta
    w = t_mat @ (k_beta * jnp.exp(g_cum)[..., None])
    qk = jnp.where(incl, jnp.einsum('bhncd,bhned->bhnce', qc, kc) * decay, 0.0)

    def step(state, inp):
        q_i, k_i, u_i, w_i, g_i, qk_i = inp
        v_new = u_i - w_i @ state
        o_i = (q_i * jnp.exp(g_i)[..., None]) @ state + qk_i @ v_new
        g_last = g_i[..., -1:]
        state = (state * jnp.exp(g_last)[..., None]
                 + jnp.einsum('bhcd,bhce->bhde', k_i * jnp.exp(g_last - g_i)[..., None], v_new))
        return state, o_i

    xs = tuple(jnp.moveaxis(t, 2, 0) for t in (qc, kc, u, w, g_cum, qk))
    state0 = jnp.zeros((bsz, GDN_HEADS, GDN_HEAD_DIM, GDN_HEAD_DIM), F32)
    _, o = lax.scan(step, state0, xs)
    o = jnp.moveaxis(o, 0, 2).reshape(bsz, GDN_HEADS, seq, GDN_HEAD_DIM)
    o = jnp.moveaxis(o, 1, 2)
    o = rmsnorm(o, gnorm_w) * jax.nn.silu(z)
    return o.reshape(bsz, seq, GDN_WIDTH)


def hybrid_mixer(h, positions, layer_idx, w_in, w_out,
                 ssm_a_re, ssm_a_im, ssm_log_dt, ssm_b_re, ssm_b_im, ssm_c_re, ssm_c_im, ssm_d, ssm_w_glu,
                 diff_lam_q1, diff_lam_k1, diff_lam_q2, diff_lam_k2, diff_subln,
                 gdn_conv, gdn_a_log, gdn_dt_bias, gdn_norm):
    bsz, seq, _ = h.shape
    proj = (h @ w_in.astype(F32)).astype(F32)
    sizes = [SSM_WIDTH, DIFF_WIDTH, DIFF_WIDTH, DIFF_WIDTH, 3 * GDN_WIDTH, GDN_WIDTH, GDN_HEADS, GDN_HEADS]
    cuts = [int(s) for s in np.cumsum(sizes)[:-1]]
    u, dq, dk, dv, gqkv, gz, ga, gb = jnp.split(proj, cuts, axis=-1)
    y_ssm = s5_mixer(u, ssm_a_re, ssm_a_im, ssm_log_dt, ssm_b_re, ssm_b_im,
                     ssm_c_re, ssm_c_im, ssm_d, ssm_w_glu)
    lambda_init = 0.8 - 0.6 * math.exp(-0.3 * layer_idx)
    y_diff = diff_attention(dq.reshape(bsz, seq, DIFF_HEADS, 2, DIFF_QK_DIM),
                            dk.reshape(bsz, seq, DIFF_HEADS, 2, DIFF_QK_DIM),
                            dv.reshape(bsz, seq, DIFF_HEADS, DIFF_V_DIM), positions,
                            diff_lam_q1, diff_lam_k1, diff_lam_q2, diff_lam_k2, diff_subln, lambda_init)
    gq, gk, gv = jnp.split(causal_short_conv(gqkv, gdn_conv), 3, axis=-1)
    hs = (bsz, seq, GDN_HEADS, GDN_HEAD_DIM)
    y_gdn = gated_delta_net(gq.reshape(hs), gk.reshape(hs), gv.reshape(hs), ga, gb, gz.reshape(hs),
                            gdn_a_log, gdn_dt_bias, gdn_norm)
    return jnp.concatenate([y_ssm, y_diff, y_gdn], axis=-1) @ w_out.astype(F32)


def swiglu(h, w1, w3, w2):
    return (jax.nn.silu(h @ w1.astype(F32)) * (h @ w3.astype(F32))) @ w2.astype(F32)


def moe_swiglu(h, w_router, w1, w3, w2):
    bsz, seq, d = h.shape
    t = h.reshape(bsz * seq, d)
    logits = t @ w_router.astype(F32)
    top_val, top_idx = lax.top_k(logits, TOP_K)
    gates = jax.nn.softmax(top_val, axis=-1)
    combine = jnp.einsum('tk,tke->te', gates, jax.nn.one_hot(top_idx, N_EXPERTS, dtype=F32))
    out = jnp.zeros_like(t)
    for e in range(N_EXPERTS):
        out = out + combine[:, e:e + 1] * swiglu(t, w1[e], w3[e], w2[e])
    return out.reshape(bsz, seq, d)


def setup_inputs(seed: int = 0) -> dict:
    key = jax.random.key(seed)
    ks = jax.random.split(key, 40)

    def nrm(k, shape, scale):
        return scale * jax.random.normal(k, shape, F32)

    x = nrm(ks[0], (BATCH, SEQ, D_MODEL), 1.0)
    c = nrm(ks[1], (BATCH, D_MODEL), 1.0)
    positions = (jax.random.randint(ks[2], (BATCH, 1), 0, 2048, dtype=jnp.int32)
                 + jnp.arange(SEQ, dtype=jnp.int32)[None, :])
    w_ada = nrm(ks[3], (DEPTH, D_MODEL, 6 * D_MODEL), 0.5 * D_MODEL ** -0.5)
    b_ada = nrm(ks[4], (DEPTH, 6 * D_MODEL), 0.01)
    norm_mix = 1.0 + nrm(ks[5], (DEPTH, D_MODEL), 0.01)
    norm_ffn = 1.0 + nrm(ks[6], (DEPTH, D_MODEL), 0.01)
    norm_final = 1.0 + nrm(ks[7], (D_MODEL,), 0.01)
    w_in = nrm(ks[8], (DEPTH, D_MODEL, IN_PROJ_WIDTH), D_MODEL ** -0.5)
    w_out = nrm(ks[9], (DEPTH, D_MODEL, D_MODEL), D_MODEL ** -0.5)
    ssm_a_re = -0.5 + nrm(ks[10], (DEPTH, SSM_GROUPS, SSM_STATE), 0.01)
    ssm_a_im = math.pi * jnp.arange(SSM_STATE, dtype=F32) + nrm(ks[11], (DEPTH, SSM_GROUPS, SSM_STATE), 0.01)
    ssm_log_dt = jax.random.uniform(ks[12], (DEPTH, SSM_GROUPS), F32, math.log(1e-3), math.log(1e-1))
    ssm_b_re = nrm(ks[13], (DEPTH, SSM_GROUPS, SSM_STATE, SSM_CH), (2 * SSM_CH) ** -0.5)
    ssm_b_im = nrm(ks[14], (DEPTH, SSM_GROUPS, SSM_STATE, SSM_CH), (2 * SSM_CH) ** -0.5)
    ssm_c_re = nrm(ks[15], (DEPTH, SSM_GROUPS, SSM_CH, SSM_STATE), 0.5)
    ssm_c_im = nrm(ks[16], (DEPTH, SSM_GROUPS, SSM_CH, SSM_STATE), 0.5)
    ssm_d = nrm(ks[17], (DEPTH, SSM_WIDTH), 1.0)
    ssm_w_glu = nrm(ks[18], (DEPTH, SSM_WIDTH, SSM_WIDTH), SSM_WIDTH ** -0.5)
    diff_lam_q1 = nrm(ks[19], (DEPTH, DIFF_QK_DIM), 0.1)
    diff_lam_k1 = nrm(ks[20], (DEPTH, DIFF_QK_DIM), 0.1)
    diff_lam_q2 = nrm(ks[21], (DEPTH, DIFF_QK_DIM), 0.1)
    diff_lam_k2 = nrm(ks[22], (DEPTH, DIFF_QK_DIM), 0.1)
    diff_subln = 1.0 + nrm(ks[23], (DEPTH, DIFF_V_DIM), 0.01)
    gdn_conv = nrm(ks[24], (DEPTH, CONV_WIDTH, 3 * GDN_WIDTH), CONV_WIDTH ** -0.5)
    gdn_a_log = jnp.log(jax.random.uniform(ks[25], (DEPTH, GDN_HEADS), F32, 1.0, 16.0))
    dt0 = jnp.exp(jax.random.uniform(ks[26], (DEPTH, GDN_HEADS), F32, math.log(1e-3), math.log(1e-1)))
    gdn_dt_bias = dt0 + jnp.log(-jnp.expm1(-dt0))
    gdn_norm = 1.0 + nrm(ks[27], (DEPTH, GDN_HEAD_DIM), 0.01)
    ffn_w1 = nrm(ks[28], (N_DENSE, D_MODEL, D_FF), D_MODEL ** -0.5)
    ffn_w3 = nrm(ks[29], (N_DENSE, D_MODEL, D_FF), D_MODEL ** -0.5)
    ffn_w2 = nrm(ks[30], (N_DENSE, D_FF, D_MODEL), D_FF ** -0.5)
    moe_router = nrm(ks[31], (N_MOE, D_MODEL, N_EXPERTS), D_MODEL ** -0.5)
    moe_w1 = nrm(ks[32], (N_MOE, N_EXPERTS, D_MODEL, D_FF_EXPERT), D_MODEL ** -0.5)
    moe_w3 = nrm(ks[33], (N_MOE, N_EXPERTS, D_MODEL, D_FF_EXPERT), D_MODEL ** -0.5)
    moe_w2 = nrm(ks[34], (N_MOE, N_EXPERTS, D_FF_EXPERT, D_MODEL), D_FF_EXPERT ** -0.5)
    return {'x': x, 'c': c, 'positions': positions, 'w_ada': w_ada, 'b_ada': b_ada,
            'norm_mix': norm_mix, 'norm_ffn': norm_ffn, 'norm_final': norm_final,
            'w_in': w_in, 'w_out': w_out,
            'ssm_a_re': ssm_a_re, 'ssm_a_im': ssm_a_im, 'ssm_log_dt': ssm_log_dt,
            'ssm_b_re': ssm_b_re, 'ssm_b_im': ssm_b_im, 'ssm_c_re': ssm_c_re, 'ssm_c_im': ssm_c_im,
            'ssm_d': ssm_d, 'ssm_w_glu': ssm_w_glu,
            'diff_lam_q1': diff_lam_q1, 'diff_lam_k1': diff_lam_k1,
            'diff_lam_q2': diff_lam_q2, 'diff_lam_k2': diff_lam_k2, 'diff_subln': diff_subln,
            'gdn_conv': gdn_conv, 'gdn_a_log': gdn_a_log, 'gdn_dt_bias': gdn_dt_bias, 'gdn_norm': gdn_norm,
            'ffn_w1': ffn_w1, 'ffn_w3': ffn_w3, 'ffn_w2': ffn_w2,
            'moe_router': moe_router, 'moe_w1': moe_w1, 'moe_w3': moe_w3, 'moe_w2': moe_w2}


def reference(x, c, positions, w_ada, b_ada, norm_mix, norm_ffn, norm_final, w_in, w_out,
              ssm_a_re, ssm_a_im, ssm_log_dt, ssm_b_re, ssm_b_im, ssm_c_re, ssm_c_im, ssm_d, ssm_w_glu,
              diff_lam_q1, diff_lam_k1, diff_lam_q2, diff_lam_k2, diff_subln,
              gdn_conv, gdn_a_log, gdn_dt_bias, gdn_norm,
              ffn_w1, ffn_w3, ffn_w2, moe_router, moe_w1, moe_w3, moe_w2):
    h_res = x.astype(F32)
    cond = jax.nn.silu(c.astype(F32))
    for l in range(DEPTH):
        mod = cond @ w_ada[l].astype(F32) + b_ada[l].astype(F32)
        shift1, scale1, gate1, shift2, scale2, gate2 = jnp.split(mod[:, None, :], 6, axis=-1)
        hn = rmsnorm(h_res, norm_mix[l]) * (1.0 + scale1) + shift1
        mix = hybrid_mixer(hn, positions, l, w_in[l], w_out[l],
                           ssm_a_re[l], ssm_a_im[l], ssm_log_dt[l], ssm_b_re[l], ssm_b_im[l],
                           ssm_c_re[l], ssm_c_im[l], ssm_d[l], ssm_w_glu[l],
                           diff_lam_q1[l], diff_lam_k1[l], diff_lam_q2[l], diff_lam_k2[l], diff_subln[l],
                           gdn_conv[l], gdn_a_log[l], gdn_dt_bias[l], gdn_norm[l])
        h_res = h_res + gate1 * mix
        hn = rmsnorm(h_res, norm_ffn[l]) * (1.0 + scale2) + shift2
        if l % 2 == 0:
            f = swiglu(hn, ffn_w1[l // 2], ffn_w3[l // 2], ffn_w2[l // 2])
        else:
            f = moe_swiglu(hn, moe_router[l // 2], moe_w1[l // 2], moe_w3[l // 2], moe_w2[l // 2])
        h_res = h_res + gate2 * f
    return rmsnorm(h_res, norm_final).astype(x.dtype)
```

```cpp
#include <hip/hip_runtime.h>
#include <hip/hip_bf16.h>
#include <cstdio>
#include <cstdint>
#include <cmath>
namespace pg8 {
#define PG8_LAS __attribute__((address_space(3)))
typedef unsigned short bf16_t;
typedef short bf16x8 __attribute__((ext_vector_type(8)));
typedef float f32x4 __attribute__((ext_vector_type(4)));
typedef unsigned u32x4 __attribute__((ext_vector_type(4)));
constexpr int BM = 256, BK = 64, HALF = 128, HTB = HALF * BK * 2  , STAGE_BYTES = 8 * HTB, NXCD = 8, WGM = 8;

__host__ __device__ __forceinline__ int lds_byte(int r, int c) { const int st = (r >> 4) * 2 + (c >> 5), rr = r & 15, cc = c & 31, ob = rr * 64 + cc * 2; return st * 1024 + (ob ^ (((ob >> 9) & 1) << 5)); }
__host__ __device__ __forceinline__ void stage_rc(int b, int& R, int& C) { const int st = b / 1024, sb = b % 1024, swz = sb ^ (((sb >> 9) & 1) << 5); R = (st >> 1) * 16 + swz / 64; C = (st & 1) * 32 + (swz % 64) / 2; }
__host__ __device__ __forceinline__ int perm32(int rho) { const int n = rho >> 4, i = rho & 15; return 8 * (i >> 2) + 4 * n + (i & 3); }

struct Unit { int pm, pn; };
struct Gemm { const bf16_t* A; const bf16_t* Bt; int M, N, K; };

struct StaticOrder {
    int nM, nN, nwg, G, c;
    __host__ __device__ void init(int M, int N, int G_, int c_) { nM = M / BM; nN = N / BM; nwg = nM * nN; G = G_; c = c_; }
    __host__ __device__ bool next(int i, Unit& u) const {
        const long L = (long)i * G + c; if (L >= nwg) return false;
        int wgid = (int)L; { const int q = nwg / NXCD, r = nwg % NXCD, xcd = wgid % NXCD, off = wgid / NXCD; wgid = (xcd < r ? xcd * (q + 1) : r * (q + 1) + (xcd - r) * q) + off; }
        const int nig = WGM * nN, gid = wgid / nig, fm = gid * WGM, gsz = (nM - fm) < WGM ? (nM - fm) : WGM;
        u.pm = fm + ((wgid % nig) % gsz); u.pn = (wgid % nig) / gsz; return true;
    }
    __device__ __forceinline__ void a_ready(const Unit&) const {}
    __device__ __forceinline__ void done(const Unit&) const {}
};

__device__ __forceinline__ unsigned cvt_pk_bf16(float lo, float hi) { unsigned r; asm volatile("v_cvt_pk_bf16_f32 %0, %1, %2" : "=v"(r) : "v"(lo), "v"(hi)); return r; }
typedef float f32x2 __attribute__((ext_vector_type(2)));
__device__ __forceinline__ f32x2 gelu_pk(f32x2 v) {
    const f32x2 av = __builtin_elementwise_abs(v), d = av * 0.2316418882f + 1.0f;
    f32x2 t; t.x = __builtin_amdgcn_rcpf(d.x); t.y = __builtin_amdgcn_rcpf(d.y);
    f32x2 q = t * 0.5307027145f + (-0.7265760135f); q = q * t + 0.7107068705f; q = q * t + (-0.142248368f); q = q * t + 0.127414796f; q = q * t;
    const f32x2 s = (v * v) * (-0.72134752044f);
    f32x2 e; e.x = __builtin_amdgcn_exp2f(s.x); e.y = __builtin_amdgcn_exp2f(s.y);
    const f32x2 m = v * (q * e), r = v - m;
    f32x2 o; o.x = v.x < 0.f ? m.x : r.x; o.y = v.y < 0.f ? m.y : r.y; return o;
}

template <int ACT  > struct EpiBf16 {
    static constexpr bool PERM = true, AFTER_DRAIN = false; static_assert(ACT == 0 || ACT == 1, "EpiBf16: ACT is 0 (none) or 1 (gelu_pk)");
    bf16_t* O; int ldc; const float* bias; int split_cols; size_t split_stride; float scale0;
    __device__ __forceinline__ void operator()(const f32x4 (&acc)[2][2][4][2], const Unit& u, int wr, int wc, int fr, int fq) const {
        const int row0 = u.pm * BM + wr * 64 + fr; int colt = u.pn * BM; bf16_t* base = O;
        float sc = 1.f; if (split_cols) { const int t = colt / split_cols; base += (size_t)t * split_stride; colt -= t * split_cols; if (t == 0) sc = scale0; }
        const int col0 = colt + wc * 32 + 8 * fq, bcol0 = u.pn * BM + wc * 32 + 8 * fq;
        f32x4 bv[2][2];
#pragma unroll
        for (int bj = 0; bj < 2; ++bj)
#pragma unroll
            for (int n = 0; n < 2; ++n) bv[bj][n] = bias ? *(const f32x4*)(bias + bcol0 + bj * HALF + 4 * n) : (f32x4){0.f, 0.f, 0.f, 0.f};
#pragma unroll
        for (int ai = 0; ai < 2; ++ai)
#pragma unroll
            for (int m = 0; m < 4; ++m) { bf16_t* rowp = base + (size_t)(row0 + ai * HALF + m * 16) * ldc + col0;
#pragma unroll
                for (int bj = 0; bj < 2; ++bj) { f32x4 v0 = acc[ai][bj][m][0] + bv[bj][0], v1 = acc[ai][bj][m][1] + bv[bj][1];
                    if (ACT == 1) { f32x2 a = gelu_pk((f32x2){v0[0], v0[1]}), b = gelu_pk((f32x2){v0[2], v0[3]}), c = gelu_pk((f32x2){v1[0], v1[1]}), d = gelu_pk((f32x2){v1[2], v1[3]});
                        v0 = (f32x4){a.x, a.y, b.x, b.y}; v1 = (f32x4){c.x, c.y, d.x, d.y}; }
                    v0 = v0 * sc; v1 = v1 * sc; u32x4 w; w.x = cvt_pk_bf16(v0[0], v0[1]); w.y = cvt_pk_bf16(v0[2], v0[3]); w.z = cvt_pk_bf16(v1[0], v1[1]); w.w = cvt_pk_bf16(v1[2], v1[3]);
                    *(u32x4*)(rowp + bj * HALF) = w; } }
    }
};

template <class Epi, class Sched, bool ALIGN_EPI = false, bool SP2 = false>
__device__ __forceinline__ void gemm_phase(PG8_LAS unsigned char* lds, const Gemm g, const Sched& S, const Epi& E) {
    const int tid = threadIdx.x, wid = __builtin_amdgcn_readfirstlane(tid >> 6), lane = tid & 63, wr = wid >> 2, wc = wid & 3, fr = lane & 15, fq = lane >> 4;
    const int K = g.K, nt = K / BK;
    unsigned voffA[2], voffB[2];
#pragma unroll
    for (int i = 0; i < 2; ++i) { int R, C; stage_rc(tid * 16 + i * 8192, R, C); const int Rb = Epi::PERM ? ((R & ~31) + perm32(R & 31)) : R;
        voffA[i] = (unsigned)(R * K + C) * 2u; voffB[i] = (unsigned)(Rb * K + C) * 2u; }
    const size_t kstep = (size_t)(BK * 2);
    const size_t hstep = (size_t)HALF * K * 2;
    const size_t tstep = 2 * hstep;
    const unsigned ldsw = (unsigned)wid * 1024u;
    const int aoff = lds_byte(wr * 64 + fr, fq * 8), boff = lds_byte(wc * 32 + fr, fq * 8);
#define PG8_SA(b, h) (((b) * 2 + (h)) * HTB)
#define PG8_SB(b, h) ((4 + (b) * 2 + (h)) * HTB)
#define PG8_STAGE(bufoff, gbase, voff) do { _Pragma("unroll") for (int _i = 0; _i < 2; ++_i) \
        __builtin_amdgcn_global_load_lds((const unsigned*)((const char*)(gbase) + (voff)[_i]), (PG8_LAS unsigned*)(lds + (bufoff) + ldsw + _i * 8192), 16, 0, 0); } while (0)
#define PG8_LDA(dst, b, h) do { _Pragma("unroll") for (int m = 0; m < 4; ++m) _Pragma("unroll") for (int k = 0; k < 2; ++k) dst[m][k] = *(const PG8_LAS bf16x8*)(lds + PG8_SA(b, h) + aoff + m * 2048 + k * 1024); } while (0)
#define PG8_LDB(dst, b, h) do { _Pragma("unroll") for (int n = 0; n < 2; ++n) _Pragma("unroll") for (int k = 0; k < 2; ++k) dst[n][k] = *(const PG8_LAS bf16x8*)(lds + PG8_SB(b, h) + boff + n * 2048 + k * 1024); } while (0)
#define PG8_MMA(ai, bj, At, Bt) do { __builtin_amdgcn_s_setprio(1); _Pragma("unroll") for (int m = 0; m < 4; ++m) _Pragma("unroll") for (int n = 0; n < 2; ++n) _Pragma("unroll") for (int k = 0; k < 2; ++k) \
        acc[ai][bj][m][n] = __builtin_amdgcn_mfma_f32_16x16x32_bf16(Bt[n][k], At[m][k], acc[ai][bj][m][n], 0, 0, 0); __builtin_amdgcn_s_setprio(0); } while (0)
#define PG8_WAIT_V(n) asm volatile("s_waitcnt vmcnt(" #n ")" ::: "memory")
#define PG8_WAIT_L(n) asm volatile("s_waitcnt lgkmcnt(" #n ")" ::: "memory")
#define PG8_BAR __builtin_amdgcn_s_barrier()
#define PG8_SCHED __builtin_amdgcn_sched_barrier(0)
    Unit cur, nxt; int ui = 0;
    if (!S.next(0, cur)) return;
    f32x4 acc[2][2][4][2];
#pragma unroll
    for (int a = 0; a < 2; ++a)
#pragma unroll
        for (int b = 0; b < 2; ++b)
#pragma unroll
            for (int m = 0; m < 4; ++m)
#pragma unroll
                for (int n = 0; n < 2; ++n) acc[a][b][m][n] = (f32x4){0.f, 0.f, 0.f, 0.f};
    bf16x8 At[4][2], B0[2][2], B1[2][2];
    const char* cA = (const char*)g.A + (size_t)cur.pm * tstep; const char* cB = (const char*)g.Bt + (size_t)cur.pn * tstep;
    S.a_ready(cur);
    if constexpr (SP2) {
        PG8_STAGE(PG8_SB(0, 0), cB, voffB); PG8_STAGE(PG8_SB(0, 1), cB + hstep, voffB); PG8_STAGE(PG8_SA(0, 0), cA, voffA); PG8_STAGE(PG8_SA(0, 1), cA + hstep, voffA);
        if (wr == 1) PG8_BAR;
        PG8_WAIT_V(2); PG8_BAR;
        PG8_STAGE(PG8_SB(1, 0), cB + kstep, voffB); PG8_STAGE(PG8_SA(1, 0), cA + kstep, voffA); PG8_STAGE(PG8_SB(1, 1), cB + hstep + kstep, voffB);
        PG8_WAIT_V(6); PG8_BAR;
    } else {
        PG8_STAGE(PG8_SB(0, 0), cB, voffB); PG8_STAGE(PG8_SA(0, 0), cA, voffA); PG8_STAGE(PG8_SB(0, 1), cB + hstep, voffB); PG8_STAGE(PG8_SA(0, 1), cA + hstep, voffA);
        if (wr == 1) PG8_BAR;
        PG8_WAIT_V(4); PG8_BAR;
        PG8_STAGE(PG8_SB(1, 0), cB + kstep, voffB); PG8_STAGE(PG8_SA(1, 0), cA + kstep, voffA); PG8_STAGE(PG8_SB(1, 1), cB + hstep + kstep, voffB);
        PG8_WAIT_V(6); PG8_BAR;
    }
    for (;;) {
        const bool has_next = S.next(ui + 1, nxt);
        const char* nA = has_next ? (const char*)g.A + (size_t)nxt.pm * tstep : cA; const char* nB = has_next ? (const char*)g.Bt + (size_t)nxt.pn * tstep : cB;
        for (int t = 0; t < nt; t += 2) {
            const bool last = (t == nt - 2);
            const char* a1 = cA + (size_t)(t + 1) * kstep;
            const char* a2 = last ? nA : cA + (size_t)(t + 2) * kstep; const char* b2 = last ? nB : cB + (size_t)(t + 2) * kstep;
            const char* a3 = a2 + kstep; const char* b3 = b2 + kstep;
            if (last && has_next) S.a_ready(nxt);
            if constexpr (SP2) {
            PG8_LDB(B0, 0, 0); PG8_LDB(B1, 0, 1); PG8_SCHED; PG8_LDA(At, 0, 0); PG8_STAGE(PG8_SA(1, 1), a1 + hstep, voffA);
            PG8_WAIT_V(8); PG8_WAIT_L(0); PG8_BAR; PG8_MMA(0, 0, At, B0); PG8_MMA(0, 1, At, B1); PG8_BAR; PG8_SCHED;
            PG8_LDA(At, 0, 1); PG8_STAGE(PG8_SB(0, 0), b2, voffB); PG8_STAGE(PG8_SB(0, 1), b2 + hstep, voffB); PG8_STAGE(PG8_SA(0, 0), a2, voffA);
            PG8_WAIT_V(8); PG8_WAIT_L(0); PG8_BAR; PG8_MMA(1, 0, At, B0); PG8_MMA(1, 1, At, B1); PG8_BAR; PG8_SCHED;
            PG8_LDB(B0, 1, 0); PG8_LDB(B1, 1, 1); PG8_SCHED; PG8_LDA(At, 1, 0); PG8_STAGE(PG8_SA(0, 1), a2 + hstep, voffA);
            PG8_WAIT_V(8); PG8_WAIT_L(0); PG8_BAR; PG8_MMA(0, 0, At, B0); PG8_MMA(0, 1, At, B1); PG8_BAR; PG8_SCHED;
            PG8_LDA(At, 1, 1); PG8_STAGE(PG8_SB(1, 0), b3, voffB); PG8_STAGE(PG8_SB(1, 1), b3 + hstep, voffB); PG8_STAGE(PG8_SA(1, 0), a3, voffA);
            PG8_WAIT_V(8); PG8_WAIT_L(0); PG8_BAR; PG8_MMA(1, 0, At, B0); PG8_MMA(1, 1, At, B1); PG8_BAR; PG8_SCHED;
            } else {
            PG8_LDB(B0, 0, 0); PG8_SCHED; PG8_LDA(At, 0, 0); PG8_STAGE(PG8_SA(1, 1), a1 + hstep, voffA);
            PG8_WAIT_L(8); PG8_BAR; PG8_WAIT_L(0); PG8_MMA(0, 0, At, B0); PG8_BAR; PG8_SCHED;
            PG8_LDB(B1, 0, 1); PG8_STAGE(PG8_SB(0, 0), b2, voffB);
            PG8_BAR; PG8_WAIT_L(0); PG8_MMA(0, 1, At, B1); PG8_BAR;
            PG8_LDA(At, 0, 1); PG8_STAGE(PG8_SA(0, 0), a2, voffA);
            PG8_BAR; PG8_WAIT_L(0); PG8_MMA(1, 0, At, B0); PG8_BAR; PG8_SCHED;
            PG8_STAGE(PG8_SB(0, 1), b2 + hstep, voffB);
            PG8_WAIT_V(6); PG8_BAR; PG8_MMA(1, 1, At, B1); PG8_BAR;
            PG8_LDB(B0, 1, 0); PG8_SCHED; PG8_LDA(At, 1, 0); PG8_STAGE(PG8_SA(0, 1), a2 + hstep, voffA);
            PG8_WAIT_L(8); PG8_BAR; PG8_WAIT_L(0); PG8_MMA(0, 0, At, B0); PG8_BAR; PG8_SCHED;
            PG8_LDB(B1, 1, 1); PG8_STAGE(PG8_SB(1, 0), b3, voffB);
            PG8_BAR; PG8_WAIT_L(0); PG8_MMA(0, 1, At, B1); PG8_BAR;
            PG8_LDA(At, 1, 1); PG8_STAGE(PG8_SA(1, 0), a3, voffA);
            PG8_BAR; PG8_WAIT_L(0); PG8_MMA(1, 0, At, B0); PG8_BAR; PG8_SCHED;
            PG8_STAGE(PG8_SB(1, 1), b3 + hstep, voffB);
            PG8_WAIT_V(6); PG8_BAR; PG8_MMA(1, 1, At, B1); PG8_BAR;
            }
        }
        if constexpr (ALIGN_EPI) { if (wr == 0) PG8_BAR; }
        if constexpr (!Epi::AFTER_DRAIN) { E(acc, cur, wr, wc, fr, fq); S.done(cur); }
        if (!has_next) break;
#pragma unroll
        for (int a = 0; a < 2; ++a)
#pragma unroll
            for (int b = 0; b < 2; ++b)
#pragma unroll
                for (int m = 0; m < 4; ++m)
#pragma unroll
                    for (int n = 0; n < 2; ++n) acc[a][b][m][n] = (f32x4){0.f, 0.f, 0.f, 0.f};
        cur = nxt; cA = nA; cB = nB; ++ui;
        if constexpr (ALIGN_EPI) { if (wr == 1) PG8_BAR; }
    }
    PG8_WAIT_V(0);
    if constexpr (!ALIGN_EPI) { if (wr == 0) PG8_BAR; }
    PG8_BAR;
    if constexpr (Epi::AFTER_DRAIN) { E.fused(acc, cur, wr, wc, fr, fq, lds, wid, lane); S.done(cur); }
#undef PG8_SA
#undef PG8_SB
#undef PG8_STAGE
#undef PG8_LDA
#undef PG8_LDB
#undef PG8_MMA
#undef PG8_WAIT_V
#undef PG8_WAIT_L
#undef PG8_BAR
#undef PG8_SCHED
}
}
#include <hip/hip_bf16.h>
#include <cmath>
namespace attn_body {
using bf16=__hip_bfloat16;
using bf16x8=__attribute__((ext_vector_type(8)))short;
using s16x4=__attribute__((ext_vector_type(4)))short;
using f32x16=__attribute__((ext_vector_type(16)))float;
using u32x4=__attribute__((ext_vector_type(4)))unsigned;
constexpr int SEQ=4096,D=64,PITCH=5888,OPITCH=1536;
constexpr int NW=8,QBLK=32,QB=QBLK*NW,KVBLK=64,NQB=SEQ/QB;
constexpr int ATTN_UNIT_ROWS=QB;
__device__ __forceinline__ int crow(int r,int hi){return (r&3)+8*(r>>2)+4*hi;}
#define SBAR() __builtin_amdgcn_sched_barrier(0)
__device__ __forceinline__ void cmask(f32x16&p0,f32x16&p1,int jb,int qrel,int hi){
  const float NEG=-INFINITY; int kb=64*jb+4*hi;
  #pragma unroll
  for(int r=0;r<16;++r){int kv=kb+(r&3)+8*(r>>2); if(kv>qrel)p0[r]=NEG; if(kv+32>qrel)p1[r]=NEG;}
}

constexpr int NSLOT=3, SLOTB=8192;
constexpr int LDS_K=0, LDS_V=NSLOT*SLOTB, LDS_WS=2*NSLOT*SLOTB, LDS_OST=LDS_WS+NW*64*4, LDS_BYTES=LDS_OST+NW*4096;
constexpr float C2=0.125f*1.4426950408889634f;
__device__ __forceinline__ void glds16(const void*gsrc,unsigned lds_dst){unsigned keep;
  asm volatile("s_mov_b32 %0, m0\n\ts_mov_b32 m0, %2\n\ts_nop 0\n\tglobal_load_lds_dwordx4 %1, off\n\ts_mov_b32 m0, %0":"=&s"(keep):"v"(gsrc),"s"(lds_dst):"memory");}
__device__ __forceinline__ float max3f(float a,float b,float c){float r;asm("v_max3_f32 %0, %1, %2, %3":"=v"(r):"v"(a),"v"(b),"v"(c));return r;}
__device__ __forceinline__ float max2f(float a,float b){float r;asm("v_max_f32_e32 %0, %1, %2":"=v"(r):"v"(a),"v"(b));return r;}
__device__ __forceinline__ float fadd_s(float a,float b){float r;asm("v_add_f32_e32 %0, %1, %2":"=v"(r):"v"(a),"v"(b));return r;}
__device__ __forceinline__ float fsub_s(float a,float b){float r;asm("v_sub_f32_e32 %0, %1, %2":"=v"(r):"v"(a),"v"(b));return r;}
typedef float f32x2_t __attribute__((ext_vector_type(2))); typedef __bf16 bf16x2_t __attribute__((ext_vector_type(2)));
__device__ __forceinline__ unsigned cvtpk_s(float lo,float hi){f32x2_t v={lo,hi};bf16x2_t b=__builtin_convertvector(v,bf16x2_t);return __builtin_bit_cast(unsigned,b);}
#define WAIT_BAR(N) asm volatile("s_waitcnt vmcnt(" #N ") lgkmcnt(0)\n\ts_barrier":::"memory")

__device__ __forceinline__ void qkt(f32x16&p0,f32x16&p1,const char*Kslot,const bf16x8*qr,const f32x16&negm,int r32,int hi){
  const char*kb=Kslot+hi*1024+r32*16;
  #pragma unroll
  for(int d0=0;d0<4;++d0){
    const bf16x8 b0=*reinterpret_cast<const bf16x8*>(kb+d0*2048);
    const bf16x8 b1=*reinterpret_cast<const bf16x8*>(kb+d0*2048+512);
    if(d0==0){p0=__builtin_amdgcn_mfma_f32_32x32x16_bf16(b0,qr[0],negm,0,0,0);p1=__builtin_amdgcn_mfma_f32_32x32x16_bf16(b1,qr[0],negm,0,0,0);}
    else{p0=__builtin_amdgcn_mfma_f32_32x32x16_bf16(b0,qr[d0],p0,0,0,0);p1=__builtin_amdgcn_mfma_f32_32x32x16_bf16(b1,qr[d0],p1,0,0,0);}}
}
typedef __attribute__((address_space(3))) const char* lds_cptr;
typedef short v4i16_t __attribute__((ext_vector_type(4)));
__device__ __forceinline__ void kload8(bf16x8*kf,lds_cptr kp){
  kf[0]=*(const __attribute__((address_space(3))) bf16x8*)(kp);      kf[1]=*(const __attribute__((address_space(3))) bf16x8*)(kp+512);
  kf[2]=*(const __attribute__((address_space(3))) bf16x8*)(kp+2048); kf[3]=*(const __attribute__((address_space(3))) bf16x8*)(kp+2560);
  kf[4]=*(const __attribute__((address_space(3))) bf16x8*)(kp+4096); kf[5]=*(const __attribute__((address_space(3))) bf16x8*)(kp+4608);
  kf[6]=*(const __attribute__((address_space(3))) bf16x8*)(kp+6144); kf[7]=*(const __attribute__((address_space(3))) bf16x8*)(kp+6656);
}
__device__ __forceinline__ void kload2(bf16x8*kf,lds_cptr kp,int j){ kf[2*j]=*(const __attribute__((address_space(3))) bf16x8*)(kp+j*2048); kf[2*j+1]=*(const __attribute__((address_space(3))) bf16x8*)(kp+j*2048+512); }
__device__ __forceinline__ s16x4 vtr(lds_cptr p){ return __builtin_bit_cast(s16x4,__builtin_amdgcn_ds_read_tr16_b64_v4i16((__attribute__((address_space(3))) v4i16_t*)p)); }
__device__ __forceinline__ float rowmax(const f32x16&p0,const f32x16&p1){
  float a=max3f(p0[0],p0[1],p1[0]),b=max3f(p0[2],p0[3],p1[1]);a=max3f(a,p1[2],p1[3]);
  #pragma unroll
  for(int r=4;r<16;r+=4){a=max3f(a,p0[r],p0[r+1]);b=max3f(b,p0[r+2],p0[r+3]);a=max3f(a,p1[r],p1[r+1]);b=max3f(b,p1[r+2],p1[r+3]);}
  const float m=max2f(a,b);
  auto rr=__builtin_amdgcn_permlane32_swap(__float_as_uint(m),__float_as_uint(m),false,false);
  return max2f(__uint_as_float(rr[0]),__uint_as_float(rr[1]));
}
__device__ __forceinline__ void pv(f32x16*o,int vb,bf16x8 pa0,bf16x8 pa1,bf16x8 pa2,bf16x8 pa3){
  #pragma unroll
  for(int d0=0;d0<2;++d0){s16x4 lo[4],hi[4];
    #pragma unroll
    for(int ks=0;ks<4;++ks){
      asm volatile("ds_read_b64_tr_b16 %0,%1 offset:%c2":"=&v"(lo[ks]):"v"(vb),"i"(d0*4096+ks*1024):"memory");
      asm volatile("ds_read_b64_tr_b16 %0,%1 offset:%c2":"=&v"(hi[ks]):"v"(vb),"i"(d0*4096+ks*1024+512):"memory");}
    asm volatile("s_waitcnt lgkmcnt(0)":::"memory");SBAR();
    #define PK(k) (bf16x8){lo[k][0],lo[k][1],lo[k][2],lo[k][3],hi[k][0],hi[k][1],hi[k][2],hi[k][3]}
    o[d0]=__builtin_amdgcn_mfma_f32_32x32x16_bf16(pa0,PK(0),o[d0],0,0,0);
    o[d0]=__builtin_amdgcn_mfma_f32_32x32x16_bf16(pa1,PK(1),o[d0],0,0,0);
    o[d0]=__builtin_amdgcn_mfma_f32_32x32x16_bf16(pa2,PK(2),o[d0],0,0,0);
    o[d0]=__builtin_amdgcn_mfma_f32_32x32x16_bf16(pa3,PK(3),o[d0],0,0,0);
    #undef PK
  }
}

#ifndef ATTN_STORE16
#define ATTN_STORE16(p,v) (*(u32x4*)(p)=(v))
#endif
template<int THRL> __device__ __forceinline__ void attn_unit(int qb,const bf16*Qh,const bf16*__restrict__ Kh,const bf16*__restrict__ Vh,bf16*Oh,char*shm){
  const int tid=threadIdx.x,lane=tid&63,r32=lane&31,hi=lane>>5; const int wid=__builtin_amdgcn_readfirstlane(tid>>6);
  const int q0=qb*QB;
  const bf16*Qw=Qh+(long)(q0+wid*QBLK)*PITCH;
  const unsigned lds0=(unsigned)(uintptr_t)shm;
  float*wsf=(float*)(shm+LDS_WS)+wid*64;
  const bf16*ksrc=Kh+(long)lane*PITCH+wid*8;
  const bf16*vsrc=Vh+(long)(16*(wid&3)+(lane>>2))*PITCH+(wid>>2)*32+(lane&3)*8;
  const unsigned kdst=lds0+LDS_K+wid*1024, vdst=lds0+LDS_V+wid*1024;
  #define DMA_K(t,slot) glds16(ksrc+(long)(t)*KVBLK*PITCH,(unsigned)__builtin_amdgcn_readfirstlane(kdst+(slot)))
  #define DMA_V(t,slot) glds16(vsrc+(long)(t)*KVBLK*PITCH,(unsigned)__builtin_amdgcn_readfirstlane(vdst+(slot)))
  const int vb0=(int)(lds0+LDS_V)+((lane>>4)&1)*32+(lane&3)*8+(4*hi+((lane&15)>>2))*64;
  const char*Kbase=shm+LDS_K; bf16x8 kf[8];
  const lds_cptr shm3=(lds_cptr)shm; const lds_cptr kp0=shm3+LDS_K+hi*1024+r32*16; const lds_cptr vp0=shm3+LDS_V+((lane>>4)&1)*32+(lane&3)*8+(4*hi+((lane&15)>>2))*64;
  const int NT=(q0+QB)/KVBLK;
  DMA_K(0,0);DMA_V(0,0);DMA_K(1,SLOTB);
  bf16x8 qr[4];
  #pragma unroll
  for(int d0=0;d0<4;++d0)qr[d0]=*reinterpret_cast<const bf16x8*>(&Qw[(long)r32*PITCH+d0*16+hi*8]);
  float mhat=0.f,l_reg=0.f;f32x16 o[2];o[0]=f32x16{};o[1]=f32x16{};f32x16 negm=f32x16{};asm volatile("":"+v"(negm));
  const int qrel=wid*QBLK+r32;
  #define CMASK(P0,P1,t) do{int jb_=(t)-(NT-4); if(jb_>=0)cmask(P0,P1,jb_,qrel,hi);}while(0)
  bool resc=false;
  #define START(P0,P1) do{ const float rm=rowmax(P0,P1); resc=false; \
    { const float dl=rm; mhat=fadd_s(mhat,dl); \
      _Pragma("unroll") for(int r=0;r<16;++r){P0[r]=fsub_s(P0[r],dl);P1[r]=fsub_s(P1[r],dl);} \
      _Pragma("unroll") for(int r=0;r<16;++r)negm[r]=-mhat; asm volatile("":"+v"(negm)); } \
    _Pragma("unroll") for(int r=0;r<16;++r)P0[r]=__builtin_amdgcn_exp2f(P0[r]); }while(0)
  #define RESC() do{ if(resc){ asm volatile("s_waitcnt lgkmcnt(0)":::"memory"); \
      _Pragma("unroll") for(int d_=0;d_<2;++d_) _Pragma("unroll") for(int r=0;r<16;++r)o[d_][r]*=wsf[crow(r,hi)]; } }while(0)
  f32x16 pA0,pA1,pB0,pB1;
  int sl_prev=0,sl_cur=0,sl_next=SLOTB;
  #define ROT() do{sl_prev=sl_cur;sl_cur=sl_next;sl_next=(sl_next==(NSLOT-1)*SLOTB)?0:sl_next+SLOTB;}while(0)
  DMA_K(2,2*SLOTB);
  WAIT_BAR(3);
  qkt(pA0,pA1,Kbase,qr,negm,r32,hi);asm volatile("s_nop 15\n\ts_nop 7":"+v"(pA0),"+v"(pA1));CMASK(pA0,pA1,0);
  START(pA0,pA1);
  _Pragma("unroll") for(int r=0;r<16;++r)pA1[r]=__builtin_amdgcn_exp2f(pA1[r]);
  WAIT_BAR(0);
  DMA_K(3,0);DMA_V(1,SLOTB);
  ROT();
  kload8(kf,kp0+sl_cur);
  WAIT_BAR(2);
  s16x4 vlo[8],vhi[8]; u32x4 pw0,pw1,pw2,pw3;
  #define PKW(P,B) cvtpk_s(P[B],P[B+1])
  #define PAF(k) __builtin_bit_cast(bf16x8,pw##k)
  #define VFR(i) (bf16x8){vlo[i][0],vlo[i][1],vlo[i][2],vlo[i][3],vhi[i][0],vhi[i][1],vhi[i][2],vhi[i][3]}
  #define PIN(x) asm volatile("":"+v"(x))
  #define MX3(a,b,c) __builtin_fmaxf(__builtin_fmaxf((a),(b)),(c))
  #define GAPA(MF,A0,A1,A2,A3,W0,W1,PW) do{ MF; sacc+=A0; sacc+=A1; sacc+=A2; sacc+=A3; PIN(sacc); W0; W1; PIN(PW); SBAR(); }while(0)
  #define EX(v) __builtin_amdgcn_exp2f(v)
  #define GAPB(MF,X,B) do{ MF; X[B]=EX(X[B]); X[B+1]=EX(X[B+1]); X[B+2]=EX(X[B+2]); X[B+3]=EX(X[B+3]); PIN(X); SBAR(); }while(0)
  #define VRD(i) do{ vlo[i]=vtr(vp_+(((i)>>2)*4096+((i)&3)*1024)); vhi[i]=vtr(vp_+(((i)>>2)*4096+((i)&3)*1024+512)); }while(0)
  #define KRD(G,j) do{ if(G){ kload2(kf,kp0+sl_next,j); SBAR(); } }while(0)
  #define STEP(C0,C1,P0,P1,t,GK,GV,GL) do{ SBAR(); \
    const lds_cptr vp_=vp0+sl_prev; \
    VRD(0); SBAR(); float sacc=(P0[0]+P0[1]); \
    GAPA(C0=__builtin_amdgcn_mfma_f32_32x32x16_bf16(kf[0],qr[0],negm,0,0,0), P0[2],P0[3],P0[4],P0[5],     pw0[0]=PKW(P0,0), pw0[1]=PKW(P0,2), pw0); \
    VRD(4); SBAR(); GAPA(C1=__builtin_amdgcn_mfma_f32_32x32x16_bf16(kf[1],qr[0],negm,0,0,0), P0[6],P0[7],P0[8],P0[9],     pw0[2]=PKW(P0,4), pw0[3]=PKW(P0,6), pw0); \
    VRD(1); SBAR(); GAPA(C0=__builtin_amdgcn_mfma_f32_32x32x16_bf16(kf[2],qr[1],C0,0,0,0),   P0[10],P0[11],P0[12],P0[13], pw1[0]=PKW(P0,8), pw1[1]=PKW(P0,10), pw1); \
    VRD(5); SBAR(); GAPA(C1=__builtin_amdgcn_mfma_f32_32x32x16_bf16(kf[3],qr[1],C1,0,0,0),   P0[14],P0[15],P1[0],P1[1],   pw1[2]=PKW(P0,12),pw1[3]=PKW(P0,14), pw1); \
    VRD(2); SBAR(); GAPA(C0=__builtin_amdgcn_mfma_f32_32x32x16_bf16(kf[4],qr[2],C0,0,0,0),   P1[2],P1[3],P1[4],P1[5],     pw2[0]=PKW(P1,0), pw2[1]=PKW(P1,2), pw2); \
    VRD(6); SBAR(); GAPA(C1=__builtin_amdgcn_mfma_f32_32x32x16_bf16(kf[5],qr[2],C1,0,0,0),   P1[6],P1[7],P1[8],P1[9],     pw2[2]=PKW(P1,4), pw2[3]=PKW(P1,6), pw2); \
    VRD(3); SBAR(); GAPA(C0=__builtin_amdgcn_mfma_f32_32x32x16_bf16(kf[6],qr[3],C0,0,0,0),   P1[10],P1[11],P1[12],P1[13], pw3[0]=PKW(P1,8), pw3[1]=PKW(P1,10), pw3); \
    VRD(7); SBAR(); GAPA(C1=__builtin_amdgcn_mfma_f32_32x32x16_bf16(kf[7],qr[3],C1,0,0,0),   P1[14],P1[15],0.f,0.f,       pw3[2]=PKW(P1,12),pw3[3]=PKW(P1,14), pw3); \
    l_reg+=sacc; \
    if(GK){DMA_K((t)+3,sl_cur);} if(GV){DMA_V((t)+1,sl_next);} \
    CMASK(C0,C1,t); \
    { float a=MX3(C0[0],C0[1],C1[0]),b=MX3(C0[2],C0[3],C1[1]); a=MX3(a,C1[2],C1[3]); \
      _Pragma("unroll") for(int r=4;r<16;r+=4){a=MX3(a,C0[r],C0[r+1]);b=MX3(b,C0[r+2],C0[r+3]);a=MX3(a,C1[r],C1[r+1]);b=MX3(b,C1[r+2],C1[r+3]);} \
      float rm=__builtin_fmaxf(a,b); { auto rr=__builtin_amdgcn_permlane32_swap(__float_as_uint(rm),__float_as_uint(rm),false,false); rm=__builtin_fmaxf(__uint_as_float(rr[0]),__uint_as_float(rr[1])); } \
      resc=false; \
      if(__builtin_expect(__any(rm>(float)THRL),0)){ const float dl=__builtin_fmaxf(rm,0.f); mhat+=dl; \
        _Pragma("unroll") for(int r=0;r<16;++r){C0[r]-=dl;C1[r]-=dl;} \
        _Pragma("unroll") for(int r=0;r<16;++r)negm[r]=-mhat; asm volatile("":"+v"(negm)); \
        const float f=__builtin_amdgcn_exp2f(-dl); l_reg*=f; if(hi==0)wsf[r32]=f; resc=true; } } \
    SBAR(); \
    GAPB(o[0]=__builtin_amdgcn_mfma_f32_32x32x16_bf16(PAF(0),VFR(0),o[0],0,0,0), C0,0); \
    GAPB(o[1]=__builtin_amdgcn_mfma_f32_32x32x16_bf16(PAF(0),VFR(4),o[1],0,0,0), C0,4); \
    KRD(GL,0); GAPB(o[0]=__builtin_amdgcn_mfma_f32_32x32x16_bf16(PAF(1),VFR(1),o[0],0,0,0), C0,8); \
    KRD(GL,1); GAPB(o[1]=__builtin_amdgcn_mfma_f32_32x32x16_bf16(PAF(1),VFR(5),o[1],0,0,0), C0,12); \
    KRD(GL,2); GAPB(o[0]=__builtin_amdgcn_mfma_f32_32x32x16_bf16(PAF(2),VFR(2),o[0],0,0,0), C1,0); \
    KRD(GL,3); GAPB(o[1]=__builtin_amdgcn_mfma_f32_32x32x16_bf16(PAF(2),VFR(6),o[1],0,0,0), C1,4); \
    GAPB(o[0]=__builtin_amdgcn_mfma_f32_32x32x16_bf16(PAF(3),VFR(3),o[0],0,0,0), C1,8); \
    GAPB(o[1]=__builtin_amdgcn_mfma_f32_32x32x16_bf16(PAF(3),VFR(7),o[1],0,0,0), C1,12); \
    }while(0)
  int t=1;
  #undef CMASK
  #define CMASK(P0,P1,t) do{}while(0)
  for(;t+5<NT;t+=2){
    STEP(pB0,pB1,pA0,pA1,t,true,true,true);     WAIT_BAR(2); RESC(); ROT();
    STEP(pA0,pA1,pB0,pB1,t+1,true,true,true);   WAIT_BAR(2); RESC(); ROT();
  }
  #undef CMASK
  #define CMASK(P0,P1,t) do{int jb_=(t)-(NT-4); if(jb_>=0)cmask(P0,P1,jb_,qrel,hi);}while(0)
  #define ENDW(tt) do{ if((tt)+3<NT){WAIT_BAR(2);} else if((tt)+2<NT){WAIT_BAR(1);} else {WAIT_BAR(0);} }while(0)
  for(;t+1<NT;t+=2){
    STEP(pB0,pB1,pA0,pA1,t,(t+3<NT),(t+1<NT),(t+1<NT));       ENDW(t);   RESC(); ROT();
    STEP(pA0,pA1,pB0,pB1,t+1,(t+4<NT),(t+2<NT),(t+2<NT));     ENDW(t+1); RESC(); ROT();
  }
  STEP(pB0,pB1,pA0,pA1,NT-1,false,false,false); RESC();
  { float sacc=pB0[0]+pB0[1]; _Pragma("unroll") for(int r=2;r<16;++r)sacc+=pB0[r]; _Pragma("unroll") for(int r=0;r<16;++r)sacc+=pB1[r]; l_reg+=sacc;
    pw0=(u32x4){PKW(pB0,0),PKW(pB0,2),PKW(pB0,4),PKW(pB0,6)};pw1=(u32x4){PKW(pB0,8),PKW(pB0,10),PKW(pB0,12),PKW(pB0,14)};pw2=(u32x4){PKW(pB1,0),PKW(pB1,2),PKW(pB1,4),PKW(pB1,6)};pw3=(u32x4){PKW(pB1,8),PKW(pB1,10),PKW(pB1,12),PKW(pB1,14)};
    SBAR(); pv(o,vb0+sl_cur,PAF(0),PAF(1),PAF(2),PAF(3)); }
  #undef PKW
  #undef PAF
  #undef VFR
  #undef PIN
  #undef MX3
  #undef GAPA
  #undef GAPB
  #undef EX
  #undef VRD
  #undef KRD
  #undef STEP
  #undef ENDW
  {auto rr=__builtin_amdgcn_permlane32_swap(__float_as_uint(l_reg),__float_as_uint(l_reg),false,false);l_reg=__uint_as_float(rr[0])+__uint_as_float(rr[1]);}
  if(hi==0)wsf[32+r32]=l_reg;asm volatile("s_waitcnt lgkmcnt(0)":::"memory");
  float rli[16];
  #pragma unroll
  for(int r=0;r<16;++r)rli[r]=__builtin_amdgcn_rcpf(wsf[32+crow(r,hi)]);
  bf16*Ow=Oh+(long)(q0+wid*QBLK)*OPITCH;
  { bf16*stg=(bf16*)(shm+LDS_OST)+wid*2048;
    #pragma unroll
    for(int r=0;r<16;++r){const int orow=crow(r,hi);
      #pragma unroll
      for(int d0=0;d0<2;++d0)stg[orow*64+d0*32+r32]=__float2bfloat16(o[d0][r]*rli[r]);}
    asm volatile("s_waitcnt lgkmcnt(0)":::"memory");
    #pragma unroll
    for(int i=0;i<4;++i){const int row=i*8+(lane>>3),ch=lane&7; const u32x4 v=*(const u32x4*)(stg+row*64+ch*8); ATTN_STORE16(Ow+(long)row*OPITCH+ch*8,v);} }
  asm volatile("s_waitcnt lgkmcnt(0)\n\ts_barrier":::"memory");
  #undef DMA_K
  #undef DMA_V
  #undef CMASK
  #undef START
  #undef RESC
  #undef ROT
}
constexpr int ATTN_LDS_BYTES=LDS_BYTES;
#undef SBAR
#undef WAIT_BAR
}
#define GAS __attribute__((address_space(1)))
#define LAS __attribute__((address_space(3)))
typedef unsigned short bf16;
typedef unsigned v4u __attribute__((ext_vector_type(4)));
typedef float f32x4 __attribute__((ext_vector_type(4)));
typedef short bf16x8 __attribute__((ext_vector_type(8)));
typedef GAS unsigned gu32;
typedef GAS unsigned long long gu64;
#define RLX_AGENT __ATOMIC_RELAXED, __HIP_MEMORY_SCOPE_AGENT
#define LDS_WAIT() asm volatile("s_waitcnt lgkmcnt(0)" ::: "memory")
#define VM_WAIT() asm volatile("s_waitcnt vmcnt(0)" ::: "memory")
__device__ __forceinline__ unsigned long long rt() { return __builtin_amdgcn_s_memrealtime(); }
__device__ __forceinline__ unsigned f2bf(float f) { unsigned u = __builtin_bit_cast(unsigned, f); return (u + 0x7fffu + ((u >> 16) & 1u)) >> 16; }
__device__ __forceinline__ unsigned pk2(float lo, float hi) { return f2bf(lo) | (f2bf(hi) << 16); }

#define XB_TMO      128
#define XB_XCNT(j)  (256  + 64 * (j))
#define XB_XSUB(j)  (1280 + 64 * (j))
#define XB_XGEN(j)  (2304 + 64 * (j))
#define XB_TOP      3328
#define XB_TOPGEN   3392
#define XCD_BAR_WORDS 3456
#define XB_SPIN_CAP (1u << 18)

__device__ __forceinline__ unsigned xb_ld(unsigned* p)              { return __hip_atomic_load(p, __ATOMIC_RELAXED, __HIP_MEMORY_SCOPE_AGENT); }
__device__ __forceinline__ unsigned xb_add(unsigned* p, unsigned v) { return __hip_atomic_fetch_add(p, v, __ATOMIC_RELAXED, __HIP_MEMORY_SCOPE_AGENT); }
__device__ __forceinline__ unsigned xb_xcc_id() { return (unsigned)__builtin_amdgcn_s_getreg((3 << 11) | 20) & 0xFu; }
#define XB_SPIN(cond, bar) do { unsigned _sp = 0; while (cond) { __builtin_amdgcn_s_sleep(1); \
    if ((++_sp & 255u) == 0u) { if (xb_ld(&(bar)[XB_TMO])) break; if (_sp > XB_SPIN_CAP) { atomicAdd(&(bar)[XB_TMO], 1u); break; } } } } while (0)

struct XcdBarrier {
    unsigned* bar; unsigned x;
    volatile LAS unsigned* st;
};

__device__ __forceinline__ XcdBarrier xcd_barrier_post(unsigned* bar, volatile LAS unsigned* st) {
    XcdBarrier b; b.bar = bar; b.x = xb_xcc_id(); b.st = st;
    if (threadIdx.x == 0) (void)xb_add(&bar[XB_XCNT(b.x)], 1u);
    return b;
}
__device__ __forceinline__ void xcd_barrier_complete(unsigned* bar, unsigned x, unsigned& nloc, unsigned& nx) {
    const unsigned G = gridDim.x * gridDim.y * gridDim.z;
    unsigned sum, cnt, mine, sp = 0u;
    for (;;) {
        sum = 0u; cnt = 0u; mine = 0u;
#pragma unroll
        for (unsigned j = 0; j < 16; ++j) { const unsigned c = xb_ld(&bar[XB_XCNT(j)]); sum += c; cnt += (c > 0u) ? 1u : 0u; mine = (j == x) ? c : mine; }
        if (sum == G) break;
        __builtin_amdgcn_s_sleep(1);
        if ((++sp & 255u) == 0u) { if (xb_ld(&bar[XB_TMO])) break; if (sp > XB_SPIN_CAP) { atomicAdd(&bar[XB_TMO], 1u); break; } }
    }
    nloc = mine > 0u ? mine : 1u; nx = cnt > 0u ? cnt : 1u;
}

__device__ __forceinline__ void xcd_barrier(const XcdBarrier& b) {
    asm volatile("s_waitcnt vmcnt(0)" ::: "memory");
    __syncthreads();
    if (threadIdx.x == 0) {
        unsigned* bar = b.bar;
        __builtin_amdgcn_s_waitcnt(0);
        unsigned nloc = b.st[0], nx = b.st[1];
        if (nloc == 0u) { xcd_barrier_complete(bar, b.x, nloc, nx); b.st[0] = nloc; b.st[1] = nx; }
        const unsigned old = xb_add(&bar[XB_XSUB(b.x)], 1u);
        const unsigned gen = old / nloc;
        if (old + 1u == (gen + 1u) * nloc) {
            __builtin_amdgcn_fence(__ATOMIC_RELEASE, "agent");
            asm volatile("s_waitcnt vmcnt(0)" ::: "memory");
            const unsigned og = xb_add(&bar[XB_TOP], 1u);
            const unsigned tg = og / nx;
            if (og + 1u == (tg + 1u) * nx) xb_add(&bar[XB_TOPGEN], 1u);
            else XB_SPIN(xb_ld(&bar[XB_TOPGEN]) == tg, bar);
            __builtin_amdgcn_fence(__ATOMIC_ACQUIRE, "agent");
            xb_add(&bar[XB_XGEN(b.x)], 1u);
            asm volatile("s_waitcnt vmcnt(0)" ::: "memory");
        } else {
            XB_SPIN(xb_ld(&bar[XB_XGEN(b.x)]) == gen, bar);
            __builtin_amdgcn_fence(__ATOMIC_ACQUIRE, "agent");
            asm volatile("s_waitcnt vmcnt(0)" ::: "memory");
        }
    }
    __syncthreads();
}

constexpr int NWAVES = 8, NTHR = 512;
constexpr int DM = 2048, NB = 4, SQ = 4096, TOK = NB * SQ;
constexpr int INW = 5900, PW = 5888;
constexpr int C_U = 0, C_DQ = 512, C_DK = 1280, C_DV = 2048, C_GQ = 2816, C_GZ = 5120, C_GA = 5888;
constexpr int DFF = 5632, DFE = 7168, NE = 8;
constexpr int MOE_ROWS = 2 * TOK + NE * 256, MOE_TILES_MAX = MOE_ROWS / 256;
constexpr float EPS = 1e-6f;
constexpr int GDN_UNIT_BYTES = 57344 + 32768 + 256;

constexpr size_t MiB = 1u << 20;
constexpr size_t WS_CTL = 0, CTL_ZERO_BYTES = 1 * MiB;
constexpr size_t WS_MOD = 1 * MiB;
constexpr size_t WS_ROPE = 2 * MiB;
constexpr size_t WS_GAB = 3 * MiB;
constexpr size_t WS_TOKE = 4 * MiB, WS_TOKG = WS_TOKE + 128 * 1024, WS_RANK = WS_TOKE + 256 * 1024, WS_POS = WS_TOKE + 384 * 1024, WS_CNT = WS_TOKE + 512 * 1024, WS_TILE = WS_TOKE + 640 * 1024;
constexpr size_t WS_GW = 5 * MiB;
constexpr size_t WS_M2 = 6 * MiB;
constexpr size_t WS_M13 = 10 * MiB;
constexpr size_t WS_A16 = 22 * MiB;
constexpr size_t WS_XC = 23 * MiB;
constexpr size_t WS_XS = 39 * MiB;
constexpr size_t WS_YGELU = 47 * MiB;
constexpr size_t WS_WIN = 64 * MiB;
constexpr size_t WS_WOUT = 110 * MiB;
constexpr size_t WS_WGLU = 126 * MiB;
constexpr size_t WS_WUP = 128 * MiB;
constexpr size_t WS_WDN = 172 * MiB;
constexpr size_t WS_MUP = 194 * MiB;
constexpr size_t WS_MDN = 642 * MiB;
constexpr size_t WS_HRES = 866 * MiB;
constexpr size_t WS_HN = 994 * MiB;
constexpr size_t WS_R = 1058 * MiB;
constexpr size_t WS_PROJ = WS_R, WS_YCAT = WS_R + 184 * MiB, WS_ATTO = WS_R + 248 * MiB, WS_OGDN = WS_R + 296 * MiB;
constexpr size_t WS_H = WS_R;
constexpr size_t WS_AS = 1534 * MiB;
constexpr size_t WS_GU = WS_AS;
constexpr size_t WS_END = 1670 * MiB;
static_assert((size_t)MOE_ROWS * DFE * 2 <= 476 * MiB && (size_t)MOE_ROWS * DM * 2 <= 136 * MiB && (size_t)1536 * GDN_UNIT_BYTES <= 136 * MiB, "ws map");
static_assert((size_t)TOK * PW * 2 <= 184 * MiB && (size_t)TOK * 768 * 4 <= 48 * MiB, "ws map 2");
constexpr int CW_BAR = 4096, CW_QUEUE = 8192;

constexpr int LDS_BYTES = 147456;
constexpr int RING_BYTES = 131072;
constexpr int TILE_OFF = 146432, MISC_OFF = 147200;

typedef unsigned u32x4_t __attribute__((ext_vector_type(4)));
typedef unsigned u32x2_t __attribute__((ext_vector_type(2)));
typedef float f32x2_t __attribute__((ext_vector_type(2)));

__device__ __forceinline__ float bf2f(unsigned short u) { return __uint_as_float((unsigned)u << 16); }
__device__ __forceinline__ float bflo(unsigned w) { return __uint_as_float(w << 16); }
__device__ __forceinline__ float bfhi(unsigned w) { return __uint_as_float(w & 0xffff0000u); }
__device__ __forceinline__ float wave_sum(float v) {
#pragma unroll
    for (int o = 1; o < 64; o <<= 1) v += __shfl_xor(v, o);
    return v;
}
__device__ __forceinline__ float sigmoid_f(float x) { return 1.f / (1.f + __expf(-x)); }
__device__ __forceinline__ float silu_f(float x) { return x / (1.f + __expf(-x)); }
__device__ __forceinline__ float gelu_tanh_f(float y) { const float z = 0.7978845608028654f * (y + 0.044715f * y * y * y); const float e = __expf(2.f * z); const float th = 1.f - 2.f / (e + 1.f); return 0.5f * y * (1.f + th); }
__device__ __forceinline__ bf16x8 pack8(const f32x4& a, const f32x4& b) {
    u32x4_t w; w.x = pk2(a[0], a[1]); w.y = pk2(a[2], a[3]); w.z = pk2(b[0], b[1]); w.w = pk2(b[2], b[3]);
    return __builtin_bit_cast(bf16x8, w);
}
__device__ __forceinline__ void sincos2pi(double r, float& s, float& c) {
    const double x = r * 6.283185307179586476925; const double x2 = x * x;
    double ss = 1.0, cc = 1.0;
#pragma unroll
    for (int k = 12; k >= 1; --k) { ss = 1.0 - x2 * ss / (double)((2 * k) * (2 * k + 1)); cc = 1.0 - x2 * cc / (double)((2 * k - 1) * (2 * k)); }
    s = (float)(x * ss); c = (float)cc;
}

namespace pg8 {
struct EpiProj {
    static constexpr bool PERM = true, AFTER_DRAIN = false;
    bf16_t* O;
    __device__ __forceinline__ void operator()(const f32x4 (&acc)[2][2][4][2], const Unit& u, int wr, int wc, int fr, int fq) const {
        const int row0 = u.pm * BM + wr * 64 + fr, col0 = u.pn * BM + wc * 32 + 8 * fq;
        const float sc = (u.pn >= 2 && u.pn <= 4) ? attn_body::C2 : 1.f;
#pragma unroll
        for (int ai = 0; ai < 2; ++ai)
#pragma unroll
            for (int m = 0; m < 4; ++m) { bf16_t* rowp = O + (size_t)(row0 + ai * HALF + m * 16) * PW + col0;
#pragma unroll
                for (int bj = 0; bj < 2; ++bj) { const f32x4 v0 = acc[ai][bj][m][0] * sc, v1 = acc[ai][bj][m][1] * sc;
                    u32x4 w; w.x = cvt_pk_bf16(v0[0], v0[1]); w.y = cvt_pk_bf16(v0[2], v0[3]); w.z = cvt_pk_bf16(v1[0], v1[1]); w.w = cvt_pk_bf16(v1[2], v1[3]);
                    *(u32x4*)(rowp + bj * HALF) = w; } }
    }
};
struct EpiGlu {
    static constexpr bool PERM = true, AFTER_DRAIN = false;
    const bf16_t* Y; bf16_t* O;
    __device__ __forceinline__ void operator()(const f32x4 (&acc)[2][2][4][2], const Unit& u, int wr, int wc, int fr, int fq) const {
        const int row0 = u.pm * BM + wr * 64 + fr, col0 = u.pn * BM + wc * 32 + 8 * fq;
#pragma unroll
        for (int ai = 0; ai < 2; ++ai)
#pragma unroll
            for (int m = 0; m < 4; ++m) { const int row = row0 + ai * HALF + m * 16;
#pragma unroll
                for (int bj = 0; bj < 2; ++bj) { const int col = col0 + bj * HALF;
                    const u32x4 yv = *(const u32x4*)(Y + (size_t)row * 512 + col);
                    const f32x4 a0 = acc[ai][bj][m][0], a1 = acc[ai][bj][m][1];
                    u32x4 w;
                    w.x = cvt_pk_bf16(bflo(yv.x) * sigmoid_f(a0[0]), bfhi(yv.x) * sigmoid_f(a0[1]));
                    w.y = cvt_pk_bf16(bflo(yv.y) * sigmoid_f(a0[2]), bfhi(yv.y) * sigmoid_f(a0[3]));
                    w.z = cvt_pk_bf16(bflo(yv.z) * sigmoid_f(a1[0]), bfhi(yv.z) * sigmoid_f(a1[1]));
                    w.w = cvt_pk_bf16(bflo(yv.w) * sigmoid_f(a1[2]), bfhi(yv.w) * sigmoid_f(a1[3]));
                    *(u32x4*)(O + (size_t)row * DM + col) = w; } }
    }
};
struct EpiRes {
    static constexpr bool PERM = false, AFTER_DRAIN = false;
    const float* res; float* out; const float* gate;
    __device__ __forceinline__ void operator()(const f32x4 (&acc)[2][2][4][2], const Unit& u, int wr, int wc, int fr, int fq) const {
        const int col0 = u.pn * BM + wc * 32 + 4 * fq;
#pragma unroll
        for (int ai = 0; ai < 2; ++ai)
#pragma unroll
            for (int m = 0; m < 4; ++m) { const int row = u.pm * BM + ai * HALF + wr * 64 + m * 16 + fr; const float* gp = gate + (size_t)(row >> 12) * (6 * DM); const size_t off = (size_t)row * DM;
#pragma unroll
                for (int bj = 0; bj < 2; ++bj)
#pragma unroll
                    for (int n = 0; n < 2; ++n) { const int col = col0 + bj * HALF + n * 16;
                        const f32x4 g = *(const f32x4*)(gp + col), r = *(const f32x4*)(res + off + col);
                        *(f32x4*)(out + off + col) = r + g * acc[ai][bj][m][n]; } }
    }
};
struct EpiSwiglu {
    static constexpr bool PERM = true, AFTER_DRAIN = false;
    bf16_t* H; int ldh; int nct;
    __device__ __forceinline__ void operator()(const f32x4 (&acc)[2][2][4][2], const Unit& u, int wr, int wc, int fr, int fq) const {
        const int pnl = u.pn % nct; const int row0 = u.pm * BM + wr * 64 + fr, col0 = pnl * HALF + wc * 32 + 8 * fq;
#pragma unroll
        for (int ai = 0; ai < 2; ++ai)
#pragma unroll
            for (int m = 0; m < 4; ++m) { const int row = row0 + ai * HALF + m * 16;
                const f32x4 g0 = acc[ai][0][m][0], g1 = acc[ai][0][m][1], u0 = acc[ai][1][m][0], u1 = acc[ai][1][m][1];
                u32x4 w;
                w.x = cvt_pk_bf16(silu_f(g0[0]) * u0[0], silu_f(g0[1]) * u0[1]); w.y = cvt_pk_bf16(silu_f(g0[2]) * u0[2], silu_f(g0[3]) * u0[3]);
                w.z = cvt_pk_bf16(silu_f(g1[0]) * u1[0], silu_f(g1[1]) * u1[1]); w.w = cvt_pk_bf16(silu_f(g1[2]) * u1[2], silu_f(g1[3]) * u1[3]);
                *(u32x4*)(H + (size_t)row * ldh + col0) = w; }
    }
};
struct EpiMoeDown {
    static constexpr bool PERM = true, AFTER_DRAIN = false;
    bf16_t* O; const float* gw;
    __device__ __forceinline__ void operator()(const f32x4 (&acc)[2][2][4][2], const Unit& u, int wr, int wc, int fr, int fq) const {
        const int row0 = u.pm * BM + wr * 64 + fr, col0 = (u.pn & 7) * BM + wc * 32 + 8 * fq;
#pragma unroll
        for (int ai = 0; ai < 2; ++ai)
#pragma unroll
            for (int m = 0; m < 4; ++m) { const int row = row0 + ai * HALF + m * 16; const float s = gw[row]; bf16_t* rowp = O + (size_t)row * DM + col0;
#pragma unroll
                for (int bj = 0; bj < 2; ++bj) { const f32x4 v0 = acc[ai][bj][m][0] * s, v1 = acc[ai][bj][m][1] * s;
                    u32x4 w; w.x = cvt_pk_bf16(v0[0], v0[1]); w.y = cvt_pk_bf16(v0[2], v0[3]); w.z = cvt_pk_bf16(v1[0], v1[1]); w.w = cvt_pk_bf16(v1[2], v1[3]);
                    *(u32x4*)(rowp + bj * HALF) = w; } }
    }
};
struct MoeOrder {
    StaticOrder so; const PG8_LAS int* tile_e; int nct;
    __device__ __forceinline__ bool next(int i, Unit& u) const { if (!so.next(i, u)) return false; u.pn += tile_e[u.pm] * nct; return true; }
    __device__ __forceinline__ void a_ready(const Unit&) const {}
    __device__ __forceinline__ void done(const Unit&) const {}
};
}

struct Params { const float* in[35]; float* out; unsigned char* ws; int ph_lo, ph_hi; };
typedef const __attribute__((address_space(4))) Params* KP;

struct Ctx {
    LAS unsigned char* lds; volatile LAS unsigned* MISC; unsigned char* ws; gu32* ctl;
    int tid, lane, wave, blk, G;
};

__device__ __forceinline__ void tr_item(const float* __restrict__ src, int ld, bf16* dst, int K, int k0, int n0, int drow0, LAS float* scr, int lane) {
#pragma unroll 8
    for (int i = 0; i < 32; ++i) { const int kk = 2 * i + (lane >> 5); scr[kk * 33 + (lane & 31)] = src[(size_t)(k0 + kk) * ld + n0 + (lane & 31)]; }
    LDS_WAIT(); asm volatile("" ::: "memory");
    const int c = lane & 7;
#pragma unroll
    for (int j = 0; j < 4; ++j) { const int n = (lane >> 3) + 8 * j; const LAS float* s = scr + (8 * c) * 33 + n;
        v4u o; o.x = pk2(s[0 * 33], s[1 * 33]); o.y = pk2(s[2 * 33], s[3 * 33]); o.z = pk2(s[4 * 33], s[5 * 33]); o.w = pk2(s[6 * 33], s[7 * 33]);
        *(GAS v4u*)(dst + (size_t)(drow0 + n) * K + k0 + 8 * c) = o; }
    LDS_WAIT(); asm volatile("" ::: "memory");
}
__device__ __forceinline__ void tr_plain(const float* src, int ld, int K, int N, bf16* dst, int item, LAS float* scr, int lane) {
    const int nblk = N / 32, kb = item / nblk, nb = item % nblk;
    tr_item(src, ld, dst, K, 64 * kb, 32 * nb, 32 * nb, scr, lane);
}
__device__ __forceinline__ void tr_inter(const float* src, int K, int N, bf16* dst, int half, int item, LAS float* scr, int lane) {
    const int nblk = N / 32, kb = item / nblk, nb = item % nblk, n0 = 32 * nb;
    tr_item(src, N, dst, K, 64 * kb, n0, (n0 >> 7) * 256 + half * 128 + (n0 & 127), scr, lane);
}

__device__ __forceinline__ void p0_ada(const Ctx& C, KP P) {
    const int u = C.blk, l = u / 96, n0 = (u % 96) * 128;
    LAS float* sc = (LAS float*)C.lds; LAS float* part = (LAS float*)(C.lds + 32768);
    const float* cin = P->in[1];
    for (int i = C.tid; i < 4 * DM; i += NTHR) sc[i] = silu_f(cin[i]);
    __syncthreads();
    const int sub = C.lane >> 5, c4 = C.lane & 31, w = C.wave;
    const float* Wp = P->in[3] + ((size_t)l * DM + 256 * w + sub) * (6 * DM) + n0 + 4 * c4;
    f32x4 acc[4];
#pragma unroll
    for (int b = 0; b < 4; ++b) acc[b] = (f32x4){0.f, 0.f, 0.f, 0.f};
#pragma unroll 8
    for (int i = 0; i < 128; ++i) { const f32x4 wv = *(const f32x4*)(Wp + (size_t)(2 * i) * (6 * DM)); const int k = 256 * w + 2 * i + sub;
#pragma unroll
        for (int b = 0; b < 4; ++b) acc[b] += wv * sc[b * DM + k]; }
#pragma unroll
    for (int b = 0; b < 4; ++b)
#pragma unroll
        for (int q = 0; q < 4; ++q) acc[b][q] += __shfl_xor(acc[b][q], 32);
    if (C.lane < 32) {
#pragma unroll
        for (int b = 0; b < 4; ++b)
#pragma unroll
            for (int q = 0; q < 4; ++q) part[(w * 4 + b) * 128 + 4 * c4 + q] = acc[b][q]; }
    __syncthreads();
    { const int b = C.tid >> 7, n = C.tid & 127; float s = P->in[4][l * (6 * DM) + n0 + n];
#pragma unroll
      for (int ww = 0; ww < 8; ++ww) s += part[(ww * 4 + b) * 128 + n];
      ((float*)(C.ws + WS_MOD))[(size_t)(l * 4 + b) * (6 * DM) + n0 + n] = s; }
    __syncthreads();
}

__device__ __forceinline__ void p0_ssm(const Ctx& C, KP P) {
    const int u = C.blk - 192, l = u >> 5, g = u & 31, lg = l * 32 + g;
    LAS f32x2_t* Pw = (LAS f32x2_t*)C.lds;
    LAS f32x2_t* Bb = (LAS f32x2_t*)(C.lds + 8704);
    LAS f32x2_t* Cc = (LAS f32x2_t*)(C.lds + 8704 + 8192);
    LAS float* Kl = (LAS float*)(C.lds + 8704 + 16384);
    const float dt = expf(P->in[12][lg]);
    if (C.tid < 64) { const int p = C.tid; const float ar = P->in[10][lg * 64 + p], ai = P->in[11][lg * 64 + p];
        for (int j = 0; j <= 16; ++j) { const float mag = expf(ar * dt * (float)j); double rev = (double)ai * (double)dt * (double)j * 0.15915494309189533577; rev -= rint(rev);
            float s, c; sincos2pi(rev, s, c); Pw[j * 64 + p] = (f32x2_t){mag * c, mag * s}; }
        const f32x2_t lb = Pw[64 + p]; const float nx = lb.x - 1.f, ny = lb.y, den = ar * ar + ai * ai;
        const float cx = (nx * ar + ny * ai) / den, cy = (ny * ar - nx * ai) / den;
        for (int h = 0; h < 16; ++h) { const float br = P->in[13][(lg * 64 + p) * 16 + h], bi = P->in[14][(lg * 64 + p) * 16 + h]; Bb[p * 16 + h] = (f32x2_t){cx * br - cy * bi, cx * bi + cy * br}; }
        ((f32x2_t*)(C.ws + WS_A16))[lg * 64 + p] = Pw[16 * 64 + p]; }
    for (int i = C.tid; i < 1024; i += NTHR) Cc[i] = (f32x2_t){P->in[15][lg * 1024 + i], P->in[16][lg * 1024 + i]};
    __syncthreads();
    for (int e = C.tid; e < 4096; e += NTHR) { const int j = e >> 8, hp = (e >> 4) & 15, h = e & 15; float s = 0.f;
        for (int p = 0; p < 64; ++p) { const f32x2_t c = Cc[hp * 64 + p], pw = Pw[j * 64 + p], bb = Bb[p * 16 + h]; const float zx = c.x * pw.x - c.y * pw.y, zy = c.x * pw.y + c.y * pw.x; s += zx * bb.x - zy * bb.y; }
        if (j == 0 && hp == h) s += P->in[17][l * 512 + g * 16 + h];
        Kl[e] = s; }
    __syncthreads();
    bf16* M2 = (bf16*)(C.ws + WS_M2) + (size_t)lg * 128 * 256;
    for (int pc = C.tid; pc < 4096; pc += NTHR) { const int n = pc >> 5, k0 = (pc & 31) * 8, p = n >> 1, ri = n & 1, s = k0 >> 4, h0 = k0 & 15; const f32x2_t pw = Pw[(15 - s) * 64 + p]; float v[8];
#pragma unroll
        for (int j = 0; j < 8; ++j) { const f32x2_t bb = Bb[p * 16 + h0 + j]; v[j] = ri ? (pw.x * bb.y + pw.y * bb.x) : (pw.x * bb.x - pw.y * bb.y); }
        v4u o; o.x = pk2(v[0], v[1]); o.y = pk2(v[2], v[3]); o.z = pk2(v[4], v[5]); o.w = pk2(v[6], v[7]); *(GAS v4u*)(M2 + (size_t)n * 256 + k0) = o; }
    bf16* M13 = (bf16*)(C.ws + WS_M13) + (size_t)lg * 256 * 384;
    for (int pc = C.tid; pc < 12288; pc += NTHR) { const int n = pc / 48, k0 = (pc % 48) * 8, i = n >> 4, hp = n & 15; float v[8];
        if (k0 < 256) { const int s = k0 >> 4, h0 = k0 & 15;
#pragma unroll
            for (int j = 0; j < 8; ++j) v[j] = (i >= s) ? Kl[((i - s) * 16 + hp) * 16 + h0 + j] : 0.f; }
        else {
#pragma unroll
            for (int j = 0; j < 8; ++j) { const int kk = k0 - 256 + j, p = kk >> 1, ri = kk & 1; const f32x2_t c = Cc[hp * 64 + p], pw = Pw[(i + 1) * 64 + p]; const float zx = c.x * pw.x - c.y * pw.y, zy = c.x * pw.y + c.y * pw.x; v[j] = ri ? -zy : zx; } }
        v4u o; o.x = pk2(v[0], v[1]); o.y = pk2(v[2], v[3]); o.z = pk2(v[4], v[5]); o.w = pk2(v[6], v[7]); *(GAS v4u*)(M13 + (size_t)n * 384 + k0) = o; }
    __syncthreads();
}

__device__ __forceinline__ void p0_prologue(const Ctx& C, KP P) {
    if (C.blk < 192) p0_ada(C, P); else p0_ssm(C, P);
    { const int* pos = (const int*)P->in[2]; float* rope = (float*)(C.ws + WS_ROPE);
      for (int idx = C.blk * NTHR + C.tid; idx < TOK * 8; idx += C.G * NTHR) { const int t = idx >> 3, i = idx & 7;
          const double invf = exp(-(double)i * (13.122363377404328 / 8.0)); double rev = (double)pos[t] * invf * 0.15915494309189533577; rev -= rint(rev);
          float s, c; sincos2pi(rev, s, c); rope[t * 16 + i] = c; rope[t * 16 + 8 + i] = s; } }
    LAS float* scr = (LAS float*)(C.lds + C.wave * 16384);
    const int gw = C.blk * NWAVES + C.wave, NGW = C.G * NWAVES, lane = C.lane;
    constexpr int I_IN = 32 * 184, I_OUT = 32 * 64, I_GLU = 8 * 16, I_F13 = 32 * 176, I_F2 = 88 * 64, I_M13 = 32 * 224, I_M2 = 112 * 64;
    constexpr int NITEMS = 2 * I_IN + 2 * I_OUT + 2 * I_GLU + 2 * I_F13 + I_F2 + 16 * I_M13 + 8 * I_M2;
    for (int it = gw; it < NITEMS; it += NGW) {
        int r = it;
        if (r < 2 * I_IN) { const int l = r / I_IN; r -= l * I_IN; tr_plain(P->in[8] + (size_t)l * DM * INW, INW, DM, PW, (bf16*)(C.ws + WS_WIN) + (size_t)l * PW * DM, r, scr, lane); continue; } r -= 2 * I_IN;
        if (r < 2 * I_OUT) { const int l = r / I_OUT; r -= l * I_OUT; tr_plain(P->in[9] + (size_t)l * DM * DM, DM, DM, DM, (bf16*)(C.ws + WS_WOUT) + (size_t)l * DM * DM, r, scr, lane); continue; } r -= 2 * I_OUT;
        if (r < 2 * I_GLU) { const int l = r / I_GLU; r -= l * I_GLU; tr_plain(P->in[18] + (size_t)l * 512 * 512, 512, 512, 512, (bf16*)(C.ws + WS_WGLU) + (size_t)l * 512 * 512, r, scr, lane); continue; } r -= 2 * I_GLU;
        if (r < I_F13) { tr_inter(P->in[28], DM, DFF, (bf16*)(C.ws + WS_WUP), 0, r, scr, lane); continue; } r -= I_F13;
        if (r < I_F13) { tr_inter(P->in[29], DM, DFF, (bf16*)(C.ws + WS_WUP), 1, r, scr, lane); continue; } r -= I_F13;
        if (r < I_F2) { tr_plain(P->in[30], DM, DFF, DM, (bf16*)(C.ws + WS_WDN), r, scr, lane); continue; } r -= I_F2;
        if (r < 16 * I_M13) { const int q = r / I_M13, e = q >> 1, half = q & 1; r -= q * I_M13;
            tr_inter((half ? P->in[33] : P->in[32]) + (size_t)e * DM * DFE, DM, DFE, (bf16*)(C.ws + WS_MUP) + (size_t)e * 2 * DFE * DM, half, r, scr, lane); continue; } r -= 16 * I_M13;
        { const int e = r / I_M2; r -= e * I_M2; tr_plain(P->in[34] + (size_t)e * DFE * DM, DM, DFE, DM, (bf16*)(C.ws + WS_MDN) + (size_t)e * DM * DFE, r, scr, lane); }
    }
}

template <bool WITH_GAB>
__device__ __forceinline__ void norm_phase(const Ctx& C, const float* __restrict__ src, const float* __restrict__ nw, const float* __restrict__ mod_shift, const float* __restrict__ mod_scale, const float* __restrict__ w12  ) {
    LAS float* W12T = (LAS float*)C.lds;
    if (WITH_GAB) { for (int idx = C.tid; idx < DM * 12; idx += NTHR) { const int k = idx / 12, j = idx % 12; W12T[j * DM + k] = w12[(size_t)k * INW + C_GA + j]; } __syncthreads(); }
    bf16* HN = (bf16*)(C.ws + WS_HN); float* GAB = (float*)(C.ws + WS_GAB);
    const int lane = C.lane;
    f32x4 nwv[8];
#pragma unroll
    for (int j = 0; j < 8; ++j) nwv[j] = *(const f32x4*)(nw + 4 * lane + 256 * j);
    for (int i = 0; i < 8; ++i) { const int t = C.blk * 64 + C.wave * 8 + i; if (t >= TOK) break; const int b = t >> 12;
        const float* xr = src + (size_t)t * DM; f32x4 v[8]; float ss = 0.f;
#pragma unroll
        for (int j = 0; j < 8; ++j) { v[j] = *(const f32x4*)(xr + 4 * lane + 256 * j); ss += (v[j].x * v[j].x + v[j].y * v[j].y) + (v[j].z * v[j].z + v[j].w * v[j].w); }
        const float r = rsqrtf(wave_sum(ss) * (1.f / DM) + EPS);
        const float* sh = mod_shift + (size_t)b * 6 * DM; const float* scp = mod_scale + (size_t)b * 6 * DM;
#pragma unroll
        for (int j = 0; j < 8; ++j) { const f32x4 s1 = *(const f32x4*)(scp + 4 * lane + 256 * j), s0 = *(const f32x4*)(sh + 4 * lane + 256 * j);
            v[j] = v[j] * r * nwv[j] * (s1 + 1.f) + s0;
            u32x2_t o; o.x = pk2(v[j].x, v[j].y); o.y = pk2(v[j].z, v[j].w); *(GAS u32x2_t*)(HN + (size_t)t * DM + 4 * lane + 256 * j) = o; }
        if (WITH_GAB) {
#pragma unroll
            for (int jj = 0; jj < 12; ++jj) { float a = 0.f;
#pragma unroll
                for (int j = 0; j < 8; ++j) { const f32x4 wv = *(const LAS f32x4*)(W12T + jj * DM + 4 * lane + 256 * j); a += (v[j].x * wv.x + v[j].y * wv.y) + (v[j].z * wv.z + v[j].w * wv.w); }
                a = wave_sum(a); if (lane == 0) GAB[(size_t)t * 12 + jj] = a; } }
    }
    __syncthreads();
}

__device__ __forceinline__ void rope_pass(const Ctx& C) {
    bf16* PROJ = (bf16*)(C.ws + WS_PROJ); const float* rope = (const float*)(C.ws + WS_ROPE);
    for (int idx = C.blk * NTHR + C.tid; idx < TOK * 24; idx += C.G * NTHR) { const int t = idx / 24, v = idx % 24;
        bf16* p = PROJ + (size_t)t * PW + (v < 12 ? C_DQ + v * 64 : C_DK + (v - 12) * 64);
        const u32x4_t a = *(const u32x4_t*)p, b = *(const u32x4_t*)(p + 8);
        const f32x4 c0 = *(const f32x4*)(rope + t * 16), c1 = *(const f32x4*)(rope + t * 16 + 4), s0 = *(const f32x4*)(rope + t * 16 + 8), s1 = *(const f32x4*)(rope + t * 16 + 12);
        const float t1[8] = {bflo(a.x), bfhi(a.x), bflo(a.y), bfhi(a.y), bflo(a.z), bfhi(a.z), bflo(a.w), bfhi(a.w)};
        const float t2[8] = {bflo(b.x), bfhi(b.x), bflo(b.y), bfhi(b.y), bflo(b.z), bfhi(b.z), bflo(b.w), bfhi(b.w)};
        const float cs[8] = {c0.x, c0.y, c0.z, c0.w, c1.x, c1.y, c1.z, c1.w}, sn[8] = {s0.x, s0.y, s0.z, s0.w, s1.x, s1.y, s1.z, s1.w};
        float o1[8], o2[8];
#pragma unroll
        for (int i = 0; i < 8; ++i) { o1[i] = t1[i] * cs[i] - t2[i] * sn[i]; o2[i] = t2[i] * cs[i] + t1[i] * sn[i]; }
        u32x4_t oa, ob; oa.x = pk2(o1[0], o1[1]); oa.y = pk2(o1[2], o1[3]); oa.z = pk2(o1[4], o1[5]); oa.w = pk2(o1[6], o1[7]);
        ob.x = pk2(o2[0], o2[1]); ob.y = pk2(o2[2], o2[3]); ob.z = pk2(o2[4], o2[5]); ob.w = pk2(o2[6], o2[7]);
        *(u32x4_t*)p = oa; *(u32x4_t*)(p + 8) = ob; }
}

__device__ __forceinline__ void ssm_gemm_a(const Ctx& C, int l) {
    const bf16* PROJ = (const bf16*)(C.ws + WS_PROJ); float* XC = (float*)(C.ws + WS_XC);
    const int lane = C.lane, fr = lane & 15, quad = lane >> 4;
    for (int wu = C.blk * NWAVES + C.wave; wu < 2048; wu += C.G * NWAVES) { const int g = wu >> 6, rt = wu & 63, r = 16 * rt + fr, tok = (r >> 8) * SQ + (r & 255) * 16;
        const bf16* arow = PROJ + (size_t)(tok + (quad >> 1)) * PW + C_U + g * 16 + 8 * (quad & 1);
        const bf16* bp = (const bf16*)(C.ws + WS_M2) + ((size_t)(l * 32 + g) * 128 + fr) * 256 + 8 * quad;
        f32x4 acc[8];
#pragma unroll
        for (int nt = 0; nt < 8; ++nt) acc[nt] = (f32x4){0.f, 0.f, 0.f, 0.f};
#pragma unroll
        for (int ks = 0; ks < 8; ++ks) { const bf16x8 a = *(const bf16x8*)(arow + (size_t)(2 * ks) * PW);
#pragma unroll
            for (int nt = 0; nt < 8; ++nt) { const bf16x8 b = *(const bf16x8*)(bp + nt * 4096 + 32 * ks); acc[nt] = __builtin_amdgcn_mfma_f32_16x16x32_bf16(a, b, acc[nt], 0, 0, 0); } }
#pragma unroll
        for (int nt = 0; nt < 8; ++nt)
#pragma unroll
            for (int j = 0; j < 4; ++j) XC[((size_t)(16 * rt + 4 * quad + j) * 32 + g) * 128 + 16 * nt + fr] = acc[nt][j];
    }
}

__device__ __forceinline__ void ssm_gemm_b(const Ctx& C, int l) {
    const bf16* PROJ = (const bf16*)(C.ws + WS_PROJ); const bf16* XS = (const bf16*)(C.ws + WS_XS); bf16* YG = (bf16*)(C.ws + WS_YGELU);
    const int lane = C.lane, fr = lane & 15, quad = lane >> 4;
    for (int wu = C.blk * NWAVES + C.wave; wu < 2048; wu += C.G * NWAVES) { const int g = wu >> 6, rt = wu & 63, r = 16 * rt + fr, tok = (r >> 8) * SQ + (r & 255) * 16;
        const bf16* arow = PROJ + (size_t)(tok + (quad >> 1)) * PW + C_U + g * 16 + 8 * (quad & 1);
        const bf16* xrow = XS + ((size_t)r * 32 + g) * 128 + 8 * quad;
        const bf16* bp = (const bf16*)(C.ws + WS_M13) + ((size_t)(l * 32 + g) * 256 + fr) * 384 + 8 * quad;
        f32x4 acc[16];
#pragma unroll
        for (int nt = 0; nt < 16; ++nt) acc[nt] = (f32x4){0.f, 0.f, 0.f, 0.f};
#pragma unroll
        for (int ks = 0; ks < 12; ++ks) { const bf16x8 a = (ks < 8) ? *(const bf16x8*)(arow + (size_t)(2 * ks) * PW) : *(const bf16x8*)(xrow + 32 * (ks - 8));
#pragma unroll
            for (int nt = 0; nt < 16; ++nt) { const bf16x8 b = *(const bf16x8*)(bp + nt * (16 * 384) + 32 * ks); acc[nt] = __builtin_amdgcn_mfma_f32_16x16x32_bf16(a, b, acc[nt], 0, 0, 0); } }
#pragma unroll
        for (int j = 0; j < 4; ++j) { const int rr = 16 * rt + 4 * quad + j; const size_t tb = (size_t)((rr >> 8) * SQ + (rr & 255) * 16);
#pragma unroll
            for (int nt = 0; nt < 16; ++nt) YG[(tb + nt) * 512 + g * 16 + fr] = (bf16)f2bf(gelu_tanh_f(acc[nt][j])); }
    }
}

__device__ __forceinline__ void ssm_scan(const Ctx& C, int l, int sblk  ) {
    const int idx = sblk * NTHR + C.tid, b = idx >> 11, g = (idx >> 6) & 31, p = idx & 63;
    const f32x2_t a = ((const f32x2_t*)(C.ws + WS_A16))[(l * 32 + g) * 64 + p];
    const f32x2_t* xc = (const f32x2_t*)(C.ws + WS_XC) + ((size_t)(b * 256) * 32 + g) * 64 + p; unsigned* xs = (unsigned*)(C.ws + WS_XS) + ((size_t)(b * 256) * 32 + g) * 64 + p;
    float xr = 0.f, xi = 0.f;
    for (int c0 = 0; c0 < 256; c0 += 8) { f32x2_t in[8];
#pragma unroll
        for (int q = 0; q < 8; ++q) in[q] = xc[(size_t)(c0 + q) * 2048];
#pragma unroll
        for (int q = 0; q < 8; ++q) { xs[(size_t)(c0 + q) * 2048] = pk2(xr, xi); const float nr = a.x * xr - a.y * xi + in[q].x, ni = a.x * xi + a.y * xr + in[q].y; xr = nr; xi = ni; } }
}

constexpr int GL_QT = 0, GL_KT = 33792, GL_VT = 67584, GL_AM = 101376, GL_QK = 118784, GL_SM = 136192;
__device__ __forceinline__ void gdn_prep_unit(const Ctx& C, KP P, int l, int unit) {
    const int b = unit / 384, h = (unit / 64) % 6, ch = unit & 63, tok0 = b * SQ + ch * 64, tid = C.tid, lane = C.lane, wave = C.wave;
    LAS float* QT = (LAS float*)(C.lds + GL_QT); LAS float* KT = (LAS float*)(C.lds + GL_KT); LAS float* VT = (LAS float*)(C.lds + GL_VT);
    LAS float* AM = (LAS float*)(C.lds + GL_AM); LAS float* QKM = (LAS float*)(C.lds + GL_QK);
    LAS float* gc = (LAS float*)(C.lds + GL_SM); LAS float* beta = gc + 64; LAS float* eg = gc + 128; LAS float* ek = gc + 192;
    const bf16* PROJ = (const bf16*)(C.ws + WS_PROJ); const float* convw = P->in[24] + (size_t)l * 4 * 2304;
    unsigned char* UB = C.ws + WS_GU + (size_t)unit * GDN_UNIT_BYTES;
    for (int idx = tid; idx < 64 * 384; idx += NTHR) { const int i = idx / 384, c = idx % 384, which = c >> 7, d = c & 127, chn = which * 768 + h * 128 + d, col = C_GQ + chn;
        float a = 0.f;
#pragma unroll
        for (int tap = 0; tap < 4; ++tap) { const int sp = ch * 64 + i - 3 + tap; if (sp >= 0) a += convw[tap * 2304 + chn] * bf2f(PROJ[(size_t)(b * SQ + sp) * PW + col]); }
        ((LAS float*)(C.lds + which * 33792))[i * 132 + d] = silu_f(a); }
    __syncthreads();
#pragma unroll 1
    for (int ii = 0; ii < 8; ++ii) { const int i = wave * 8 + ii;
        { const float a = QT[i * 132 + lane], c = QT[i * 132 + 64 + lane]; const float sc = rsqrtf(wave_sum(a * a + c * c) + EPS) * 0.08838834764831845f; QT[i * 132 + lane] = a * sc; QT[i * 132 + 64 + lane] = c * sc; }
        { const float a = KT[i * 132 + lane], c = KT[i * 132 + 64 + lane]; const float sc = rsqrtf(wave_sum(a * a + c * c) + EPS); KT[i * 132 + lane] = a * sc; KT[i * 132 + 64 + lane] = c * sc; } }
    if (wave == 0) { const float* GAB = (const float*)(C.ws + WS_GAB) + (size_t)(tok0 + lane) * 12;
        const float av = GAB[h], bv = GAB[6 + h]; const float x = av + P->in[26][l * 6 + h]; const float sp = (x > 20.f) ? x : log1pf(__expf(x));
        float g = -__expf(P->in[25][l * 6 + h]) * sp;
#pragma unroll
        for (int o = 1; o < 64; o <<= 1) { const float t = __shfl_up(g, o); if (lane >= o) g += t; }
        const float glast = __shfl(g, 63);
        gc[lane] = g; beta[lane] = sigmoid_f(bv); eg[lane] = __expf(g); ek[lane] = __expf(glast - g);
        if (lane == 0) *(float*)(UB + 57344 + 32768) = __expf(glast); }
    __syncthreads();
    { const int fr = lane & 15, quad = lane >> 4;
#pragma unroll 1
      for (int job = wave; job < 32; job += NWAVES) { const int mat = job >> 4, ti = (job >> 2) & 3, tj = job & 3; LAS float* OUT = mat ? QKM : AM;
          f32x4 acc = (f32x4){0.f, 0.f, 0.f, 0.f};
          if (ti >= tj) { const LAS float* ap = (mat ? QT : KT) + (16 * ti + fr) * 132 + quad; const LAS float* bp = KT + (16 * tj + fr) * 132 + quad;
#pragma unroll 8
              for (int kk = 0; kk < 32; ++kk) acc = __builtin_amdgcn_mfma_f32_16x16x4f32(ap[4 * kk], bp[4 * kk], acc, 0, 0, 0); }
#pragma unroll
          for (int j = 0; j < 4; ++j) { const int i = 16 * ti + 4 * quad + j, jj = 16 * tj + fr; float v = 0.f;
              if (mat == 0) { if (i > jj) v = beta[i] * acc[j] * __expf(gc[i] - gc[jj]); } else { if (i >= jj) v = acc[j] * __expf(gc[i] - gc[jj]); }
              OUT[i * 68 + jj] = v; } } }
    __syncthreads();
    float x[64];
    if (tid < 256) { const int c = tid & 127; const bool isw = tid >= 128;
#pragma unroll
        for (int i = 0; i < 64; ++i) x[i] = isw ? KT[i * 132 + c] * beta[i] * eg[i] : VT[i * 132 + c] * beta[i]; }
    __syncthreads();
    if (tid < 256) {
        unsigned amb = GL_AM; asm volatile("" : "+v"(amb));
        const LAS float* AMv = (const LAS float*)(size_t)amb;
#pragma unroll
        for (int i = 1; i < 64; ++i) { float s0 = 0.f, s1 = 0.f, s2 = 0.f, s3 = 0.f;
#pragma unroll
            for (int j4 = 0; j4 < (i + 3) / 4; ++j4) { const f32x4 a = *(const LAS f32x4*)(AMv + i * 68 + 4 * j4); s0 += a.x * x[4 * j4]; s1 += a.y * x[4 * j4 + 1]; s2 += a.z * x[4 * j4 + 2]; s3 += a.w * x[4 * j4 + 3]; }
            x[i] -= (s0 + s1) + (s2 + s3); }
        if (tid < 128) { const int slice = tid >> 4, col = tid & 15; float* U = (float*)(UB + 57344);
#pragma unroll
            for (int mt = 0; mt < 4; ++mt)
#pragma unroll
                for (int q = 0; q < 4; ++q) *(f32x4*)(U + ((((slice * 4 + mt) * 4 + q) * 16 + col) * 4)) = (f32x4){x[16 * mt + 4 * q], x[16 * mt + 4 * q + 1], x[16 * mt + 4 * q + 2], x[16 * mt + 4 * q + 3]}; }
        else { const int c = tid - 128;
#pragma unroll
            for (int i = 0; i < 64; ++i) VT[i * 132 + c] = x[i]; } }
    __syncthreads();
    for (int pc = tid; pc < 3584; pc += NTHR) { const int ln = pc & 63, row = ln & 15, quad = ln >> 4; float v[8];
        if (pc < 2048) { const int tile = (pc >> 6) & 15, mt = tile >> 2, s = tile & 3, i = 16 * mt + row, cb = 32 * s + 4 * quad; const LAS float* src = (pc < 1024 ? VT : QT) + i * 132 + cb; const float sc = (pc < 1024) ? 1.f : eg[i];
            const f32x4 a = *(const LAS f32x4*)src, c = *(const LAS f32x4*)(src + 16);
            v[0] = a.x * sc; v[1] = a.y * sc; v[2] = a.z * sc; v[3] = a.w * sc; v[4] = c.x * sc; v[5] = c.y * sc; v[6] = c.z * sc; v[7] = c.w * sc; }
        else if (pc < 3072) { const int tile = (pc - 2048) >> 6, dt = tile >> 1, s2 = tile & 1, d = 16 * dt + row;
#pragma unroll
            for (int j = 0; j < 8; ++j) { const int jj = 32 * s2 + 4 * quad + (j & 3) + 16 * (j >> 2); v[j] = KT[jj * 132 + d] * ek[jj]; } }
        else { const int tile = (pc - 3072) >> 6, mt = tile >> 1, s2 = tile & 1, i = 16 * mt + row; const LAS float* src = QKM + i * 68 + 32 * s2 + 4 * quad;
            const f32x4 a = *(const LAS f32x4*)src, c = *(const LAS f32x4*)(src + 16);
            v[0] = a.x; v[1] = a.y; v[2] = a.z; v[3] = a.w; v[4] = c.x; v[5] = c.y; v[6] = c.z; v[7] = c.w; }
        v4u o; o.x = pk2(v[0], v[1]); o.y = pk2(v[2], v[3]); o.z = pk2(v[4], v[5]); o.w = pk2(v[6], v[7]); *(GAS v4u*)(UB + (size_t)pc * 16) = o; }
    __syncthreads();
}

__device__ __forceinline__ void gdn_seq(const Ctx& C, int bh) {
    const int b = bh / 6, h = bh % 6, slice = C.wave, lane = C.lane, col = lane & 15, quad = lane >> 4, tid = C.tid;
    const unsigned char* UB = C.ws + WS_GU + (size_t)(bh * 64) * GDN_UNIT_BYTES;
    float* OG = (float*)(C.ws + WS_OGDN) + (size_t)(b * SQ) * 768 + h * 128 + slice * 16 + col;
    u32x4_t r[7];
#pragma unroll
    for (int k = 0; k < 7; ++k) r[k] = *(const u32x4_t*)(UB + (size_t)(tid + NTHR * k) * 16);
#pragma unroll
    for (int k = 0; k < 7; ++k) *(LAS u32x4_t*)(C.lds + (size_t)(tid + NTHR * k) * 16) = r[k];
    __syncthreads();
    f32x4 S[8];
#pragma unroll
    for (int d = 0; d < 8; ++d) S[d] = (f32x4){0.f, 0.f, 0.f, 0.f};
#pragma unroll 1
    for (int n = 0; n < 64; ++n) { const LAS unsigned char* cur = C.lds + (n & 1) * 57344; const unsigned char* un = UB + (size_t)n * GDN_UNIT_BYTES;
        if (n + 1 < 64) {
#pragma unroll
            for (int k = 0; k < 7; ++k) r[k] = *(const u32x4_t*)(un + GDN_UNIT_BYTES + (size_t)(tid + NTHR * k) * 16); }
        f32x4 uu[4];
#pragma unroll
        for (int mt = 0; mt < 4; ++mt) uu[mt] = *(const f32x4*)(un + 57344 + (size_t)((((slice * 4 + mt) * 4 + quad) * 16 + col) * 16));
        const float egl = *(const float*)(un + 57344 + 32768);
        bf16x8 sb[4];
#pragma unroll
        for (int s = 0; s < 4; ++s) sb[s] = pack8(S[2 * s], S[2 * s + 1]);
        f32x4 vn[4];
#pragma unroll
        for (int mt = 0; mt < 4; ++mt) { f32x4 ws = (f32x4){0.f, 0.f, 0.f, 0.f};
#pragma unroll
            for (int s = 0; s < 4; ++s) { const bf16x8 a = *(const LAS bf16x8*)(cur + ((mt * 4 + s) * 64 + lane) * 16); ws = __builtin_amdgcn_mfma_f32_16x16x32_bf16(a, sb[s], ws, 0, 0, 0); }
            vn[mt] = uu[mt] - ws; }
        bf16x8 vb[2]; vb[0] = pack8(vn[0], vn[1]); vb[1] = pack8(vn[2], vn[3]);
#pragma unroll
        for (int mt = 0; mt < 4; ++mt) { f32x4 o = (f32x4){0.f, 0.f, 0.f, 0.f};
#pragma unroll
            for (int s = 0; s < 4; ++s) { const bf16x8 a = *(const LAS bf16x8*)(cur + 16384 + ((mt * 4 + s) * 64 + lane) * 16); o = __builtin_amdgcn_mfma_f32_16x16x32_bf16(a, sb[s], o, 0, 0, 0); }
#pragma unroll
            for (int s2 = 0; s2 < 2; ++s2) { const bf16x8 a = *(const LAS bf16x8*)(cur + 49152 + ((mt * 2 + s2) * 64 + lane) * 16); o = __builtin_amdgcn_mfma_f32_16x16x32_bf16(a, vb[s2], o, 0, 0, 0); }
#pragma unroll
            for (int j = 0; j < 4; ++j) OG[(size_t)(n * 64 + 16 * mt + 4 * quad + j) * 768] = o[j]; }
#pragma unroll
        for (int d = 0; d < 8; ++d) { f32x4 sd = S[d] * egl;
#pragma unroll
            for (int s2 = 0; s2 < 2; ++s2) { const bf16x8 a = *(const LAS bf16x8*)(cur + 32768 + ((d * 2 + s2) * 64 + lane) * 16); sd = __builtin_amdgcn_mfma_f32_16x16x32_bf16(a, vb[s2], sd, 0, 0, 0); }
            S[d] = sd; }
        if (n + 1 < 64) {
#pragma unroll
            for (int k = 0; k < 7; ++k) *(LAS u32x4_t*)(C.lds + ((n + 1) & 1) * 57344 + (size_t)(tid + NTHR * k) * 16) = r[k]; }
        __syncthreads();
    }
}

__device__ __forceinline__ void attn_queue(const Ctx& C, int l) {
    gu32* qw = C.ctl + CW_QUEUE + 64 * l;
    const attn_body::bf16* PROJ = (const attn_body::bf16*)(C.ws + WS_PROJ); attn_body::bf16* ATTO = (attn_body::bf16*)(C.ws + WS_ATTO);
    for (;;) {
        if (C.tid == 0) C.MISC[16] = __hip_atomic_fetch_add(qw, 1u, RLX_AGENT);
        __syncthreads();
        const unsigned q = C.MISC[16];
        __syncthreads();
        if (q >= 1536u) break;
        const int qb = 15 - (int)(q / 96u), r = (int)(q % 96u), b = r / 24, vh = r % 24;
        const attn_body::bf16* base = PROJ + (size_t)(b * SQ) * PW;
        attn_body::attn_unit<8>(qb, base + C_DQ + (vh >> 1) * 64, base + C_DK + (vh >> 1) * 64, base + C_DV + (vh >> 2) * 128 + (vh & 1) * 64, ATTO + (size_t)(b * SQ) * 1536 + vh * 64, (char*)C.lds);
    }
}

__device__ __forceinline__ void post_mix(const Ctx& C, KP P, int l) {
    const int lane = C.lane; const bf16* ATTO = (const bf16*)(C.ws + WS_ATTO); const float* OG = (const float*)(C.ws + WS_OGDN); const bf16* PROJ = (const bf16*)(C.ws + WS_PROJ); bf16* YCAT = (bf16*)(C.ws + WS_YCAT);
    const float linit = 0.8f - 0.6f * expf(-0.3f * (float)l);
    const float lam = expf(wave_sum(P->in[19][l * 64 + lane] * P->in[20][l * 64 + lane])) - expf(wave_sum(P->in[21][l * 64 + lane] * P->in[22][l * 64 + lane])) + linit;
    const float sl0 = P->in[23][l * 128 + 2 * lane] * (1.f - linit), sl1 = P->in[23][l * 128 + 2 * lane + 1] * (1.f - linit);
    const float gn0 = P->in[27][l * 128 + 2 * lane], gn1 = P->in[27][l * 128 + 2 * lane + 1];
    for (int it = C.blk * NWAVES + C.wave; it < TOK * 6; it += C.G * NWAVES) { const int t = it / 6, h = it % 6;
        { const unsigned o1 = *(const unsigned*)(ATTO + (size_t)t * 1536 + (2 * h) * 128 + 2 * lane), o2 = *(const unsigned*)(ATTO + (size_t)t * 1536 + (2 * h + 1) * 128 + 2 * lane);
          const float a = bflo(o1) - lam * bflo(o2), c = bfhi(o1) - lam * bfhi(o2); const float r = rsqrtf(wave_sum(a * a + c * c) * (1.f / 128.f) + EPS);
          *(unsigned*)(YCAT + (size_t)t * DM + 512 + h * 128 + 2 * lane) = pk2(a * r * sl0, c * r * sl1); }
        { const f32x2_t o = *(const f32x2_t*)(OG + (size_t)t * 768 + h * 128 + 2 * lane); const unsigned z = *(const unsigned*)(PROJ + (size_t)t * PW + C_GZ + h * 128 + 2 * lane);
          const float r = rsqrtf(wave_sum(o.x * o.x + o.y * o.y) * (1.f / 128.f) + EPS);
          *(unsigned*)(YCAT + (size_t)t * DM + 1280 + h * 128 + 2 * lane) = pk2(o.x * r * gn0 * silu_f(bflo(z)), o.y * r * gn1 * silu_f(bfhi(z))); } }
}

__device__ __forceinline__ void norm_router_phase(const Ctx& C, KP P, const float* __restrict__ nw, const float* __restrict__ mod_shift, const float* __restrict__ mod_scale) {
    LAS float* WRT = (LAS float*)C.lds;
    LAS int* esel = (LAS int*)(C.lds + 65536); LAS int* rankl = esel + 128;
    const float* wr = P->in[31];
    for (int idx = C.tid; idx < DM * 8; idx += NTHR) { const int k = idx >> 3, e = idx & 7; WRT[e * DM + k] = wr[idx]; }
    __syncthreads();
    const float* src = (const float*)(C.ws + WS_HRES); bf16* HN = (bf16*)(C.ws + WS_HN); const int lane = C.lane;
    f32x4 nwv[8];
#pragma unroll
    for (int j = 0; j < 8; ++j) nwv[j] = *(const f32x4*)(nw + 4 * lane + 256 * j);
    for (int i = 0; i < 8; ++i) { const int tl = C.wave * 8 + i, t = C.blk * 64 + tl, b = t >> 12;
        const float* xr = src + (size_t)t * DM; f32x4 v[8]; float ss = 0.f;
#pragma unroll
        for (int j = 0; j < 8; ++j) { v[j] = *(const f32x4*)(xr + 4 * lane + 256 * j); ss += (v[j].x * v[j].x + v[j].y * v[j].y) + (v[j].z * v[j].z + v[j].w * v[j].w); }
        const float r = rsqrtf(wave_sum(ss) * (1.f / DM) + EPS);
        const float* sh = mod_shift + (size_t)b * 6 * DM; const float* scp = mod_scale + (size_t)b * 6 * DM;
#pragma unroll
        for (int j = 0; j < 8; ++j) { const f32x4 s1 = *(const f32x4*)(scp + 4 * lane + 256 * j), s0 = *(const f32x4*)(sh + 4 * lane + 256 * j);
            v[j] = v[j] * r * nwv[j] * (s1 + 1.f) + s0;
            u32x2_t o; o.x = pk2(v[j].x, v[j].y); o.y = pk2(v[j].z, v[j].w); *(GAS u32x2_t*)(HN + (size_t)t * DM + 4 * lane + 256 * j) = o; }
        float lg[8];
#pragma unroll
        for (int e = 0; e < 8; ++e) { float a = 0.f;
#pragma unroll
            for (int j = 0; j < 8; ++j) { const f32x4 wv = *(const LAS f32x4*)(WRT + e * DM + 4 * lane + 256 * j); a += (v[j].x * wv.x + v[j].y * wv.y) + (v[j].z * wv.z + v[j].w * wv.w); }
            lg[e] = wave_sum(a); }
        int e0 = 0; float v0 = lg[0];
#pragma unroll
        for (int e = 1; e < 8; ++e) if (lg[e] > v0) { v0 = lg[e]; e0 = e; }
        int e1 = -1; float v1 = -INFINITY;
#pragma unroll
        for (int e = 0; e < 8; ++e) if (e != e0 && lg[e] > v1) { v1 = lg[e]; e1 = e; }
        const float g0 = 1.f / (1.f + __expf(v1 - v0)), g1 = 1.f - g0;
        if (lane == 0) { esel[2 * tl] = e0; esel[2 * tl + 1] = e1; ((int*)(C.ws + WS_TOKE))[2 * t] = e0; ((int*)(C.ws + WS_TOKE))[2 * t + 1] = e1; ((float*)(C.ws + WS_TOKG))[2 * t] = g0; ((float*)(C.ws + WS_TOKG))[2 * t + 1] = g1; }
    }
    __syncthreads();
    if (C.tid < 8) { int cnt = 0; for (int i = 0; i < 128; ++i) if (esel[i] == C.tid) rankl[i] = cnt++; ((int*)(C.ws + WS_CNT))[C.blk * 8 + C.tid] = cnt; }
    __syncthreads();
    if (C.tid < 128) ((int*)(C.ws + WS_RANK))[(size_t)C.blk * 128 + C.tid] = rankl[C.tid];
    __syncthreads();
}

__device__ __forceinline__ void route_phase(const Ctx& C) {
    LAS int* tot = (LAS int*)C.lds; LAS int* pre = tot + 8; LAS int* base = tot + 16;
    const int* CNT = (const int*)(C.ws + WS_CNT);
    if (C.tid < 8) { int s = 0, mine = 0; for (int bb = 0; bb < C.G; ++bb) { const int c = CNT[bb * 8 + C.tid]; if (bb < C.blk) mine += c; s += c; } tot[C.tid] = s; pre[C.tid] = mine; }
    __syncthreads();
    if (C.tid == 0) { int run = 0; int* TILE = (int*)(C.ws + WS_TILE);
        for (int e = 0; e < 8; ++e) { base[e] = run; const int nt = (tot[e] + 255) >> 8; if (C.blk == 0) for (int q = 0; q < nt; ++q) TILE[1 + (run >> 8) + q] = e; run += nt << 8; }
        if (C.blk == 0) TILE[0] = run >> 8; }
    __syncthreads();
    const int* TOKE = (const int*)(C.ws + WS_TOKE); const float* TOKG = (const float*)(C.ws + WS_TOKG); const int* RANK = (const int*)(C.ws + WS_RANK);
    int* POS = (int*)(C.ws + WS_POS); float* GW = (float*)(C.ws + WS_GW); const bf16* HN = (const bf16*)(C.ws + WS_HN); bf16* AS = (bf16*)(C.ws + WS_AS);
    for (int i = 0; i < 8; ++i) { const int t = C.blk * 64 + C.wave * 8 + i;
        const int e0 = TOKE[2 * t], e1 = TOKE[2 * t + 1]; const int p0 = base[e0] + pre[e0] + RANK[2 * t], p1 = base[e1] + pre[e1] + RANK[2 * t + 1];
        if (C.lane == 0) { POS[2 * t] = p0; POS[2 * t + 1] = p1; GW[p0] = TOKG[2 * t]; GW[p1] = TOKG[2 * t + 1]; }
#pragma unroll
        for (int j = 0; j < 4; ++j) { const u32x4_t v = *(const u32x4_t*)(HN + (size_t)t * DM + 8 * C.lane + 512 * j); *(u32x4_t*)(AS + (size_t)p0 * DM + 8 * C.lane + 512 * j) = v; *(u32x4_t*)(AS + (size_t)p1 * DM + 8 * C.lane + 512 * j) = v; } }
    __syncthreads();
}

__device__ __forceinline__ void final_phase(const Ctx& C, KP P) {
    const float* HR = (const float*)(C.ws + WS_HRES); const bf16* YS = (const bf16*)(C.ws + WS_AS); const int* POS = (const int*)(C.ws + WS_POS);
    const float* gate2 = (const float*)(C.ws + WS_MOD) + (size_t)(1 * 4) * 6 * DM + 5 * DM; const float* nf = P->in[7]; const int lane = C.lane;
    for (int t = C.blk * NWAVES + C.wave; t < TOK; t += C.G * NWAVES) { const int b = t >> 12, p0 = POS[2 * t], p1 = POS[2 * t + 1];
        f32x4 v[8]; float ss = 0.f;
#pragma unroll
        for (int j = 0; j < 8; ++j) { const int c = 4 * lane + 256 * j; const f32x4 hr = *(const f32x4*)(HR + (size_t)t * DM + c), g = *(const f32x4*)(gate2 + (size_t)b * 6 * DM + c);
            const u32x2_t y0 = *(const u32x2_t*)(YS + (size_t)p0 * DM + c), y1 = *(const u32x2_t*)(YS + (size_t)p1 * DM + c);
            const f32x4 y = (f32x4){bflo(y0.x) + bflo(y1.x), bfhi(y0.x) + bfhi(y1.x), bflo(y0.y) + bflo(y1.y), bfhi(y0.y) + bfhi(y1.y)};
            v[j] = hr + g * y; ss += (v[j].x * v[j].x + v[j].y * v[j].y) + (v[j].z * v[j].z + v[j].w * v[j].w); }
        const float r = rsqrtf(wave_sum(ss) * (1.f / DM) + EPS);
#pragma unroll
        for (int j = 0; j < 8; ++j) { const int c = 4 * lane + 256 * j; *(f32x4*)(P->out + (size_t)t * DM + c) = v[j] * r * *(const f32x4*)(nf + c); } }
}

#ifndef MK_N_LAUNCHES
#define MK_N_LAUNCHES 1
#endif
constexpr int N_PHASES = 24;

template <int L>
__device__ __forceinline__ void layer_phases(const Ctx& C0, KP P0, const XcdBarrier& bar, int lo, int hi) {
#define IN(k) (lo <= (k) && (k) < hi)
#define SEAM(k) do { if (IN(k) && IN((k) + 1)) xcd_barrier(bar); } while (0)
    constexpr int PB = 1 + 11 * L;
#define PHASE_ENV Ctx C = C0; KP P = P0; asm volatile("" : "+s"(C.ws), "+s"(P)); unsigned char* ws = C.ws; C.ctl = (gu32*)(ws + WS_CTL); \
    C.tid = threadIdx.x; asm volatile("" : "+v"(C.tid)); C.lane = C.tid & 63; C.wave = __builtin_amdgcn_readfirstlane(C.tid >> 6); \
    const float* MOD = (const float*)(ws + WS_MOD) + (size_t)(L * 4) * 6 * DM; float* HRES = (float*)(ws + WS_HRES); bf16* HN = (bf16*)(ws + WS_HN); bf16* PROJ = (bf16*)(ws + WS_PROJ); bf16* YCAT = (bf16*)(ws + WS_YCAT); \
    (void)MOD; (void)HRES; (void)HN; (void)PROJ; (void)YCAT; (void)P;
    if (IN(PB + 0)) { PHASE_ENV norm_phase<true>(C, L == 0 ? P->in[0] : HRES, P->in[5] + L * DM, MOD + 0 * DM, MOD + 1 * DM, P->in[8] + (size_t)L * DM * INW); }
    SEAM(PB + 0);
    if (IN(PB + 1)) { PHASE_ENV pg8::Gemm g{HN, (const bf16*)(ws + WS_WIN) + (size_t)L * PW * DM, TOK, PW, DM}; pg8::StaticOrder S; S.init(TOK, PW, C.G, C.blk); pg8::EpiProj E{PROJ};
        pg8::gemm_phase<pg8::EpiProj, pg8::StaticOrder, true, true>(C.lds, g, S, E); }
    SEAM(PB + 1);
    if (IN(PB + 2)) { PHASE_ENV rope_pass(C); ssm_gemm_a(C, L);
#pragma unroll 1
        for (int u = C.blk; u < 1536; u += C.G) gdn_prep_unit(C, P, L, u); }
    SEAM(PB + 2);
    if (IN(PB + 3)) { PHASE_ENV if (C.blk < 24) gdn_seq(C, C.blk); else if (C.blk >= C.G - 16) ssm_scan(C, L, C.blk - (C.G - 16)); attn_queue(C, L); }
    SEAM(PB + 3);
    if (IN(PB + 4)) { PHASE_ENV ssm_gemm_b(C, L); post_mix(C, P, L); }
    SEAM(PB + 4);
    if (IN(PB + 5)) { PHASE_ENV pg8::Gemm g{(const bf16*)(ws + WS_YGELU), (const bf16*)(ws + WS_WGLU) + (size_t)L * 512 * 512, TOK, 512, 512}; pg8::StaticOrder S; S.init(TOK, 512, C.G, C.blk); pg8::EpiGlu E{(const bf16*)(ws + WS_YGELU), YCAT};
        pg8::gemm_phase<pg8::EpiGlu, pg8::StaticOrder, true, true>(C.lds, g, S, E); }
    SEAM(PB + 5);
    if (IN(PB + 6)) { PHASE_ENV pg8::Gemm g{YCAT, (const bf16*)(ws + WS_WOUT) + (size_t)L * DM * DM, TOK, DM, DM}; pg8::StaticOrder S; S.init(TOK, DM, C.G, C.blk); pg8::EpiRes E{L == 0 ? P->in[0] : HRES, HRES, MOD + 2 * DM};
        pg8::gemm_phase<pg8::EpiRes, pg8::StaticOrder, true, true>(C.lds, g, S, E); }
    SEAM(PB + 6);
    if (L == 0) {
        if (IN(PB + 7)) { PHASE_ENV norm_phase<false>(C, HRES, P->in[6] + L * DM, MOD + 3 * DM, MOD + 4 * DM, nullptr); }
        SEAM(PB + 7);
        SEAM(PB + 8);
        if (IN(PB + 9)) { PHASE_ENV pg8::Gemm g{HN, (const bf16*)(ws + WS_WUP), TOK, 2 * DFF, DM}; pg8::StaticOrder S; S.init(TOK, 2 * DFF, C.G, C.blk); pg8::EpiSwiglu E{(bf16*)(ws + WS_H), DFF, 2 * DFF / 256};
            pg8::gemm_phase<pg8::EpiSwiglu, pg8::StaticOrder, true, true>(C.lds, g, S, E); }
        SEAM(PB + 9);
        if (IN(PB + 10)) { PHASE_ENV pg8::Gemm g{(const bf16*)(ws + WS_H), (const bf16*)(ws + WS_WDN), TOK, DM, DFF}; pg8::StaticOrder S; S.init(TOK, DM, C.G, C.blk); pg8::EpiRes E{HRES, HRES, MOD + 5 * DM};
            pg8::gemm_phase<pg8::EpiRes, pg8::StaticOrder, true, true>(C.lds, g, S, E); }
        SEAM(PB + 10);
    } else {
        if (IN(PB + 7)) { PHASE_ENV norm_router_phase(C, P, P->in[6] + L * DM, MOD + 3 * DM, MOD + 4 * DM); }
        SEAM(PB + 7);
        if (IN(PB + 8)) { PHASE_ENV route_phase(C); }
        SEAM(PB + 8);
        if (IN(PB + 9)) { PHASE_ENV LAS int* TL = (LAS int*)(C.lds + TILE_OFF); for (int i = C.tid; i <= MOE_TILES_MAX; i += NTHR) TL[i] = ((const int*)(ws + WS_TILE))[i]; __syncthreads(); const int R = TL[0];
            pg8::Gemm g{(const bf16*)(ws + WS_AS), (const bf16*)(ws + WS_MUP), R * 256, 2 * DFE, DM}; pg8::MoeOrder S; S.so.init(R * 256, 2 * DFE, C.G, C.blk); S.tile_e = TL + 1; S.nct = 2 * DFE / 256; pg8::EpiSwiglu E{(bf16*)(ws + WS_H), DFE, 2 * DFE / 256};
            pg8::gemm_phase<pg8::EpiSwiglu, pg8::MoeOrder, true, true>(C.lds, g, S, E); }
        SEAM(PB + 9);
        if (IN(PB + 10)) { PHASE_ENV LAS int* TL = (LAS int*)(C.lds + TILE_OFF); for (int i = C.tid; i <= MOE_TILES_MAX; i += NTHR) TL[i] = ((const int*)(ws + WS_TILE))[i]; __syncthreads(); const int R = TL[0];
            pg8::Gemm g{(const bf16*)(ws + WS_H), (const bf16*)(ws + WS_MDN), R * 256, DM, DFE}; pg8::MoeOrder S; S.so.init(R * 256, DM, C.G, C.blk); S.tile_e = TL + 1; S.nct = DM / 256; pg8::EpiMoeDown E{(bf16*)(ws + WS_AS), (const float*)(ws + WS_GW)};
            pg8::gemm_phase<pg8::EpiMoeDown, pg8::MoeOrder, true, true>(C.lds, g, S, E); }
        SEAM(PB + 10);
    }
#undef IN
#undef SEAM
#undef PHASE_ENV
}

__global__ void __launch_bounds__(NTHR, 2) mk_fwd(Params P) {
    extern __shared__ __attribute__((aligned(16))) unsigned char lds[];
    KP KPp = (KP)__builtin_amdgcn_kernarg_segment_ptr();
    Ctx C; C.lds = (LAS unsigned char*)lds; C.MISC = (volatile LAS unsigned*)(C.lds + MISC_OFF); C.ws = KPp->ws; C.ctl = (gu32*)(C.ws + WS_CTL);
    C.tid = threadIdx.x; C.lane = C.tid & 63; C.wave = __builtin_amdgcn_readfirstlane(C.tid >> 6); C.blk = blockIdx.x; C.G = gridDim.x;
    for (int u = C.tid; u < (LDS_BYTES - TILE_OFF) / 4; u += NTHR) ((LAS unsigned*)(C.lds + TILE_OFF))[u] = 0u;
    __syncthreads();
    const int lo = KPp->ph_lo, hi = KPp->ph_hi;
    XcdBarrier bar = xcd_barrier_post((unsigned*)(C.ctl + CW_BAR) + (MK_N_LAUNCHES == 1 ? 0 : lo) * XCD_BAR_WORDS, C.MISC + 8);
    if (lo <= 0 && 0 < hi) { Ctx Cp = C; KP Pp = KPp; asm volatile("" : "+s"(Cp.ws), "+s"(Pp)); Cp.tid = threadIdx.x; asm volatile("" : "+v"(Cp.tid)); Cp.lane = Cp.tid & 63; Cp.wave = __builtin_amdgcn_readfirstlane(Cp.tid >> 6); p0_prologue(Cp, Pp); if (1 < hi) xcd_barrier(bar); }
    layer_phases<0>(C, KPp, bar, lo, hi);
    layer_phases<1>(C, KPp, bar, lo, hi);
    if (lo <= 23 && 23 < hi) { Ctx Cp = C; KP Pp = KPp; asm volatile("" : "+s"(Cp.ws), "+s"(Pp)); Cp.tid = threadIdx.x; asm volatile("" : "+v"(Cp.tid)); Cp.lane = Cp.tid & 63; Cp.wave = __builtin_amdgcn_readfirstlane(Cp.tid >> 6); final_phase(Cp, Pp); }
}

extern "C" void kernel_launch(void* const* d_in, const int* in_sizes, int n_in, void* d_out, int out_size, void* d_ws, size_t ws_size, hipStream_t stream) {
    static int grid = 0;
    if (grid == 0) {
        if (n_in != 35 || in_sizes[0] != TOK * DM || out_size != TOK * DM || ws_size < WS_END) { fprintf(stderr, "kernel_launch: unexpected problem: n_in %d in0 %d out %d ws %zu (need %zu)\n", n_in, n_in > 0 ? in_sizes[0] : -1, out_size, ws_size, (size_t)WS_END); grid = -1; return; }
        int dev = 0, cus = 0, per_cu = 0;
        if (hipGetDevice(&dev) != hipSuccess || hipDeviceGetAttribute(&cus, hipDeviceAttributeMultiprocessorCount, dev) != hipSuccess) { grid = -1; return; }
        if (hipFuncSetAttribute((const void*)mk_fwd, hipFuncAttributeMaxDynamicSharedMemorySize, LDS_BYTES) != hipSuccess) { fprintf(stderr, "kernel_launch: hipFuncSetAttribute failed\n"); grid = -1; return; }
        if (hipOccupancyMaxActiveBlocksPerMultiprocessor(&per_cu, (const void*)mk_fwd, NTHR, LDS_BYTES) != hipSuccess || per_cu < 1) fprintf(stderr, "kernel_launch: occupancy query says %d\n", per_cu);
        (void)hipGetLastError();
        grid = 256;
        if (cus < 256) { fprintf(stderr, "kernel_launch: device has %d CUs, this kernel needs 256\n", cus); grid = -1; return; }
    }
    if (grid < 0) return;
    if (hipMemsetAsync((char*)d_ws + WS_CTL, 0, CTL_ZERO_BYTES, stream) != hipSuccess) return;
    Params p{};
    for (int i = 0; i < 35; ++i) p.in[i] = (const float*)d_in[i];
    p.out = (float*)d_out; p.ws = (unsigned char*)d_ws;
#if MK_N_LAUNCHES == 1
    p.ph_lo = 0; p.ph_hi = N_PHASES;
    hipLaunchKernelGGL(mk_fwd, dim3(grid), dim3(NTHR), LDS_BYTES, stream, p);
#else
    for (int k = 0; k < N_PHASES; ++k) { p.ph_lo = k; p.ph_hi = k + 1; hipLaunchKernelGGL(mk_fwd, dim3(grid), dim3(NTHR), LDS_BYTES, stream, p); }
#endif
}
```

```cpp
#include <hip/hip_runtime.h>
#include <hip/hip_bf16.h>
#include <cstdio>
#include <cstdint>
#include <cmath>
__device__ __forceinline__ int mk_lane() { int l = (int)__builtin_amdgcn_mbcnt_hi(~0u, __builtin_amdgcn_mbcnt_lo(~0u, 0u)); asm volatile("" : "+v"(l)); return l; }
namespace pg8 {
#define PG8_LAS __attribute__((address_space(3)))
typedef unsigned short bf16_t;
typedef short bf16x8 __attribute__((ext_vector_type(8)));
typedef float f32x4 __attribute__((ext_vector_type(4)));
typedef unsigned u32x4 __attribute__((ext_vector_type(4)));
constexpr int BM = 256, BK = 64, HALF = 128, HTB = HALF * BK * 2  , STAGE_BYTES = 8 * HTB, NXCD = 8, WGM = 8;

__host__ __device__ __forceinline__ int lds_byte(int r, int c) { const int st = (r >> 4) * 2 + (c >> 5), rr = r & 15, cc = c & 31, ob = rr * 64 + cc * 2; return st * 1024 + (ob ^ (((ob >> 9) & 1) << 5)); }
__host__ __device__ __forceinline__ void stage_rc(int b, int& R, int& C) { const int st = b / 1024, sb = b % 1024, swz = sb ^ (((sb >> 9) & 1) << 5); R = (st >> 1) * 16 + swz / 64; C = (st & 1) * 32 + (swz % 64) / 2; }
__host__ __device__ __forceinline__ int perm32(int rho) { const int n = rho >> 4, i = rho & 15; return 8 * (i >> 2) + 4 * n + (i & 3); }

struct Unit { int pm, pn, aux = 0, kt0 = 0, nt = 0, ks = 0, slot = 0; };
struct Gemm { const bf16_t* A; const bf16_t* Bt; int M, N, K; };

struct StaticOrder {
    static constexpr bool SPLITK = false;
    int nM, nN, nwg, G, c;
    __host__ __device__ void init(int M, int N, int G_, int c_) { nM = M / BM; nN = N / BM; nwg = nM * nN; G = G_; c = c_; }
    __host__ __device__ bool next(int i, Unit& u) const {
        const long L = (long)i * G + c; if (L >= nwg) return false;
        int wgid = (int)L; { const int q = nwg / NXCD, r = nwg % NXCD, xcd = wgid % NXCD, off = wgid / NXCD; wgid = (xcd < r ? xcd * (q + 1) : r * (q + 1) + (xcd - r) * q) + off; }
        const int nig = WGM * nN, gid = wgid / nig, fm = gid * WGM, gsz = (nM - fm) < WGM ? (nM - fm) : WGM;
        u.pm = fm + ((wgid % nig) % gsz); u.pn = (wgid % nig) / gsz; return true;
    }
    __device__ __forceinline__ void a_ready(const Unit&) const {}
    __device__ __forceinline__ void done(const Unit&) const {}
};

__device__ __forceinline__ unsigned cvt_pk_bf16(float lo, float hi) { unsigned r; asm volatile("v_cvt_pk_bf16_f32 %0, %1, %2" : "=v"(r) : "v"(lo), "v"(hi)); return r; }
typedef float f32x2 __attribute__((ext_vector_type(2)));
__device__ __forceinline__ f32x2 gelu_pk(f32x2 v) {
    const f32x2 av = __builtin_elementwise_abs(v), d = av * 0.2316418882f + 1.0f;
    f32x2 t; t.x = __builtin_amdgcn_rcpf(d.x); t.y = __builtin_amdgcn_rcpf(d.y);
    f32x2 q = t * 0.5307027145f + (-0.7265760135f); q = q * t + 0.7107068705f; q = q * t + (-0.142248368f); q = q * t + 0.127414796f; q = q * t;
    const f32x2 s = (v * v) * (-0.72134752044f);
    f32x2 e; e.x = __builtin_amdgcn_exp2f(s.x); e.y = __builtin_amdgcn_exp2f(s.y);
    const f32x2 m = v * (q * e), r = v - m;
    f32x2 o; o.x = v.x < 0.f ? m.x : r.x; o.y = v.y < 0.f ? m.y : r.y; return o;
}

template <int ACT  > struct EpiBf16 {
    static constexpr bool PERM = true, AFTER_DRAIN = false; static_assert(ACT == 0 || ACT == 1, "EpiBf16: ACT is 0 (none) or 1 (gelu_pk)");
    bf16_t* O; int ldc; const float* bias; int split_cols; size_t split_stride; float scale0;
    __device__ __forceinline__ void operator()(const f32x4 (&acc)[2][2][4][2], const Unit& u, int wr, int wc, int fr, int fq) const {
        const int row0 = u.pm * BM + wr * 64 + fr; int colt = u.pn * BM; bf16_t* base = O;
        float sc = 1.f; if (split_cols) { const int t = colt / split_cols; base += (size_t)t * split_stride; colt -= t * split_cols; if (t == 0) sc = scale0; }
        const int col0 = colt + wc * 32 + 8 * fq, bcol0 = u.pn * BM + wc * 32 + 8 * fq;
        f32x4 bv[2][2];
#pragma unroll
        for (int bj = 0; bj < 2; ++bj)
#pragma unroll
            for (int n = 0; n < 2; ++n) bv[bj][n] = bias ? *(const f32x4*)(bias + bcol0 + bj * HALF + 4 * n) : (f32x4){0.f, 0.f, 0.f, 0.f};
#pragma unroll
        for (int ai = 0; ai < 2; ++ai)
#pragma unroll
            for (int m = 0; m < 4; ++m) { bf16_t* rowp = base + (size_t)(row0 + ai * HALF + m * 16) * ldc + col0;
#pragma unroll
                for (int bj = 0; bj < 2; ++bj) { f32x4 v0 = acc[ai][bj][m][0] + bv[bj][0], v1 = acc[ai][bj][m][1] + bv[bj][1];
                    if (ACT == 1) { f32x2 a = gelu_pk((f32x2){v0[0], v0[1]}), b = gelu_pk((f32x2){v0[2], v0[3]}), c = gelu_pk((f32x2){v1[0], v1[1]}), d = gelu_pk((f32x2){v1[2], v1[3]});
                        v0 = (f32x4){a.x, a.y, b.x, b.y}; v1 = (f32x4){c.x, c.y, d.x, d.y}; }
                    v0 = v0 * sc; v1 = v1 * sc; u32x4 w; w.x = cvt_pk_bf16(v0[0], v0[1]); w.y = cvt_pk_bf16(v0[2], v0[3]); w.z = cvt_pk_bf16(v1[0], v1[1]); w.w = cvt_pk_bf16(v1[2], v1[3]);
                    *(u32x4*)(rowp + bj * HALF) = w; } }
    }
};

typedef int v8i_t __attribute__((ext_vector_type(8))); typedef int v4i_t __attribute__((ext_vector_type(4)));
__device__ __forceinline__ v8i_t cat8(const bf16x8& a, const bf16x8& b) { return __builtin_shufflevector(__builtin_bit_cast(v4i_t, a), __builtin_bit_cast(v4i_t, b), 0, 1, 2, 3, 4, 5, 6, 7); }
template <class Epi, class Sched, bool ALIGN_EPI = false, bool SP2 = false, bool FP8 = false>
__device__ __forceinline__ void gemm_phase(PG8_LAS unsigned char* lds, const Gemm g, const Sched& S, const Epi& E, const int wv  ) {
    const int lane = mk_lane(), wid = wv, tid = wv * 64 + lane, wr = wid >> 2, wc = wid & 3, fr = lane & 15, fq = lane >> 4;
    const int K = g.K, nt = K / BK;
    unsigned voffA[2], voffB[2];
#pragma unroll
    for (int i = 0; i < 2; ++i) { int R, C; stage_rc(tid * 16 + i * 8192, R, C); const int Rb = Epi::PERM ? ((R & ~31) + perm32(R & 31)) : R;
        voffA[i] = (unsigned)(R * K + C) * 2u; voffB[i] = (unsigned)(Rb * K + C) * 2u; }
    const size_t kstep = (size_t)(BK * 2);
    const size_t hstep = (size_t)HALF * K * 2;
    const size_t tstep = 2 * hstep;
    const unsigned ldsw = (unsigned)wid * 1024u;
    const int aoff = lds_byte(wr * 64 + fr, fq * 8), boff = lds_byte(wc * 32 + fr, fq * 8);
#define PG8_SA(b, h) (((b) * 2 + (h)) * HTB)
#define PG8_SB(b, h) ((4 + (b) * 2 + (h)) * HTB)
#define PG8_STAGE(bufoff, gbase, voff) do { _Pragma("unroll") for (int _i = 0; _i < 2; ++_i) \
        __builtin_amdgcn_global_load_lds((const unsigned*)((const char*)(gbase) + (voff)[_i]), (PG8_LAS unsigned*)(lds + (bufoff) + ldsw + _i * 8192), 16, 0, 0); } while (0)
#define PG8_LDA(dst, b, h) do { _Pragma("unroll") for (int m = 0; m < 4; ++m) _Pragma("unroll") for (int k = 0; k < 2; ++k) dst[m][k] = *(const PG8_LAS bf16x8*)(lds + PG8_SA(b, h) + aoff + m * 2048 + k * 1024); } while (0)
#define PG8_LDB(dst, b, h) do { _Pragma("unroll") for (int n = 0; n < 2; ++n) _Pragma("unroll") for (int k = 0; k < 2; ++k) dst[n][k] = *(const PG8_LAS bf16x8*)(lds + PG8_SB(b, h) + boff + n * 2048 + k * 1024); } while (0)
#define PG8_MMA(ai, bj, At, Bt) do { __builtin_amdgcn_s_setprio(1); \
        if constexpr (FP8) { asm volatile("s_nop 1" ::: ); _Pragma("unroll") for (int m = 0; m < 4; ++m) _Pragma("unroll") for (int n = 0; n < 2; ++n) \
            asm volatile("v_mfma_scale_f32_16x16x128_f8f6f4 %0, %1, %2, %0, %3, %3 op_sel_hi:[0,0,0]" : "+v"(acc[ai][bj][m][n]) : "v"(cat8(Bt[n][0], Bt[n][1])), "v"(cat8(At[m][0], At[m][1])), "v"(sc_one)); } \
        else { _Pragma("unroll") for (int m = 0; m < 4; ++m) _Pragma("unroll") for (int n = 0; n < 2; ++n) _Pragma("unroll") for (int k = 0; k < 2; ++k) \
            acc[ai][bj][m][n] = __builtin_amdgcn_mfma_f32_16x16x32_bf16(Bt[n][k], At[m][k], acc[ai][bj][m][n], 0, 0, 0); } \
        __builtin_amdgcn_s_setprio(0); } while (0)
#define PG8_WAIT_V(n) asm volatile("s_waitcnt vmcnt(" #n ")" ::: "memory")
#define PG8_WAIT_L(n) asm volatile("s_waitcnt lgkmcnt(" #n ")" ::: "memory")
#define PG8_BAR __builtin_amdgcn_s_barrier()
#define PG8_SCHED __builtin_amdgcn_sched_barrier(0)
    Unit cur, nxt; int ui = 0;
    if (!S.next(0, cur)) return;
    unsigned sc_one = 0x7f7f7f7fu; asm volatile("" : "+v"(sc_one));
    (void)sc_one;
    f32x4 acc[2][2][4][2];
#pragma unroll
    for (int a = 0; a < 2; ++a)
#pragma unroll
        for (int b = 0; b < 2; ++b)
#pragma unroll
            for (int m = 0; m < 4; ++m)
#pragma unroll
                for (int n = 0; n < 2; ++n) acc[a][b][m][n] = (f32x4){0.f, 0.f, 0.f, 0.f};
    bf16x8 At[4][2], B0[2][2], B1[2][2];
    const char* cA = (const char*)g.A + (size_t)cur.pm * tstep; const char* cB = (const char*)g.Bt + (size_t)cur.pn * tstep;
    if constexpr (Sched::SPLITK) { cA += (size_t)cur.kt0 * kstep; cB += (size_t)cur.kt0 * kstep; }
    S.a_ready(cur);
    if constexpr (SP2) {
        PG8_STAGE(PG8_SB(0, 0), cB, voffB); PG8_STAGE(PG8_SB(0, 1), cB + hstep, voffB); PG8_STAGE(PG8_SA(0, 0), cA, voffA); PG8_STAGE(PG8_SA(0, 1), cA + hstep, voffA);
        if (wr == 1) PG8_BAR;
        PG8_WAIT_V(2); PG8_BAR;
        PG8_STAGE(PG8_SB(1, 0), cB + kstep, voffB); PG8_STAGE(PG8_SA(1, 0), cA + kstep, voffA); PG8_STAGE(PG8_SB(1, 1), cB + hstep + kstep, voffB);
        PG8_WAIT_V(6); PG8_BAR;
    } else {
        PG8_STAGE(PG8_SB(0, 0), cB, voffB); PG8_STAGE(PG8_SA(0, 0), cA, voffA); PG8_STAGE(PG8_SB(0, 1), cB + hstep, voffB); PG8_STAGE(PG8_SA(0, 1), cA + hstep, voffA);
        if (wr == 1) PG8_BAR;
        PG8_WAIT_V(4); PG8_BAR;
        PG8_STAGE(PG8_SB(1, 0), cB + kstep, voffB); PG8_STAGE(PG8_SA(1, 0), cA + kstep, voffA); PG8_STAGE(PG8_SB(1, 1), cB + hstep + kstep, voffB);
        PG8_WAIT_V(6); PG8_BAR;
    }
    for (;;) {
        const bool has_next = S.next(ui + 1, nxt);
        const char* nA = has_next ? (const char*)g.A + (size_t)nxt.pm * tstep : cA; const char* nB = has_next ? (const char*)g.Bt + (size_t)nxt.pn * tstep : cB;
        if constexpr (Sched::SPLITK) { if (has_next) { nA += (size_t)nxt.kt0 * kstep; nB += (size_t)nxt.kt0 * kstep; } }
        const int cnt = Sched::SPLITK ? cur.nt : nt;
        for (int t = 0; t < cnt; t += 2) {
            const bool last = (t == cnt - 2);
            const char* a1 = cA + (size_t)(t + 1) * kstep;
            const char* a2 = last ? nA : cA + (size_t)(t + 2) * kstep; const char* b2 = last ? nB : cB + (size_t)(t + 2) * kstep;
            const char* a3 = a2 + kstep; const char* b3 = b2 + kstep;
            if (last && has_next) S.a_ready(nxt);
            if constexpr (SP2) {
            PG8_LDB(B0, 0, 0); PG8_LDB(B1, 0, 1); PG8_SCHED; PG8_LDA(At, 0, 0); PG8_STAGE(PG8_SA(1, 1), a1 + hstep, voffA);
            PG8_WAIT_V(8); PG8_WAIT_L(0); PG8_BAR; PG8_MMA(0, 0, At, B0); PG8_MMA(0, 1, At, B1); PG8_BAR; PG8_SCHED;
            PG8_LDA(At, 0, 1); PG8_STAGE(PG8_SB(0, 0), b2, voffB); PG8_STAGE(PG8_SB(0, 1), b2 + hstep, voffB); PG8_STAGE(PG8_SA(0, 0), a2, voffA);
            PG8_WAIT_V(8); PG8_WAIT_L(0); PG8_BAR; PG8_MMA(1, 0, At, B0); PG8_MMA(1, 1, At, B1); PG8_BAR; PG8_SCHED;
            PG8_LDB(B0, 1, 0); PG8_LDB(B1, 1, 1); PG8_SCHED; PG8_LDA(At, 1, 0); PG8_STAGE(PG8_SA(0, 1), a2 + hstep, voffA);
            PG8_WAIT_V(8); PG8_WAIT_L(0); PG8_BAR; PG8_MMA(0, 0, At, B0); PG8_MMA(0, 1, At, B1); PG8_BAR; PG8_SCHED;
            PG8_LDA(At, 1, 1); PG8_STAGE(PG8_SB(1, 0), b3, voffB); PG8_STAGE(PG8_SB(1, 1), b3 + hstep, voffB); PG8_STAGE(PG8_SA(1, 0), a3, voffA);
            PG8_WAIT_V(8); PG8_WAIT_L(0); PG8_BAR; PG8_MMA(1, 0, At, B0); PG8_MMA(1, 1, At, B1); PG8_BAR; PG8_SCHED;
            } else {
            PG8_LDB(B0, 0, 0); PG8_SCHED; PG8_LDA(At, 0, 0); PG8_STAGE(PG8_SA(1, 1), a1 + hstep, voffA);
            PG8_WAIT_L(8); PG8_BAR; PG8_WAIT_L(0); PG8_MMA(0, 0, At, B0); PG8_BAR; PG8_SCHED;
            PG8_LDB(B1, 0, 1); PG8_STAGE(PG8_SB(0, 0), b2, voffB);
            PG8_BAR; PG8_WAIT_L(0); PG8_MMA(0, 1, At, B1); PG8_BAR;
            PG8_LDA(At, 0, 1); PG8_STAGE(PG8_SA(0, 0), a2, voffA);
            PG8_BAR; PG8_WAIT_L(0); PG8_MMA(1, 0, At, B0); PG8_BAR; PG8_SCHED;
            PG8_STAGE(PG8_SB(0, 1), b2 + hstep, voffB);
            PG8_WAIT_V(6); PG8_BAR; PG8_MMA(1, 1, At, B1); PG8_BAR;
            PG8_LDB(B0, 1, 0); PG8_SCHED; PG8_LDA(At, 1, 0); PG8_STAGE(PG8_SA(0, 1), a2 + hstep, voffA);
            PG8_WAIT_L(8); PG8_BAR; PG8_WAIT_L(0); PG8_MMA(0, 0, At, B0); PG8_BAR; PG8_SCHED;
            PG8_LDB(B1, 1, 1); PG8_STAGE(PG8_SB(1, 0), b3, voffB);
            PG8_BAR; PG8_WAIT_L(0); PG8_MMA(0, 1, At, B1); PG8_BAR;
            PG8_LDA(At, 1, 1); PG8_STAGE(PG8_SA(1, 0), a3, voffA);
            PG8_BAR; PG8_WAIT_L(0); PG8_MMA(1, 0, At, B0); PG8_BAR; PG8_SCHED;
            PG8_STAGE(PG8_SB(1, 1), b3 + hstep, voffB);
            PG8_WAIT_V(6); PG8_BAR; PG8_MMA(1, 1, At, B1); PG8_BAR;
            }
        }
        if constexpr (FP8) asm volatile("s_nop 15\n\ts_nop 15" ::: );
        if constexpr (ALIGN_EPI) { if (wr == 0) PG8_BAR; }
        if constexpr (!Epi::AFTER_DRAIN) { E(acc, cur, wr, wc, fr, fq); S.done(cur); }
        if (!has_next) break;
#pragma unroll
        for (int a = 0; a < 2; ++a)
#pragma unroll
            for (int b = 0; b < 2; ++b)
#pragma unroll
                for (int m = 0; m < 4; ++m)
#pragma unroll
                    for (int n = 0; n < 2; ++n) acc[a][b][m][n] = (f32x4){0.f, 0.f, 0.f, 0.f};
        cur = nxt; cA = nA; cB = nB; ++ui;
        if constexpr (ALIGN_EPI) { if (wr == 1) PG8_BAR; }
    }
    PG8_WAIT_V(0);
    if constexpr (!ALIGN_EPI) { if (wr == 0) PG8_BAR; }
    PG8_BAR;
    if constexpr (Epi::AFTER_DRAIN) { E.fused(acc, cur, wr, wc, fr, fq, lds, wid, lane); S.done(cur); }
#undef PG8_SA
#undef PG8_SB
#undef PG8_STAGE
#undef PG8_LDA
#undef PG8_LDB
#undef PG8_MMA
#undef PG8_WAIT_V
#undef PG8_WAIT_L
#undef PG8_BAR
#undef PG8_SCHED
}
}
#include <hip/hip_bf16.h>
#include <cmath>
namespace attn_body {
using bf16=__hip_bfloat16;
using bf16x8=__attribute__((ext_vector_type(8)))short;
using s16x4=__attribute__((ext_vector_type(4)))short;
using f32x16=__attribute__((ext_vector_type(16)))float;
using u32x4=__attribute__((ext_vector_type(4)))unsigned;
constexpr int SEQ=4096,D=64,PITCH=5888,OPITCH=1536;
constexpr int NW=8,QBLK=32,QB=QBLK*NW,KVBLK=64,NQB=SEQ/QB;
constexpr int ATTN_UNIT_ROWS=QB;
__device__ __forceinline__ int crow(int r,int hi){return (r&3)+8*(r>>2)+4*hi;}
#define SBAR() __builtin_amdgcn_sched_barrier(0)
__device__ __forceinline__ void cmask(f32x16&p0,f32x16&p1,int jb,int qrel,int hi){
  const float NEG=-INFINITY; int kb=64*jb+4*hi;
  #pragma unroll
  for(int r=0;r<16;++r){int kv=kb+(r&3)+8*(r>>2); if(kv>qrel)p0[r]=NEG; if(kv+32>qrel)p1[r]=NEG;}
}

constexpr int NSLOT=3, SLOTB=8192;
constexpr int LDS_K=0, LDS_V=NSLOT*SLOTB, LDS_WS=2*NSLOT*SLOTB, LDS_OST=LDS_WS+NW*64*4, LDS_BYTES=LDS_OST+NW*4096;
constexpr float C2=0.125f*1.4426950408889634f;
__device__ __forceinline__ void glds16(const void*gsrc,unsigned lds_dst){unsigned keep;
  asm volatile("s_mov_b32 %0, m0\n\ts_mov_b32 m0, %2\n\ts_nop 0\n\tglobal_load_lds_dwordx4 %1, off\n\ts_mov_b32 m0, %0":"=&s"(keep):"v"(gsrc),"s"(lds_dst):"memory");}
__device__ __forceinline__ void glds16s(const void*sbase,unsigned voff,unsigned lds_dst){unsigned keep;
  asm volatile("s_mov_b32 %0, m0\n\ts_mov_b32 m0, %3\n\ts_nop 0\n\tglobal_load_lds_dwordx4 %1, %2\n\ts_mov_b32 m0, %0":"=&s"(keep):"v"(voff),"s"(sbase),"s"(lds_dst):"memory");}
__device__ __forceinline__ float max3f(float a,float b,float c){float r;asm("v_max3_f32 %0, %1, %2, %3":"=v"(r):"v"(a),"v"(b),"v"(c));return r;}
__device__ __forceinline__ float max2f(float a,float b){float r;asm("v_max_f32_e32 %0, %1, %2":"=v"(r):"v"(a),"v"(b));return r;}
__device__ __forceinline__ float fadd_s(float a,float b){float r;asm("v_add_f32_e32 %0, %1, %2":"=v"(r):"v"(a),"v"(b));return r;}
__device__ __forceinline__ float fsub_s(float a,float b){float r;asm("v_sub_f32_e32 %0, %1, %2":"=v"(r):"v"(a),"v"(b));return r;}
typedef float f32x2_t __attribute__((ext_vector_type(2))); typedef __bf16 bf16x2_t __attribute__((ext_vector_type(2)));
__device__ __forceinline__ unsigned cvtpk_s(float lo,float hi){f32x2_t v={lo,hi};bf16x2_t b=__builtin_convertvector(v,bf16x2_t);return __builtin_bit_cast(unsigned,b);}
#define WAIT_BAR(N) asm volatile("s_waitcnt vmcnt(" #N ") lgkmcnt(0)\n\ts_barrier":::"memory")

__device__ __forceinline__ void qkt(f32x16&p0,f32x16&p1,const char*Kslot,const bf16x8*qr,const f32x16&negm,int r32,int hi){
  const char*kb=Kslot+hi*1024+r32*16;
  #pragma unroll
  for(int d0=0;d0<4;++d0){
    const bf16x8 b0=*reinterpret_cast<const bf16x8*>(kb+d0*2048);
    const bf16x8 b1=*reinterpret_cast<const bf16x8*>(kb+d0*2048+512);
    if(d0==0){p0=__builtin_amdgcn_mfma_f32_32x32x16_bf16(b0,qr[0],negm,0,0,0);p1=__builtin_amdgcn_mfma_f32_32x32x16_bf16(b1,qr[0],negm,0,0,0);}
    else{p0=__builtin_amdgcn_mfma_f32_32x32x16_bf16(b0,qr[d0],p0,0,0,0);p1=__builtin_amdgcn_mfma_f32_32x32x16_bf16(b1,qr[d0],p1,0,0,0);}}
}
typedef __attribute__((address_space(3))) const char* lds_cptr;
typedef short v4i16_t __attribute__((ext_vector_type(4)));
__device__ __forceinline__ void kload8(bf16x8*kf,lds_cptr kp){
  kf[0]=*(const __attribute__((address_space(3))) bf16x8*)(kp);      kf[1]=*(const __attribute__((address_space(3))) bf16x8*)(kp+512);
  kf[2]=*(const __attribute__((address_space(3))) bf16x8*)(kp+2048); kf[3]=*(const __attribute__((address_space(3))) bf16x8*)(kp+2560);
  kf[4]=*(const __attribute__((address_space(3))) bf16x8*)(kp+4096); kf[5]=*(const __attribute__((address_space(3))) bf16x8*)(kp+4608);
  kf[6]=*(const __attribute__((address_space(3))) bf16x8*)(kp+6144); kf[7]=*(const __attribute__((address_space(3))) bf16x8*)(kp+6656);
}
__device__ __forceinline__ void kload2(bf16x8*kf,lds_cptr kp,int j){ kf[2*j]=*(const __attribute__((address_space(3))) bf16x8*)(kp+j*2048); kf[2*j+1]=*(const __attribute__((address_space(3))) bf16x8*)(kp+j*2048+512); }
__device__ __forceinline__ s16x4 vtr(lds_cptr p){ return __builtin_bit_cast(s16x4,__builtin_amdgcn_ds_read_tr16_b64_v4i16((__attribute__((address_space(3))) v4i16_t*)p)); }
__device__ __forceinline__ float rowmax(const f32x16&p0,const f32x16&p1){
  float a=max3f(p0[0],p0[1],p1[0]),b=max3f(p0[2],p0[3],p1[1]);a=max3f(a,p1[2],p1[3]);
  #pragma unroll
  for(int r=4;r<16;r+=4){a=max3f(a,p0[r],p0[r+1]);b=max3f(b,p0[r+2],p0[r+3]);a=max3f(a,p1[r],p1[r+1]);b=max3f(b,p1[r+2],p1[r+3]);}
  const float m=max2f(a,b);
  auto rr=__builtin_amdgcn_permlane32_swap(__float_as_uint(m),__float_as_uint(m),false,false);
  return max2f(__uint_as_float(rr[0]),__uint_as_float(rr[1]));
}
__device__ __forceinline__ void pv(f32x16*o,int vb,bf16x8 pa0,bf16x8 pa1,bf16x8 pa2,bf16x8 pa3){
  #pragma unroll
  for(int d0=0;d0<2;++d0){s16x4 lo[4],hi[4];
    #pragma unroll
    for(int ks=0;ks<4;++ks){
      asm volatile("ds_read_b64_tr_b16 %0,%1 offset:%c2":"=&v"(lo[ks]):"v"(vb),"i"(d0*4096+ks*1024):"memory");
      asm volatile("ds_read_b64_tr_b16 %0,%1 offset:%c2":"=&v"(hi[ks]):"v"(vb),"i"(d0*4096+ks*1024+512):"memory");}
    asm volatile("s_waitcnt lgkmcnt(0)":::"memory");SBAR();
    #define PK(k) (bf16x8){lo[k][0],lo[k][1],lo[k][2],lo[k][3],hi[k][0],hi[k][1],hi[k][2],hi[k][3]}
    o[d0]=__builtin_amdgcn_mfma_f32_32x32x16_bf16(pa0,PK(0),o[d0],0,0,0);
    o[d0]=__builtin_amdgcn_mfma_f32_32x32x16_bf16(pa1,PK(1),o[d0],0,0,0);
    o[d0]=__builtin_amdgcn_mfma_f32_32x32x16_bf16(pa2,PK(2),o[d0],0,0,0);
    o[d0]=__builtin_amdgcn_mfma_f32_32x32x16_bf16(pa3,PK(3),o[d0],0,0,0);
    #undef PK
  }
}

#ifndef ATTN_STORE16
#define ATTN_STORE16(p,v) (*(u32x4*)(p)=(v))
#endif
template<int THRL> __device__ __forceinline__ void attn_unit(int qb,const bf16*Qh,const bf16*__restrict__ Kh,const bf16*__restrict__ Vh,bf16*Oh,char*shm,const int wv){
  const int lane=mk_lane(),r32=lane&31,hi=lane>>5; const int wid=wv;
  const int q0=qb*QB;
  const bf16*Qw=Qh+(long)(q0+wid*QBLK)*PITCH;
  const unsigned lds0=(unsigned)(uintptr_t)shm;
  float*wsf=(float*)(shm+LDS_WS)+wid*64;
  const bf16*ksrc=Kh+(long)lane*PITCH+wid*8;
  const bf16*vsrc=Vh+(long)(16*(wid&3)+(lane>>2))*PITCH+(wid>>2)*32+(lane&3)*8;
  const unsigned kdst=lds0+LDS_K+wid*1024, vdst=lds0+LDS_V+wid*1024;
  #define DMA_K(t,slot) glds16(ksrc+(long)(t)*KVBLK*PITCH,(unsigned)__builtin_amdgcn_readfirstlane(kdst+(slot)))
  #define DMA_V(t,slot) glds16(vsrc+(long)(t)*KVBLK*PITCH,(unsigned)__builtin_amdgcn_readfirstlane(vdst+(slot)))
  const int vb0=(int)(lds0+LDS_V)+((lane>>4)&1)*32+(lane&3)*8+(4*hi+((lane&15)>>2))*64;
  const char*Kbase=shm+LDS_K; bf16x8 kf[8];
  const lds_cptr shm3=(lds_cptr)shm; const lds_cptr kp0=shm3+LDS_K+hi*1024+r32*16; const lds_cptr vp0=shm3+LDS_V+((lane>>4)&1)*32+(lane&3)*8+(4*hi+((lane&15)>>2))*64;
  const int NT=(q0+QB)/KVBLK;
  DMA_K(0,0);DMA_V(0,0);DMA_K(1,SLOTB);
  bf16x8 qr[4];
  #pragma unroll
  for(int d0=0;d0<4;++d0)qr[d0]=*reinterpret_cast<const bf16x8*>(&Qw[(long)r32*PITCH+d0*16+hi*8]);
  float mhat=0.f,l_reg=0.f;f32x16 o[2];o[0]=f32x16{};o[1]=f32x16{};f32x16 negm=f32x16{};asm volatile("":"+v"(negm));
  const int qrel=wid*QBLK+r32;
  #define CMASK(P0,P1,t) do{int jb_=(t)-(NT-4); if(jb_>=0)cmask(P0,P1,jb_,qrel,hi);}while(0)
  bool resc=false;
  #define START(P0,P1) do{ const float rm=rowmax(P0,P1); resc=false; \
    { const float dl=rm; mhat=fadd_s(mhat,dl); \
      _Pragma("unroll") for(int r=0;r<16;++r){P0[r]=fsub_s(P0[r],dl);P1[r]=fsub_s(P1[r],dl);} \
      _Pragma("unroll") for(int r=0;r<16;++r)negm[r]=-mhat; asm volatile("":"+v"(negm)); } \
    _Pragma("unroll") for(int r=0;r<16;++r)P0[r]=__builtin_amdgcn_exp2f(P0[r]); }while(0)
  #define RESC() do{ if(resc){ asm volatile("s_waitcnt lgkmcnt(0)":::"memory"); \
      _Pragma("unroll") for(int d_=0;d_<2;++d_) _Pragma("unroll") for(int r=0;r<16;++r)o[d_][r]*=wsf[crow(r,hi)]; } }while(0)
  f32x16 pA0,pA1,pB0,pB1;
  int sl_prev=0,sl_cur=0,sl_next=SLOTB;
  #define ROT() do{sl_prev=sl_cur;sl_cur=sl_next;sl_next=(sl_next==(NSLOT-1)*SLOTB)?0:sl_next+SLOTB;}while(0)
  DMA_K(2,2*SLOTB);
  WAIT_BAR(3);
  qkt(pA0,pA1,Kbase,qr,negm,r32,hi);asm volatile("s_nop 15\n\ts_nop 7":"+v"(pA0),"+v"(pA1));CMASK(pA0,pA1,0);
  START(pA0,pA1);
  _Pragma("unroll") for(int r=0;r<16;++r)pA1[r]=__builtin_amdgcn_exp2f(pA1[r]);
  WAIT_BAR(0);
  DMA_K(3,0);DMA_V(1,SLOTB);
  ROT();
  kload8(kf,kp0+sl_cur);
  WAIT_BAR(2);
  s16x4 vlo[8],vhi[8]; u32x4 pw0,pw1,pw2,pw3;
  #define PKW(P,B) cvtpk_s(P[B],P[B+1])
  #define PAF(k) __builtin_bit_cast(bf16x8,pw##k)
  #define VFR(i) (bf16x8){vlo[i][0],vlo[i][1],vlo[i][2],vlo[i][3],vhi[i][0],vhi[i][1],vhi[i][2],vhi[i][3]}
  #define PIN(x) asm volatile("":"+v"(x))
  #define MX3(a,b,c) __builtin_fmaxf(__builtin_fmaxf((a),(b)),(c))
  #define GAPA(MF,A0,A1,A2,A3,W0,W1,PW) do{ MF; sacc+=A0; sacc+=A1; sacc+=A2; sacc+=A3; PIN(sacc); W0; W1; PIN(PW); SBAR(); }while(0)
  #define EX(v) __builtin_amdgcn_exp2f(v)
  #define GAPB(MF,X,B) do{ MF; X[B]=EX(X[B]); X[B+1]=EX(X[B+1]); X[B+2]=EX(X[B+2]); X[B+3]=EX(X[B+3]); PIN(X); SBAR(); }while(0)
  #define VRD(i) do{ vlo[i]=vtr(vp_+(((i)>>2)*4096+((i)&3)*1024)); vhi[i]=vtr(vp_+(((i)>>2)*4096+((i)&3)*1024+512)); }while(0)
  #define KRD(G,j) do{ if(G){ kload2(kf,kp0+sl_next,j); SBAR(); } }while(0)
  #define STEP(C0,C1,P0,P1,t,GK,GV,GL) do{ SBAR(); \
    const lds_cptr vp_=vp0+sl_prev; \
    VRD(0); SBAR(); float sacc=(P0[0]+P0[1]); \
    GAPA(C0=__builtin_amdgcn_mfma_f32_32x32x16_bf16(kf[0],qr[0],negm,0,0,0), P0[2],P0[3],P0[4],P0[5],     pw0[0]=PKW(P0,0), pw0[1]=PKW(P0,2), pw0); \
    VRD(4); SBAR(); GAPA(C1=__builtin_amdgcn_mfma_f32_32x32x16_bf16(kf[1],qr[0],negm,0,0,0), P0[6],P0[7],P0[8],P0[9],     pw0[2]=PKW(P0,4), pw0[3]=PKW(P0,6), pw0); \
    VRD(1); SBAR(); GAPA(C0=__builtin_amdgcn_mfma_f32_32x32x16_bf16(kf[2],qr[1],C0,0,0,0),   P0[10],P0[11],P0[12],P0[13], pw1[0]=PKW(P0,8), pw1[1]=PKW(P0,10), pw1); \
    VRD(5); SBAR(); GAPA(C1=__builtin_amdgcn_mfma_f32_32x32x16_bf16(kf[3],qr[1],C1,0,0,0),   P0[14],P0[15],P1[0],P1[1],   pw1[2]=PKW(P0,12),pw1[3]=PKW(P0,14), pw1); \
    VRD(2); SBAR(); GAPA(C0=__builtin_amdgcn_mfma_f32_32x32x16_bf16(kf[4],qr[2],C0,0,0,0),   P1[2],P1[3],P1[4],P1[5],     pw2[0]=PKW(P1,0), pw2[1]=PKW(P1,2), pw2); \
    VRD(6); SBAR(); GAPA(C1=__builtin_amdgcn_mfma_f32_32x32x16_bf16(kf[5],qr[2],C1,0,0,0),   P1[6],P1[7],P1[8],P1[9],     pw2[2]=PKW(P1,4), pw2[3]=PKW(P1,6), pw2); \
    VRD(3); SBAR(); GAPA(C0=__builtin_amdgcn_mfma_f32_32x32x16_bf16(kf[6],qr[3],C0,0,0,0),   P1[10],P1[11],P1[12],P1[13], pw3[0]=PKW(P1,8), pw3[1]=PKW(P1,10), pw3); \
    VRD(7); SBAR(); GAPA(C1=__builtin_amdgcn_mfma_f32_32x32x16_bf16(kf[7],qr[3],C1,0,0,0),   P1[14],P1[15],0.f,0.f,       pw3[2]=PKW(P1,12),pw3[3]=PKW(P1,14), pw3); \
    l_reg+=sacc; \
    if(GK){DMA_K((t)+3,sl_cur);} if(GV){DMA_V((t)+1,sl_next);} \
    CMASK(C0,C1,t); \
    { float a=MX3(C0[0],C0[1],C1[0]),b=MX3(C0[2],C0[3],C1[1]); a=MX3(a,C1[2],C1[3]); \
      _Pragma("unroll") for(int r=4;r<16;r+=4){a=MX3(a,C0[r],C0[r+1]);b=MX3(b,C0[r+2],C0[r+3]);a=MX3(a,C1[r],C1[r+1]);b=MX3(b,C1[r+2],C1[r+3]);} \
      float rm=__builtin_fmaxf(a,b); { auto rr=__builtin_amdgcn_permlane32_swap(__float_as_uint(rm),__float_as_uint(rm),false,false); rm=__builtin_fmaxf(__uint_as_float(rr[0]),__uint_as_float(rr[1])); } \
      resc=false; \
      if(__builtin_expect(__any(rm>(float)THRL),0)){ const float dl=__builtin_fmaxf(rm,0.f); mhat+=dl; \
        _Pragma("unroll") for(int r=0;r<16;++r){C0[r]-=dl;C1[r]-=dl;} \
        _Pragma("unroll") for(int r=0;r<16;++r)negm[r]=-mhat; asm volatile("":"+v"(negm)); \
        const float f=__builtin_amdgcn_exp2f(-dl); l_reg*=f; if(hi==0)wsf[r32]=f; resc=true; } } \
    SBAR(); \
    GAPB(o[0]=__builtin_amdgcn_mfma_f32_32x32x16_bf16(PAF(0),VFR(0),o[0],0,0,0), C0,0); \
    GAPB(o[1]=__builtin_amdgcn_mfma_f32_32x32x16_bf16(PAF(0),VFR(4),o[1],0,0,0), C0,4); \
    KRD(GL,0); GAPB(o[0]=__builtin_amdgcn_mfma_f32_32x32x16_bf16(PAF(1),VFR(1),o[0],0,0,0), C0,8); \
    KRD(GL,1); GAPB(o[1]=__builtin_amdgcn_mfma_f32_32x32x16_bf16(PAF(1),VFR(5),o[1],0,0,0), C0,12); \
    KRD(GL,2); GAPB(o[0]=__builtin_amdgcn_mfma_f32_32x32x16_bf16(PAF(2),VFR(2),o[0],0,0,0), C1,0); \
    KRD(GL,3); GAPB(o[1]=__builtin_amdgcn_mfma_f32_32x32x16_bf16(PAF(2),VFR(6),o[1],0,0,0), C1,4); \
    GAPB(o[0]=__builtin_amdgcn_mfma_f32_32x32x16_bf16(PAF(3),VFR(3),o[0],0,0,0), C1,8); \
    GAPB(o[1]=__builtin_amdgcn_mfma_f32_32x32x16_bf16(PAF(3),VFR(7),o[1],0,0,0), C1,12); \
    }while(0)
  int t=1;
  #undef CMASK
  #define CMASK(P0,P1,t) do{}while(0)
  for(;t+5<NT;t+=2){
    STEP(pB0,pB1,pA0,pA1,t,true,true,true);     WAIT_BAR(2); RESC(); ROT();
    STEP(pA0,pA1,pB0,pB1,t+1,true,true,true);   WAIT_BAR(2); RESC(); ROT();
  }
  #undef CMASK
  #define CMASK(P0,P1,t) do{int jb_=(t)-(NT-4); if(jb_>=0)cmask(P0,P1,jb_,qrel,hi);}while(0)
  #define ENDW(tt) do{ if((tt)+3<NT){WAIT_BAR(2);} else if((tt)+2<NT){WAIT_BAR(1);} else {WAIT_BAR(0);} }while(0)
  for(;t+1<NT;t+=2){
    STEP(pB0,pB1,pA0,pA1,t,(t+3<NT),(t+1<NT),(t+1<NT));       ENDW(t);   RESC(); ROT();
    STEP(pA0,pA1,pB0,pB1,t+1,(t+4<NT),(t+2<NT),(t+2<NT));     ENDW(t+1); RESC(); ROT();
  }
  STEP(pB0,pB1,pA0,pA1,NT-1,false,false,false); RESC();
  { float sacc=pB0[0]+pB0[1]; _Pragma("unroll") for(int r=2;r<16;++r)sacc+=pB0[r]; _Pragma("unroll") for(int r=0;r<16;++r)sacc+=pB1[r]; l_reg+=sacc;
    pw0=(u32x4){PKW(pB0,0),PKW(pB0,2),PKW(pB0,4),PKW(pB0,6)};pw1=(u32x4){PKW(pB0,8),PKW(pB0,10),PKW(pB0,12),PKW(pB0,14)};pw2=(u32x4){PKW(pB1,0),PKW(pB1,2),PKW(pB1,4),PKW(pB1,6)};pw3=(u32x4){PKW(pB1,8),PKW(pB1,10),PKW(pB1,12),PKW(pB1,14)};
    SBAR(); pv(o,vb0+sl_cur,PAF(0),PAF(1),PAF(2),PAF(3)); }
  #undef PKW
  #undef PAF
  #undef VFR
  #undef PIN
  #undef MX3
  #undef GAPA
  #undef GAPB
  #undef EX
  #undef VRD
  #undef KRD
  #undef STEP
  #undef ENDW
  {auto rr=__builtin_amdgcn_permlane32_swap(__float_as_uint(l_reg),__float_as_uint(l_reg),false,false);l_reg=__uint_as_float(rr[0])+__uint_as_float(rr[1]);}
  if(hi==0)wsf[32+r32]=l_reg;asm volatile("s_waitcnt lgkmcnt(0)":::"memory");
  float rli[16];
  #pragma unroll
  for(int r=0;r<16;++r)rli[r]=__builtin_amdgcn_rcpf(wsf[32+crow(r,hi)]);
  bf16*Ow=Oh+(long)(q0+wid*QBLK)*OPITCH;
  { bf16*stg=(bf16*)(shm+LDS_OST)+wid*2048;
    #pragma unroll
    for(int r=0;r<16;++r){const int orow=crow(r,hi);
      #pragma unroll
      for(int d0=0;d0<2;++d0)stg[orow*64+d0*32+r32]=__float2bfloat16(o[d0][r]*rli[r]);}
    asm volatile("s_waitcnt lgkmcnt(0)":::"memory");
    #pragma unroll
    for(int i=0;i<4;++i){const int row=i*8+(lane>>3),ch=lane&7; const u32x4 v=*(const u32x4*)(stg+row*64+ch*8); ATTN_STORE16(Ow+(long)row*OPITCH+ch*8,v);} }
  asm volatile("s_waitcnt lgkmcnt(0)\n\ts_barrier":::"memory");
  #undef DMA_K
  #undef DMA_V
  #undef CMASK
  #undef START
  #undef RESC
  #undef ROT
}
constexpr int LV_V=NSLOT*SLOTB, LV_WS=LV_V+NSLOT*2*SLOTB, LV_OST=LV_WS+NW*64*4, LV_BYTES=LV_OST+NW*8192;
__device__ __forceinline__ void pv4(f32x16*o,int vb,bf16x8 pa0,bf16x8 pa1,bf16x8 pa2,bf16x8 pa3){
  #pragma unroll
  for(int d0=0;d0<4;++d0){s16x4 lo[4],hi[4];
    #pragma unroll
    for(int ks=0;ks<4;++ks){
      asm volatile("ds_read_b64_tr_b16 %0,%1 offset:%c2":"=&v"(lo[ks]):"v"(vb),"i"(d0*4096+ks*1024):"memory");
      asm volatile("ds_read_b64_tr_b16 %0,%1 offset:%c2":"=&v"(hi[ks]):"v"(vb),"i"(d0*4096+ks*1024+512):"memory");}
    asm volatile("s_waitcnt lgkmcnt(0)":::"memory");SBAR();
    #define PK(k) (bf16x8){lo[k][0],lo[k][1],lo[k][2],lo[k][3],hi[k][0],hi[k][1],hi[k][2],hi[k][3]}
    o[d0]=__builtin_amdgcn_mfma_f32_32x32x16_bf16(pa0,PK(0),o[d0],0,0,0);
    o[d0]=__builtin_amdgcn_mfma_f32_32x32x16_bf16(pa1,PK(1),o[d0],0,0,0);
    o[d0]=__builtin_amdgcn_mfma_f32_32x32x16_bf16(pa2,PK(2),o[d0],0,0,0);
    o[d0]=__builtin_amdgcn_mfma_f32_32x32x16_bf16(pa3,PK(3),o[d0],0,0,0);
    #undef PK
  }
}
#ifndef ATTN_STORE16
#define ATTN_STORE16(p,v) (*(u32x4*)(p)=(v))
#endif
template<int THRL> __device__ __forceinline__ void attn_unit128(int qb,const bf16*Qh,const bf16*__restrict__ Kh,const bf16*__restrict__ Vh,bf16*Oh,char*shm,const int wv){
  const int lane=mk_lane(),r32=lane&31,hi=lane>>5; const int wid=wv;
  const int q0=qb*QB;
  const bf16*Qw=Qh+(long)(q0+wid*QBLK)*PITCH;
  const unsigned lds0=(unsigned)(uintptr_t)shm;
  float*wsf=(float*)(shm+LV_WS)+wid*64;
  const unsigned koff=(unsigned)((lane*PITCH+wid*8)*2), voff=(unsigned)(((16*(wid&3)+(lane>>2))*PITCH+(wid>>2)*32+(lane&3)*8)*2);
  const unsigned kdst=lds0+LDS_K+wid*1024, vdst=lds0+LV_V+wid*1024;
  #define DMA_K(t,slot) glds16s(Kh+(long)(t)*KVBLK*PITCH,koff,(unsigned)__builtin_amdgcn_readfirstlane(kdst+(slot)))
  #define DMA_V(t,slot) do{ glds16s(Vh+(long)(t)*KVBLK*PITCH,voff,(unsigned)__builtin_amdgcn_readfirstlane(vdst+2*(slot))); glds16s(Vh+64+(long)(t)*KVBLK*PITCH,voff,(unsigned)__builtin_amdgcn_readfirstlane(vdst+2*(slot)+8192)); }while(0)
  const char*Kbase=shm+LDS_K; bf16x8 kf[8];
  const lds_cptr shm3=(lds_cptr)shm; const lds_cptr kp0=shm3+LDS_K+hi*1024+r32*16; const lds_cptr vp0=shm3+LV_V+((lane>>4)&1)*32+(lane&3)*8+(4*hi+((lane&15)>>2))*64;
  const int NT=(q0+QB)/KVBLK;
  DMA_K(0,0);DMA_V(0,0);DMA_K(1,SLOTB);
  bf16x8 qr[4];
  #pragma unroll
  for(int d0=0;d0<4;++d0)qr[d0]=*reinterpret_cast<const bf16x8*>(&Qw[(long)r32*PITCH+d0*16+hi*8]);
  float mhat=0.f,l_reg=0.f;f32x16 o[4];o[0]=f32x16{};o[1]=f32x16{};o[2]=f32x16{};o[3]=f32x16{};const f32x16 zero16=f32x16{};
  const int qrel=wid*QBLK+r32;
  #define CMASK(P0,P1,t) do{int jb_=(t)-(NT-4); if(jb_>=0)cmask(P0,P1,jb_,qrel,hi);}while(0)
  bool resc=false;
  #define START(P0,P1) do{ const float rm=rowmax(P0,P1); resc=false; \
    { const float dl=rm; mhat=fadd_s(mhat,dl); \
      _Pragma("unroll") for(int r=0;r<16;++r){P0[r]=fsub_s(P0[r],dl);P1[r]=fsub_s(P1[r],dl);} \
      } \
    _Pragma("unroll") for(int r=0;r<16;++r)P0[r]=__builtin_amdgcn_exp2f(P0[r]); }while(0)
  #define RESC() do{ if(resc){ asm volatile("s_waitcnt lgkmcnt(0)":::"memory"); \
      _Pragma("unroll") for(int d_=0;d_<4;++d_) _Pragma("unroll") for(int r=0;r<16;++r)o[d_][r]*=wsf[crow(r,hi)]; } }while(0)
  f32x16 pA0,pA1,pB0,pB1;
  int sl_prev=0,sl_cur=0,sl_next=SLOTB;
  #define ROT() do{sl_prev=sl_cur;sl_cur=sl_next;sl_next=(sl_next==(NSLOT-1)*SLOTB)?0:sl_next+SLOTB;}while(0)
  DMA_K(2,2*SLOTB);
  WAIT_BAR(4);
  qkt(pA0,pA1,Kbase,qr,zero16,r32,hi);asm volatile("s_nop 15\n\ts_nop 7":"+v"(pA0),"+v"(pA1));CMASK(pA0,pA1,0);
  START(pA0,pA1);
  _Pragma("unroll") for(int r=0;r<16;++r)pA1[r]=__builtin_amdgcn_exp2f(pA1[r]);
  WAIT_BAR(0);
  DMA_K(3,0);DMA_V(1,SLOTB);
  ROT();
  kload8(kf,kp0+sl_cur);
  WAIT_BAR(3);
  s16x4 vq0lo,vq0hi,vq1lo,vq1hi,vq2lo,vq2hi; u32x4 pw0,pw1,pw2,pw3;
  #define PKW(P,B) cvtpk_s(P[B],P[B+1])
  #define PAF(k) __builtin_bit_cast(bf16x8,pw##k)
  #define VFQ(B) (bf16x8){B##lo[0],B##lo[1],B##lo[2],B##lo[3],B##hi[0],B##hi[1],B##hi[2],B##hi[3]}
  #define PIN(x) asm volatile("":"+v"(x))
  #define MX3(a,b,c) __builtin_fmaxf(__builtin_fmaxf((a),(b)),(c))
  #define GAPA(MF,A0,A1,A2,A3,W0,W1,PW) do{ MF; sacc+=A0; sacc+=A1; sacc+=A2; sacc+=A3; PIN(sacc); W0; W1; PIN(PW); SBAR(); }while(0)
  #define EX(v) __builtin_amdgcn_exp2f(v)
  #define GAPB(MF,X,B) do{ MF; X[B]=EX(X[B]); X[B+1]=EX(X[B+1]); PIN(X); SBAR(); }while(0)
  #define VRD(B,i) do{ B##lo=vtr(vp_+(((i)>>2)*4096+((i)&3)*1024)); B##hi=vtr(vp_+(((i)>>2)*4096+((i)&3)*1024+512)); SBAR(); }while(0)
  #define KRD(G,j) do{ if(G){ kload2(kf,kp0+sl_next,j); SBAR(); } }while(0)
  #define STEP(C0,C1,P0,P1,t,GK,GV,GL) do{ SBAR(); \
    const lds_cptr vp_=vp0+2*sl_prev; \
    float sacc=(P0[0]+P0[1]); \
    GAPA(C0=__builtin_amdgcn_mfma_f32_32x32x16_bf16(kf[0],qr[0],zero16,0,0,0), P0[2],P0[3],P0[4],P0[5],     pw0[0]=PKW(P0,0), pw0[1]=PKW(P0,2), pw0); \
    GAPA(C1=__builtin_amdgcn_mfma_f32_32x32x16_bf16(kf[1],qr[0],zero16,0,0,0), P0[6],P0[7],P0[8],P0[9],     pw0[2]=PKW(P0,4), pw0[3]=PKW(P0,6), pw0); \
    GAPA(C0=__builtin_amdgcn_mfma_f32_32x32x16_bf16(kf[2],qr[1],C0,0,0,0),   P0[10],P0[11],P0[12],P0[13], pw1[0]=PKW(P0,8), pw1[1]=PKW(P0,10), pw1); \
    GAPA(C1=__builtin_amdgcn_mfma_f32_32x32x16_bf16(kf[3],qr[1],C1,0,0,0),   P0[14],P0[15],P1[0],P1[1],   pw1[2]=PKW(P0,12),pw1[3]=PKW(P0,14), pw1); \
    GAPA(C0=__builtin_amdgcn_mfma_f32_32x32x16_bf16(kf[4],qr[2],C0,0,0,0),   P1[2],P1[3],P1[4],P1[5],     pw2[0]=PKW(P1,0), pw2[1]=PKW(P1,2), pw2); \
    GAPA(C1=__builtin_amdgcn_mfma_f32_32x32x16_bf16(kf[5],qr[2],C1,0,0,0),   P1[6],P1[7],P1[8],P1[9],     pw2[2]=PKW(P1,4), pw2[3]=PKW(P1,6), pw2); \
    VRD(vq0,0); GAPA(C0=__builtin_amdgcn_mfma_f32_32x32x16_bf16(kf[6],qr[3],C0,0,0,0),   P1[10],P1[11],P1[12],P1[13], pw3[0]=PKW(P1,8), pw3[1]=PKW(P1,10), pw3); \
    VRD(vq1,4); GAPA(C1=__builtin_amdgcn_mfma_f32_32x32x16_bf16(kf[7],qr[3],C1,0,0,0),   P1[14],P1[15],0.f,0.f,       pw3[2]=PKW(P1,12),pw3[3]=PKW(P1,14), pw3); \
    l_reg+=sacc; \
    _Pragma("unroll") for(int r=0;r<16;++r){C0[r]-=mhat;C1[r]-=mhat;} \
    if(GK){DMA_K((t)+3,sl_cur);} if(GV){DMA_V((t)+1,sl_next);} \
    CMASK(C0,C1,t); \
    { float a=MX3(C0[0],C0[1],C1[0]),b=MX3(C0[2],C0[3],C1[1]); a=MX3(a,C1[2],C1[3]); \
      _Pragma("unroll") for(int r=4;r<16;r+=4){a=MX3(a,C0[r],C0[r+1]);b=MX3(b,C0[r+2],C0[r+3]);a=MX3(a,C1[r],C1[r+1]);b=MX3(b,C1[r+2],C1[r+3]);} \
      float rm=__builtin_fmaxf(a,b); { auto rr=__builtin_amdgcn_permlane32_swap(__float_as_uint(rm),__float_as_uint(rm),false,false); rm=__builtin_fmaxf(__uint_as_float(rr[0]),__uint_as_float(rr[1])); } \
      resc=false; \
      if(__builtin_expect(__any(rm>(float)THRL),0)){ const float dl=__builtin_fmaxf(rm,0.f); mhat+=dl; \
        _Pragma("unroll") for(int r=0;r<16;++r){C0[r]-=dl;C1[r]-=dl;} \
        const float f=__builtin_amdgcn_exp2f(-dl); l_reg*=f; if(hi==0)wsf[r32]=f; resc=true; } } \
    SBAR(); \
    VRD(vq2,8); GAPB(o[0]=__builtin_amdgcn_mfma_f32_32x32x16_bf16(PAF(0),VFQ(vq0),o[0],0,0,0), C0,0); \
    VRD(vq0,12); GAPB(o[1]=__builtin_amdgcn_mfma_f32_32x32x16_bf16(PAF(0),VFQ(vq1),o[1],0,0,0), C0,2); \
    VRD(vq1,1); GAPB(o[2]=__builtin_amdgcn_mfma_f32_32x32x16_bf16(PAF(0),VFQ(vq2),o[2],0,0,0), C0,4); \
    VRD(vq2,5); GAPB(o[3]=__builtin_amdgcn_mfma_f32_32x32x16_bf16(PAF(0),VFQ(vq0),o[3],0,0,0), C0,6); \
    VRD(vq0,9); GAPB(o[0]=__builtin_amdgcn_mfma_f32_32x32x16_bf16(PAF(1),VFQ(vq1),o[0],0,0,0), C0,8); \
    VRD(vq1,13); GAPB(o[1]=__builtin_amdgcn_mfma_f32_32x32x16_bf16(PAF(1),VFQ(vq2),o[1],0,0,0), C0,10); \
    VRD(vq2,2); GAPB(o[2]=__builtin_amdgcn_mfma_f32_32x32x16_bf16(PAF(1),VFQ(vq0),o[2],0,0,0), C0,12); \
    VRD(vq0,6); GAPB(o[3]=__builtin_amdgcn_mfma_f32_32x32x16_bf16(PAF(1),VFQ(vq1),o[3],0,0,0), C0,14); \
    VRD(vq1,10); GAPB(o[0]=__builtin_amdgcn_mfma_f32_32x32x16_bf16(PAF(2),VFQ(vq2),o[0],0,0,0), C1,0); \
    VRD(vq2,14); GAPB(o[1]=__builtin_amdgcn_mfma_f32_32x32x16_bf16(PAF(2),VFQ(vq0),o[1],0,0,0), C1,2); \
    VRD(vq0,3); GAPB(o[2]=__builtin_amdgcn_mfma_f32_32x32x16_bf16(PAF(2),VFQ(vq1),o[2],0,0,0), C1,4); \
    VRD(vq1,7); GAPB(o[3]=__builtin_amdgcn_mfma_f32_32x32x16_bf16(PAF(2),VFQ(vq2),o[3],0,0,0), C1,6); \
    VRD(vq2,11); KRD(GL,0); GAPB(o[0]=__builtin_amdgcn_mfma_f32_32x32x16_bf16(PAF(3),VFQ(vq0),o[0],0,0,0), C1,8); \
    VRD(vq0,15); KRD(GL,1); GAPB(o[1]=__builtin_amdgcn_mfma_f32_32x32x16_bf16(PAF(3),VFQ(vq1),o[1],0,0,0), C1,10); \
    KRD(GL,2); GAPB(o[2]=__builtin_amdgcn_mfma_f32_32x32x16_bf16(PAF(3),VFQ(vq2),o[2],0,0,0), C1,12); \
    KRD(GL,3); GAPB(o[3]=__builtin_amdgcn_mfma_f32_32x32x16_bf16(PAF(3),VFQ(vq0),o[3],0,0,0), C1,14); \
    }while(0)
  int t=1;
  #undef CMASK
  #define CMASK(P0,P1,t) do{}while(0)
  for(;t+5<NT;t+=2){
    STEP(pB0,pB1,pA0,pA1,t,true,true,true);     WAIT_BAR(3); RESC(); ROT();
    STEP(pA0,pA1,pB0,pB1,t+1,true,true,true);   WAIT_BAR(3); RESC(); ROT();
  }
  #undef CMASK
  #define CMASK(P0,P1,t) do{int jb_=(t)-(NT-4); if(jb_>=0)cmask(P0,P1,jb_,qrel,hi);}while(0)
  #define ENDW(tt) do{ if((tt)+3<NT){WAIT_BAR(3);} else if((tt)+2<NT){WAIT_BAR(2);} else {WAIT_BAR(0);} }while(0)
  for(;t+1<NT;t+=2){
    STEP(pB0,pB1,pA0,pA1,t,(t+3<NT),(t+1<NT),(t+1<NT));       ENDW(t);   RESC(); ROT();
    STEP(pA0,pA1,pB0,pB1,t+1,(t+4<NT),(t+2<NT),(t+2<NT));     ENDW(t+1); RESC(); ROT();
  }
  STEP(pB0,pB1,pA0,pA1,NT-1,false,false,false); RESC();
  { float sacc=pB0[0]+pB0[1]; _Pragma("unroll") for(int r=2;r<16;++r)sacc+=pB0[r]; _Pragma("unroll") for(int r=0;r<16;++r)sacc+=pB1[r]; l_reg+=sacc;
    pw0=(u32x4){PKW(pB0,0),PKW(pB0,2),PKW(pB0,4),PKW(pB0,6)};pw1=(u32x4){PKW(pB0,8),PKW(pB0,10),PKW(pB0,12),PKW(pB0,14)};pw2=(u32x4){PKW(pB1,0),PKW(pB1,2),PKW(pB1,4),PKW(pB1,6)};pw3=(u32x4){PKW(pB1,8),PKW(pB1,10),PKW(pB1,12),PKW(pB1,14)};
    SBAR(); pv4(o,(int)(lds0+LV_V)+((lane>>4)&1)*32+(lane&3)*8+(4*hi+((lane&15)>>2))*64+2*sl_cur,PAF(0),PAF(1),PAF(2),PAF(3)); }
  #undef PKW
  #undef PAF
  #undef VFQ
  #undef PIN
  #undef MX3
  #undef GAPA
  #undef GAPB
  #undef EX
  #undef VRD
  #undef KRD
  #undef STEP
  #undef ENDW
  {auto rr=__builtin_amdgcn_permlane32_swap(__float_as_uint(l_reg),__float_as_uint(l_reg),false,false);l_reg=__uint_as_float(rr[0])+__uint_as_float(rr[1]);}
  if(hi==0)wsf[32+r32]=l_reg;asm volatile("s_waitcnt lgkmcnt(0)":::"memory");
  float rli[16];
  #pragma unroll
  for(int r=0;r<16;++r)rli[r]=__builtin_amdgcn_rcpf(wsf[32+crow(r,hi)]);
  bf16*Ow=Oh+(long)(q0+wid*QBLK)*OPITCH;
  { bf16*stg=(bf16*)(shm+LV_OST)+wid*4096;
    #pragma unroll
    for(int r=0;r<16;++r){const int orow=crow(r,hi);
      #pragma unroll
      for(int d0=0;d0<4;++d0)stg[orow*128+d0*32+r32]=__float2bfloat16(o[d0][r]*rli[r]);}
    asm volatile("s_waitcnt lgkmcnt(0)":::"memory");
    #pragma unroll
    for(int i=0;i<8;++i){const int row=i*4+(lane>>4),ch=lane&15; const u32x4 v=*(const u32x4*)(stg+row*128+ch*8); ATTN_STORE16(Ow+(long)row*OPITCH+ch*8,v);} }
  asm volatile("s_waitcnt lgkmcnt(0)\n\ts_barrier":::"memory");
  #undef DMA_K
  #undef DMA_V
  #undef CMASK
  #undef START
  #undef RESC
  #undef ROT
}
constexpr int ATTN_LDS_BYTES=LDS_BYTES;
#undef SBAR
#undef WAIT_BAR
}
#define GAS __attribute__((address_space(1)))
#define LAS __attribute__((address_space(3)))
typedef unsigned short bf16;
typedef unsigned v4u __attribute__((ext_vector_type(4)));
typedef float f32x4 __attribute__((ext_vector_type(4)));
typedef short bf16x8 __attribute__((ext_vector_type(8)));
typedef GAS unsigned gu32;
typedef GAS unsigned long long gu64;
#define RLX_AGENT __ATOMIC_RELAXED, __HIP_MEMORY_SCOPE_AGENT
#define LDS_WAIT() asm volatile("s_waitcnt lgkmcnt(0)" ::: "memory")
#define VM_WAIT() asm volatile("s_waitcnt vmcnt(0)" ::: "memory")
__device__ __forceinline__ unsigned long long rt() { return __builtin_amdgcn_s_memrealtime(); }
__device__ __forceinline__ unsigned f2bf(float f) { unsigned u = __builtin_bit_cast(unsigned, f); return (u + 0x7fffu + ((u >> 16) & 1u)) >> 16; }
__device__ __forceinline__ unsigned pk2(float lo, float hi) { return attn_body::cvtpk_s(lo, hi); }

#define XB_TMO      128
#define XB_XCNT(j)  (256  + 64 * (j))
#define XB_XSUB(j)  (1280 + 64 * (j))
#define XB_XGEN(j)  (2304 + 64 * (j))
#define XB_TOP      3328
#define XB_TOPGEN   3392
#define XCD_BAR_WORDS 3456
#define XB_SPIN_CAP (1u << 18)

__device__ __forceinline__ unsigned xb_ld(unsigned* p)              { return __hip_atomic_load(p, __ATOMIC_RELAXED, __HIP_MEMORY_SCOPE_AGENT); }
__device__ __forceinline__ unsigned xb_add(unsigned* p, unsigned v) { return __hip_atomic_fetch_add(p, v, __ATOMIC_RELAXED, __HIP_MEMORY_SCOPE_AGENT); }
__device__ __forceinline__ unsigned xb_xcc_id() { return (unsigned)__builtin_amdgcn_s_getreg((3 << 11) | 20) & 0xFu; }
#define XB_SPIN(cond, bar) do { unsigned _sp = 0; while (cond) { __builtin_amdgcn_s_sleep(1); \
    if ((++_sp & 255u) == 0u) { if (xb_ld(&(bar)[XB_TMO])) break; if (_sp > XB_SPIN_CAP) { atomicAdd(&(bar)[XB_TMO], 1u); break; } } } } while (0)

struct XcdBarrier {
    unsigned* bar; unsigned x; bool lead;
    volatile LAS unsigned* st;
};

__device__ __forceinline__ XcdBarrier xcd_barrier_post(unsigned* bar, volatile LAS unsigned* st) {
    XcdBarrier b; b.bar = bar; b.x = xb_xcc_id(); b.st = st;
    if (threadIdx.x == 0) (void)xb_add(&bar[XB_XCNT(b.x)], 1u);
    return b;
}
__device__ __forceinline__ void xcd_barrier_complete(unsigned* bar, unsigned x, unsigned& nloc, unsigned& nx) {
    const unsigned G = gridDim.x * gridDim.y * gridDim.z;
    unsigned sum, cnt, mine, sp = 0u;
    for (;;) {
        sum = 0u; cnt = 0u; mine = 0u;
#pragma unroll
        for (unsigned j = 0; j < 16; ++j) { const unsigned c = xb_ld(&bar[XB_XCNT(j)]); sum += c; cnt += (c > 0u) ? 1u : 0u; mine = (j == x) ? c : mine; }
        if (sum == G) break;
        __builtin_amdgcn_s_sleep(1);
        if ((++sp & 255u) == 0u) { if (xb_ld(&bar[XB_TMO])) break; if (sp > XB_SPIN_CAP) { atomicAdd(&bar[XB_TMO], 1u); break; } }
    }
    nloc = mine > 0u ? mine : 1u; nx = cnt > 0u ? cnt : 1u;
}

__device__ __forceinline__ void xcd_barrier(const XcdBarrier& b) {
    asm volatile("s_waitcnt vmcnt(0)" ::: "memory");
    __syncthreads();
    if (b.lead) {
        unsigned* bar = b.bar;
        __builtin_amdgcn_s_waitcnt(0);
        unsigned nloc = b.st[0], nx = b.st[1];
        if (nloc == 0u) { xcd_barrier_complete(bar, b.x, nloc, nx); b.st[0] = nloc; b.st[1] = nx; }
        const unsigned old = xb_add(&bar[XB_XSUB(b.x)], 1u);
        const unsigned gen = old / nloc;
        if (old + 1u == (gen + 1u) * nloc) {
            __builtin_amdgcn_fence(__ATOMIC_RELEASE, "agent");
            asm volatile("s_waitcnt vmcnt(0)" ::: "memory");
            const unsigned og = xb_add(&bar[XB_TOP], 1u);
            const unsigned tg = og / nx;
            if (og + 1u == (tg + 1u) * nx) xb_add(&bar[XB_TOPGEN], 1u);
            else XB_SPIN(xb_ld(&bar[XB_TOPGEN]) == tg, bar);
            __builtin_amdgcn_fence(__ATOMIC_ACQUIRE, "agent");
            xb_add(&bar[XB_XGEN(b.x)], 1u);
            asm volatile("s_waitcnt vmcnt(0)" ::: "memory");
        } else {
            XB_SPIN(xb_ld(&bar[XB_XGEN(b.x)]) == gen, bar);
            __builtin_amdgcn_fence(__ATOMIC_ACQUIRE, "agent");
            asm volatile("s_waitcnt vmcnt(0)" ::: "memory");
        }
    }
    __syncthreads();
}

constexpr int NWAVES = 8, NTHR = 512;
constexpr int DM = 2048, NB = 4, SQ = 4096, TOK = NB * SQ;
constexpr int INW = 5900, PW = 5888;
constexpr int C_U = 0, C_DQ = 512, C_DK = 1280, C_DV = 2048, C_GQ = 2816, C_GZ = 5120, C_GA = 5888;
constexpr int DFF = 5632, DFE = 7168, NE = 8;
constexpr int MOE_ROWS = 2 * TOK + NE * 256, MOE_TILES_MAX = MOE_ROWS / 256;
constexpr float EPS = 1e-6f;
constexpr int GDN_UNIT_BYTES = 57344 + 32768 + 256;

constexpr size_t MiB = 1u << 20;
constexpr size_t WS_CTL = 0, CTL_ZERO_BYTES = 1 * MiB;
constexpr size_t WS_MOD = 1 * MiB;
constexpr size_t WS_ROPE = 2 * MiB;
constexpr size_t WS_GAB = 3 * MiB;
constexpr size_t WS_TOKE = 4 * MiB, WS_TOKG = WS_TOKE + 128 * 1024, WS_RANK = WS_TOKE + 256 * 1024, WS_POS = WS_TOKE + 384 * 1024, WS_CNT = WS_TOKE + 512 * 1024, WS_TILE = WS_TOKE + 640 * 1024;
constexpr size_t WS_GW = 5 * MiB;
constexpr size_t WS_M2 = 6 * MiB;
constexpr size_t WS_M13 = 10 * MiB;
constexpr size_t WS_A16 = 22 * MiB;
constexpr size_t WS_XC = 23 * MiB;
constexpr size_t WS_XS = 39 * MiB;
constexpr size_t WS_YGELU = 47 * MiB;
constexpr size_t WS_WIN = 64 * MiB;
constexpr size_t WS_WOUT = 110 * MiB;
constexpr size_t WS_WGLU = 126 * MiB;
constexpr size_t WS_WUP = 128 * MiB;
constexpr size_t WS_WDN = 172 * MiB;
constexpr size_t WS_MUP = 194 * MiB;
constexpr size_t WS_MDN = 642 * MiB;
constexpr size_t WS_HRES = 866 * MiB;
constexpr size_t WS_HN = 994 * MiB;
constexpr size_t WS_R = 1058 * MiB;
constexpr size_t WS_PROJ = WS_R, WS_YCAT = WS_R + 184 * MiB, WS_ATTO = WS_R + 248 * MiB, WS_OGDN = WS_R + 296 * MiB;
constexpr size_t WS_H = WS_R;
constexpr size_t WS_AS = 1534 * MiB;
constexpr size_t WS_GU = WS_AS;
constexpr size_t WS_END = 1670 * MiB;
static_assert((size_t)MOE_ROWS * DFE * 2 <= 476 * MiB && (size_t)MOE_ROWS * DM * 2 <= 136 * MiB && (size_t)1536 * GDN_UNIT_BYTES <= 136 * MiB, "ws map");
static_assert((size_t)TOK * PW * 2 <= 184 * MiB && (size_t)TOK * 768 * 4 <= 48 * MiB, "ws map 2");
constexpr int CW_BAR = 4096, CW_QUEUE = 8192, CW_CVQ = 9216, CW_ARR = 9280, CW_SCAN = 11008, CW_FIN = 12288;

constexpr int LDS_BYTES = 147456;
constexpr int RING_BYTES = 131072;
constexpr int TILE_OFF = 146432, MISC_OFF = 147200;

typedef unsigned u32x4_t __attribute__((ext_vector_type(4)));
typedef unsigned u32x2_t __attribute__((ext_vector_type(2)));
typedef float f32x2_t __attribute__((ext_vector_type(2)));

__device__ __forceinline__ float bf2f(unsigned short u) { return __uint_as_float((unsigned)u << 16); }
__device__ __forceinline__ float bflo(unsigned w) { return __uint_as_float(w << 16); }
__device__ __forceinline__ float bfhi(unsigned w) { return __uint_as_float(w & 0xffff0000u); }
__device__ __forceinline__ float wave_sum(float v) {
    v += __builtin_bit_cast(float, __builtin_amdgcn_update_dpp(0, __builtin_bit_cast(int, v), 0xB1, 0xF, 0xF, false));
    v += __builtin_bit_cast(float, __builtin_amdgcn_update_dpp(0, __builtin_bit_cast(int, v), 0x4E, 0xF, 0xF, false));
    v += __builtin_bit_cast(float, __builtin_amdgcn_update_dpp(0, __builtin_bit_cast(int, v), 0x141, 0xF, 0xF, false));
    v += __builtin_bit_cast(float, __builtin_amdgcn_update_dpp(0, __builtin_bit_cast(int, v), 0x140, 0xF, 0xF, false));
    v += __builtin_bit_cast(float, __builtin_amdgcn_update_dpp(0, __builtin_bit_cast(int, v), 0x142, 0xA, 0xF, false));
    v += __builtin_bit_cast(float, __builtin_amdgcn_update_dpp(0, __builtin_bit_cast(int, v), 0x143, 0xC, 0xF, false));
    return __builtin_bit_cast(float, __builtin_amdgcn_readlane(__builtin_bit_cast(int, v), 63));
}
__device__ __forceinline__ float sigmoid_f(float x) { return __builtin_amdgcn_rcpf(1.f + __expf(-x)); }
__device__ __forceinline__ float silu_f(float x) { return x * __builtin_amdgcn_rcpf(1.f + __expf(-x)); }
__device__ __forceinline__ float gelu_tanh_f(float y) { const float z = 0.7978845608028654f * (y + 0.044715f * y * y * y); const float e = __expf(2.f * z); const float th = 1.f - 2.f * __builtin_amdgcn_rcpf(e + 1.f); return 0.5f * y * (1.f + th); }
__device__ __forceinline__ bf16x8 pack8(const f32x4& a, const f32x4& b) {
    u32x4_t w; w.x = pk2(a[0], a[1]); w.y = pk2(a[2], a[3]); w.z = pk2(b[0], b[1]); w.w = pk2(b[2], b[3]);
    return __builtin_bit_cast(bf16x8, w);
}
__device__ __forceinline__ unsigned pk4_fp8(float a, float b, float c, float d) {
    a = __builtin_amdgcn_fmed3f(a, -448.f, 448.f); b = __builtin_amdgcn_fmed3f(b, -448.f, 448.f); c = __builtin_amdgcn_fmed3f(c, -448.f, 448.f); d = __builtin_amdgcn_fmed3f(d, -448.f, 448.f);
    int w = 0; w = __builtin_amdgcn_cvt_pk_fp8_f32(a, b, w, false); w = __builtin_amdgcn_cvt_pk_fp8_f32(c, d, w, true); return (unsigned)w;
}
#ifndef DENSE_FP8
#define DENSE_FP8 2
#endif
constexpr float S8_HN = 4.f, S8_W13 = 64.f, S8_H = 8.f, S8_W2 = 128.f;
__device__ __forceinline__ void sincos2pi(double r, float& s, float& c) {
    const double x = r * 6.283185307179586476925; const double x2 = x * x;
    double ss = 1.0, cc = 1.0;
#pragma unroll
    for (int k = 12; k >= 1; --k) { ss = 1.0 - x2 * ss / (double)((2 * k) * (2 * k + 1)); cc = 1.0 - x2 * cc / (double)((2 * k - 1) * (2 * k)); }
    s = (float)(x * ss); c = (float)cc;
}

namespace pg8 {
struct EpiProj {
    static constexpr bool PERM = true, AFTER_DRAIN = false;
    bf16_t* O;
    __device__ __forceinline__ void operator()(const f32x4 (&acc)[2][2][4][2], const Unit& u, int wr, int wc, int fr, int fq) const {
        const int row0 = u.pm * BM + wr * 64 + fr, col0 = u.pn * BM + wc * 32 + 8 * fq;
        const float sc = (u.pn >= 2 && u.pn <= 4) ? attn_body::C2 : 1.f;
#pragma unroll
        for (int ai = 0; ai < 2; ++ai)
#pragma unroll
            for (int m = 0; m < 4; ++m) { bf16_t* rowp = O + (size_t)(row0 + ai * HALF + m * 16) * PW + col0;
#pragma unroll
                for (int bj = 0; bj < 2; ++bj) { const f32x4 v0 = acc[ai][bj][m][0] * sc, v1 = acc[ai][bj][m][1] * sc;
                    u32x4 w; w.x = cvt_pk_bf16(v0[0], v0[1]); w.y = cvt_pk_bf16(v0[2], v0[3]); w.z = cvt_pk_bf16(v1[0], v1[1]); w.w = cvt_pk_bf16(v1[2], v1[3]);
                    *(u32x4*)(rowp + bj * HALF) = w; } }
    }
};
struct EpiGlu {
    static constexpr bool PERM = true, AFTER_DRAIN = false;
    const bf16_t* Y; bf16_t* O;
    __device__ __forceinline__ void operator()(const f32x4 (&acc)[2][2][4][2], const Unit& u, int wr, int wc, int fr, int fq) const {
        const int row0 = u.pm * BM + wr * 64 + fr, col0 = u.pn * BM + wc * 32 + 8 * fq;
#pragma unroll
        for (int ai = 0; ai < 2; ++ai)
#pragma unroll
            for (int m = 0; m < 4; ++m) { const int row = row0 + ai * HALF + m * 16;
#pragma unroll
                for (int bj = 0; bj < 2; ++bj) { const int col = col0 + bj * HALF;
                    const u32x4 yv = *(const u32x4*)(Y + (size_t)row * 512 + col);
                    const f32x4 a0 = acc[ai][bj][m][0], a1 = acc[ai][bj][m][1];
                    u32x4 w;
                    w.x = cvt_pk_bf16(bflo(yv.x) * sigmoid_f(a0[0]), bfhi(yv.x) * sigmoid_f(a0[1]));
                    w.y = cvt_pk_bf16(bflo(yv.y) * sigmoid_f(a0[2]), bfhi(yv.y) * sigmoid_f(a0[3]));
                    w.z = cvt_pk_bf16(bflo(yv.z) * sigmoid_f(a1[0]), bfhi(yv.z) * sigmoid_f(a1[1]));
                    w.w = cvt_pk_bf16(bflo(yv.w) * sigmoid_f(a1[2]), bfhi(yv.w) * sigmoid_f(a1[3]));
                    *(u32x4*)(O + (size_t)row * DM + col) = w; } }
    }
};
struct EpiRes {
    static constexpr bool PERM = false, AFTER_DRAIN = false;
    const float* res; float* out; const float* gate; float sin;
    __device__ __forceinline__ void operator()(const f32x4 (&acc)[2][2][4][2], const Unit& u, int wr, int wc, int fr, int fq) const {
        const int col0 = u.pn * BM + wc * 32 + 4 * fq;
#pragma unroll
        for (int ai = 0; ai < 2; ++ai)
#pragma unroll
            for (int m = 0; m < 4; ++m) { const int row = u.pm * BM + ai * HALF + wr * 64 + m * 16 + fr; const float* gp = gate + (size_t)(row >> 12) * (6 * DM); const size_t off = (size_t)row * DM;
#pragma unroll
                for (int bj = 0; bj < 2; ++bj)
#pragma unroll
                    for (int n = 0; n < 2; ++n) { const int col = col0 + bj * HALF + n * 16;
                        const f32x4 g = *(const f32x4*)(gp + col), r = *(const f32x4*)(res + off + col);
                        *(f32x4*)(out + off + col) = r + g * (acc[ai][bj][m][n] * sin); } }
    }
};
struct EpiSwiglu {
    static constexpr bool PERM = true, AFTER_DRAIN = false;
    bf16_t* H; int ldh; int nct; float sin;
    __device__ __forceinline__ void operator()(const f32x4 (&acc)[2][2][4][2], const Unit& u, int wr, int wc, int fr, int fq) const {
        const int pnl = u.pn % nct; const int row0 = u.pm * BM + wr * 64 + fr, col0 = pnl * HALF + wc * 32 + 8 * fq;
#pragma unroll
        for (int ai = 0; ai < 2; ++ai)
#pragma unroll
            for (int m = 0; m < 4; ++m) { const int row = row0 + ai * HALF + m * 16;
                const f32x4 g0 = acc[ai][0][m][0] * sin, g1 = acc[ai][0][m][1] * sin, u0 = acc[ai][1][m][0] * sin, u1 = acc[ai][1][m][1] * sin;
                u32x4 w;
                w.x = cvt_pk_bf16(silu_f(g0[0]) * u0[0], silu_f(g0[1]) * u0[1]); w.y = cvt_pk_bf16(silu_f(g0[2]) * u0[2], silu_f(g0[3]) * u0[3]);
                w.z = cvt_pk_bf16(silu_f(g1[0]) * u1[0], silu_f(g1[1]) * u1[1]); w.w = cvt_pk_bf16(silu_f(g1[2]) * u1[2], silu_f(g1[3]) * u1[3]);
                *(u32x4*)(H + (size_t)row * ldh + col0) = w; }
    }
};
struct EpiSwiglu8 {
    static constexpr bool PERM = true, AFTER_DRAIN = false;
    unsigned char* H; int ldh; int nct; float sin;
    __device__ __forceinline__ void operator()(const f32x4 (&acc)[2][2][4][2], const Unit& u, int wr, int wc, int fr, int fq) const {
        const int pnl = u.pn % nct; const int row0 = u.pm * BM + wr * 64 + fr, col0 = pnl * HALF + wc * 32 + 8 * fq;
#pragma unroll
        for (int ai = 0; ai < 2; ++ai)
#pragma unroll
            for (int m = 0; m < 4; ++m) { const int row = row0 + ai * HALF + m * 16;
                const f32x4 g0 = acc[ai][0][m][0] * sin, g1 = acc[ai][0][m][1] * sin, u0 = acc[ai][1][m][0] * (sin * S8_H), u1 = acc[ai][1][m][1] * (sin * S8_H);
                u32x2_t w; w.x = pk4_fp8(silu_f(g0[0]) * u0[0], silu_f(g0[1]) * u0[1], silu_f(g0[2]) * u0[2], silu_f(g0[3]) * u0[3]);
                w.y = pk4_fp8(silu_f(g1[0]) * u1[0], silu_f(g1[1]) * u1[1], silu_f(g1[2]) * u1[2], silu_f(g1[3]) * u1[3]);
                *(u32x2_t*)(H + (size_t)row * ldh + col0) = w; }
    }
};
struct EpiMoeDown {
    static constexpr bool PERM = true, AFTER_DRAIN = false;
    bf16_t* O; const float* gw; float sin;
    f32x4* part; gu32* flag; PG8_LAS unsigned* wcnt;
    __device__ __forceinline__ void operator()(const f32x4 (&acc)[2][2][4][2], const Unit& u, int wr, int wc, int fr, int fq) const {
        const int row0 = u.pm * BM + wr * 64 + fr, col0 = (u.pn & 7) * BM + wc * 32 + 8 * fq;
        f32x4* pp = part + ((size_t)(u.slot * 8 + wr * 4 + wc) * 32) * 64 + (fq * 16 + fr);
        if (u.ks == 1) {
#pragma unroll
            for (int ai = 0; ai < 2; ++ai)
#pragma unroll
                for (int bj = 0; bj < 2; ++bj)
#pragma unroll
                    for (int m = 0; m < 4; ++m)
#pragma unroll
                        for (int n = 0; n < 2; ++n) pp[(((ai * 2 + bj) * 4 + m) * 2 + n) * 64] = acc[ai][bj][m][n];
            asm volatile("s_waitcnt vmcnt(0)" ::: "memory");
            if (fq * 16 + fr == 0) { const unsigned old = __hip_atomic_fetch_add(wcnt, 1u, __ATOMIC_RELAXED, __HIP_MEMORY_SCOPE_WORKGROUP);
                if (old == 7u) { __builtin_amdgcn_fence(__ATOMIC_RELEASE, "agent"); asm volatile("s_waitcnt vmcnt(0)" ::: "memory"); __hip_atomic_store(flag + u.slot, 1u, RLX_AGENT); } }
            return; }
        if (u.ks == 2) {
            if (fq * 16 + fr == 0) { unsigned sp = 0; while (__hip_atomic_load(flag + u.slot, RLX_AGENT) == 0u && ++sp < (1u << 22)) __builtin_amdgcn_s_sleep(1); }
            __builtin_amdgcn_fence(__ATOMIC_ACQUIRE, "agent"); asm volatile("s_waitcnt vmcnt(0)" ::: "memory");
#pragma unroll
            for (int ai = 0; ai < 2; ++ai)
#pragma unroll
                for (int m = 0; m < 4; ++m) { const int row = row0 + ai * HALF + m * 16; const float s = gw[row] * sin; bf16_t* rowp = O + (size_t)row * DM + col0;
#pragma unroll
                    for (int bj = 0; bj < 2; ++bj) { const f32x4 v0 = (acc[ai][bj][m][0] + pp[(((ai * 2 + bj) * 4 + m) * 2 + 0) * 64]) * s, v1 = (acc[ai][bj][m][1] + pp[(((ai * 2 + bj) * 4 + m) * 2 + 1) * 64]) * s;
                        u32x4 w; w.x = cvt_pk_bf16(v0[0], v0[1]); w.y = cvt_pk_bf16(v0[2], v0[3]); w.z = cvt_pk_bf16(v1[0], v1[1]); w.w = cvt_pk_bf16(v1[2], v1[3]);
                        *(u32x4*)(rowp + bj * HALF) = w; }
                    asm volatile("" ::: "memory"); }
            return; }
#pragma unroll
        for (int ai = 0; ai < 2; ++ai)
#pragma unroll
            for (int m = 0; m < 4; ++m) { const int row = row0 + ai * HALF + m * 16; const float s = gw[row] * sin; bf16_t* rowp = O + (size_t)row * DM + col0;
#pragma unroll
                for (int bj = 0; bj < 2; ++bj) { const f32x4 v0 = acc[ai][bj][m][0] * s, v1 = acc[ai][bj][m][1] * s;
                    u32x4 w; w.x = cvt_pk_bf16(v0[0], v0[1]); w.y = cvt_pk_bf16(v0[2], v0[3]); w.z = cvt_pk_bf16(v1[0], v1[1]); w.w = cvt_pk_bf16(v1[2], v1[3]);
                    *(u32x4*)(rowp + bj * HALF) = w; } }
    }
};
struct MoeOrder {
    static constexpr bool SPLITK = false;
    StaticOrder so; const PG8_LAS int* tile_e; int nct; int rev = 0;
    __device__ __forceinline__ bool next(int i, Unit& u) const { if (!so.next(i, u)) return false; if (rev) u.pm = so.nM - 1 - u.pm; u.pn += __builtin_amdgcn_readfirstlane(tile_e[u.pm]) * nct; return true; }
    __device__ __forceinline__ void a_ready(const Unit&) const {}
    __device__ __forceinline__ void done(const Unit&) const {}
};
struct MoeDownOrder {
    static constexpr bool SPLITK = true;
    StaticOrder so; const PG8_LAS int* tile_e; int nct, nM, nl, R, c, ntf; gu32* arr; LAS unsigned* wc;
    __device__ __forceinline__ bool next(int i, Unit& u) const {
        if (i < R) { (void)so.next(i, u); u.pm = nM - 1 - u.pm; }
        else if (i == R && c < nl * 16) { u.pm = c >> 4; u.pn = c & 7; const int h = (c >> 3) & 1; u.kt0 = h * (ntf >> 1); u.nt = ntf >> 1; u.ks = 1 + h; u.slot = (c >> 4) * 8 + (c & 7); }
        else return false;
        if (i < R) { u.kt0 = 0; u.nt = ntf; u.ks = 0; }
        u.aux = i; u.pn += __builtin_amdgcn_readfirstlane(tile_e[u.pm]) * nct; return true; }
    __device__ __forceinline__ void a_ready(const Unit&) const {}
    __device__ __forceinline__ void done(const Unit& u) const {
        if (u.aux == R - 1) { asm volatile("s_waitcnt vmcnt(0)" ::: "memory");
            if (mk_lane() == 0) { const unsigned old = __hip_atomic_fetch_add(wc, 1u, __ATOMIC_RELAXED, __HIP_MEMORY_SCOPE_WORKGROUP);
                if (old == 7u) { __builtin_amdgcn_fence(__ATOMIC_RELEASE, "agent"); asm volatile("s_waitcnt vmcnt(0)" ::: "memory"); (void)__hip_atomic_fetch_add(arr, 1u, RLX_AGENT); } } } }
};
}

#if defined(PROBE_LO)
#define PSPAN_BEGIN(C, id) do { if ((id) == PROBE_LO && blockIdx.x == 0 && (C).wave == 0 && mk_lane() == 0) { const unsigned long long t_ = __builtin_amdgcn_s_memrealtime(); (C).MISC[20] = (unsigned)t_; (C).MISC[21] = (unsigned)(t_ >> 32); } } while (0)
#define PSPAN_END(C, id) do { if ((id) == PROBE_LO && blockIdx.x == 0 && (C).wave == 0 && mk_lane() == 0) { const unsigned long long t_ = __builtin_amdgcn_s_memrealtime() - (((unsigned long long)(C).MISC[21] << 32) | (C).MISC[20]); (C).MISC[22] += (unsigned)t_; } } while (0)
#else
#define PSPAN_BEGIN(C, id) do {} while (0)
#define PSPAN_END(C, id) do {} while (0)
#endif
struct Params { const float* in[35]; float* out; unsigned char* ws; int ph_lo, ph_hi; };
typedef const __attribute__((address_space(4))) Params* KP;

#define PIN(i) ((const float*)(const GAS float*)(P->in[i]))
#define POUT ((float*)(GAS float*)(P->out))
struct Ctx {
    LAS unsigned char* lds; volatile LAS unsigned* MISC; GAS unsigned char* ws; gu32* ctl;
    int tid, lane, wave, blk, G;
};

__device__ __forceinline__ void tr_tile(const float* __restrict__ src, int ld, bf16* dst, int K, int k0, int n0, int drow0, int lane) {
    const int c4 = lane & 15, r = lane >> 4;
    const float* sp = src + (size_t)(k0 + 16 * r) * ld + n0 + 4 * c4;
    f32x4 x[16];
#pragma unroll
    for (int i = 0; i < 16; ++i) x[i] = __builtin_nontemporal_load((const f32x4*)(sp + (size_t)i * ld));
    bf16* dp = dst + (size_t)(drow0 + 4 * c4) * K + k0 + 16 * r;
#pragma unroll
    for (int q = 0; q < 4; ++q)
#pragma unroll
        for (int hf = 0; hf < 2; ++hf) { v4u o; o.x = pk2(x[8 * hf + 0][q], x[8 * hf + 1][q]); o.y = pk2(x[8 * hf + 2][q], x[8 * hf + 3][q]); o.z = pk2(x[8 * hf + 4][q], x[8 * hf + 5][q]); o.w = pk2(x[8 * hf + 6][q], x[8 * hf + 7][q]);
            *(GAS v4u*)(dp + (size_t)q * K + 8 * hf) = o; }
}
__device__ __forceinline__ void tr_tile8(const float* __restrict__ src, int ld, unsigned char* dst, int K, int k0, int n0, int drow0, int lane, float sc) {
    const int c4 = lane & 15, r = lane >> 4;
    const float* sp = src + (size_t)(k0 + 16 * r) * ld + n0 + 4 * c4;
    f32x4 x[16];
#pragma unroll
    for (int i = 0; i < 16; ++i) x[i] = __builtin_nontemporal_load((const f32x4*)(sp + (size_t)i * ld)) * sc;
    unsigned char* dp = dst + (size_t)(drow0 + 4 * c4) * K + k0 + 16 * r;
#pragma unroll
    for (int q = 0; q < 4; ++q) { v4u o; o.x = pk4_fp8(x[0][q], x[1][q], x[2][q], x[3][q]); o.y = pk4_fp8(x[4][q], x[5][q], x[6][q], x[7][q]); o.z = pk4_fp8(x[8][q], x[9][q], x[10][q], x[11][q]); o.w = pk4_fp8(x[12][q], x[13][q], x[14][q], x[15][q]);
        *(GAS v4u*)(dp + (size_t)q * K) = o; }
}
__device__ __forceinline__ void tr_plain(const float* src, int ld, int K, int N, bf16* dst, int item, int lane) {
    const int nblk = N / 64, kb = item / nblk, nb = item % nblk;
    tr_tile(src, ld, dst, K, 64 * kb, 64 * nb, 64 * nb, lane);
}
__device__ __forceinline__ void tr_inter(const float* src, int K, int N, bf16* dst, int half, int item, int lane) {
    const int nblk = N / 64, kb = item / nblk, nb = item % nblk, n0 = 64 * nb;
    tr_tile(src, N, dst, K, 64 * kb, n0, (n0 >> 7) * 256 + half * 128 + (n0 & 127), lane);
}

__device__ __forceinline__ void p0_ada(const Ctx& C, KP P) {
    const int u = C.blk, l = u / 96, n0 = (u % 96) * 128;
    LAS float* sc = (LAS float*)C.lds; LAS float* part = (LAS float*)(C.lds + 32768);
    const float* cin = PIN(1);
    for (int i = C.tid; i < 4 * DM; i += NTHR) sc[i] = silu_f(cin[i]);
    __syncthreads();
    const int sub = C.lane >> 5, c4 = C.lane & 31, w = C.wave;
    const float* Wp = PIN(3) + ((size_t)l * DM + 256 * w + sub) * (6 * DM) + n0 + 4 * c4;
    f32x4 acc[4];
#pragma unroll
    for (int b = 0; b < 4; ++b) acc[b] = (f32x4){0.f, 0.f, 0.f, 0.f};
#pragma unroll 8
    for (int i = 0; i < 128; ++i) { const f32x4 wv = *(const f32x4*)(Wp + (size_t)(2 * i) * (6 * DM)); const int k = 256 * w + 2 * i + sub;
#pragma unroll
        for (int b = 0; b < 4; ++b) acc[b] += wv * sc[b * DM + k]; }
#pragma unroll
    for (int b = 0; b < 4; ++b)
#pragma unroll
        for (int q = 0; q < 4; ++q) acc[b][q] += __shfl_xor(acc[b][q], 32);
    if (C.lane < 32) {
#pragma unroll
        for (int b = 0; b < 4; ++b)
#pragma unroll
            for (int q = 0; q < 4; ++q) part[(w * 4 + b) * 128 + 4 * c4 + q] = acc[b][q]; }
    __syncthreads();
    { const int b = C.tid >> 7, n = C.tid & 127; float s = PIN(4)[l * (6 * DM) + n0 + n];
#pragma unroll
      for (int ww = 0; ww < 8; ++ww) s += part[(ww * 4 + b) * 128 + n];
      ((float*)(C.ws + WS_MOD))[(size_t)(l * 4 + b) * (6 * DM) + n0 + n] = s; }
    __syncthreads();
}

__device__ __forceinline__ void p0_ssm(const Ctx& C, KP P) {
    const int u = C.blk - 192, l = u >> 5, g = u & 31, lg = l * 32 + g;
    LAS f32x2_t* Pw = (LAS f32x2_t*)C.lds;
    LAS f32x2_t* Bb = (LAS f32x2_t*)(C.lds + 8704);
    LAS f32x2_t* Cc = (LAS f32x2_t*)(C.lds + 8704 + 8192);
    LAS float* Kl = (LAS float*)(C.lds + 8704 + 16384);
    const float dt = expf(PIN(12)[lg]);
    if (C.tid < 64) { const int p = C.tid; const float ar = PIN(10)[lg * 64 + p], ai = PIN(11)[lg * 64 + p];
        for (int j = 0; j <= 16; ++j) { const float mag = expf(ar * dt * (float)j); double rev = (double)ai * (double)dt * (double)j * 0.15915494309189533577; rev -= rint(rev);
            float s, c; sincos2pi(rev, s, c); Pw[j * 64 + p] = (f32x2_t){mag * c, mag * s}; }
        const f32x2_t lb = Pw[64 + p]; const float nx = lb.x - 1.f, ny = lb.y, den = ar * ar + ai * ai;
        const float cx = (nx * ar + ny * ai) / den, cy = (ny * ar - nx * ai) / den;
        for (int h = 0; h < 16; ++h) { const float br = PIN(13)[(lg * 64 + p) * 16 + h], bi = PIN(14)[(lg * 64 + p) * 16 + h]; Bb[p * 16 + h] = (f32x2_t){cx * br - cy * bi, cx * bi + cy * br}; }
        ((f32x2_t*)(C.ws + WS_A16))[lg * 64 + p] = Pw[16 * 64 + p]; }
    for (int i = C.tid; i < 1024; i += NTHR) Cc[i] = (f32x2_t){PIN(15)[lg * 1024 + i], PIN(16)[lg * 1024 + i]};
    __syncthreads();
    for (int e = C.tid; e < 4096; e += NTHR) { const int j = e >> 8, hp = (e >> 4) & 15, h = e & 15; float s = 0.f;
        for (int p = 0; p < 64; ++p) { const f32x2_t c = Cc[hp * 64 + p], pw = Pw[j * 64 + p], bb = Bb[p * 16 + h]; const float zx = c.x * pw.x - c.y * pw.y, zy = c.x * pw.y + c.y * pw.x; s += zx * bb.x - zy * bb.y; }
        if (j == 0 && hp == h) s += PIN(17)[l * 512 + g * 16 + h];
        Kl[e] = s; }
    __syncthreads();
    bf16* M2 = (bf16*)(C.ws + WS_M2) + (size_t)lg * 128 * 256;
    for (int pc = C.tid; pc < 4096; pc += NTHR) { const int n = pc >> 5, k0 = (pc & 31) * 8, p = n >> 1, ri = n & 1, s = k0 >> 4, h0 = k0 & 15; const f32x2_t pw = Pw[(15 - s) * 64 + p]; float v[8];
#pragma unroll
        for (int j = 0; j < 8; ++j) { const f32x2_t bb = Bb[p * 16 + h0 + j]; v[j] = ri ? (pw.x * bb.y + pw.y * bb.x) : (pw.x * bb.x - pw.y * bb.y); }
        v4u o; o.x = pk2(v[0], v[1]); o.y = pk2(v[2], v[3]); o.z = pk2(v[4], v[5]); o.w = pk2(v[6], v[7]); *(GAS v4u*)(M2 + (size_t)n * 256 + k0) = o; }
    bf16* M13 = (bf16*)(C.ws + WS_M13) + (size_t)lg * 256 * 384;
    for (int pc = C.tid; pc < 12288; pc += NTHR) { const int n = pc / 48, k0 = (pc % 48) * 8, i = n >> 4, hp = n & 15; float v[8];
        if (k0 < 256) { const int s = k0 >> 4, h0 = k0 & 15;
#pragma unroll
            for (int j = 0; j < 8; ++j) v[j] = (i >= s) ? Kl[((i - s) * 16 + hp) * 16 + h0 + j] : 0.f; }
        else {
#pragma unroll
            for (int j = 0; j < 8; ++j) { const int kk = k0 - 256 + j, p = kk >> 1, ri = kk & 1; const f32x2_t c = Cc[hp * 64 + p], pw = Pw[(i + 1) * 64 + p]; const float zx = c.x * pw.x - c.y * pw.y, zy = c.x * pw.y + c.y * pw.x; v[j] = ri ? -zy : zx; } }
        v4u o; o.x = pk2(v[0], v[1]); o.y = pk2(v[2], v[3]); o.z = pk2(v[4], v[5]); o.w = pk2(v[6], v[7]); *(GAS v4u*)(M13 + (size_t)n * 384 + k0) = o; }
    __syncthreads();
}

__device__ __forceinline__ void p0_prologue(const Ctx& C, KP P) {
    if (C.blk < 192) p0_ada(C, P); else p0_ssm(C, P);
    { const int* pos = (const int*)PIN(2); float* rope = (float*)(C.ws + WS_ROPE);
      for (int idx = C.blk * NTHR + C.tid; idx < TOK * 8; idx += C.G * NTHR) { const int t = idx >> 3, i = idx & 7;
          const double invf = exp(-(double)i * (13.122363377404328 / 8.0)); double rev = (double)pos[t] * invf * 0.15915494309189533577; rev -= rint(rev);
          float s, c; sincos2pi(rev, s, c); rope[t * 16 + i] = c; rope[t * 16 + 8 + i] = s; } }
    const int gw = C.blk * NWAVES + C.wave, NGW = C.G * NWAVES, lane = C.lane;
    constexpr int I_IN = 32 * 92, I_OUT = 32 * 32, I_GLU = 8 * 8, I_F13 = 32 * 88, I_F2 = 88 * 32, I_M13 = 32 * 112, I_M2 = 112 * 32;
    constexpr int NITEMS = 2 * I_IN + 2 * I_OUT + 2 * I_GLU + 2 * I_F13 + I_F2;
#pragma unroll 1
    for (int it = gw; it < NITEMS; it += NGW) {
        int r = it;
        if (r < 2 * I_IN) { const int l = r / I_IN; r -= l * I_IN; tr_plain(PIN(8) + (size_t)l * DM * INW, INW, DM, PW, (bf16*)(C.ws + WS_WIN) + (size_t)l * PW * DM, r, lane); continue; } r -= 2 * I_IN;
        if (r < 2 * I_OUT) { const int l = r / I_OUT; r -= l * I_OUT; tr_plain(PIN(9) + (size_t)l * DM * DM, DM, DM, DM, (bf16*)(C.ws + WS_WOUT) + (size_t)l * DM * DM, r, lane); continue; } r -= 2 * I_OUT;
        if (r < 2 * I_GLU) { const int l = r / I_GLU; r -= l * I_GLU; tr_plain(PIN(18) + (size_t)l * 512 * 512, 512, 512, 512, (bf16*)(C.ws + WS_WGLU) + (size_t)l * 512 * 512, r, lane); continue; } r -= 2 * I_GLU;
        if (r < 2 * I_F13) { const int half = r / I_F13; r -= half * I_F13;
            if (DENSE_FP8 >= 1) { const int nblk = DFF / 64, kb = r / nblk, n0 = 64 * (r % nblk); tr_tile8(half ? PIN(29) : PIN(28), DFF, (unsigned char*)(C.ws + WS_WUP), DM, 64 * kb, n0, (n0 >> 7) * 256 + half * 128 + (n0 & 127), lane, S8_W13); }
            else tr_inter(half ? PIN(29) : PIN(28), DM, DFF, (bf16*)(C.ws + WS_WUP), half, r, lane);
            continue; } r -= 2 * I_F13;
        if (r < I_F2) { if (DENSE_FP8 >= 2) { const int nblk = DM / 64, kb = r / nblk, n0 = 64 * (r % nblk); tr_tile8(PIN(30), DM, (unsigned char*)(C.ws + WS_WDN), DFF, 64 * kb, n0, n0, lane, S8_W2); }
            else tr_plain(PIN(30), DM, DFF, DM, (bf16*)(C.ws + WS_WDN), r, lane); }
    }
}

constexpr int MOE_CVT_TILES = 16 * (32 * 112) + 8 * (112 * 32), MOE_CVT_CHUNKS = MOE_CVT_TILES / 16;
__device__ __forceinline__ void moe_cvt_tile(const Ctx& C, KP P, int r, int lane) {
    constexpr int I_M13 = 32 * 112, I_M2 = 112 * 32;
    if (r < 16 * I_M13) { const int q = r / I_M13, e = q >> 1, half = q & 1; r -= q * I_M13; const int nblk = DFE / 64, kb = r / nblk, n0 = 64 * (r % nblk);
        tr_tile8((half ? PIN(33) : PIN(32)) + (size_t)e * DM * DFE, DFE, (unsigned char*)(C.ws + WS_MUP) + (size_t)e * 2 * DFE * DM, DM, 64 * kb, n0, (n0 >> 7) * 256 + half * 128 + (n0 & 127), lane, S8_W13); }
    else { r -= 16 * I_M13; const int e = r / I_M2; r -= e * I_M2; const int nblk = DM / 64, kb = r / nblk, n0 = 64 * (r % nblk);
        tr_tile8(PIN(34) + (size_t)e * DFE * DM, DM, (unsigned char*)(C.ws + WS_MDN) + (size_t)e * DM * DFE, DFE, 64 * kb, n0, n0, lane, S8_W2); }
}
__device__ __forceinline__ void moe_cvt_fill(const Ctx& C, KP P, int k, bool all) {
    gu32* arr = C.ctl + CW_ARR + 64 * k; gu32* head = C.ctl + CW_CVQ;
    if (!all && C.wave == 0 && C.lane == 0) (void)__hip_atomic_fetch_add(arr, 1u, RLX_AGENT);
    for (;;) {
        if (C.wave == 0 && C.lane == 0) { unsigned q = 0xffffffffu; if (all || __hip_atomic_load(arr, RLX_AGENT) < (unsigned)C.G) q = __hip_atomic_fetch_add(head, 1u, RLX_AGENT); C.MISC[24] = q; }
        __syncthreads();
        const unsigned q = (unsigned)__builtin_amdgcn_readfirstlane((int)C.MISC[24]);
        __syncthreads();
        if (q >= (unsigned)MOE_CVT_CHUNKS) break;
        { const int tb = (MOE_CVT_CHUNKS - 1 - (int)q) * 16 + C.wave * 2;
          moe_cvt_tile(C, P, tb, C.lane); moe_cvt_tile(C, P, tb + 1, C.lane); }
    }
}

template <bool WITH_GAB, bool OUT8 = false>
__device__ __forceinline__ void norm_phase(const Ctx& C, const float* __restrict__ src, const float* __restrict__ nw, const float* __restrict__ mod_shift, const float* __restrict__ mod_scale, const float* __restrict__ w12  ) {
    LAS float* W12T = (LAS float*)C.lds;
    if (WITH_GAB) { for (int idx = C.tid; idx < DM * 12; idx += NTHR) { const int k = idx / 12, j = idx % 12; W12T[j * DM + k] = w12[(size_t)k * INW + C_GA + j]; } __syncthreads(); }
    bf16* HN = (bf16*)(C.ws + WS_HN); float* GAB = (float*)(C.ws + WS_GAB);
    const int lane = C.lane;
    f32x4 nwv[8];
#pragma unroll
    for (int j = 0; j < 8; ++j) nwv[j] = *(const f32x4*)(nw + 4 * lane + 256 * j);
    f32x4 vn[2][8];
#pragma unroll
    for (int u = 0; u < 2; ++u)
#pragma unroll
        for (int j = 0; j < 8; ++j) vn[u][j] = *(const f32x4*)(src + (size_t)(C.blk * 64 + C.wave * 8 + u) * DM + 4 * lane + 256 * j);
    int nlim = 4; asm volatile("" : "+s"(nlim));
#pragma unroll 1
    for (int i = 0; i < nlim; ++i) { const int t0 = C.blk * 64 + C.wave * 8 + 2 * i; const int b = t0 >> 12;
        f32x4 v[2][8]; float ss0 = 0.f, ss1 = 0.f;
#pragma unroll
        for (int j = 0; j < 8; ++j) { v[0][j] = vn[0][j]; v[1][j] = vn[1][j];
            ss0 += (v[0][j].x * v[0][j].x + v[0][j].y * v[0][j].y) + (v[0][j].z * v[0][j].z + v[0][j].w * v[0][j].w); ss1 += (v[1][j].x * v[1][j].x + v[1][j].y * v[1][j].y) + (v[1][j].z * v[1][j].z + v[1][j].w * v[1][j].w); }
        if (i + 1 < nlim) {
#pragma unroll
            for (int u = 0; u < 2; ++u)
#pragma unroll
                for (int j = 0; j < 8; ++j) vn[u][j] = *(const f32x4*)(src + (size_t)(t0 + 2 + u) * DM + 4 * lane + 256 * j); }
        const float r0 = rsqrtf(wave_sum(ss0) * (1.f / DM) + EPS), r1 = rsqrtf(wave_sum(ss1) * (1.f / DM) + EPS);
        const float* sh = mod_shift + (size_t)b * 6 * DM; const float* scp = mod_scale + (size_t)b * 6 * DM;
#pragma unroll
        for (int j = 0; j < 8; ++j) { const f32x4 s1 = *(const f32x4*)(scp + 4 * lane + 256 * j), s0 = *(const f32x4*)(sh + 4 * lane + 256 * j); const f32x4 m1 = nwv[j] * (s1 + 1.f);
            v[0][j] = v[0][j] * r0 * m1 + s0; v[1][j] = v[1][j] * r1 * m1 + s0;
#pragma unroll
            for (int u = 0; u < 2; ++u) {
                if (OUT8) *(GAS unsigned*)((unsigned char*)HN + (size_t)(t0 + u) * DM + 4 * lane + 256 * j) = pk4_fp8(v[u][j].x * S8_HN, v[u][j].y * S8_HN, v[u][j].z * S8_HN, v[u][j].w * S8_HN);
                else { u32x2_t o; o.x = pk2(v[u][j].x, v[u][j].y); o.y = pk2(v[u][j].z, v[u][j].w); *(GAS u32x2_t*)(HN + (size_t)(t0 + u) * DM + 4 * lane + 256 * j) = o; } } }
        if (WITH_GAB) { unsigned wb = 16u * (unsigned)lane; asm volatile("" : "+v"(wb));
            const LAS float* W12L = (const LAS float*)(size_t)wb;
#pragma unroll
            for (int jj = 0; jj < 12; ++jj) { float a0 = 0.f, a1 = 0.f;
#pragma unroll
                for (int j = 0; j < 8; ++j) { const f32x4 wv = *(const LAS f32x4*)(W12L + jj * DM + 256 * j);
                    a0 += (v[0][j].x * wv.x + v[0][j].y * wv.y) + (v[0][j].z * wv.z + v[0][j].w * wv.w); a1 += (v[1][j].x * wv.x + v[1][j].y * wv.y) + (v[1][j].z * wv.z + v[1][j].w * wv.w); }
                a0 = wave_sum(a0); a1 = wave_sum(a1); if (lane == 0) { GAB[(size_t)t0 * 12 + jj] = a0; GAB[(size_t)(t0 + 1) * 12 + jj] = a1; } } }
    }
    __syncthreads();
}

__device__ __forceinline__ void rope_pass(const Ctx& C) {
    bf16* PROJ = (bf16*)(C.ws + WS_PROJ); const float* rope = (const float*)(C.ws + WS_ROPE);
    for (int idx = C.blk * NTHR + C.tid; idx < TOK * 24; idx += C.G * NTHR) { const int t = idx / 24, v = idx % 24;
        bf16* p = PROJ + (size_t)t * PW + (v < 12 ? C_DQ + v * 64 : C_DK + (v - 12) * 64);
        const u32x4_t a = *(const u32x4_t*)p, b = *(const u32x4_t*)(p + 8);
        const f32x4 c0 = *(const f32x4*)(rope + t * 16), c1 = *(const f32x4*)(rope + t * 16 + 4), s0 = *(const f32x4*)(rope + t * 16 + 8), s1 = *(const f32x4*)(rope + t * 16 + 12);
        const float t1[8] = {bflo(a.x), bfhi(a.x), bflo(a.y), bfhi(a.y), bflo(a.z), bfhi(a.z), bflo(a.w), bfhi(a.w)};
        const float t2[8] = {bflo(b.x), bfhi(b.x), bflo(b.y), bfhi(b.y), bflo(b.z), bfhi(b.z), bflo(b.w), bfhi(b.w)};
        const float cs[8] = {c0.x, c0.y, c0.z, c0.w, c1.x, c1.y, c1.z, c1.w}, sn[8] = {s0.x, s0.y, s0.z, s0.w, s1.x, s1.y, s1.z, s1.w};
        float o1[8], o2[8];
#pragma unroll
        for (int i = 0; i < 8; ++i) { o1[i] = t1[i] * cs[i] - t2[i] * sn[i]; o2[i] = t2[i] * cs[i] + t1[i] * sn[i]; }
        u32x4_t oa, ob; oa.x = pk2(o1[0], o1[1]); oa.y = pk2(o1[2], o1[3]); oa.z = pk2(o1[4], o1[5]); oa.w = pk2(o1[6], o1[7]);
        ob.x = pk2(o2[0], o2[1]); ob.y = pk2(o2[2], o2[3]); ob.z = pk2(o2[4], o2[5]); ob.w = pk2(o2[6], o2[7]);
        *(u32x4_t*)p = oa; *(u32x4_t*)(p + 8) = ob; }
}

#define SSM_BAR() asm volatile("s_waitcnt lgkmcnt(0)\n\ts_barrier" ::: "memory")
__device__ __forceinline__ void ssm_gemm_a(const Ctx& C, int l) {
    const bf16* PROJ = (const bf16*)(C.ws + WS_PROJ); float* XC = (float*)(C.ws + WS_XC);
    const int lane = C.lane, fr = lane & 15, quad = lane >> 4, tid = C.tid;
    for (int bu = C.blk; bu < 256; bu += C.G) { const int g = bu >> 3, rt = (bu & 7) * 8 + C.wave, r = 16 * rt + fr, tok = (r >> 8) * SQ + (r & 255) * 16;
        const bf16* arow = PROJ + (size_t)(tok + (quad >> 1)) * PW + C_U + g * 16 + 8 * (quad & 1);
        const bf16* bsrc = (const bf16*)(C.ws + WS_M2) + ((size_t)(l * 32 + g) * 128 + 16 * (tid >> 6) + fr) * 256 + 8 * quad;
        f32x4 acc[8];
#pragma unroll
        for (int nt = 0; nt < 8; ++nt) acc[nt] = (f32x4){0.f, 0.f, 0.f, 0.f};
        u32x4_t rb = *(const u32x4_t*)bsrc; bf16x8 an = *(const bf16x8*)arow;
        *(LAS u32x4_t*)(C.lds + tid * 16) = rb;
        SSM_BAR();
#pragma unroll 1
        for (int ks = 0; ks < 8; ++ks) { const bf16x8 a = an; const LAS unsigned char* cur = C.lds + (ks & 1) * 8192;
            if (ks + 1 < 8) { rb = *(const u32x4_t*)(bsrc + 32 * (ks + 1)); an = *(const bf16x8*)(arow + (size_t)(2 * (ks + 1)) * PW); }
#pragma unroll
            for (int nt = 0; nt < 8; ++nt) { const bf16x8 b = *(const LAS bf16x8*)(cur + (nt * 64 + lane) * 16); acc[nt] = __builtin_amdgcn_mfma_f32_16x16x32_bf16(a, b, acc[nt], 0, 0, 0); }
            if (ks + 1 < 8) *(LAS u32x4_t*)(C.lds + ((ks + 1) & 1) * 8192 + tid * 16) = rb;
            SSM_BAR(); }
#pragma unroll
        for (int nt = 0; nt < 8; ++nt)
#pragma unroll
            for (int j = 0; j < 4; ++j) XC[((size_t)(16 * rt + 4 * quad + j) * 32 + g) * 128 + 16 * nt + fr] = acc[nt][j];
    }
}

__device__ __forceinline__ void ssm_gemm_b(const Ctx& C, int l) {
    const bf16* PROJ = (const bf16*)(C.ws + WS_PROJ); const bf16* XS = (const bf16*)(C.ws + WS_XS); bf16* YG = (bf16*)(C.ws + WS_YGELU);
    const int lane = C.lane, fr = lane & 15, quad = lane >> 4, tid = C.tid;
    for (int bu = C.blk; bu < 256; bu += C.G) { const int g = bu >> 3, rt = (bu & 7) * 8 + C.wave, r = 16 * rt + fr, tok = (r >> 8) * SQ + (r & 255) * 16;
        const bf16* arow = PROJ + (size_t)(tok + (quad >> 1)) * PW + C_U + g * 16 + 8 * (quad & 1);
        const bf16* xrow = XS + ((size_t)r * 32 + g) * 128 + 8 * quad;
        const bf16* bsrc = (const bf16*)(C.ws + WS_M13) + ((size_t)(l * 32 + g) * 256 + 16 * (tid >> 6) + fr) * 384 + 8 * quad;
        f32x4 acc[16];
#pragma unroll
        for (int nt = 0; nt < 16; ++nt) acc[nt] = (f32x4){0.f, 0.f, 0.f, 0.f};
        u32x4_t rb0 = *(const u32x4_t*)bsrc, rb1 = *(const u32x4_t*)(bsrc + 128 * 384); bf16x8 an = *(const bf16x8*)arow;
        *(LAS u32x4_t*)(C.lds + tid * 16) = rb0; *(LAS u32x4_t*)(C.lds + 8192 + tid * 16) = rb1;
        SSM_BAR();
#pragma unroll 1
        for (int ks = 0; ks < 12; ++ks) { const bf16x8 a = an; const LAS unsigned char* cur = C.lds + (ks & 1) * 16384;
            if (ks + 1 < 12) { rb0 = *(const u32x4_t*)(bsrc + 32 * (ks + 1)); rb1 = *(const u32x4_t*)(bsrc + 128 * 384 + 32 * (ks + 1));
                an = (ks + 1 < 8) ? *(const bf16x8*)(arow + (size_t)(2 * (ks + 1)) * PW) : *(const bf16x8*)(xrow + 32 * (ks + 1 - 8)); }
#pragma unroll
            for (int nt = 0; nt < 16; ++nt) { const bf16x8 b = *(const LAS bf16x8*)(cur + (nt * 64 + lane) * 16); acc[nt] = __builtin_amdgcn_mfma_f32_16x16x32_bf16(a, b, acc[nt], 0, 0, 0); }
            if (ks + 1 < 12) { *(LAS u32x4_t*)(C.lds + ((ks + 1) & 1) * 16384 + tid * 16) = rb0; *(LAS u32x4_t*)(C.lds + ((ks + 1) & 1) * 16384 + 8192 + tid * 16) = rb1; }
            SSM_BAR(); }
#pragma unroll
        for (int j = 0; j < 4; ++j) { const int rr = 16 * rt + 4 * quad + j; const size_t tb = (size_t)((rr >> 8) * SQ + (rr & 255) * 16);
#pragma unroll
            for (int nt = 0; nt < 16; ++nt) YG[(tb + nt) * 512 + g * 16 + fr] = (bf16)f2bf(gelu_tanh_f(acc[nt][j])); }
    }
}

__device__ __forceinline__ void ssm_scan(const Ctx& C, int l, int sblk  ) {
    const int idx = sblk * NTHR + C.tid, b = idx >> 11, g = (idx >> 6) & 31, p = idx & 63;
    const f32x2_t a = ((const f32x2_t*)(C.ws + WS_A16))[(l * 32 + g) * 64 + p];
    const f32x2_t* xc = (const f32x2_t*)(C.ws + WS_XC) + ((size_t)(b * 256) * 32 + g) * 64 + p; unsigned* xs = (unsigned*)(C.ws + WS_XS) + ((size_t)(b * 256) * 32 + g) * 64 + p;
    float xr = 0.f, xi = 0.f;
    for (int c0 = 0; c0 < 256; c0 += 8) { f32x2_t in[8];
#pragma unroll
        for (int q = 0; q < 8; ++q) in[q] = xc[(size_t)(c0 + q) * 2048];
#pragma unroll
        for (int q = 0; q < 8; ++q) { xs[(size_t)(c0 + q) * 2048] = pk2(xr, xi); const float nr = a.x * xr - a.y * xi + in[q].x, ni = a.x * xi + a.y * xr + in[q].y; xr = nr; xi = ni; } }
}

constexpr int GL_QT = 0, GL_KT = 33792, GL_VT = 67584, GL_AM = 101376, GL_QK = 118784, GL_SM = 136192;
__device__ __forceinline__ void gdn_prep_unit(const Ctx& C, KP P, int l, int unit) {
    const int b = unit / 384, h = (unit / 64) % 6, ch = unit & 63, tok0 = b * SQ + ch * 64, tid = C.tid, lane = C.lane, wave = C.wave;
    LAS float* QT = (LAS float*)(C.lds + GL_QT); LAS float* KT = (LAS float*)(C.lds + GL_KT); LAS float* VT = (LAS float*)(C.lds + GL_VT);
    LAS float* AM = (LAS float*)(C.lds + GL_AM); LAS float* QKM = (LAS float*)(C.lds + GL_QK);
    unsigned smb = GL_SM; asm volatile("" : "+v"(smb));
    LAS float* gc = (LAS float*)(size_t)smb; LAS float* beta = gc + 64; LAS float* eg = gc + 128; LAS float* ek = gc + 192;
    const bf16* PROJ = (const bf16*)(C.ws + WS_PROJ); const float* convw = PIN(24) + (size_t)l * 4 * 2304;
    GAS unsigned char* UB = C.ws + WS_GU + (size_t)unit * GDN_UNIT_BYTES;
    PSPAN_BEGIN(C, 110);
    if (tid < 384) { const int cg = tid % 48, seg = tid / 48, which = cg >> 4, d0 = (cg & 15) * 8, chn = which * 768 + h * 128 + d0, sp0 = ch * 64 + 8 * seg - 3;
        const bf16* src = PROJ + ((size_t)(b * SQ) + sp0) * PW + C_GQ + chn;
        u32x4_t raw[11];
#pragma unroll
        for (int r = 0; r < 11; ++r) raw[r] = (r >= 3 || sp0 + r >= 0) ? *(const u32x4_t*)(src + (ptrdiff_t)r * PW) : (u32x4_t){0u, 0u, 0u, 0u};
        f32x4 wv[4][2];
#pragma unroll
        for (int tap = 0; tap < 4; ++tap) { wv[tap][0] = *(const f32x4*)(convw + tap * 2304 + chn); wv[tap][1] = *(const f32x4*)(convw + tap * 2304 + chn + 4); }
        LAS float* T = (LAS float*)(C.lds + which * 33792) + (8 * seg) * 132 + d0;
#pragma unroll
        for (int i = 0; i < 8; ++i) { f32x4 a0 = (f32x4){0.f, 0.f, 0.f, 0.f}, a1 = a0;
#pragma unroll
            for (int tap = 0; tap < 4; ++tap) { const u32x4_t w = raw[i + tap];
                a0 += wv[tap][0] * (f32x4){bflo(w.x), bfhi(w.x), bflo(w.y), bfhi(w.y)}; a1 += wv[tap][1] * (f32x4){bflo(w.z), bfhi(w.z), bflo(w.w), bfhi(w.w)}; }
            *(LAS f32x4*)(T + i * 132) = (f32x4){silu_f(a0.x), silu_f(a0.y), silu_f(a0.z), silu_f(a0.w)}; *(LAS f32x4*)(T + i * 132 + 4) = (f32x4){silu_f(a1.x), silu_f(a1.y), silu_f(a1.z), silu_f(a1.w)}; } }
    __syncthreads();
    PSPAN_END(C, 110); PSPAN_BEGIN(C, 111);
#pragma unroll
    for (int ii = 0; ii < 8; ++ii) { const int i = wave * 8 + ii;
        { const float a = QT[i * 132 + lane], c = QT[i * 132 + 64 + lane]; const float sc = rsqrtf(wave_sum(a * a + c * c) + EPS) * 0.08838834764831845f; QT[i * 132 + lane] = a * sc; QT[i * 132 + 64 + lane] = c * sc; }
        { const float a = KT[i * 132 + lane], c = KT[i * 132 + 64 + lane]; const float sc = rsqrtf(wave_sum(a * a + c * c) + EPS); KT[i * 132 + lane] = a * sc; KT[i * 132 + 64 + lane] = c * sc; } }
    if (wave == 0) { const float* GAB = (const float*)(C.ws + WS_GAB) + (size_t)(tok0 + lane) * 12;
        const float av = GAB[h], bv = GAB[6 + h]; const float x = av + PIN(26)[l * 6 + h]; const float sp = (x > 20.f) ? x : log1pf(__expf(x));
        float g = -__expf(PIN(25)[l * 6 + h]) * sp;
#pragma unroll
        for (int o = 1; o < 64; o <<= 1) { const float t = __shfl_up(g, o); if (lane >= o) g += t; }
        const float glast = __shfl(g, 63);
        gc[lane] = g; beta[lane] = sigmoid_f(bv); eg[lane] = __expf(g); ek[lane] = __expf(glast - g);
        if (lane == 0) *(float*)(UB + 57344 + 32768) = __expf(glast); }
    __syncthreads();
    PSPAN_END(C, 111); PSPAN_BEGIN(C, 112);
    for (int z = tid; z < 6 * 256; z += NTHR) { const int t = z >> 8, e = z & 255, ti = (t >= 3) ? (t >= 5 ? 2 : 1) : 0, tj = (t >= 3) ? (t >= 5 ? 3 : t - 1) : t + 1;
        QKM[(16 * ti + (e >> 4)) * 68 + 16 * tj + (e & 15)] = 0.f; }
    { const int fr = lane & 15, quad = lane >> 4;
#pragma unroll 1
      for (int job = wave; job < 20; job += NWAVES) { const int mat = job / 10, t = job % 10, ti = (t >= 6) ? 3 : (t >= 3) ? 2 : (t >= 1) ? 1 : 0, tj = t - ti * (ti + 1) / 2; LAS float* OUT = mat ? QKM : AM;
          const LAS float* ap = (mat ? QT : KT) + (16 * ti + fr) * 132 + quad; const LAS float* bp = KT + (16 * tj + fr) * 132 + quad;
          f32x4 a0 = (f32x4){0.f, 0.f, 0.f, 0.f}, a1 = a0, a2 = a0, a3 = a0;
#pragma unroll
          for (int kk = 0; kk < 32; kk += 4) { a0 = __builtin_amdgcn_mfma_f32_16x16x4f32(ap[4 * kk], bp[4 * kk], a0, 0, 0, 0); a1 = __builtin_amdgcn_mfma_f32_16x16x4f32(ap[4 * kk + 4], bp[4 * kk + 4], a1, 0, 0, 0);
              a2 = __builtin_amdgcn_mfma_f32_16x16x4f32(ap[4 * kk + 8], bp[4 * kk + 8], a2, 0, 0, 0); a3 = __builtin_amdgcn_mfma_f32_16x16x4f32(ap[4 * kk + 12], bp[4 * kk + 12], a3, 0, 0, 0); }
          const f32x4 acc = (a0 + a1) + (a2 + a3);
#pragma unroll
          for (int j = 0; j < 4; ++j) { const int i = 16 * ti + 4 * quad + j, jj = 16 * tj + fr; float v = 0.f;
              if (mat == 0) { if (i > jj) v = beta[i] * acc[j] * __expf(gc[i] - gc[jj]); } else { if (i >= jj) v = acc[j] * __expf(gc[i] - gc[jj]); }
              OUT[i * 68 + jj] = v; } } }
    __syncthreads();
    PSPAN_END(C, 112); PSPAN_BEGIN(C, 113);
    { LAS float* TM = (LAS float*)(C.lds + GL_SM + 1024);
      const int fr = lane & 15, quad = lane >> 4;
      f32x4 acc[2][4];
#pragma unroll
      for (int r = 0; r < 4; ++r)
#pragma unroll
          for (int jq = 0; jq < 4; ++jq) { const int i = 16 * r + 4 * quad + jq; const float bi = beta[i];
              acc[0][r][jq] = VT[i * 132 + 16 * wave + fr] * bi; acc[1][r][jq] = KT[i * 132 + 16 * wave + fr] * bi * eg[i]; }
      if (wave == 0) { const int r = lane >> 4, c = lane & 15; const LAS float* Ar = AM + (16 * r) * 68 + 16 * r; float t[16];
#pragma unroll
          for (int i2 = 0; i2 < 16; ++i2) { float sacc = (i2 == c) ? 1.f : 0.f;
#pragma unroll
              for (int j2 = 0; j2 < i2; ++j2) sacc -= Ar[i2 * 68 + j2] * t[j2];
              t[i2] = sacc; TM[(r * 16 + i2) * 16 + c] = sacc; } }
      __syncthreads();
      f32x4 X[2][4];
#pragma unroll
      for (int r = 0; r < 4; ++r) {
#pragma unroll
          for (int q = 0; q < r; ++q) { const f32x4 a = *(const LAS f32x4*)(AM + (16 * r + fr) * 68 + 16 * q + 4 * quad);
#pragma unroll
              for (int jq = 0; jq < 4; ++jq) { acc[0][r] = __builtin_amdgcn_mfma_f32_16x16x4f32(-a[jq], X[0][q][jq], acc[0][r], 0, 0, 0); acc[1][r] = __builtin_amdgcn_mfma_f32_16x16x4f32(-a[jq], X[1][q][jq], acc[1][r], 0, 0, 0); } }
          const f32x4 tt = *(const LAS f32x4*)(TM + (r * 16 + fr) * 16 + 4 * quad);
          X[0][r] = (f32x4){0.f, 0.f, 0.f, 0.f}; X[1][r] = X[0][r];
#pragma unroll
          for (int jq = 0; jq < 4; ++jq) { X[0][r] = __builtin_amdgcn_mfma_f32_16x16x4f32(tt[jq], acc[0][r][jq], X[0][r], 0, 0, 0); X[1][r] = __builtin_amdgcn_mfma_f32_16x16x4f32(tt[jq], acc[1][r][jq], X[1][r], 0, 0, 0); }
          *(f32x4*)((float*)(UB + 57344) + ((((wave * 4 + r) * 4 + quad) * 16 + fr) * 4)) = X[0][r];
#pragma unroll
          for (int jq = 0; jq < 4; ++jq) VT[(16 * r + 4 * quad + jq) * 132 + 16 * wave + fr] = X[1][r][jq]; } }
    __syncthreads();
    PSPAN_END(C, 113); PSPAN_BEGIN(C, 114);
    for (int pc = tid; pc < 3584; pc += NTHR) { const int ln = pc & 63, row = ln & 15, quad = ln >> 4; float v[8];
        if (pc < 2048) { const int tile = (pc >> 6) & 15, mt = tile >> 2, s = tile & 3, i = 16 * mt + row, cb = 32 * s + 4 * quad; const LAS float* src = (pc < 1024 ? VT : QT) + i * 132 + cb; const float sc = (pc < 1024) ? 1.f : eg[i];
            const f32x4 a = *(const LAS f32x4*)src, c = *(const LAS f32x4*)(src + 16);
            v[0] = a.x * sc; v[1] = a.y * sc; v[2] = a.z * sc; v[3] = a.w * sc; v[4] = c.x * sc; v[5] = c.y * sc; v[6] = c.z * sc; v[7] = c.w * sc; }
        else if (pc < 3072) { const int tile = (pc - 2048) >> 6, dt = tile >> 1, s2 = tile & 1, d = 16 * dt + row;
#pragma unroll
            for (int j = 0; j < 8; ++j) { const int jj = 32 * s2 + 4 * quad + (j & 3) + 16 * (j >> 2); v[j] = KT[jj * 132 + d] * ek[jj]; } }
        else { const int tile = (pc - 3072) >> 6, mt = tile >> 1, s2 = tile & 1, i = 16 * mt + row; const LAS float* src = QKM + i * 68 + 32 * s2 + 4 * quad;
            const f32x4 a = *(const LAS f32x4*)src, c = *(const LAS f32x4*)(src + 16);
            v[0] = a.x; v[1] = a.y; v[2] = a.z; v[3] = a.w; v[4] = c.x; v[5] = c.y; v[6] = c.z; v[7] = c.w; }
        v4u o; o.x = pk2(v[0], v[1]); o.y = pk2(v[2], v[3]); o.z = pk2(v[4], v[5]); o.w = pk2(v[6], v[7]); *(GAS v4u*)(UB + (size_t)pc * 16) = o; }
    __syncthreads();
    PSPAN_END(C, 114);
}

#define GDN_BAR() asm volatile("s_waitcnt lgkmcnt(0)\n\ts_barrier" ::: "memory")
template <int PAR>
__device__ __forceinline__ void gdn_step_c(const Ctx& C, int n, const GAS unsigned char* UB, float* OG, int slice, f32x4 (&S)[8], f32x4 (&uu)[4], float& ue) {
    const int lane = C.lane, col = lane & 15, quad = lane >> 4;
    const LAS unsigned char* cur = C.lds + PAR * 57344;
    f32x4 u4[4];
#pragma unroll
    for (int mt = 0; mt < 4; ++mt) u4[mt] = uu[mt];
    const float egl = ue;
    if (n + 2 < 64) { const GAS unsigned char* un = UB + (size_t)(n + 2) * GDN_UNIT_BYTES + 57344;
#pragma unroll
        for (int mt = 0; mt < 4; ++mt) uu[mt] = *(const GAS f32x4*)(un + (size_t)((((slice * 4 + mt) * 4 + quad) * 16 + col) * 16));
        ue = *(const GAS float*)(un + 32768); }
    bf16x8 sb[4];
#pragma unroll
    for (int s = 0; s < 4; ++s) sb[s] = pack8(S[2 * s], S[2 * s + 1]);
    f32x4 vn[4];
#pragma unroll
    for (int mt = 0; mt < 4; ++mt) { f32x4 ws = (f32x4){0.f, 0.f, 0.f, 0.f};
#pragma unroll
        for (int s = 0; s < 4; ++s) { const bf16x8 a = *(const LAS bf16x8*)(cur + ((mt * 4 + s) * 64 + lane) * 16); ws = __builtin_amdgcn_mfma_f32_16x16x32_bf16(a, sb[s], ws, 0, 0, 0); }
        vn[mt] = u4[mt] - ws; }
    bf16x8 vb[2]; vb[0] = pack8(vn[0], vn[1]); vb[1] = pack8(vn[2], vn[3]);
#pragma unroll
    for (int d = 0; d < 8; ++d) { f32x4 sd = S[d] * egl;
#pragma unroll
        for (int s2 = 0; s2 < 2; ++s2) { const bf16x8 a = *(const LAS bf16x8*)(cur + 32768 + ((d * 2 + s2) * 64 + lane) * 16); sd = __builtin_amdgcn_mfma_f32_16x16x32_bf16(a, vb[s2], sd, 0, 0, 0); }
        S[d] = sd; }
#pragma unroll
    for (int mt = 0; mt < 4; ++mt) { f32x4 o = (f32x4){0.f, 0.f, 0.f, 0.f};
#pragma unroll
        for (int s = 0; s < 4; ++s) { const bf16x8 a = *(const LAS bf16x8*)(cur + 16384 + ((mt * 4 + s) * 64 + lane) * 16); o = __builtin_amdgcn_mfma_f32_16x16x32_bf16(a, sb[s], o, 0, 0, 0); }
#pragma unroll
        for (int s2 = 0; s2 < 2; ++s2) { const bf16x8 a = *(const LAS bf16x8*)(cur + 49152 + ((mt * 2 + s2) * 64 + lane) * 16); o = __builtin_amdgcn_mfma_f32_16x16x32_bf16(a, vb[s2], o, 0, 0, 0); }
#pragma unroll
        for (int j = 0; j < 4; ++j) OG[(size_t)(n * 64 + 16 * mt + 4 * quad + j) * 768] = o[j]; }
}
template <int PAR>
__device__ __forceinline__ void gdn_step_l(const Ctx& C, int n, const GAS unsigned char* UB, int lt, u32x4_t (&rr)[14]) {
    if (n + 1 < 64) {
#pragma unroll
        for (int k = 0; k < 14; ++k) *(LAS u32x4_t*)(C.lds + (1 - PAR) * 57344 + (size_t)(lt + 256 * k) * 16) = rr[k]; }
    if (n + 3 < 64) { const GAS unsigned char* un = UB + (size_t)(n + 3) * GDN_UNIT_BYTES;
#pragma unroll
        for (int k = 0; k < 14; ++k) rr[k] = *(const GAS u32x4_t*)(un + (size_t)(lt + 256 * k) * 16); }
}
__device__ __forceinline__ void gdn_seq(const Ctx& C, int gi) {
    const int bh = gi >> 1, b = bh / 6, h = bh % 6, lane = C.lane, col = lane & 15, quad = lane >> 4;
    const GAS unsigned char* UB = C.ws + WS_GU + (size_t)(bh * 64) * GDN_UNIT_BYTES;
    if (C.wave < 4) {
        const int slice = (gi & 1) * 4 + C.wave;
        float* OG = (float*)(C.ws + WS_OGDN) + (size_t)(b * SQ) * 768 + h * 128 + slice * 16 + col;
        f32x4 S[8], uu0[4], uu1[4]; float ue0, ue1;
#pragma unroll
        for (int d = 0; d < 8; ++d) S[d] = (f32x4){0.f, 0.f, 0.f, 0.f};
#pragma unroll
        for (int mt = 0; mt < 4; ++mt) { uu0[mt] = *(const GAS f32x4*)(UB + 57344 + (size_t)((((slice * 4 + mt) * 4 + quad) * 16 + col) * 16)); uu1[mt] = *(const GAS f32x4*)(UB + GDN_UNIT_BYTES + 57344 + (size_t)((((slice * 4 + mt) * 4 + quad) * 16 + col) * 16)); }
        ue0 = *(const GAS float*)(UB + 57344 + 32768); ue1 = *(const GAS float*)(UB + GDN_UNIT_BYTES + 57344 + 32768);
        GDN_BAR();
#pragma unroll 1
        for (int n = 0; n < 64; n += 2) {
            gdn_step_c<0>(C, n, UB, OG, slice, S, uu0, ue0); GDN_BAR();
            gdn_step_c<1>(C, n + 1, UB, OG, slice, S, uu1, ue1); GDN_BAR();
        }
    } else {
        const int lt = C.tid - 256; u32x4_t ra[14], rb[14];
#pragma unroll
        for (int k = 0; k < 14; ++k) { const u32x4_t v = *(const GAS u32x4_t*)(UB + (size_t)(lt + 256 * k) * 16); *(LAS u32x4_t*)(C.lds + (size_t)(lt + 256 * k) * 16) = v; }
#pragma unroll
        for (int k = 0; k < 14; ++k) { ra[k] = *(const GAS u32x4_t*)(UB + GDN_UNIT_BYTES + (size_t)(lt + 256 * k) * 16); rb[k] = *(const GAS u32x4_t*)(UB + 2 * (size_t)GDN_UNIT_BYTES + (size_t)(lt + 256 * k) * 16); }
        GDN_BAR();
#pragma unroll 1
        for (int n = 0; n < 64; n += 2) {
            gdn_step_l<0>(C, n, UB, lt, ra); GDN_BAR();
            gdn_step_l<1>(C, n + 1, UB, lt, rb); GDN_BAR();
        }
    }
}

__device__ __forceinline__ void attn_queue(const Ctx& C, int l) {
    const attn_body::bf16* PROJ = (const attn_body::bf16*)(C.ws + WS_PROJ); attn_body::bf16* ATTO = (attn_body::bf16*)(C.ws + WS_ATTO);
    if (C.tid == 0) C.MISC[18] = 0u;
    for (;;) {
        if (C.tid == 0) { unsigned d = C.MISC[18], q = 0xffffffffu; const unsigned x0 = xb_xcc_id() & 7u;
            for (; d < 8u; ++d) { const unsigned x = (x0 + d) & 7u; const unsigned t = __hip_atomic_fetch_add(C.ctl + CW_QUEUE + 64 * (l * 8 + (int)x), 1u, RLX_AGENT); if (t < 192u) { q = (x << 8) | t; break; } }
            C.MISC[18] = d; C.MISC[16] = q; }
        __syncthreads();
        const unsigned q = (unsigned)__builtin_amdgcn_readfirstlane((int)C.MISC[16]);
        __syncthreads();
        if (q == 0xffffffffu) break;
        const int x = (int)(q >> 8), t = (int)(q & 255u), g = t >> 6, r = t & 63, qb = 15 - (r >> 2), bh = x * 3 + g, b = bh / 6, vh = (bh % 6) * 4 + (r & 3);
        const attn_body::bf16* base = PROJ + (size_t)(b * SQ) * PW;
        attn_body::attn_unit<8>(qb, base + C_DQ + (vh >> 1) * 64, base + C_DK + (vh >> 1) * 64, base + C_DV + (vh >> 2) * 128 + (vh & 1) * 64, ATTO + (size_t)(b * SQ) * 1536 + vh * 64, (char*)C.lds, C.wave);
    }
}

__device__ __forceinline__ volatile LAS unsigned* misc_at(int i) { unsigned a = (unsigned)(MISC_OFF + 4 * i); asm volatile("" : "+v"(a)); return (volatile LAS unsigned*)(size_t)a; }
__device__ __forceinline__ void attn_queue128(const Ctx& C, int l) {
    const attn_body::bf16* PROJ = (const attn_body::bf16*)(C.ws + WS_PROJ); attn_body::bf16* ATTO = (attn_body::bf16*)(C.ws + WS_ATTO);
    if (C.tid == 0) *misc_at(18) = 0u;
    for (;;) {
        if (C.tid == 0) { unsigned d = *misc_at(18), q = 0xffffffffu; const unsigned x0 = xb_xcc_id() & 7u;
            for (; d < 8u; ++d) { const unsigned x = (x0 + d) & 7u; const unsigned t = __hip_atomic_fetch_add(C.ctl + CW_QUEUE + 64 * (l * 8 + (int)x), 1u, RLX_AGENT); if (t < 96u) { q = (x << 8) | t; break; } }
            *misc_at(18) = d; *misc_at(16) = q; }
        __syncthreads();
        const unsigned q = (unsigned)__builtin_amdgcn_readfirstlane((int)*misc_at(16));
        __syncthreads();
        if (q == 0xffffffffu) break;
        const int x = (int)(q >> 8), t = (int)(q & 255u), g = t >> 5, r = t & 31, qb = 15 - (r >> 1), bh = x * 3 + g, b = bh / 6, hm = (bh % 6) * 2 + (r & 1);
        const attn_body::bf16* base = PROJ + (size_t)(b * SQ) * PW;
        attn_body::attn_unit128<8>(qb, base + C_DQ + hm * 64, base + C_DK + hm * 64, base + C_DV + (hm >> 1) * 128, ATTO + (size_t)(b * SQ) * 1536 + hm * 128, (char*)C.lds, C.wave);
    }
}

__device__ __forceinline__ void scan_publish(const Ctx& C, int l) {
    asm volatile("s_waitcnt vmcnt(0)" ::: "memory"); __syncthreads();
    if (C.tid == 0) { __builtin_amdgcn_fence(__ATOMIC_RELEASE, "agent"); asm volatile("s_waitcnt vmcnt(0)" ::: "memory"); (void)__hip_atomic_fetch_add(C.ctl + CW_SCAN + 64 * l, 1u, RLX_AGENT); }
}
__device__ __forceinline__ void scan_wait(const Ctx& C, int l) {
    if (C.tid == 0) { unsigned sp = 0; while (__hip_atomic_load(C.ctl + CW_SCAN + 64 * l, RLX_AGENT) < 16u && ++sp < (1u << 22)) __builtin_amdgcn_s_sleep(2);
        __builtin_amdgcn_fence(__ATOMIC_ACQUIRE, "agent"); asm volatile("s_waitcnt vmcnt(0)" ::: "memory"); }
    __syncthreads();
}

__device__ __forceinline__ void post_mix(const Ctx& C, KP P, int l) {
    const int lane = C.lane; const bf16* ATTO = (const bf16*)(C.ws + WS_ATTO); const float* OG = (const float*)(C.ws + WS_OGDN); const bf16* PROJ = (const bf16*)(C.ws + WS_PROJ); bf16* YCAT = (bf16*)(C.ws + WS_YCAT);
    const float linit = 0.8f - 0.6f * expf(-0.3f * (float)l);
    const float lam = expf(wave_sum(PIN(19)[l * 64 + lane] * PIN(20)[l * 64 + lane])) - expf(wave_sum(PIN(21)[l * 64 + lane] * PIN(22)[l * 64 + lane])) + linit;
    const float sl0 = PIN(23)[l * 128 + 2 * lane] * (1.f - linit), sl1 = PIN(23)[l * 128 + 2 * lane + 1] * (1.f - linit);
    const float gn0 = PIN(27)[l * 128 + 2 * lane], gn1 = PIN(27)[l * 128 + 2 * lane + 1];
    const int tb = (C.blk < 128) ? 48 * C.blk : 6144 + 80 * (C.blk - 128), tn = (C.blk < 128) ? 48 : 80;
    for (int t0 = tb + 2 * C.wave; t0 < tb + tn; t0 += 2 * NWAVES) {
        unsigned o1[2][6], o2[2][6], zz[2][6]; f32x2_t og[2][6];
#pragma unroll
        for (int u = 0; u < 2; ++u)
#pragma unroll
            for (int h = 0; h < 6; ++h) { const int t = t0 + u; o1[u][h] = *(const unsigned*)(ATTO + (size_t)t * 1536 + (2 * h) * 128 + 2 * lane); o2[u][h] = *(const unsigned*)(ATTO + (size_t)t * 1536 + (2 * h + 1) * 128 + 2 * lane);
                og[u][h] = *(const f32x2_t*)(OG + (size_t)t * 768 + h * 128 + 2 * lane); zz[u][h] = *(const unsigned*)(PROJ + (size_t)t * PW + C_GZ + h * 128 + 2 * lane); }
#pragma unroll
        for (int u = 0; u < 2; ++u)
#pragma unroll
            for (int h = 0; h < 6; ++h) { const int t = t0 + u;
                { const float a = bflo(o1[u][h]) - lam * bflo(o2[u][h]), c = bfhi(o1[u][h]) - lam * bfhi(o2[u][h]); const float r = rsqrtf(wave_sum(a * a + c * c) * (1.f / 128.f) + EPS);
                  *(unsigned*)(YCAT + (size_t)t * DM + 512 + h * 128 + 2 * lane) = pk2(a * r * sl0, c * r * sl1); }
                { const f32x2_t o = og[u][h]; const float r = rsqrtf(wave_sum(o.x * o.x + o.y * o.y) * (1.f / 128.f) + EPS);
                  *(unsigned*)(YCAT + (size_t)t * DM + 1280 + h * 128 + 2 * lane) = pk2(o.x * r * gn0 * silu_f(bflo(zz[u][h])), o.y * r * gn1 * silu_f(bfhi(zz[u][h]))); } } }
}

__device__ __forceinline__ void norm_router_phase(const Ctx& C, KP P, const float* __restrict__ nw, const float* __restrict__ mod_shift, const float* __restrict__ mod_scale) {
    LAS float* WRT = (LAS float*)C.lds;
    LAS int* esel = (LAS int*)(C.lds + 65536); LAS int* rankl = esel + 128;
    const float* wr = PIN(31);
    for (int idx = C.tid; idx < DM * 8; idx += NTHR) { const int k = idx >> 3, e = idx & 7; WRT[e * DM + k] = wr[idx]; }
    __syncthreads();
    const float* src = (const float*)(C.ws + WS_HRES); unsigned char* HN8 = (unsigned char*)(C.ws + WS_HN); const int lane = C.lane;
    f32x4 nwv[8];
#pragma unroll
    for (int j = 0; j < 8; ++j) nwv[j] = *(const f32x4*)(nw + 4 * lane + 256 * j);
    f32x4 vn[8];
#pragma unroll
    for (int j = 0; j < 8; ++j) vn[j] = *(const f32x4*)(src + (size_t)(C.blk * 64 + C.wave * 8) * DM + 4 * lane + 256 * j);
    int nlim = 8; asm volatile("" : "+s"(nlim));
#pragma unroll 1
    for (int i = 0; i < nlim; ++i) { const int tl = C.wave * 8 + i, t = C.blk * 64 + tl, b = t >> 12;
        f32x4 v[8]; float ss = 0.f;
#pragma unroll
        for (int j = 0; j < 8; ++j) { v[j] = vn[j]; ss += (v[j].x * v[j].x + v[j].y * v[j].y) + (v[j].z * v[j].z + v[j].w * v[j].w); }
        if (i + 1 < nlim) {
#pragma unroll
            for (int j = 0; j < 8; ++j) vn[j] = *(const f32x4*)(src + (size_t)(t + 1) * DM + 4 * lane + 256 * j); }
        const float r = rsqrtf(wave_sum(ss) * (1.f / DM) + EPS);
        const float* sh = mod_shift + (size_t)b * 6 * DM; const float* scp = mod_scale + (size_t)b * 6 * DM;
#pragma unroll
        for (int j = 0; j < 8; ++j) { const f32x4 s1 = *(const f32x4*)(scp + 4 * lane + 256 * j), s0 = *(const f32x4*)(sh + 4 * lane + 256 * j);
            v[j] = v[j] * r * nwv[j] * (s1 + 1.f) + s0;
            *(GAS unsigned*)(HN8 + (size_t)t * DM + 4 * lane + 256 * j) = pk4_fp8(v[j].x * S8_HN, v[j].y * S8_HN, v[j].z * S8_HN, v[j].w * S8_HN); }
        float lg[8];
        unsigned wb = 16u * (unsigned)lane; asm volatile("" : "+v"(wb)); const LAS float* WRL = (const LAS float*)(size_t)wb;
#pragma unroll
        for (int e = 0; e < 8; ++e) { float a = 0.f;
#pragma unroll
            for (int j = 0; j < 8; ++j) { const f32x4 wv = *(const LAS f32x4*)(WRL + e * DM + 256 * j); a += (v[j].x * wv.x + v[j].y * wv.y) + (v[j].z * wv.z + v[j].w * wv.w); }
            lg[e] = wave_sum(a); }
        int e0 = 0; float v0 = lg[0];
#pragma unroll
        for (int e = 1; e < 8; ++e) if (lg[e] > v0) { v0 = lg[e]; e0 = e; }
        int e1 = -1; float v1 = -INFINITY;
#pragma unroll
        for (int e = 0; e < 8; ++e) if (e != e0 && lg[e] > v1) { v1 = lg[e]; e1 = e; }
        const float g0 = 1.f / (1.f + __expf(v1 - v0)), g1 = 1.f - g0;
        if (lane == 0) { esel[2 * tl] = e0; esel[2 * tl + 1] = e1; ((int*)(C.ws + WS_TOKE))[2 * t] = e0; ((int*)(C.ws + WS_TOKE))[2 * t + 1] = e1; ((float*)(C.ws + WS_TOKG))[2 * t] = g0; ((float*)(C.ws + WS_TOKG))[2 * t + 1] = g1; }
    }
    __syncthreads();
    if (C.tid < 8) { int cnt = 0; for (int i = 0; i < 128; ++i) if (esel[i] == C.tid) rankl[i] = cnt++; ((int*)(C.ws + WS_CNT))[C.blk * 8 + C.tid] = cnt; }
    __syncthreads();
    if (C.tid < 128) ((int*)(C.ws + WS_RANK))[(size_t)C.blk * 128 + C.tid] = rankl[C.tid];
    __syncthreads();
}

__device__ __forceinline__ void route_phase(const Ctx& C) {
    LAS int* tot = (LAS int*)C.lds; LAS int* pre = tot + 8; LAS int* base = tot + 16;
    const int* CNT = (const int*)(C.ws + WS_CNT);
    LAS int* part = tot + 32;
    if (C.tid < 256) { const int bb = C.tid; const int4 ca = *(const int4*)(CNT + bb * 8), cb = *(const int4*)(CNT + bb * 8 + 4); const int cv[8] = {ca.x, ca.y, ca.z, ca.w, cb.x, cb.y, cb.z, cb.w};
#pragma unroll
        for (int e = 0; e < 8; ++e) { int s = cv[e], m = (bb < C.blk) ? cv[e] : 0;
#pragma unroll
            for (int o = 1; o < 64; o <<= 1) { s += __shfl_xor(s, o); m += __shfl_xor(m, o); }
            if (C.lane == 0) { part[C.wave * 16 + e] = s; part[C.wave * 16 + 8 + e] = m; } } }
    __syncthreads();
    if (C.tid < 8) { tot[C.tid] = part[C.tid] + part[16 + C.tid] + part[32 + C.tid] + part[48 + C.tid]; pre[C.tid] = part[8 + C.tid] + part[24 + C.tid] + part[40 + C.tid] + part[56 + C.tid]; }
    __syncthreads();
    if (C.tid == 0) { int run = 0; int* TILE = (int*)(C.ws + WS_TILE);
        for (int e = 0; e < 8; ++e) { base[e] = run; const int nt = (tot[e] + 255) >> 8; if (C.blk == 0) for (int q = 0; q < nt; ++q) TILE[1 + (run >> 8) + q] = e; run += nt << 8; }
        if (C.blk == 0) TILE[0] = run >> 8; }
    __syncthreads();
    const int* TOKE = (const int*)(C.ws + WS_TOKE); const float* TOKG = (const float*)(C.ws + WS_TOKG); const int* RANK = (const int*)(C.ws + WS_RANK);
    int* POS = (int*)(C.ws + WS_POS); float* GW = (float*)(C.ws + WS_GW); const unsigned char* HN8 = (const unsigned char*)(C.ws + WS_HN); unsigned char* AS8 = (unsigned char*)(C.ws + WS_AS);
    for (int i = 0; i < 8; ++i) { const int t = C.blk * 64 + C.wave * 8 + i;
        const int e0 = TOKE[2 * t], e1 = TOKE[2 * t + 1]; const int p0 = base[e0] + pre[e0] + RANK[2 * t], p1 = base[e1] + pre[e1] + RANK[2 * t + 1];
        if (C.lane == 0) { POS[2 * t] = p0; POS[2 * t + 1] = p1; GW[p0] = TOKG[2 * t]; GW[p1] = TOKG[2 * t + 1]; }
#pragma unroll
        for (int j = 0; j < 2; ++j) { const u32x4_t v = *(const u32x4_t*)(HN8 + (size_t)t * DM + 16 * C.lane + 1024 * j); *(u32x4_t*)(AS8 + (size_t)p0 * DM + 16 * C.lane + 1024 * j) = v; *(u32x4_t*)(AS8 + (size_t)p1 * DM + 16 * C.lane + 1024 * j) = v; } }
    __syncthreads();
}

__device__ __forceinline__ void ctr_wait(const Ctx& C, gu32* w, unsigned n) {
    if (C.tid == 0) { unsigned sp = 0; while (__hip_atomic_load(w, RLX_AGENT) < n && ++sp < (1u << 22)) __builtin_amdgcn_s_sleep(2);
        __builtin_amdgcn_fence(__ATOMIC_ACQUIRE, "agent"); asm volatile("s_waitcnt vmcnt(0)" ::: "memory"); }
    __syncthreads();
}
constexpr int FIN_W1 = 4;
template <int LATE>
__device__ __forceinline__ void final_pass(const Ctx& C, KP P, int late_row, int first, int step) {
    const float* HR = (const float*)(C.ws + WS_HRES); const bf16* YS = (const bf16*)(C.ws + WS_AS); const int* POS = (const int*)(C.ws + WS_POS);
    const float* gate2 = (const float*)(C.ws + WS_MOD) + (size_t)(1 * 4) * 6 * DM + 5 * DM; const float* nf = PIN(7); const int lane = C.lane;
    for (int it = first; it < TOK / 2; it += step) {
        const int t0 = 2 * (int)it; const int b = t0 >> 12; const int4 pp = *(const int4*)(POS + 2 * t0);
        const int pmin = __builtin_amdgcn_readfirstlane(min(min(pp.x, pp.y), min(pp.z, pp.w)));
        if ((pmin < late_row) == (LATE == 1)) {
        f32x4 v[2][8]; float ss0 = 0.f, ss1 = 0.f;
#pragma unroll
        for (int j = 0; j < 8; ++j) { const int c = 4 * lane + 256 * j; const f32x4 g = *(const f32x4*)(gate2 + (size_t)b * 6 * DM + c);
            const f32x4 ha = *(const f32x4*)(HR + (size_t)t0 * DM + c), hb = *(const f32x4*)(HR + (size_t)(t0 + 1) * DM + c);
            const u32x2_t a0 = *(const u32x2_t*)(YS + (size_t)pp.x * DM + c), a1 = *(const u32x2_t*)(YS + (size_t)pp.y * DM + c), b0 = *(const u32x2_t*)(YS + (size_t)pp.z * DM + c), b1 = *(const u32x2_t*)(YS + (size_t)pp.w * DM + c);
            const f32x4 ya = (f32x4){bflo(a0.x) + bflo(a1.x), bfhi(a0.x) + bfhi(a1.x), bflo(a0.y) + bflo(a1.y), bfhi(a0.y) + bfhi(a1.y)};
            const f32x4 yb = (f32x4){bflo(b0.x) + bflo(b1.x), bfhi(b0.x) + bfhi(b1.x), bflo(b0.y) + bflo(b1.y), bfhi(b0.y) + bfhi(b1.y)};
            v[0][j] = ha + g * ya; v[1][j] = hb + g * yb;
            ss0 += (v[0][j].x * v[0][j].x + v[0][j].y * v[0][j].y) + (v[0][j].z * v[0][j].z + v[0][j].w * v[0][j].w); ss1 += (v[1][j].x * v[1][j].x + v[1][j].y * v[1][j].y) + (v[1][j].z * v[1][j].z + v[1][j].w * v[1][j].w); }
        const float r0 = rsqrtf(wave_sum(ss0) * (1.f / DM) + EPS), r1 = rsqrtf(wave_sum(ss1) * (1.f / DM) + EPS);
#pragma unroll
        for (int j = 0; j < 8; ++j) { const int c = 4 * lane + 256 * j; const f32x4 w = *(const f32x4*)(nf + c); *(f32x4*)(POUT + (size_t)t0 * DM + c) = v[0][j] * r0 * w; *(f32x4*)(POUT + (size_t)(t0 + 1) * DM + c) = v[1][j] * r1 * w; } }
    }
}
__device__ __forceinline__ void final_phase(const Ctx& C, KP P) {
    const int late_row = (__builtin_amdgcn_readfirstlane(((const int*)(C.ws + WS_TILE))[0]) & 31) * 256;
    const int nb = late_row >> 4;
    ctr_wait(C, C.ctl + CW_FIN, (unsigned)C.G); if (C.blk >= nb && C.wave < FIN_W1) final_pass<0>(C, P, late_row, (C.blk - nb) * FIN_W1 + C.wave, (C.G - nb) * FIN_W1);
    ctr_wait(C, C.ctl + CW_FIN + 64, (unsigned)C.G); final_pass<1>(C, P, late_row, C.blk * NWAVES + C.wave, C.G * NWAVES);
}

#ifndef MK_N_LAUNCHES
#define MK_N_LAUNCHES 1
#endif
constexpr int N_PHASES = 24;

#if defined(PROBE_LO)
#define PROBE_BEGIN(k) do { if ((k) == PROBE_LO && blockIdx.x == 0 && C0.wave == 0 && mk_lane() == 0) { const unsigned long long t_ = __builtin_amdgcn_s_memrealtime(); C0.MISC[20] = (unsigned)t_; C0.MISC[21] = (unsigned)(t_ >> 32); } } while (0)
#define PROBE_END(k) do { if ((k) == PROBE_HI && blockIdx.x == 0 && C0.wave == 0 && mk_lane() == 0) { const unsigned long long t_ = __builtin_amdgcn_s_memrealtime() - (((unsigned long long)C0.MISC[21] << 32) | C0.MISC[20]); C0.MISC[22] = (unsigned)t_; } } while (0)
#else
#define PROBE_BEGIN(k) do {} while (0)
#define PROBE_END(k) do {} while (0)
#endif
template <int L>
__device__ __forceinline__ void layer_phases(const Ctx& C0, KP P0, int lo, int hi) {
#define IN(k) (lo <= (k) && (k) < hi)
#define SEAM_FILL(k) do { if (IN(k) && IN((k) + 1)) { PHASE_ENV moe_cvt_fill(C, P, (k), false); } } while (0)
#define SEAM(k) do { if (IN(k) && IN((k) + 1)) { GAS unsigned char* w_ = C0.ws; asm volatile("" : "+s"(w_)); XcdBarrier b_; b_.bar = (unsigned*)(w_ + WS_CTL) + CW_BAR + (MK_N_LAUNCHES == 1 ? 0 : lo) * XCD_BAR_WORDS; b_.x = xb_xcc_id(); b_.st = C0.MISC + 8; b_.lead = (C0.wave == 0 && mk_lane() == 0); xcd_barrier(b_); } PROBE_END(k); } while (0)
    constexpr int PB = 1 + 11 * L;
#define PHASE_ENV Ctx C = C0; KP P = P0; asm volatile("" : "+s"(C.ws), "+s"(P)); GAS unsigned char* ws = C.ws; C.ctl = (gu32*)(ws + WS_CTL); \
    C.lane = mk_lane(); asm volatile("" : "+v"(C.lane)); C.tid = C.wave * 64 + C.lane; \
    const float* MOD = (const float*)(ws + WS_MOD) + (size_t)(L * 4) * 6 * DM; float* HRES = (float*)(ws + WS_HRES); bf16* HN = (bf16*)(ws + WS_HN); bf16* PROJ = (bf16*)(ws + WS_PROJ); bf16* YCAT = (bf16*)(ws + WS_YCAT); \
    (void)MOD; (void)HRES; (void)HN; (void)PROJ; (void)YCAT; (void)P;
    PROBE_BEGIN(PB + 0); if (IN(PB + 0)) { PHASE_ENV norm_phase<true>(C, L == 0 ? PIN(0) : HRES, PIN(5) + L * DM, MOD + 0 * DM, MOD + 1 * DM, PIN(8) + (size_t)L * DM * INW); }
    SEAM(PB + 0);
    PROBE_BEGIN(PB + 1); if (IN(PB + 1)) { PHASE_ENV pg8::Gemm g{HN, (const bf16*)(ws + WS_WIN) + (size_t)L * PW * DM, TOK, PW, DM}; pg8::StaticOrder S; S.init(TOK, PW, C.G, C.blk); pg8::EpiProj E{PROJ};
        pg8::gemm_phase<pg8::EpiProj, pg8::StaticOrder, true, true>(C.lds, g, S, E, C.wave); }
    SEAM_FILL(PB + 1); SEAM(PB + 1);
    PROBE_BEGIN(PB + 2); if (IN(PB + 2)) { PHASE_ENV rope_pass(C); ssm_gemm_a(C, L);
#pragma unroll 1
        for (int u = C.blk; u < 1536; u += C.G) gdn_prep_unit(C, P, L, u); }
    SEAM(PB + 2);
    PROBE_BEGIN(PB + 3); if (IN(PB + 3)) { PHASE_ENV if (C.blk < 48) { PSPAN_BEGIN(C, 100); gdn_seq(C, C.blk); PSPAN_END(C, 100); __syncthreads(); } else if (C.blk >= C.G - 16) { ssm_scan(C, L, C.blk - (C.G - 16)); scan_publish(C, L); } attn_queue128(C, L); }
    if (IN(PB + 3)) { PHASE_ENV scan_wait(C, L); ssm_gemm_b(C, L); }
    SEAM_FILL(PB + 3); SEAM(PB + 3);
    PROBE_BEGIN(PB + 4); if (IN(PB + 4)) { PHASE_ENV
        { pg8::Gemm g{(const bf16*)(ws + WS_YGELU), (const bf16*)(ws + WS_WGLU) + (size_t)L * 512 * 512, TOK, 512, 512}; pg8::StaticOrder S; S.init(TOK, 512, C.G, C.blk); pg8::EpiGlu E{(const bf16*)(ws + WS_YGELU), YCAT};
          pg8::gemm_phase<pg8::EpiGlu, pg8::StaticOrder, true, true>(C.lds, g, S, E, C.wave); }
        post_mix(C, P, L); }
    SEAM(PB + 4);
    PROBE_BEGIN(PB + 6); if (IN(PB + 6)) { PHASE_ENV pg8::Gemm g{YCAT, (const bf16*)(ws + WS_WOUT) + (size_t)L * DM * DM, TOK, DM, DM}; pg8::StaticOrder S; S.init(TOK, DM, C.G, C.blk); pg8::EpiRes E{L == 0 ? PIN(0) : HRES, HRES, MOD + 2 * DM, 1.f};
        pg8::gemm_phase<pg8::EpiRes, pg8::StaticOrder, true, true>(C.lds, g, S, E, C.wave); }
    SEAM(PB + 6);
    if (L == 0) {
        PROBE_BEGIN(PB + 7); if (IN(PB + 7)) { PHASE_ENV norm_phase<false, (DENSE_FP8 >= 1)>(C, HRES, PIN(6) + L * DM, MOD + 3 * DM, MOD + 4 * DM, nullptr); }
        SEAM(PB + 7);
        SEAM(PB + 8);
        PROBE_BEGIN(PB + 9); if (IN(PB + 9)) { PHASE_ENV pg8::StaticOrder S; S.init(TOK, 2 * DFF, C.G, C.blk);
            if (DENSE_FP8 == 2) { pg8::Gemm g{HN, (const bf16*)(ws + WS_WUP), TOK, 2 * DFF, DM / 2}; pg8::EpiSwiglu8 E{(unsigned char*)(ws + WS_H), DFF, 2 * DFF / 256, 1.f / (S8_HN * S8_W13)}; pg8::gemm_phase<pg8::EpiSwiglu8, pg8::StaticOrder, true, true, true>(C.lds, g, S, E, C.wave); }
            else if (DENSE_FP8 == 1) { pg8::Gemm g{HN, (const bf16*)(ws + WS_WUP), TOK, 2 * DFF, DM / 2}; pg8::EpiSwiglu E{(bf16*)(ws + WS_H), DFF, 2 * DFF / 256, 1.f / (S8_HN * S8_W13)}; pg8::gemm_phase<pg8::EpiSwiglu, pg8::StaticOrder, true, true, true>(C.lds, g, S, E, C.wave); }
            else { pg8::Gemm g{HN, (const bf16*)(ws + WS_WUP), TOK, 2 * DFF, DM}; pg8::EpiSwiglu E{(bf16*)(ws + WS_H), DFF, 2 * DFF / 256, 1.f}; pg8::gemm_phase<pg8::EpiSwiglu, pg8::StaticOrder, true, true>(C.lds, g, S, E, C.wave); } }
        SEAM(PB + 9);
        PROBE_BEGIN(PB + 10); if (IN(PB + 10)) { PHASE_ENV pg8::StaticOrder S; S.init(TOK, DM, C.G, C.blk);
            if (DENSE_FP8 == 2) { pg8::Gemm g{(const bf16*)(ws + WS_H), (const bf16*)(ws + WS_WDN), TOK, DM, DFF / 2}; pg8::EpiRes E{HRES, HRES, MOD + 5 * DM, 1.f / (S8_H * S8_W2)}; pg8::gemm_phase<pg8::EpiRes, pg8::StaticOrder, true, true, true>(C.lds, g, S, E, C.wave); }
            else { pg8::Gemm g{(const bf16*)(ws + WS_H), (const bf16*)(ws + WS_WDN), TOK, DM, DFF}; pg8::EpiRes E{HRES, HRES, MOD + 5 * DM, 1.f}; pg8::gemm_phase<pg8::EpiRes, pg8::StaticOrder, true, true>(C.lds, g, S, E, C.wave); } }
        SEAM(PB + 10);
    } else {
        PROBE_BEGIN(PB + 7); if (IN(PB + 7)) { PHASE_ENV norm_router_phase(C, P, PIN(6) + L * DM, MOD + 3 * DM, MOD + 4 * DM); }
        SEAM(PB + 7);
        PROBE_BEGIN(PB + 8); if (IN(PB + 8)) { PHASE_ENV moe_cvt_fill(C, P, 0, true); route_phase(C); }
        SEAM(PB + 8);
        PROBE_BEGIN(PB + 9); if (IN(PB + 9)) { PHASE_ENV LAS int* TL = (LAS int*)(C.lds + TILE_OFF); for (int i = C.tid; i <= MOE_TILES_MAX; i += NTHR) TL[i] = ((const int*)(ws + WS_TILE))[i]; __syncthreads(); const int R = __builtin_amdgcn_readfirstlane(TL[0]);
            pg8::Gemm g{(const bf16*)(ws + WS_AS), (const bf16*)(ws + WS_MUP), R * 256, 2 * DFE, DM / 2}; pg8::MoeOrder S; S.so.init(R * 256, 2 * DFE, C.G, C.blk); S.tile_e = TL + 1; S.nct = 2 * DFE / 256;
            pg8::EpiSwiglu8 E{(unsigned char*)(ws + WS_H), DFE, 2 * DFE / 256, 1.f / (S8_HN * S8_W13)};
            pg8::gemm_phase<pg8::EpiSwiglu8, pg8::MoeOrder, true, true, true>(C.lds, g, S, E, C.wave); }
        SEAM(PB + 9);
        PROBE_BEGIN(PB + 10); if (IN(PB + 10)) { PHASE_ENV LAS int* TL = (LAS int*)(C.lds + TILE_OFF); for (int i = C.tid; i <= MOE_TILES_MAX; i += NTHR) TL[i] = ((const int*)(ws + WS_TILE))[i]; __syncthreads(); const int R = __builtin_amdgcn_readfirstlane(TL[0]);
            pg8::Gemm g{(const bf16*)(ws + WS_H), (const bf16*)(ws + WS_MDN), R * 256, DM, DFE / 2}; pg8::MoeDownOrder S; S.nM = R; S.nl = R & 31; S.R = R >> 5; S.c = C.blk; S.so.init((R - S.nl) * 256, DM, C.G, C.blk); S.tile_e = TL + 1; S.nct = DM / 256; S.ntf = DFE / 128;
            S.arr = (gu32*)(ws + WS_CTL) + CW_FIN; S.wc = (LAS unsigned*)(C.lds + MISC_OFF) + 28;
            pg8::EpiMoeDown E{(bf16*)(ws + WS_AS), (const float*)(ws + WS_GW), 1.f / (S8_H * S8_W2), (f32x4*)(ws + WS_XC), (gu32*)(ws + WS_CTL) + CW_FIN + 256, (LAS unsigned*)(C.lds + MISC_OFF) + 29};
            pg8::gemm_phase<pg8::EpiMoeDown, pg8::MoeDownOrder, true, true, true>(C.lds, g, S, E, C.wave);
            asm volatile("s_waitcnt vmcnt(0)" ::: "memory"); __syncthreads();
            if (C.wave == 0 && mk_lane() == 0) { __builtin_amdgcn_fence(__ATOMIC_RELEASE, "agent"); asm volatile("s_waitcnt vmcnt(0)" ::: "memory"); (void)__hip_atomic_fetch_add((gu32*)(ws + WS_CTL) + CW_FIN + 64, 1u, RLX_AGENT); } }
        PROBE_END(PB + 10);
    }
#undef IN
#undef SEAM
#undef PHASE_ENV
}

__global__ void __launch_bounds__(NTHR, 2) mk_fwd(Params P) {
    extern __shared__ __attribute__((aligned(16))) unsigned char lds[];
    KP KPp = (KP)__builtin_amdgcn_kernarg_segment_ptr();
    Ctx C; C.lds = (LAS unsigned char*)lds; C.MISC = (volatile LAS unsigned*)(C.lds + MISC_OFF); C.ws = (GAS unsigned char*)KPp->ws; C.ctl = (gu32*)(C.ws + WS_CTL);
    C.tid = threadIdx.x; C.lane = C.tid & 63; C.wave = __builtin_amdgcn_readfirstlane(C.tid >> 6); C.blk = blockIdx.x; C.G = 256;
    for (int u = C.tid; u < (LDS_BYTES - TILE_OFF) / 4; u += NTHR) ((LAS unsigned*)(C.lds + TILE_OFF))[u] = 0u;
    __syncthreads();
    const int lo = KPp->ph_lo, hi = KPp->ph_hi;
    (void)xcd_barrier_post((unsigned*)(C.ctl + CW_BAR) + (MK_N_LAUNCHES == 1 ? 0 : lo) * XCD_BAR_WORDS, C.MISC + 8);
    { const Ctx& C0 = C; PROBE_BEGIN(0); }
    if (lo <= 0 && 0 < hi) { Ctx Cp = C; KP Pp = KPp; asm volatile("" : "+s"(Cp.ws), "+s"(Pp)); Cp.lane = mk_lane(); asm volatile("" : "+v"(Cp.lane)); Cp.tid = Cp.wave * 64 + Cp.lane; p0_prologue(Cp, Pp); if (1 < hi) { XcdBarrier b_; b_.bar = (unsigned*)(Cp.ws + WS_CTL) + CW_BAR + (MK_N_LAUNCHES == 1 ? 0 : lo) * XCD_BAR_WORDS; b_.x = xb_xcc_id(); b_.st = C.MISC + 8; b_.lead = (C.wave == 0 && mk_lane() == 0); xcd_barrier(b_); } }
    { const Ctx& C0 = C; PROBE_END(0); }
    layer_phases<0>(C, KPp, lo, hi);
    layer_phases<1>(C, KPp, lo, hi);
    { const Ctx& C0 = C; PROBE_BEGIN(23); }
    if (lo <= 23 && 23 < hi) { Ctx Cp = C; KP Pp = KPp; asm volatile("" : "+s"(Cp.ws), "+s"(Pp)); Cp.lane = mk_lane(); asm volatile("" : "+v"(Cp.lane)); Cp.tid = Cp.wave * 64 + Cp.lane; final_phase(Cp, Pp); }
    { const Ctx& C0 = C; PROBE_END(23); }
#if defined(PROBE_LO)
    if (blockIdx.x == 0 && C.wave == 0 && mk_lane() == 0) { const unsigned long long t0_ = __builtin_amdgcn_s_memrealtime(), w_ = (unsigned long long)C.MISC[22] * PROBE_MULT; while (__builtin_amdgcn_s_memrealtime() - t0_ < w_) __builtin_amdgcn_s_sleep(8); }
#endif
}

extern "C" void kernel_launch(void* const* d_in, const int* in_sizes, int n_in, void* d_out, int out_size, void* d_ws, size_t ws_size, hipStream_t stream) {
    static int grid = 0;
    if (grid == 0) {
        if (n_in != 35 || in_sizes[0] != TOK * DM || out_size != TOK * DM || ws_size < WS_END) { fprintf(stderr, "kernel_launch: unexpected problem: n_in %d in0 %d out %d ws %zu (need %zu)\n", n_in, n_in > 0 ? in_sizes[0] : -1, out_size, ws_size, (size_t)WS_END); grid = -1; return; }
        int dev = 0, cus = 0, per_cu = 0;
        if (hipGetDevice(&dev) != hipSuccess || hipDeviceGetAttribute(&cus, hipDeviceAttributeMultiprocessorCount, dev) != hipSuccess) { grid = -1; return; }
        if (hipFuncSetAttribute((const void*)mk_fwd, hipFuncAttributeMaxDynamicSharedMemorySize, LDS_BYTES) != hipSuccess) { fprintf(stderr, "kernel_launch: hipFuncSetAttribute failed\n"); grid = -1; return; }
        if (hipOccupancyMaxActiveBlocksPerMultiprocessor(&per_cu, (const void*)mk_fwd, NTHR, LDS_BYTES) != hipSuccess || per_cu < 1) fprintf(stderr, "kernel_launch: occupancy query says %d\n", per_cu);
        (void)hipGetLastError();
        grid = 256;
        if (cus < 256) { fprintf(stderr, "kernel_launch: device has %d CUs, this kernel needs 256\n", cus); grid = -1; return; }
    }
    if (grid < 0) return;
    if (hipMemsetAsync((char*)d_ws + WS_CTL, 0, CTL_ZERO_BYTES, stream) != hipSuccess) return;
    Params p{};
    for (int i = 0; i < 35; ++i) p.in[i] = (const float*)d_in[i];
    p.out = (float*)d_out; p.ws = (unsigned char*)d_ws;
#if MK_N_LAUNCHES == 1
    p.ph_lo = 0; p.ph_hi = N_PHASES;
    hipLaunchKernelGGL(mk_fwd, dim3(grid), dim3(NTHR), LDS_BYTES, stream, p);
#else
    for (int k = 0; k < N_PHASES; ++k) { p.ph_lo = k; p.ph_hi = k + 1; hipLaunchKernelGGL(mk_fwd, dim3(grid), dim3(NTHR), LDS_BYTES, stream, p); }
#endif
}
```

```cpp
#include <hip/hip_runtime.h>
#include <hip/hip_bf16.h>
#include <cstdio>
#include <cstdint>
#include <cmath>
__device__ __forceinline__ int mk_lane() { int l = (int)__builtin_amdgcn_mbcnt_hi(~0u, __builtin_amdgcn_mbcnt_lo(~0u, 0u)); asm volatile("" : "+v"(l)); return l; }
namespace pg8 {
#define PG8_LAS __attribute__((address_space(3)))
typedef unsigned short bf16_t;
typedef short bf16x8 __attribute__((ext_vector_type(8)));
typedef float f32x4 __attribute__((ext_vector_type(4)));
typedef unsigned u32x4 __attribute__((ext_vector_type(4)));
constexpr int BM = 256, BK = 64, HALF = 128, HTB = HALF * BK * 2  , STAGE_BYTES = 8 * HTB, NXCD = 8, WGM = 8;

__host__ __device__ __forceinline__ int lds_byte(int r, int c) { const int st = (r >> 4) * 2 + (c >> 5), rr = r & 15, cc = c & 31, ob = rr * 64 + cc * 2; return st * 1024 + (ob ^ (((ob >> 9) & 1) << 5)); }
__host__ __device__ __forceinline__ void stage_rc(int b, int& R, int& C) { const int st = b / 1024, sb = b % 1024, swz = sb ^ (((sb >> 9) & 1) << 5); R = (st >> 1) * 16 + swz / 64; C = (st & 1) * 32 + (swz % 64) / 2; }
__host__ __device__ __forceinline__ int perm32(int rho) { const int n = rho >> 4, i = rho & 15; return 8 * (i >> 2) + 4 * n + (i & 3); }

struct Unit { int pm, pn, aux = 0, kt0 = 0, nt = 0, ks = 0, slot = 0; };
struct Gemm { const bf16_t* A; const bf16_t* Bt; int M, N, K; };

struct StaticOrder {
    static constexpr bool SPLITK = false;
    int nM, nN, nwg, G, c;
    __host__ __device__ void init(int M, int N, int G_, int c_) { nM = M / BM; nN = N / BM; nwg = nM * nN; G = G_; c = c_; }
    __host__ __device__ bool next(int i, Unit& u) const {
        const long L = (long)i * G + c; if (L >= nwg) return false;
        int wgid = (int)L; { const int q = nwg / NXCD, r = nwg % NXCD, xcd = wgid % NXCD, off = wgid / NXCD; wgid = (xcd < r ? xcd * (q + 1) : r * (q + 1) + (xcd - r) * q) + off; }
        const int nig = WGM * nN, gid = wgid / nig, fm = gid * WGM, gsz = (nM - fm) < WGM ? (nM - fm) : WGM;
        u.pm = fm + ((wgid % nig) % gsz); u.pn = (wgid % nig) / gsz; return true;
    }
    __device__ __forceinline__ void a_ready(const Unit&) const {}
    __device__ __forceinline__ void done(const Unit&) const {}
};

__device__ __forceinline__ unsigned cvt_pk_bf16(float lo, float hi) { unsigned r; asm volatile("v_cvt_pk_bf16_f32 %0, %1, %2" : "=v"(r) : "v"(lo), "v"(hi)); return r; }
typedef float f32x2 __attribute__((ext_vector_type(2)));
__device__ __forceinline__ f32x2 gelu_pk(f32x2 v) {
    const f32x2 av = __builtin_elementwise_abs(v), d = av * 0.2316418882f + 1.0f;
    f32x2 t; t.x = __builtin_amdgcn_rcpf(d.x); t.y = __builtin_amdgcn_rcpf(d.y);
    f32x2 q = t * 0.5307027145f + (-0.7265760135f); q = q * t + 0.7107068705f; q = q * t + (-0.142248368f); q = q * t + 0.127414796f; q = q * t;
    const f32x2 s = (v * v) * (-0.72134752044f);
    f32x2 e; e.x = __builtin_amdgcn_exp2f(s.x); e.y = __builtin_amdgcn_exp2f(s.y);
    const f32x2 m = v * (q * e), r = v - m;
    f32x2 o; o.x = v.x < 0.f ? m.x : r.x; o.y = v.y < 0.f ? m.y : r.y; return o;
}

template <int ACT  > struct EpiBf16 {
    static constexpr bool PERM = true, AFTER_DRAIN = false; static_assert(ACT == 0 || ACT == 1, "EpiBf16: ACT is 0 (none) or 1 (gelu_pk)");
    bf16_t* O; int ldc; const float* bias; int split_cols; size_t split_stride; float scale0;
    __device__ __forceinline__ void operator()(const f32x4 (&acc)[2][2][4][2], const Unit& u, int wr, int wc, int fr, int fq) const {
        const int row0 = u.pm * BM + wr * 64 + fr; int colt = u.pn * BM; bf16_t* base = O;
        float sc = 1.f; if (split_cols) { const int t = colt / split_cols; base += (size_t)t * split_stride; colt -= t * split_cols; if (t == 0) sc = scale0; }
        const int col0 = colt + wc * 32 + 8 * fq, bcol0 = u.pn * BM + wc * 32 + 8 * fq;
        f32x4 bv[2][2];
#pragma unroll
        for (int bj = 0; bj < 2; ++bj)
#pragma unroll
            for (int n = 0; n < 2; ++n) bv[bj][n] = bias ? *(const f32x4*)(bias + bcol0 + bj * HALF + 4 * n) : (f32x4){0.f, 0.f, 0.f, 0.f};
#pragma unroll
        for (int ai = 0; ai < 2; ++ai)
#pragma unroll
            for (int m = 0; m < 4; ++m) { bf16_t* rowp = base + (size_t)(row0 + ai * HALF + m * 16) * ldc + col0;
#pragma unroll
                for (int bj = 0; bj < 2; ++bj) { f32x4 v0 = acc[ai][bj][m][0] + bv[bj][0], v1 = acc[ai][bj][m][1] + bv[bj][1];
                    if (ACT == 1) { f32x2 a = gelu_pk((f32x2){v0[0], v0[1]}), b = gelu_pk((f32x2){v0[2], v0[3]}), c = gelu_pk((f32x2){v1[0], v1[1]}), d = gelu_pk((f32x2){v1[2], v1[3]});
                        v0 = (f32x4){a.x, a.y, b.x, b.y}; v1 = (f32x4){c.x, c.y, d.x, d.y}; }
                    v0 = v0 * sc; v1 = v1 * sc; u32x4 w; w.x = cvt_pk_bf16(v0[0], v0[1]); w.y = cvt_pk_bf16(v0[2], v0[3]); w.z = cvt_pk_bf16(v1[0], v1[1]); w.w = cvt_pk_bf16(v1[2], v1[3]);
                    *(u32x4*)(rowp + bj * HALF) = w; } }
    }
};

typedef int v8i_t __attribute__((ext_vector_type(8))); typedef int v4i_t __attribute__((ext_vector_type(4)));
__device__ __forceinline__ v8i_t cat8(const bf16x8& a, const bf16x8& b) { return __builtin_shufflevector(__builtin_bit_cast(v4i_t, a), __builtin_bit_cast(v4i_t, b), 0, 1, 2, 3, 4, 5, 6, 7); }
template <class Epi, class Sched, bool ALIGN_EPI = false, bool SP2 = false, bool FP8 = false>
__device__ __forceinline__ void gemm_phase(PG8_LAS unsigned char* lds, const Gemm g, const Sched& S, const Epi& E, const int wv  ) {
    const int lane = mk_lane(), wid = wv, tid = wv * 64 + lane, wr = wid >> 2, wc = wid & 3, fr = lane & 15, fq = lane >> 4;
    const int K = g.K, nt = K / BK;
    unsigned voffA[2], voffB[2];
#pragma unroll
    for (int i = 0; i < 2; ++i) { int R, C; stage_rc(tid * 16 + i * 8192, R, C); const int Rb = Epi::PERM ? ((R & ~31) + perm32(R & 31)) : R;
        voffA[i] = (unsigned)(R * K + C) * 2u; voffB[i] = (unsigned)(Rb * K + C) * 2u; }
    const size_t kstep = (size_t)(BK * 2);
    const size_t hstep = (size_t)HALF * K * 2;
    const size_t tstep = 2 * hstep;
    const unsigned ldsw = (unsigned)wid * 1024u;
    const int aoff = lds_byte(wr * 64 + fr, fq * 8), boff = lds_byte(wc * 32 + fr, fq * 8);
#define PG8_SA(b, h) (((b) * 2 + (h)) * HTB)
#define PG8_SB(b, h) ((4 + (b) * 2 + (h)) * HTB)
#define PG8_STAGE(bufoff, gbase, voff) do { _Pragma("unroll") for (int _i = 0; _i < 2; ++_i) \
        __builtin_amdgcn_global_load_lds((const unsigned*)((const char*)(gbase) + (voff)[_i]), (PG8_LAS unsigned*)(lds + (bufoff) + ldsw + _i * 8192), 16, 0, 0); } while (0)
#define PG8_LDA(dst, b, h) do { _Pragma("unroll") for (int m = 0; m < 4; ++m) _Pragma("unroll") for (int k = 0; k < 2; ++k) dst[m][k] = *(const PG8_LAS bf16x8*)(lds + PG8_SA(b, h) + aoff + m * 2048 + k * 1024); } while (0)
#define PG8_LDB(dst, b, h) do { _Pragma("unroll") for (int n = 0; n < 2; ++n) _Pragma("unroll") for (int k = 0; k < 2; ++k) dst[n][k] = *(const PG8_LAS bf16x8*)(lds + PG8_SB(b, h) + boff + n * 2048 + k * 1024); } while (0)
#define PG8_MMA(ai, bj, At, Bt) do { __builtin_amdgcn_s_setprio(1); \
        if constexpr (FP8) { asm volatile("s_nop 1" ::: ); _Pragma("unroll") for (int m = 0; m < 4; ++m) _Pragma("unroll") for (int n = 0; n < 2; ++n) \
            asm volatile("v_mfma_scale_f32_16x16x128_f8f6f4 %0, %1, %2, %0, %3, %3 op_sel_hi:[0,0,0]" : "+v"(acc[ai][bj][m][n]) : "v"(cat8(Bt[n][0], Bt[n][1])), "v"(cat8(At[m][0], At[m][1])), "v"(sc_one)); } \
        else { _Pragma("unroll") for (int m = 0; m < 4; ++m) _Pragma("unroll") for (int n = 0; n < 2; ++n) _Pragma("unroll") for (int k = 0; k < 2; ++k) \
            acc[ai][bj][m][n] = __builtin_amdgcn_mfma_f32_16x16x32_bf16(Bt[n][k], At[m][k], acc[ai][bj][m][n], 0, 0, 0); } \
        __builtin_amdgcn_s_setprio(0); } while (0)
#define PG8_WAIT_V(n) asm volatile("s_waitcnt vmcnt(" #n ")" ::: "memory")
#define PG8_WAIT_L(n) asm volatile("s_waitcnt lgkmcnt(" #n ")" ::: "memory")
#define PG8_BAR __builtin_amdgcn_s_barrier()
#define PG8_SCHED __builtin_amdgcn_sched_barrier(0)
    Unit cur, nxt; int ui = 0;
    if (!S.next(0, cur)) return;
    unsigned sc_one = 0x7f7f7f7fu; asm volatile("" : "+v"(sc_one));
    (void)sc_one;
    f32x4 acc[2][2][4][2];
#pragma unroll
    for (int a = 0; a < 2; ++a)
#pragma unroll
        for (int b = 0; b < 2; ++b)
#pragma unroll
            for (int m = 0; m < 4; ++m)
#pragma unroll
                for (int n = 0; n < 2; ++n) acc[a][b][m][n] = (f32x4){0.f, 0.f, 0.f, 0.f};
    bf16x8 At[4][2], B0[2][2], B1[2][2];
    const char* cA = (const char*)g.A + (size_t)cur.pm * tstep; const char* cB = (const char*)g.Bt + (size_t)cur.pn * tstep;
    if constexpr (Sched::SPLITK) { cA += (size_t)cur.kt0 * kstep; cB += (size_t)cur.kt0 * kstep; }
    S.a_ready(cur);
    if constexpr (SP2) {
        PG8_STAGE(PG8_SB(0, 0), cB, voffB); PG8_STAGE(PG8_SB(0, 1), cB + hstep, voffB); PG8_STAGE(PG8_SA(0, 0), cA, voffA); PG8_STAGE(PG8_SA(0, 1), cA + hstep, voffA);
        if (wr == 1) PG8_BAR;
        PG8_WAIT_V(2); PG8_BAR;
        PG8_STAGE(PG8_SB(1, 0), cB + kstep, voffB); PG8_STAGE(PG8_SA(1, 0), cA + kstep, voffA); PG8_STAGE(PG8_SB(1, 1), cB + hstep + kstep, voffB);
        PG8_WAIT_V(6); PG8_BAR;
    } else {
        PG8_STAGE(PG8_SB(0, 0), cB, voffB); PG8_STAGE(PG8_SA(0, 0), cA, voffA); PG8_STAGE(PG8_SB(0, 1), cB + hstep, voffB); PG8_STAGE(PG8_SA(0, 1), cA + hstep, voffA);
        if (wr == 1) PG8_BAR;
        PG8_WAIT_V(4); PG8_BAR;
        PG8_STAGE(PG8_SB(1, 0), cB + kstep, voffB); PG8_STAGE(PG8_SA(1, 0), cA + kstep, voffA); PG8_STAGE(PG8_SB(1, 1), cB + hstep + kstep, voffB);
        PG8_WAIT_V(6); PG8_BAR;
    }
    for (;;) {
        const bool has_next = S.next(ui + 1, nxt);
        const char* nA = has_next ? (const char*)g.A + (size_t)nxt.pm * tstep : cA; const char* nB = has_next ? (const char*)g.Bt + (size_t)nxt.pn * tstep : cB;
        if constexpr (Sched::SPLITK) { if (has_next) { nA += (size_t)nxt.kt0 * kstep; nB += (size_t)nxt.kt0 * kstep; } }
        const int cnt = Sched::SPLITK ? cur.nt : nt;
        for (int t = 0; t < cnt; t += 2) {
            const bool last = (t == cnt - 2);
            const char* a1 = cA + (size_t)(t + 1) * kstep;
            const char* a2 = last ? nA : cA + (size_t)(t + 2) * kstep; const char* b2 = last ? nB : cB + (size_t)(t + 2) * kstep;
            const char* a3 = a2 + kstep; const char* b3 = b2 + kstep;
            if (last && has_next) S.a_ready(nxt);
            if constexpr (SP2) {
            PG8_LDB(B0, 0, 0); PG8_LDB(B1, 0, 1); PG8_SCHED; PG8_LDA(At, 0, 0); PG8_STAGE(PG8_SA(1, 1), a1 + hstep, voffA);
            PG8_WAIT_V(8); PG8_WAIT_L(0); PG8_BAR; PG8_MMA(0, 0, At, B0); PG8_MMA(0, 1, At, B1); PG8_BAR; PG8_SCHED;
            PG8_LDA(At, 0, 1); PG8_STAGE(PG8_SB(0, 0), b2, voffB); PG8_STAGE(PG8_SB(0, 1), b2 + hstep, voffB); PG8_STAGE(PG8_SA(0, 0), a2, voffA);
            PG8_WAIT_V(8); PG8_WAIT_L(0); PG8_BAR; PG8_MMA(1, 0, At, B0); PG8_MMA(1, 1, At, B1); PG8_BAR; PG8_SCHED;
            PG8_LDB(B0, 1, 0); PG8_LDB(B1, 1, 1); PG8_SCHED; PG8_LDA(At, 1, 0); PG8_STAGE(PG8_SA(0, 1), a2 + hstep, voffA);
            PG8_WAIT_V(8); PG8_WAIT_L(0); PG8_BAR; PG8_MMA(0, 0, At, B0); PG8_MMA(0, 1, At, B1); PG8_BAR; PG8_SCHED;
            PG8_LDA(At, 1, 1); PG8_STAGE(PG8_SB(1, 0), b3, voffB); PG8_STAGE(PG8_SB(1, 1), b3 + hstep, voffB); PG8_STAGE(PG8_SA(1, 0), a3, voffA);
            PG8_WAIT_V(8); PG8_WAIT_L(0); PG8_BAR; PG8_MMA(1, 0, At, B0); PG8_MMA(1, 1, At, B1); PG8_BAR; PG8_SCHED;
            } else {
            PG8_LDB(B0, 0, 0); PG8_SCHED; PG8_LDA(At, 0, 0); PG8_STAGE(PG8_SA(1, 1), a1 + hstep, voffA);
            PG8_WAIT_L(8); PG8_BAR; PG8_WAIT_L(0); PG8_MMA(0, 0, At, B0); PG8_BAR; PG8_SCHED;
            PG8_LDB(B1, 0, 1); PG8_STAGE(PG8_SB(0, 0), b2, voffB);
            PG8_BAR; PG8_WAIT_L(0); PG8_MMA(0, 1, At, B1); PG8_BAR;
            PG8_LDA(At, 0, 1); PG8_STAGE(PG8_SA(0, 0), a2, voffA);
            PG8_BAR; PG8_WAIT_L(0); PG8_MMA(1, 0, At, B0); PG8_BAR; PG8_SCHED;
            PG8_STAGE(PG8_SB(0, 1), b2 + hstep, voffB);
            PG8_WAIT_V(6); PG8_BAR; PG8_MMA(1, 1, At, B1); PG8_BAR;
            PG8_LDB(B0, 1, 0); PG8_SCHED; PG8_LDA(At, 1, 0); PG8_STAGE(PG8_SA(0, 1), a2 + hstep, voffA);
            PG8_WAIT_L(8); PG8_BAR; PG8_WAIT_L(0); PG8_MMA(0, 0, At, B0); PG8_BAR; PG8_SCHED;
            PG8_LDB(B1, 1, 1); PG8_STAGE(PG8_SB(1, 0), b3, voffB);
            PG8_BAR; PG8_WAIT_L(0); PG8_MMA(0, 1, At, B1); PG8_BAR;
            PG8_LDA(At, 1, 1); PG8_STAGE(PG8_SA(1, 0), a3, voffA);
            PG8_BAR; PG8_WAIT_L(0); PG8_MMA(1, 0, At, B0); PG8_BAR; PG8_SCHED;
            PG8_STAGE(PG8_SB(1, 1), b3 + hstep, voffB);
            PG8_WAIT_V(6); PG8_BAR; PG8_MMA(1, 1, At, B1); PG8_BAR;
            }
        }
        if constexpr (FP8) asm volatile("s_nop 15\n\ts_nop 15" ::: );
        if constexpr (ALIGN_EPI) { if (wr == 0) PG8_BAR; }
        if constexpr (!Epi::AFTER_DRAIN) { E(acc, cur, wr, wc, fr, fq); S.done(cur); }
        if (!has_next) break;
#pragma unroll
        for (int a = 0; a < 2; ++a)
#pragma unroll
            for (int b = 0; b < 2; ++b)
#pragma unroll
                for (int m = 0; m < 4; ++m)
#pragma unroll
                    for (int n = 0; n < 2; ++n) acc[a][b][m][n] = (f32x4){0.f, 0.f, 0.f, 0.f};
        cur = nxt; cA = nA; cB = nB; ++ui;
        if constexpr (ALIGN_EPI) { if (wr == 1) PG8_BAR; }
    }
    PG8_WAIT_V(0);
    if constexpr (!ALIGN_EPI) { if (wr == 0) PG8_BAR; }
    PG8_BAR;
    if constexpr (Epi::AFTER_DRAIN) { E.fused(acc, cur, wr, wc, fr, fq, lds, wid, lane); S.done(cur); }
#undef PG8_SA
#undef PG8_SB
#undef PG8_STAGE
#undef PG8_LDA
#undef PG8_LDB
#undef PG8_MMA
#undef PG8_WAIT_V
#undef PG8_WAIT_L
#undef PG8_BAR
#undef PG8_SCHED
}
}
#include <hip/hip_bf16.h>
#include <cmath>
namespace attn_body {
using bf16=__hip_bfloat16;
using bf16x8=__attribute__((ext_vector_type(8)))short;
using s16x4=__attribute__((ext_vector_type(4)))short;
using f32x16=__attribute__((ext_vector_type(16)))float;
using u32x4=__attribute__((ext_vector_type(4)))unsigned;
constexpr int SEQ=4096,D=64,PITCH=5888,OPITCH=1536;
constexpr int NW=8,QBLK=32,QB=QBLK*NW,KVBLK=64,NQB=SEQ/QB;
constexpr int ATTN_UNIT_ROWS=QB;
__device__ __forceinline__ int crow(int r,int hi){return (r&3)+8*(r>>2)+4*hi;}
#define SBAR() __builtin_amdgcn_sched_barrier(0)
__device__ __forceinline__ void cmask(f32x16&p0,f32x16&p1,int jb,int qrel,int hi){
  const float NEG=-INFINITY; int kb=64*jb+4*hi;
  #pragma unroll
  for(int r=0;r<16;++r){int kv=kb+(r&3)+8*(r>>2); if(kv>qrel)p0[r]=NEG; if(kv+32>qrel)p1[r]=NEG;}
}

constexpr int NSLOT=3, SLOTB=8192;
constexpr int LDS_K=0, LDS_V=NSLOT*SLOTB, LDS_WS=2*NSLOT*SLOTB, LDS_OST=LDS_WS+NW*64*4, LDS_BYTES=LDS_OST+NW*4096;
constexpr float C2=0.125f*1.4426950408889634f;
__device__ __forceinline__ void glds16(const void*gsrc,unsigned lds_dst){unsigned keep;
  asm volatile("s_mov_b32 %0, m0\n\ts_mov_b32 m0, %2\n\ts_nop 0\n\tglobal_load_lds_dwordx4 %1, off\n\ts_mov_b32 m0, %0":"=&s"(keep):"v"(gsrc),"s"(lds_dst):"memory");}
__device__ __forceinline__ void glds16s(const void*sbase,unsigned voff,unsigned lds_dst){unsigned keep;
  asm volatile("s_mov_b32 %0, m0\n\ts_mov_b32 m0, %3\n\ts_nop 0\n\tglobal_load_lds_dwordx4 %1, %2\n\ts_mov_b32 m0, %0":"=&s"(keep):"v"(voff),"s"(sbase),"s"(lds_dst):"memory");}
__device__ __forceinline__ float max3f(float a,float b,float c){float r;asm("v_max3_f32 %0, %1, %2, %3":"=v"(r):"v"(a),"v"(b),"v"(c));return r;}
__device__ __forceinline__ float max2f(float a,float b){float r;asm("v_max_f32_e32 %0, %1, %2":"=v"(r):"v"(a),"v"(b));return r;}
__device__ __forceinline__ float fadd_s(float a,float b){float r;asm("v_add_f32_e32 %0, %1, %2":"=v"(r):"v"(a),"v"(b));return r;}
__device__ __forceinline__ float fsub_s(float a,float b){float r;asm("v_sub_f32_e32 %0, %1, %2":"=v"(r):"v"(a),"v"(b));return r;}
typedef float f32x2_t __attribute__((ext_vector_type(2))); typedef __bf16 bf16x2_t __attribute__((ext_vector_type(2)));
__device__ __forceinline__ unsigned cvtpk_s(float lo,float hi){f32x2_t v={lo,hi};bf16x2_t b=__builtin_convertvector(v,bf16x2_t);return __builtin_bit_cast(unsigned,b);}
#define WAIT_BAR(N) asm volatile("s_waitcnt vmcnt(" #N ") lgkmcnt(0)\n\ts_barrier":::"memory")

__device__ __forceinline__ void qkt(f32x16&p0,f32x16&p1,const char*Kslot,const bf16x8*qr,const f32x16&negm,int r32,int hi){
  const char*kb=Kslot+hi*1024+r32*16;
  #pragma unroll
  for(int d0=0;d0<4;++d0){
    const bf16x8 b0=*reinterpret_cast<const bf16x8*>(kb+d0*2048);
    const bf16x8 b1=*reinterpret_cast<const bf16x8*>(kb+d0*2048+512);
    if(d0==0){p0=__builtin_amdgcn_mfma_f32_32x32x16_bf16(b0,qr[0],negm,0,0,0);p1=__builtin_amdgcn_mfma_f32_32x32x16_bf16(b1,qr[0],negm,0,0,0);}
    else{p0=__builtin_amdgcn_mfma_f32_32x32x16_bf16(b0,qr[d0],p0,0,0,0);p1=__builtin_amdgcn_mfma_f32_32x32x16_bf16(b1,qr[d0],p1,0,0,0);}}
}
typedef __attribute__((address_space(3))) const char* lds_cptr;
typedef short v4i16_t __attribute__((ext_vector_type(4)));
__device__ __forceinline__ void kload8(bf16x8*kf,lds_cptr kp){
  kf[0]=*(const __attribute__((address_space(3))) bf16x8*)(kp);      kf[1]=*(const __attribute__((address_space(3))) bf16x8*)(kp+512);
  kf[2]=*(const __attribute__((address_space(3))) bf16x8*)(kp+2048); kf[3]=*(const __attribute__((address_space(3))) bf16x8*)(kp+2560);
  kf[4]=*(const __attribute__((address_space(3))) bf16x8*)(kp+4096); kf[5]=*(const __attribute__((address_space(3))) bf16x8*)(kp+4608);
  kf[6]=*(const __attribute__((address_space(3))) bf16x8*)(kp+6144); kf[7]=*(const __attribute__((address_space(3))) bf16x8*)(kp+6656);
}
__device__ __forceinline__ void kload2(bf16x8*kf,lds_cptr kp,int j){ kf[2*j]=*(const __attribute__((address_space(3))) bf16x8*)(kp+j*2048); kf[2*j+1]=*(const __attribute__((address_space(3))) bf16x8*)(kp+j*2048+512); }
__device__ __forceinline__ s16x4 vtr(lds_cptr p){ return __builtin_bit_cast(s16x4,__builtin_amdgcn_ds_read_tr16_b64_v4i16((__attribute__((address_space(3))) v4i16_t*)p)); }
__device__ __forceinline__ float rowmax(const f32x16&p0,const f32x16&p1){
  float a=max3f(p0[0],p0[1],p1[0]),b=max3f(p0[2],p0[3],p1[1]);a=max3f(a,p1[2],p1[3]);
  #pragma unroll
  for(int r=4;r<16;r+=4){a=max3f(a,p0[r],p0[r+1]);b=max3f(b,p0[r+2],p0[r+3]);a=max3f(a,p1[r],p1[r+1]);b=max3f(b,p1[r+2],p1[r+3]);}
  const float m=max2f(a,b);
  auto rr=__builtin_amdgcn_permlane32_swap(__float_as_uint(m),__float_as_uint(m),false,false);
  return max2f(__uint_as_float(rr[0]),__uint_as_float(rr[1]));
}
__device__ __forceinline__ void pv(f32x16*o,int vb,bf16x8 pa0,bf16x8 pa1,bf16x8 pa2,bf16x8 pa3){
  #pragma unroll
  for(int d0=0;d0<2;++d0){s16x4 lo[4],hi[4];
    #pragma unroll
    for(int ks=0;ks<4;++ks){
      asm volatile("ds_read_b64_tr_b16 %0,%1 offset:%c2":"=&v"(lo[ks]):"v"(vb),"i"(d0*4096+ks*1024):"memory");
      asm volatile("ds_read_b64_tr_b16 %0,%1 offset:%c2":"=&v"(hi[ks]):"v"(vb),"i"(d0*4096+ks*1024+512):"memory");}
    asm volatile("s_waitcnt lgkmcnt(0)":::"memory");SBAR();
    #define PK(k) (bf16x8){lo[k][0],lo[k][1],lo[k][2],lo[k][3],hi[k][0],hi[k][1],hi[k][2],hi[k][3]}
    o[d0]=__builtin_amdgcn_mfma_f32_32x32x16_bf16(pa0,PK(0),o[d0],0,0,0);
    o[d0]=__builtin_amdgcn_mfma_f32_32x32x16_bf16(pa1,PK(1),o[d0],0,0,0);
    o[d0]=__builtin_amdgcn_mfma_f32_32x32x16_bf16(pa2,PK(2),o[d0],0,0,0);
    o[d0]=__builtin_amdgcn_mfma_f32_32x32x16_bf16(pa3,PK(3),o[d0],0,0,0);
    #undef PK
  }
}

#ifndef ATTN_STORE16
#define ATTN_STORE16(p,v) (*(u32x4*)(p)=(v))
#endif
template<int THRL> __device__ __forceinline__ void attn_unit(int qb,const bf16*Qh,const bf16*__restrict__ Kh,const bf16*__restrict__ Vh,bf16*Oh,char*shm,const int wv){
  const int lane=mk_lane(),r32=lane&31,hi=lane>>5; const int wid=wv;
  const int q0=qb*QB;
  const bf16*Qw=Qh+(long)(q0+wid*QBLK)*PITCH;
  const unsigned lds0=(unsigned)(uintptr_t)shm;
  float*wsf=(float*)(shm+LDS_WS)+wid*64;
  const bf16*ksrc=Kh+(long)lane*PITCH+wid*8;
  const bf16*vsrc=Vh+(long)(16*(wid&3)+(lane>>2))*PITCH+(wid>>2)*32+(lane&3)*8;
  const unsigned kdst=lds0+LDS_K+wid*1024, vdst=lds0+LDS_V+wid*1024;
  #define DMA_K(t,slot) glds16(ksrc+(long)(t)*KVBLK*PITCH,(unsigned)__builtin_amdgcn_readfirstlane(kdst+(slot)))
  #define DMA_V(t,slot) glds16(vsrc+(long)(t)*KVBLK*PITCH,(unsigned)__builtin_amdgcn_readfirstlane(vdst+(slot)))
  const int vb0=(int)(lds0+LDS_V)+((lane>>4)&1)*32+(lane&3)*8+(4*hi+((lane&15)>>2))*64;
  const char*Kbase=shm+LDS_K; bf16x8 kf[8];
  const lds_cptr shm3=(lds_cptr)shm; const lds_cptr kp0=shm3+LDS_K+hi*1024+r32*16; const lds_cptr vp0=shm3+LDS_V+((lane>>4)&1)*32+(lane&3)*8+(4*hi+((lane&15)>>2))*64;
  const int NT=(q0+QB)/KVBLK;
  DMA_K(0,0);DMA_V(0,0);DMA_K(1,SLOTB);
  bf16x8 qr[4];
  #pragma unroll
  for(int d0=0;d0<4;++d0)qr[d0]=*reinterpret_cast<const bf16x8*>(&Qw[(long)r32*PITCH+d0*16+hi*8]);
  float mhat=0.f,l_reg=0.f;f32x16 o[2];o[0]=f32x16{};o[1]=f32x16{};f32x16 negm=f32x16{};asm volatile("":"+v"(negm));
  const int qrel=wid*QBLK+r32;
  #define CMASK(P0,P1,t) do{int jb_=(t)-(NT-4); if(jb_>=0)cmask(P0,P1,jb_,qrel,hi);}while(0)
  bool resc=false;
  #define START(P0,P1) do{ const float rm=rowmax(P0,P1); resc=false; \
    { const float dl=rm; mhat=fadd_s(mhat,dl); \
      _Pragma("unroll") for(int r=0;r<16;++r){P0[r]=fsub_s(P0[r],dl);P1[r]=fsub_s(P1[r],dl);} \
      _Pragma("unroll") for(int r=0;r<16;++r)negm[r]=-mhat; asm volatile("":"+v"(negm)); } \
    _Pragma("unroll") for(int r=0;r<16;++r)P0[r]=__builtin_amdgcn_exp2f(P0[r]); }while(0)
  #define RESC() do{ if(resc){ asm volatile("s_waitcnt lgkmcnt(0)":::"memory"); \
      _Pragma("unroll") for(int d_=0;d_<2;++d_) _Pragma("unroll") for(int r=0;r<16;++r)o[d_][r]*=wsf[crow(r,hi)]; } }while(0)
  f32x16 pA0,pA1,pB0,pB1;
  int sl_prev=0,sl_cur=0,sl_next=SLOTB;
  #define ROT() do{sl_prev=sl_cur;sl_cur=sl_next;sl_next=(sl_next==(NSLOT-1)*SLOTB)?0:sl_next+SLOTB;}while(0)
  DMA_K(2,2*SLOTB);
  WAIT_BAR(3);
  qkt(pA0,pA1,Kbase,qr,negm,r32,hi);asm volatile("s_nop 15\n\ts_nop 7":"+v"(pA0),"+v"(pA1));CMASK(pA0,pA1,0);
  START(pA0,pA1);
  _Pragma("unroll") for(int r=0;r<16;++r)pA1[r]=__builtin_amdgcn_exp2f(pA1[r]);
  WAIT_BAR(0);
  DMA_K(3,0);DMA_V(1,SLOTB);
  ROT();
  kload8(kf,kp0+sl_cur);
  WAIT_BAR(2);
  s16x4 vlo[8],vhi[8]; u32x4 pw0,pw1,pw2,pw3;
  #define PKW(P,B) cvtpk_s(P[B],P[B+1])
  #define PAF(k) __builtin_bit_cast(bf16x8,pw##k)
  #define VFR(i) (bf16x8){vlo[i][0],vlo[i][1],vlo[i][2],vlo[i][3],vhi[i][0],vhi[i][1],vhi[i][2],vhi[i][3]}
  #define PIN(x) asm volatile("":"+v"(x))
  #define MX3(a,b,c) __builtin_fmaxf(__builtin_fmaxf((a),(b)),(c))
  #define GAPA(MF,A0,A1,A2,A3,W0,W1,PW) do{ MF; sacc+=A0; sacc+=A1; sacc+=A2; sacc+=A3; PIN(sacc); W0; W1; PIN(PW); SBAR(); }while(0)
  #define EX(v) __builtin_amdgcn_exp2f(v)
  #define GAPB(MF,X,B) do{ MF; X[B]=EX(X[B]); X[B+1]=EX(X[B+1]); X[B+2]=EX(X[B+2]); X[B+3]=EX(X[B+3]); PIN(X); SBAR(); }while(0)
  #define VRD(i) do{ vlo[i]=vtr(vp_+(((i)>>2)*4096+((i)&3)*1024)); vhi[i]=vtr(vp_+(((i)>>2)*4096+((i)&3)*1024+512)); }while(0)
  #define KRD(G,j) do{ if(G){ kload2(kf,kp0+sl_next,j); SBAR(); } }while(0)
  #define STEP(C0,C1,P0,P1,t,GK,GV,GL) do{ SBAR(); \
    const lds_cptr vp_=vp0+sl_prev; \
    VRD(0); SBAR(); float sacc=(P0[0]+P0[1]); \
    GAPA(C0=__builtin_amdgcn_mfma_f32_32x32x16_bf16(kf[0],qr[0],negm,0,0,0), P0[2],P0[3],P0[4],P0[5],     pw0[0]=PKW(P0,0), pw0[1]=PKW(P0,2), pw0); \
    VRD(4); SBAR(); GAPA(C1=__builtin_amdgcn_mfma_f32_32x32x16_bf16(kf[1],qr[0],negm,0,0,0), P0[6],P0[7],P0[8],P0[9],     pw0[2]=PKW(P0,4), pw0[3]=PKW(P0,6), pw0); \
    VRD(1); SBAR(); GAPA(C0=__builtin_amdgcn_mfma_f32_32x32x16_bf16(kf[2],qr[1],C0,0,0,0),   P0[10],P0[11],P0[12],P0[13], pw1[0]=PKW(P0,8), pw1[1]=PKW(P0,10), pw1); \
    VRD(5); SBAR(); GAPA(C1=__builtin_amdgcn_mfma_f32_32x32x16_bf16(kf[3],qr[1],C1,0,0,0),   P0[14],P0[15],P1[0],P1[1],   pw1[2]=PKW(P0,12),pw1[3]=PKW(P0,14), pw1); \
    VRD(2); SBAR(); GAPA(C0=__builtin_amdgcn_mfma_f32_32x32x16_bf16(kf[4],qr[2],C0,0,0,0),   P1[2],P1[3],P1[4],P1[5],     pw2[0]=PKW(P1,0), pw2[1]=PKW(P1,2), pw2); \
    VRD(6); SBAR(); GAPA(C1=__builtin_amdgcn_mfma_f32_32x32x16_bf16(kf[5],qr[2],C1,0,0,0),   P1[6],P1[7],P1[8],P1[9],     pw2[2]=PKW(P1,4), pw2[3]=PKW(P1,6), pw2); \
    VRD(3); SBAR(); GAPA(C0=__builtin_amdgcn_mfma_f32_32x32x16_bf16(kf[6],qr[3],C0,0,0,0),   P1[10],P1[11],P1[12],P1[13], pw3[0]=PKW(P1,8), pw3[1]=PKW(P1,10), pw3); \
    VRD(7); SBAR(); GAPA(C1=__builtin_amdgcn_mfma_f32_32x32x16_bf16(kf[7],qr[3],C1,0,0,0),   P1[14],P1[15],0.f,0.f,       pw3[2]=PKW(P1,12),pw3[3]=PKW(P1,14), pw3); \
    l_reg+=sacc; \
    if(GK){DMA_K((t)+3,sl_cur);} if(GV){DMA_V((t)+1,sl_next);} \
    CMASK(C0,C1,t); \
    { float a=MX3(C0[0],C0[1],C1[0]),b=MX3(C0[2],C0[3],C1[1]); a=MX3(a,C1[2],C1[3]); \
      _Pragma("unroll") for(int r=4;r<16;r+=4){a=MX3(a,C0[r],C0[r+1]);b=MX3(b,C0[r+2],C0[r+3]);a=MX3(a,C1[r],C1[r+1]);b=MX3(b,C1[r+2],C1[r+3]);} \
      float rm=__builtin_fmaxf(a,b); { auto rr=__builtin_amdgcn_permlane32_swap(__float_as_uint(rm),__float_as_uint(rm),false,false); rm=__builtin_fmaxf(__uint_as_float(rr[0]),__uint_as_float(rr[1])); } \
      resc=false; \
      if(__builtin_expect(__any(rm>(float)THRL),0)){ const float dl=__builtin_fmaxf(rm,0.f); mhat+=dl; \
        _Pragma("unroll") for(int r=0;r<16;++r){C0[r]-=dl;C1[r]-=dl;} \
        _Pragma("unroll") for(int r=0;r<16;++r)negm[r]=-mhat; asm volatile("":"+v"(negm)); \
        const float f=__builtin_amdgcn_exp2f(-dl); l_reg*=f; if(hi==0)wsf[r32]=f; resc=true; } } \
    SBAR(); \
    GAPB(o[0]=__builtin_amdgcn_mfma_f32_32x32x16_bf16(PAF(0),VFR(0),o[0],0,0,0), C0,0); \
    GAPB(o[1]=__builtin_amdgcn_mfma_f32_32x32x16_bf16(PAF(0),VFR(4),o[1],0,0,0), C0,4); \
    KRD(GL,0); GAPB(o[0]=__builtin_amdgcn_mfma_f32_32x32x16_bf16(PAF(1),VFR(1),o[0],0,0,0), C0,8); \
    KRD(GL,1); GAPB(o[1]=__builtin_amdgcn_mfma_f32_32x32x16_bf16(PAF(1),VFR(5),o[1],0,0,0), C0,12); \
    KRD(GL,2); GAPB(o[0]=__builtin_amdgcn_mfma_f32_32x32x16_bf16(PAF(2),VFR(2),o[0],0,0,0), C1,0); \
    KRD(GL,3); GAPB(o[1]=__builtin_amdgcn_mfma_f32_32x32x16_bf16(PAF(2),VFR(6),o[1],0,0,0), C1,4); \
    GAPB(o[0]=__builtin_amdgcn_mfma_f32_32x32x16_bf16(PAF(3),VFR(3),o[0],0,0,0), C1,8); \
    GAPB(o[1]=__builtin_amdgcn_mfma_f32_32x32x16_bf16(PAF(3),VFR(7),o[1],0,0,0), C1,12); \
    }while(0)
  int t=1;
  #undef CMASK
  #define CMASK(P0,P1,t) do{}while(0)
  for(;t+5<NT;t+=2){
    STEP(pB0,pB1,pA0,pA1,t,true,true,true);     WAIT_BAR(2); RESC(); ROT();
    STEP(pA0,pA1,pB0,pB1,t+1,true,true,true);   WAIT_BAR(2); RESC(); ROT();
  }
  #undef CMASK
  #define CMASK(P0,P1,t) do{int jb_=(t)-(NT-4); if(jb_>=0)cmask(P0,P1,jb_,qrel,hi);}while(0)
  #define ENDW(tt) do{ if((tt)+3<NT){WAIT_BAR(2);} else if((tt)+2<NT){WAIT_BAR(1);} else {WAIT_BAR(0);} }while(0)
  for(;t+1<NT;t+=2){
    STEP(pB0,pB1,pA0,pA1,t,(t+3<NT),(t+1<NT),(t+1<NT));       ENDW(t);   RESC(); ROT();
    STEP(pA0,pA1,pB0,pB1,t+1,(t+4<NT),(t+2<NT),(t+2<NT));     ENDW(t+1); RESC(); ROT();
  }
  STEP(pB0,pB1,pA0,pA1,NT-1,false,false,false); RESC();
  { float sacc=pB0[0]+pB0[1]; _Pragma("unroll") for(int r=2;r<16;++r)sacc+=pB0[r]; _Pragma("unroll") for(int r=0;r<16;++r)sacc+=pB1[r]; l_reg+=sacc;
    pw0=(u32x4){PKW(pB0,0),PKW(pB0,2),PKW(pB0,4),PKW(pB0,6)};pw1=(u32x4){PKW(pB0,8),PKW(pB0,10),PKW(pB0,12),PKW(pB0,14)};pw2=(u32x4){PKW(pB1,0),PKW(pB1,2),PKW(pB1,4),PKW(pB1,6)};pw3=(u32x4){PKW(pB1,8),PKW(pB1,10),PKW(pB1,12),PKW(pB1,14)};
    SBAR(); pv(o,vb0+sl_cur,PAF(0),PAF(1),PAF(2),PAF(3)); }
  #undef PKW
  #undef PAF
  #undef VFR
  #undef PIN
  #undef MX3
  #undef GAPA
  #undef GAPB
  #undef EX
  #undef VRD
  #undef KRD
  #undef STEP
  #undef ENDW
  {auto rr=__builtin_amdgcn_permlane32_swap(__float_as_uint(l_reg),__float_as_uint(l_reg),false,false);l_reg=__uint_as_float(rr[0])+__uint_as_float(rr[1]);}
  if(hi==0)wsf[32+r32]=l_reg;asm volatile("s_waitcnt lgkmcnt(0)":::"memory");
  float rli[16];
  #pragma unroll
  for(int r=0;r<16;++r)rli[r]=__builtin_amdgcn_rcpf(wsf[32+crow(r,hi)]);
  bf16*Ow=Oh+(long)(q0+wid*QBLK)*OPITCH;
  { bf16*stg=(bf16*)(shm+LDS_OST)+wid*2048;
    #pragma unroll
    for(int r=0;r<16;++r){const int orow=crow(r,hi);
      #pragma unroll
      for(int d0=0;d0<2;++d0)stg[orow*64+d0*32+r32]=__float2bfloat16(o[d0][r]*rli[r]);}
    asm volatile("s_waitcnt lgkmcnt(0)":::"memory");
    #pragma unroll
    for(int i=0;i<4;++i){const int row=i*8+(lane>>3),ch=lane&7; const u32x4 v=*(const u32x4*)(stg+row*64+ch*8); ATTN_STORE16(Ow+(long)row*OPITCH+ch*8,v);} }
  asm volatile("s_waitcnt lgkmcnt(0)\n\ts_barrier":::"memory");
  #undef DMA_K
  #undef DMA_V
  #undef CMASK
  #undef START
  #undef RESC
  #undef ROT
}
constexpr int LV_V=NSLOT*SLOTB, LV_WS=LV_V+NSLOT*2*SLOTB, LV_OST=LV_WS+NW*64*4, LV_BYTES=LV_OST+NW*8192;
__device__ __forceinline__ void pv4(f32x16*o,int vb,bf16x8 pa0,bf16x8 pa1,bf16x8 pa2,bf16x8 pa3){
  #pragma unroll
  for(int d0=0;d0<4;++d0){s16x4 lo[4],hi[4];
    #pragma unroll
    for(int ks=0;ks<4;++ks){
      asm volatile("ds_read_b64_tr_b16 %0,%1 offset:%c2":"=&v"(lo[ks]):"v"(vb),"i"(d0*4096+ks*1024):"memory");
      asm volatile("ds_read_b64_tr_b16 %0,%1 offset:%c2":"=&v"(hi[ks]):"v"(vb),"i"(d0*4096+ks*1024+512):"memory");}
    asm volatile("s_waitcnt lgkmcnt(0)":::"memory");SBAR();
    #define PK(k) (bf16x8){lo[k][0],lo[k][1],lo[k][2],lo[k][3],hi[k][0],hi[k][1],hi[k][2],hi[k][3]}
    o[d0]=__builtin_amdgcn_mfma_f32_32x32x16_bf16(pa0,PK(0),o[d0],0,0,0);
    o[d0]=__builtin_amdgcn_mfma_f32_32x32x16_bf16(pa1,PK(1),o[d0],0,0,0);
    o[d0]=__builtin_amdgcn_mfma_f32_32x32x16_bf16(pa2,PK(2),o[d0],0,0,0);
    o[d0]=__builtin_amdgcn_mfma_f32_32x32x16_bf16(pa3,PK(3),o[d0],0,0,0);
    #undef PK
  }
}
#ifndef ATTN_STORE16
#define ATTN_STORE16(p,v) (*(u32x4*)(p)=(v))
#endif
template<int THRL> __device__ __forceinline__ void attn_unit128(int qb,const bf16*Qh,const bf16*__restrict__ Kh,const bf16*__restrict__ Vh,bf16*Oh,char*shm,const int wv){
  const int lane=mk_lane(),r32=lane&31,hi=lane>>5; const int wid=wv;
  const int q0=qb*QB;
  const bf16*Qw=Qh+(long)(q0+wid*QBLK)*PITCH;
  const unsigned lds0=(unsigned)(uintptr_t)shm;
  float*wsf=(float*)(shm+LV_WS)+wid*64;
  const unsigned koff=(unsigned)((lane*PITCH+wid*8)*2), voff=(unsigned)(((16*(wid&3)+(lane>>2))*PITCH+(wid>>2)*32+(lane&3)*8)*2);
  const unsigned kdst=lds0+LDS_K+wid*1024, vdst=lds0+LV_V+wid*1024;
  #define DMA_K(t,slot) glds16s(Kh+(long)(t)*KVBLK*PITCH,koff,(unsigned)__builtin_amdgcn_readfirstlane(kdst+(slot)))
  #define DMA_V(t,slot) do{ glds16s(Vh+(long)(t)*KVBLK*PITCH,voff,(unsigned)__builtin_amdgcn_readfirstlane(vdst+2*(slot))); glds16s(Vh+64+(long)(t)*KVBLK*PITCH,voff,(unsigned)__builtin_amdgcn_readfirstlane(vdst+2*(slot)+8192)); }while(0)
  const char*Kbase=shm+LDS_K; bf16x8 kf[8];
  const lds_cptr shm3=(lds_cptr)shm; const lds_cptr kp0=shm3+LDS_K+hi*1024+r32*16; const lds_cptr vp0=shm3+LV_V+((lane>>4)&1)*32+(lane&3)*8+(4*hi+((lane&15)>>2))*64;
  const int NT=(q0+QB)/KVBLK;
  DMA_K(0,0);DMA_V(0,0);DMA_K(1,SLOTB);
  bf16x8 qr[4];
  #pragma unroll
  for(int d0=0;d0<4;++d0)qr[d0]=*reinterpret_cast<const bf16x8*>(&Qw[(long)r32*PITCH+d0*16+hi*8]);
  float mhat=0.f,l_reg=0.f;f32x16 o[4];o[0]=f32x16{};o[1]=f32x16{};o[2]=f32x16{};o[3]=f32x16{};const f32x16 zero16=f32x16{};
  const int qrel=wid*QBLK+r32;
  #define CMASK(P0,P1,t) do{int jb_=(t)-(NT-4); if(jb_>=0)cmask(P0,P1,jb_,qrel,hi);}while(0)
  bool resc=false;
  #define START(P0,P1) do{ const float rm=rowmax(P0,P1); resc=false; \
    { const float dl=rm; mhat=fadd_s(mhat,dl); \
      _Pragma("unroll") for(int r=0;r<16;++r){P0[r]=fsub_s(P0[r],dl);P1[r]=fsub_s(P1[r],dl);} \
      } \
    _Pragma("unroll") for(int r=0;r<16;++r)P0[r]=__builtin_amdgcn_exp2f(P0[r]); }while(0)
  #define RESC() do{ if(resc){ asm volatile("s_waitcnt lgkmcnt(0)":::"memory"); \
      _Pragma("unroll") for(int d_=0;d_<4;++d_) _Pragma("unroll") for(int r=0;r<16;++r)o[d_][r]*=wsf[crow(r,hi)]; } }while(0)
  f32x16 pA0,pA1,pB0,pB1;
  int sl_prev=0,sl_cur=0,sl_next=SLOTB;
  #define ROT() do{sl_prev=sl_cur;sl_cur=sl_next;sl_next=(sl_next==(NSLOT-1)*SLOTB)?0:sl_next+SLOTB;}while(0)
  DMA_K(2,2*SLOTB);
  WAIT_BAR(4);
  qkt(pA0,pA1,Kbase,qr,zero16,r32,hi);asm volatile("s_nop 15\n\ts_nop 7":"+v"(pA0),"+v"(pA1));CMASK(pA0,pA1,0);
  START(pA0,pA1);
  _Pragma("unroll") for(int r=0;r<16;++r)pA1[r]=__builtin_amdgcn_exp2f(pA1[r]);
  WAIT_BAR(0);
  DMA_K(3,0);DMA_V(1,SLOTB);
  ROT();
  kload8(kf,kp0+sl_cur);
  WAIT_BAR(3);
  s16x4 vq0lo,vq0hi,vq1lo,vq1hi,vq2lo,vq2hi; u32x4 pw0,pw1,pw2,pw3;
  #define PKW(P,B) cvtpk_s(P[B],P[B+1])
  #define PAF(k) __builtin_bit_cast(bf16x8,pw##k)
  #define VFQ(B) (bf16x8){B##lo[0],B##lo[1],B##lo[2],B##lo[3],B##hi[0],B##hi[1],B##hi[2],B##hi[3]}
  #define PIN(x) asm volatile("":"+v"(x))
  #define MX3(a,b,c) __builtin_fmaxf(__builtin_fmaxf((a),(b)),(c))
  #define GAPA(MF,A0,A1,A2,A3,W0,W1,PW) do{ MF; sacc+=A0; sacc+=A1; sacc+=A2; sacc+=A3; PIN(sacc); W0; W1; PIN(PW); SBAR(); }while(0)
  #define EX(v) __builtin_amdgcn_exp2f(v)
  #define GAPB(MF,X,B) do{ MF; X[B]=EX(X[B]); X[B+1]=EX(X[B+1]); PIN(X); SBAR(); }while(0)
  #define VRD(B,i) do{ B##lo=vtr(vp_+(((i)>>2)*4096+((i)&3)*1024)); B##hi=vtr(vp_+(((i)>>2)*4096+((i)&3)*1024+512)); SBAR(); }while(0)
  #define KRD(G,j) do{ if(G){ kload2(kf,kp0+sl_next,j); SBAR(); } }while(0)
  #define STEP(C0,C1,P0,P1,t,GK,GV,GL) do{ SBAR(); \
    const lds_cptr vp_=vp0+2*sl_prev; \
    float sacc=(P0[0]+P0[1]); \
    GAPA(C0=__builtin_amdgcn_mfma_f32_32x32x16_bf16(kf[0],qr[0],zero16,0,0,0), P0[2],P0[3],P0[4],P0[5],     pw0[0]=PKW(P0,0), pw0[1]=PKW(P0,2), pw0); \
    GAPA(C1=__builtin_amdgcn_mfma_f32_32x32x16_bf16(kf[1],qr[0],zero16,0,0,0), P0[6],P0[7],P0[8],P0[9],     pw0[2]=PKW(P0,4), pw0[3]=PKW(P0,6), pw0); \
    GAPA(C0=__builtin_amdgcn_mfma_f32_32x32x16_bf16(kf[2],qr[1],C0,0,0,0),   P0[10],P0[11],P0[12],P0[13], pw1[0]=PKW(P0,8), pw1[1]=PKW(P0,10), pw1); \
    GAPA(C1=__builtin_amdgcn_mfma_f32_32x32x16_bf16(kf[3],qr[1],C1,0,0,0),   P0[14],P0[15],P1[0],P1[1],   pw1[2]=PKW(P0,12),pw1[3]=PKW(P0,14), pw1); \
    GAPA(C0=__builtin_amdgcn_mfma_f32_32x32x16_bf16(kf[4],qr[2],C0,0,0,0),   P1[2],P1[3],P1[4],P1[5],     pw2[0]=PKW(P1,0), pw2[1]=PKW(P1,2), pw2); \
    GAPA(C1=__builtin_amdgcn_mfma_f32_32x32x16_bf16(kf[5],qr[2],C1,0,0,0),   P1[6],P1[7],P1[8],P1[9],     pw2[2]=PKW(P1,4), pw2[3]=PKW(P1,6), pw2); \
    VRD(vq0,0); GAPA(C0=__builtin_amdgcn_mfma_f32_32x32x16_bf16(kf[6],qr[3],C0,0,0,0),   P1[10],P1[11],P1[12],P1[13], pw3[0]=PKW(P1,8), pw3[1]=PKW(P1,10), pw3); \
    VRD(vq1,4); GAPA(C1=__builtin_amdgcn_mfma_f32_32x32x16_bf16(kf[7],qr[3],C1,0,0,0),   P1[14],P1[15],0.f,0.f,       pw3[2]=PKW(P1,12),pw3[3]=PKW(P1,14), pw3); \
    l_reg+=sacc; \
    _Pragma("unroll") for(int r=0;r<16;++r){C0[r]-=mhat;C1[r]-=mhat;} \
    if(GK){DMA_K((t)+3,sl_cur);} if(GV){DMA_V((t)+1,sl_next);} \
    CMASK(C0,C1,t); \
    { float a=MX3(C0[0],C0[1],C1[0]),b=MX3(C0[2],C0[3],C1[1]); a=MX3(a,C1[2],C1[3]); \
      _Pragma("unroll") for(int r=4;r<16;r+=4){a=MX3(a,C0[r],C0[r+1]);b=MX3(b,C0[r+2],C0[r+3]);a=MX3(a,C1[r],C1[r+1]);b=MX3(b,C1[r+2],C1[r+3]);} \
      float rm=__builtin_fmaxf(a,b); { auto rr=__builtin_amdgcn_permlane32_swap(__float_as_uint(rm),__float_as_uint(rm),false,false); rm=__builtin_fmaxf(__uint_as_float(rr[0]),__uint_as_float(rr[1])); } \
      resc=false; \
      if(__builtin_expect(__any(rm>(float)THRL),0)){ const float dl=__builtin_fmaxf(rm,0.f); mhat+=dl; \
        _Pragma("unroll") for(int r=0;r<16;++r){C0[r]-=dl;C1[r]-=dl;} \
        const float f=__builtin_amdgcn_exp2f(-dl); l_reg*=f; if(hi==0)wsf[r32]=f; resc=true; } } \
    SBAR(); \
    VRD(vq2,8); GAPB(o[0]=__builtin_amdgcn_mfma_f32_32x32x16_bf16(PAF(0),VFQ(vq0),o[0],0,0,0), C0,0); \
    VRD(vq0,12); GAPB(o[1]=__builtin_amdgcn_mfma_f32_32x32x16_bf16(PAF(0),VFQ(vq1),o[1],0,0,0), C0,2); \
    VRD(vq1,1); GAPB(o[2]=__builtin_amdgcn_mfma_f32_32x32x16_bf16(PAF(0),VFQ(vq2),o[2],0,0,0), C0,4); \
    VRD(vq2,5); GAPB(o[3]=__builtin_amdgcn_mfma_f32_32x32x16_bf16(PAF(0),VFQ(vq0),o[3],0,0,0), C0,6); \
    VRD(vq0,9); GAPB(o[0]=__builtin_amdgcn_mfma_f32_32x32x16_bf16(PAF(1),VFQ(vq1),o[0],0,0,0), C0,8); \
    VRD(vq1,13); GAPB(o[1]=__builtin_amdgcn_mfma_f32_32x32x16_bf16(PAF(1),VFQ(vq2),o[1],0,0,0), C0,10); \
    VRD(vq2,2); GAPB(o[2]=__builtin_amdgcn_mfma_f32_32x32x16_bf16(PAF(1),VFQ(vq0),o[2],0,0,0), C0,12); \
    VRD(vq0,6); GAPB(o[3]=__builtin_amdgcn_mfma_f32_32x32x16_bf16(PAF(1),VFQ(vq1),o[3],0,0,0), C0,14); \
    VRD(vq1,10); GAPB(o[0]=__builtin_amdgcn_mfma_f32_32x32x16_bf16(PAF(2),VFQ(vq2),o[0],0,0,0), C1,0); \
    VRD(vq2,14); GAPB(o[1]=__builtin_amdgcn_mfma_f32_32x32x16_bf16(PAF(2),VFQ(vq0),o[1],0,0,0), C1,2); \
    VRD(vq0,3); GAPB(o[2]=__builtin_amdgcn_mfma_f32_32x32x16_bf16(PAF(2),VFQ(vq1),o[2],0,0,0), C1,4); \
    VRD(vq1,7); GAPB(o[3]=__builtin_amdgcn_mfma_f32_32x32x16_bf16(PAF(2),VFQ(vq2),o[3],0,0,0), C1,6); \
    VRD(vq2,11); KRD(GL,0); GAPB(o[0]=__builtin_amdgcn_mfma_f32_32x32x16_bf16(PAF(3),VFQ(vq0),o[0],0,0,0), C1,8); \
    VRD(vq0,15); KRD(GL,1); GAPB(o[1]=__builtin_amdgcn_mfma_f32_32x32x16_bf16(PAF(3),VFQ(vq1),o[1],0,0,0), C1,10); \
    KRD(GL,2); GAPB(o[2]=__builtin_amdgcn_mfma_f32_32x32x16_bf16(PAF(3),VFQ(vq2),o[2],0,0,0), C1,12); \
    KRD(GL,3); GAPB(o[3]=__builtin_amdgcn_mfma_f32_32x32x16_bf16(PAF(3),VFQ(vq0),o[3],0,0,0), C1,14); \
    }while(0)
  int t=1;
  #undef CMASK
  #define CMASK(P0,P1,t) do{}while(0)
  for(;t+5<NT;t+=2){
    STEP(pB0,pB1,pA0,pA1,t,true,true,true);     WAIT_BAR(3); RESC(); ROT();
    STEP(pA0,pA1,pB0,pB1,t+1,true,true,true);   WAIT_BAR(3); RESC(); ROT();
  }
  #undef CMASK
  #define CMASK(P0,P1,t) do{int jb_=(t)-(NT-4); if(jb_>=0)cmask(P0,P1,jb_,qrel,hi);}while(0)
  #define ENDW(tt) do{ if((tt)+3<NT){WAIT_BAR(3);} else if((tt)+2<NT){WAIT_BAR(2);} else {WAIT_BAR(0);} }while(0)
  for(;t+1<NT;t+=2){
    STEP(pB0,pB1,pA0,pA1,t,(t+3<NT),(t+1<NT),(t+1<NT));       ENDW(t);   RESC(); ROT();
    STEP(pA0,pA1,pB0,pB1,t+1,(t+4<NT),(t+2<NT),(t+2<NT));     ENDW(t+1); RESC(); ROT();
  }
  STEP(pB0,pB1,pA0,pA1,NT-1,false,false,false); RESC();
  { float sacc=pB0[0]+pB0[1]; _Pragma("unroll") for(int r=2;r<16;++r)sacc+=pB0[r]; _Pragma("unroll") for(int r=0;r<16;++r)sacc+=pB1[r]; l_reg+=sacc;
    pw0=(u32x4){PKW(pB0,0),PKW(pB0,2),PKW(pB0,4),PKW(pB0,6)};pw1=(u32x4){PKW(pB0,8),PKW(pB0,10),PKW(pB0,12),PKW(pB0,14)};pw2=(u32x4){PKW(pB1,0),PKW(pB1,2),PKW(pB1,4),PKW(pB1,6)};pw3=(u32x4){PKW(pB1,8),PKW(pB1,10),PKW(pB1,12),PKW(pB1,14)};
    SBAR(); pv4(o,(int)(lds0+LV_V)+((lane>>4)&1)*32+(lane&3)*8+(4*hi+((lane&15)>>2))*64+2*sl_cur,PAF(0),PAF(1),PAF(2),PAF(3)); }
  #undef PKW
  #undef PAF
  #undef VFQ
  #undef PIN
  #undef MX3
  #undef GAPA
  #undef GAPB
  #undef EX
  #undef VRD
  #undef KRD
  #undef STEP
  #undef ENDW
  {auto rr=__builtin_amdgcn_permlane32_swap(__float_as_uint(l_reg),__float_as_uint(l_reg),false,false);l_reg=__uint_as_float(rr[0])+__uint_as_float(rr[1]);}
  if(hi==0)wsf[32+r32]=l_reg;asm volatile("s_waitcnt lgkmcnt(0)":::"memory");
  float rli[16];
  #pragma unroll
  for(int r=0;r<16;++r)rli[r]=__builtin_amdgcn_rcpf(wsf[32+crow(r,hi)]);
  bf16*Ow=Oh+(long)(q0+wid*QBLK)*OPITCH;
  { bf16*stg=(bf16*)(shm+LV_OST)+wid*4096;
    #pragma unroll
    for(int r=0;r<16;++r){const int orow=crow(r,hi);
      #pragma unroll
      for(int d0=0;d0<4;++d0)stg[orow*128+d0*32+r32]=__float2bfloat16(o[d0][r]*rli[r]);}
    asm volatile("s_waitcnt lgkmcnt(0)":::"memory");
    #pragma unroll
    for(int i=0;i<8;++i){const int row=i*4+(lane>>4),ch=lane&15; const u32x4 v=*(const u32x4*)(stg+row*128+ch*8); ATTN_STORE16(Ow+(long)row*OPITCH+ch*8,v);} }
  asm volatile("s_waitcnt lgkmcnt(0)\n\ts_barrier":::"memory");
  #undef DMA_K
  #undef DMA_V
  #undef CMASK
  #undef START
  #undef RESC
  #undef ROT
}
constexpr int ATTN_LDS_BYTES=LDS_BYTES;
#undef SBAR
#undef WAIT_BAR
}
#define GAS __attribute__((address_space(1)))
#define LAS __attribute__((address_space(3)))
typedef unsigned short bf16;
typedef unsigned v4u __attribute__((ext_vector_type(4)));
typedef float f32x4 __attribute__((ext_vector_type(4)));
typedef short bf16x8 __attribute__((ext_vector_type(8)));
typedef GAS unsigned gu32;
typedef GAS unsigned long long gu64;
#define RLX_AGENT __ATOMIC_RELAXED, __HIP_MEMORY_SCOPE_AGENT
#define LDS_WAIT() asm volatile("s_waitcnt lgkmcnt(0)" ::: "memory")
#define VM_WAIT() asm volatile("s_waitcnt vmcnt(0)" ::: "memory")
__device__ __forceinline__ unsigned long long rt() { return __builtin_amdgcn_s_memrealtime(); }
__device__ __forceinline__ unsigned f2bf(float f) { unsigned u = __builtin_bit_cast(unsigned, f); return (u + 0x7fffu + ((u >> 16) & 1u)) >> 16; }
__device__ __forceinline__ unsigned pk2(float lo, float hi) { return attn_body::cvtpk_s(lo, hi); }

#define XB_TMO      128
#define XB_XCNT(j)  (256  + 64 * (j))
#define XB_XSUB(j)  (1280 + 64 * (j))
#define XB_XGEN(j)  (2304 + 64 * (j))
#define XB_TOP      3328
#define XB_TOPGEN   3392
#define XCD_BAR_WORDS 3456
#define XB_SPIN_CAP (1u << 18)

__device__ __forceinline__ unsigned xb_ld(unsigned* p)              { return __hip_atomic_load(p, __ATOMIC_RELAXED, __HIP_MEMORY_SCOPE_AGENT); }
__device__ __forceinline__ unsigned xb_add(unsigned* p, unsigned v) { return __hip_atomic_fetch_add(p, v, __ATOMIC_RELAXED, __HIP_MEMORY_SCOPE_AGENT); }
__device__ __forceinline__ unsigned xb_xcc_id() { return (unsigned)__builtin_amdgcn_s_getreg((3 << 11) | 20) & 0xFu; }
#define XB_SPIN(cond, bar) do { unsigned _sp = 0; while (cond) { __builtin_amdgcn_s_sleep(1); \
    if ((++_sp & 255u) == 0u) { if (xb_ld(&(bar)[XB_TMO])) break; if (_sp > XB_SPIN_CAP) { atomicAdd(&(bar)[XB_TMO], 1u); break; } } } } while (0)

struct XcdBarrier {
    unsigned* bar; unsigned x; bool lead;
    volatile LAS unsigned* st;
};

__device__ __forceinline__ XcdBarrier xcd_barrier_post(unsigned* bar, volatile LAS unsigned* st) {
    XcdBarrier b; b.bar = bar; b.x = xb_xcc_id(); b.st = st;
    if (threadIdx.x == 0) (void)xb_add(&bar[XB_XCNT(b.x)], 1u);
    return b;
}
__device__ __forceinline__ void xcd_barrier_complete(unsigned* bar, unsigned x, unsigned& nloc, unsigned& nx) {
    const unsigned G = gridDim.x * gridDim.y * gridDim.z;
    unsigned sum, cnt, mine, sp = 0u;
    for (;;) {
        sum = 0u; cnt = 0u; mine = 0u;
#pragma unroll
        for (unsigned j = 0; j < 16; ++j) { const unsigned c = xb_ld(&bar[XB_XCNT(j)]); sum += c; cnt += (c > 0u) ? 1u : 0u; mine = (j == x) ? c : mine; }
        if (sum == G) break;
        __builtin_amdgcn_s_sleep(1);
        if ((++sp & 255u) == 0u) { if (xb_ld(&bar[XB_TMO])) break; if (sp > XB_SPIN_CAP) { atomicAdd(&bar[XB_TMO], 1u); break; } }
    }
    nloc = mine > 0u ? mine : 1u; nx = cnt > 0u ? cnt : 1u;
}

__device__ __forceinline__ void xcd_barrier(const XcdBarrier& b) {
    asm volatile("s_waitcnt vmcnt(0)" ::: "memory");
    __syncthreads();
    if (b.lead) {
        unsigned* bar = b.bar;
        __builtin_amdgcn_s_waitcnt(0);
        unsigned nloc = b.st[0], nx = b.st[1];
        if (nloc == 0u) { xcd_barrier_complete(bar, b.x, nloc, nx); b.st[0] = nloc; b.st[1] = nx; }
        const unsigned old = xb_add(&bar[XB_XSUB(b.x)], 1u);
        const unsigned gen = old / nloc;
        if (old + 1u == (gen + 1u) * nloc) {
            __builtin_amdgcn_fence(__ATOMIC_RELEASE, "agent");
            asm volatile("s_waitcnt vmcnt(0)" ::: "memory");
            const unsigned og = xb_add(&bar[XB_TOP], 1u);
            const unsigned tg = og / nx;
            if (og + 1u == (tg + 1u) * nx) xb_add(&bar[XB_TOPGEN], 1u);
            else XB_SPIN(xb_ld(&bar[XB_TOPGEN]) == tg, bar);
            __builtin_amdgcn_fence(__ATOMIC_ACQUIRE, "agent");
            xb_add(&bar[XB_XGEN(b.x)], 1u);
            asm volatile("s_waitcnt vmcnt(0)" ::: "memory");
        } else {
            XB_SPIN(xb_ld(&bar[XB_XGEN(b.x)]) == gen, bar);
            __builtin_amdgcn_fence(__ATOMIC_ACQUIRE, "agent");
            asm volatile("s_waitcnt vmcnt(0)" ::: "memory");
        }
    }
    __syncthreads();
}

constexpr int NWAVES = 8, NTHR = 512;
constexpr int DM = 2048, NB = 4, SQ = 4096, TOK = NB * SQ;
constexpr int INW = 5900, PW = 5888;
constexpr int C_U = 0, C_DQ = 512, C_DK = 1280, C_DV = 2048, C_GQ = 2816, C_GZ = 5120, C_GA = 5888;
constexpr int DFF = 5632, DFE = 7168, NE = 8;
constexpr int MOE_ROWS = 2 * TOK + NE * 256, MOE_TILES_MAX = MOE_ROWS / 256;
constexpr float EPS = 1e-6f;
constexpr int GDN_UNIT_BYTES = 57344 + 32768 + 256;

constexpr size_t MiB = 1u << 20;
constexpr size_t WS_CTL = 0, CTL_ZERO_BYTES = 1 * MiB;
constexpr size_t WS_MOD = 1 * MiB;
constexpr size_t WS_ROPE = 2 * MiB;
constexpr size_t WS_GAB = 3 * MiB;
constexpr size_t WS_TOKE = 4 * MiB, WS_TOKG = WS_TOKE + 128 * 1024, WS_RANK = WS_TOKE + 256 * 1024, WS_POS = WS_TOKE + 384 * 1024, WS_CNT = WS_TOKE + 512 * 1024, WS_TILE = WS_TOKE + 640 * 1024;
constexpr size_t WS_GW = 5 * MiB;
constexpr size_t WS_M2 = 6 * MiB;
constexpr size_t WS_M13 = 10 * MiB;
constexpr size_t WS_A16 = 22 * MiB;
constexpr size_t WS_XC = 23 * MiB;
constexpr size_t WS_XS = 39 * MiB;
constexpr size_t WS_YGELU = 47 * MiB;
constexpr size_t WS_WIN = 64 * MiB;
constexpr size_t WS_WOUT = 110 * MiB;
constexpr size_t WS_WGLU = 126 * MiB;
constexpr size_t WS_WUP = 128 * MiB;
constexpr size_t WS_WDN = 172 * MiB;
constexpr size_t WS_MUP = 194 * MiB;
constexpr size_t WS_MDN = 642 * MiB;
constexpr size_t WS_HRES = 866 * MiB;
constexpr size_t WS_HN = 994 * MiB;
constexpr size_t WS_R = 1058 * MiB;
constexpr size_t WS_PROJ = WS_R, WS_YCAT = WS_R + 184 * MiB, WS_ATTO = WS_R + 248 * MiB, WS_OGDN = WS_R + 296 * MiB;
constexpr size_t WS_H = WS_R;
constexpr size_t WS_AS = 1534 * MiB;
constexpr size_t WS_GU = WS_AS;
constexpr size_t WS_END = 1670 * MiB;
static_assert((size_t)MOE_ROWS * DFE * 2 <= 476 * MiB && (size_t)MOE_ROWS * DM * 2 <= 136 * MiB && (size_t)1536 * GDN_UNIT_BYTES <= 136 * MiB, "ws map");
static_assert((size_t)TOK * PW * 2 <= 184 * MiB && (size_t)TOK * 768 * 4 <= 48 * MiB, "ws map 2");
constexpr int CW_BAR = 4096, CW_QUEUE = 8192, CW_CVQ = 9216, CW_ARR = 9280, CW_SCAN = 11008, CW_FIN = 12288;

constexpr int LDS_BYTES = 147456;
constexpr int RING_BYTES = 131072;
constexpr int TILE_OFF = 146432, MISC_OFF = 147200;

typedef unsigned u32x4_t __attribute__((ext_vector_type(4)));
typedef unsigned u32x2_t __attribute__((ext_vector_type(2)));
typedef float f32x2_t __attribute__((ext_vector_type(2)));

__device__ __forceinline__ float bf2f(unsigned short u) { return __uint_as_float((unsigned)u << 16); }
__device__ __forceinline__ float bflo(unsigned w) { return __uint_as_float(w << 16); }
__device__ __forceinline__ float bfhi(unsigned w) { return __uint_as_float(w & 0xffff0000u); }
__device__ __forceinline__ float wave_sum(float v) {
    v += __builtin_bit_cast(float, __builtin_amdgcn_update_dpp(0, __builtin_bit_cast(int, v), 0xB1, 0xF, 0xF, false));
    v += __builtin_bit_cast(float, __builtin_amdgcn_update_dpp(0, __builtin_bit_cast(int, v), 0x4E, 0xF, 0xF, false));
    v += __builtin_bit_cast(float, __builtin_amdgcn_update_dpp(0, __builtin_bit_cast(int, v), 0x141, 0xF, 0xF, false));
    v += __builtin_bit_cast(float, __builtin_amdgcn_update_dpp(0, __builtin_bit_cast(int, v), 0x140, 0xF, 0xF, false));
    v += __builtin_bit_cast(float, __builtin_amdgcn_update_dpp(0, __builtin_bit_cast(int, v), 0x142, 0xA, 0xF, false));
    v += __builtin_bit_cast(float, __builtin_amdgcn_update_dpp(0, __builtin_bit_cast(int, v), 0x143, 0xC, 0xF, false));
    return __builtin_bit_cast(float, __builtin_amdgcn_readlane(__builtin_bit_cast(int, v), 63));
}
__device__ __forceinline__ float sigmoid_f(float x) { return __builtin_amdgcn_rcpf(1.f + __expf(-x)); }
__device__ __forceinline__ float silu_f(float x) { return x * __builtin_amdgcn_rcpf(1.f + __expf(-x)); }
__device__ __forceinline__ float gelu_tanh_f(float y) { const float z = 0.7978845608028654f * (y + 0.044715f * y * y * y); const float e = __expf(2.f * z); const float th = 1.f - 2.f * __builtin_amdgcn_rcpf(e + 1.f); return 0.5f * y * (1.f + th); }
__device__ __forceinline__ bf16x8 pack8(const f32x4& a, const f32x4& b) {
    u32x4_t w; w.x = pk2(a[0], a[1]); w.y = pk2(a[2], a[3]); w.z = pk2(b[0], b[1]); w.w = pk2(b[2], b[3]);
    return __builtin_bit_cast(bf16x8, w);
}
__device__ __forceinline__ unsigned pk4_fp8(float a, float b, float c, float d) {
    a = __builtin_amdgcn_fmed3f(a, -448.f, 448.f); b = __builtin_amdgcn_fmed3f(b, -448.f, 448.f); c = __builtin_amdgcn_fmed3f(c, -448.f, 448.f); d = __builtin_amdgcn_fmed3f(d, -448.f, 448.f);
    int w = 0; w = __builtin_amdgcn_cvt_pk_fp8_f32(a, b, w, false); w = __builtin_amdgcn_cvt_pk_fp8_f32(c, d, w, true); return (unsigned)w;
}
#ifndef DENSE_FP8
#define DENSE_FP8 2
#endif
constexpr float S8_HN = 4.f, S8_W13 = 64.f, S8_H = 8.f, S8_W2 = 128.f;
__device__ __forceinline__ void sincos2pi(double r, float& s, float& c) {
    const double x = r * 6.283185307179586476925; const double x2 = x * x;
    double ss = 1.0, cc = 1.0;
#pragma unroll
    for (int k = 12; k >= 1; --k) { ss = 1.0 - x2 * ss / (double)((2 * k) * (2 * k + 1)); cc = 1.0 - x2 * cc / (double)((2 * k - 1) * (2 * k)); }
    s = (float)(x * ss); c = (float)cc;
}

namespace pg8 {
struct EpiProj {
    static constexpr bool PERM = true, AFTER_DRAIN = false;
    bf16_t* O;
    __device__ __forceinline__ void operator()(const f32x4 (&acc)[2][2][4][2], const Unit& u, int wr, int wc, int fr, int fq) const {
        const int row0 = u.pm * BM + wr * 64 + fr, col0 = u.pn * BM + wc * 32 + 8 * fq;
        const float sc = (u.pn >= 2 && u.pn <= 4) ? attn_body::C2 : 1.f;
#pragma unroll
        for (int ai = 0; ai < 2; ++ai)
#pragma unroll
            for (int m = 0; m < 4; ++m) { bf16_t* rowp = O + (size_t)(row0 + ai * HALF + m * 16) * PW + col0;
#pragma unroll
                for (int bj = 0; bj < 2; ++bj) { const f32x4 v0 = acc[ai][bj][m][0] * sc, v1 = acc[ai][bj][m][1] * sc;
                    u32x4 w; w.x = cvt_pk_bf16(v0[0], v0[1]); w.y = cvt_pk_bf16(v0[2], v0[3]); w.z = cvt_pk_bf16(v1[0], v1[1]); w.w = cvt_pk_bf16(v1[2], v1[3]);
                    *(u32x4*)(rowp + bj * HALF) = w; } }
    }
};
struct EpiGlu {
    static constexpr bool PERM = true, AFTER_DRAIN = false;
    const bf16_t* Y; bf16_t* O;
    __device__ __forceinline__ void operator()(const f32x4 (&acc)[2][2][4][2], const Unit& u, int wr, int wc, int fr, int fq) const {
        const int row0 = u.pm * BM + wr * 64 + fr, col0 = u.pn * BM + wc * 32 + 8 * fq;
#pragma unroll
        for (int ai = 0; ai < 2; ++ai)
#pragma unroll
            for (int m = 0; m < 4; ++m) { const int row = row0 + ai * HALF + m * 16;
#pragma unroll
                for (int bj = 0; bj < 2; ++bj) { const int col = col0 + bj * HALF;
                    const u32x4 yv = *(const u32x4*)(Y + (size_t)row * 512 + col);
                    const f32x4 a0 = acc[ai][bj][m][0], a1 = acc[ai][bj][m][1];
                    u32x4 w;
                    w.x = cvt_pk_bf16(bflo(yv.x) * sigmoid_f(a0[0]), bfhi(yv.x) * sigmoid_f(a0[1]));
                    w.y = cvt_pk_bf16(bflo(yv.y) * sigmoid_f(a0[2]), bfhi(yv.y) * sigmoid_f(a0[3]));
                    w.z = cvt_pk_bf16(bflo(yv.z) * sigmoid_f(a1[0]), bfhi(yv.z) * sigmoid_f(a1[1]));
                    w.w = cvt_pk_bf16(bflo(yv.w) * sigmoid_f(a1[2]), bfhi(yv.w) * sigmoid_f(a1[3]));
                    *(u32x4*)(O + (size_t)row * DM + col) = w; } }
    }
};
struct EpiRes {
    static constexpr bool PERM = false, AFTER_DRAIN = false;
    const float* res; float* out; const float* gate; float sin;
    __device__ __forceinline__ void operator()(const f32x4 (&acc)[2][2][4][2], const Unit& u, int wr, int wc, int fr, int fq) const {
        const int col0 = u.pn * BM + wc * 32 + 4 * fq;
#pragma unroll
        for (int ai = 0; ai < 2; ++ai)
#pragma unroll
            for (int m = 0; m < 4; ++m) { const int row = u.pm * BM + ai * HALF + wr * 64 + m * 16 + fr; const float* gp = gate + (size_t)(row >> 12) * (6 * DM); const size_t off = (size_t)row * DM;
#pragma unroll
                for (int bj = 0; bj < 2; ++bj)
#pragma unroll
                    for (int n = 0; n < 2; ++n) { const int col = col0 + bj * HALF + n * 16;
                        const f32x4 g = *(const f32x4*)(gp + col), r = *(const f32x4*)(res + off + col);
                        *(f32x4*)(out + off + col) = r + g * (acc[ai][bj][m][n] * sin); } }
    }
};
struct EpiSwiglu {
    static constexpr bool PERM = true, AFTER_DRAIN = false;
    bf16_t* H; int ldh; int nct; float sin;
    __device__ __forceinline__ void operator()(const f32x4 (&acc)[2][2][4][2], const Unit& u, int wr, int wc, int fr, int fq) const {
        const int pnl = u.pn % nct; const int row0 = u.pm * BM + wr * 64 + fr, col0 = pnl * HALF + wc * 32 + 8 * fq;
#pragma unroll
        for (int ai = 0; ai < 2; ++ai)
#pragma unroll
            for (int m = 0; m < 4; ++m) { const int row = row0 + ai * HALF + m * 16;
                const f32x4 g0 = acc[ai][0][m][0] * sin, g1 = acc[ai][0][m][1] * sin, u0 = acc[ai][1][m][0] * sin, u1 = acc[ai][1][m][1] * sin;
                u32x4 w;
                w.x = cvt_pk_bf16(silu_f(g0[0]) * u0[0], silu_f(g0[1]) * u0[1]); w.y = cvt_pk_bf16(silu_f(g0[2]) * u0[2], silu_f(g0[3]) * u0[3]);
                w.z = cvt_pk_bf16(silu_f(g1[0]) * u1[0], silu_f(g1[1]) * u1[1]); w.w = cvt_pk_bf16(silu_f(g1[2]) * u1[2], silu_f(g1[3]) * u1[3]);
                *(u32x4*)(H + (size_t)row * ldh + col0) = w; }
    }
};
struct EpiSwiglu8 {
    static constexpr bool PERM = true, AFTER_DRAIN = false;
    unsigned char* H; int ldh; int nct; float sin;
    __device__ __forceinline__ void operator()(const f32x4 (&acc)[2][2][4][2], const Unit& u, int wr, int wc, int fr, int fq) const {
        const int pnl = u.pn % nct; const int row0 = u.pm * BM + wr * 64 + fr, col0 = pnl * HALF + wc * 32 + 8 * fq;
#pragma unroll
        for (int ai = 0; ai < 2; ++ai)
#pragma unroll
            for (int m = 0; m < 4; ++m) { const int row = row0 + ai * HALF + m * 16;
                const f32x4 g0 = acc[ai][0][m][0] * sin, g1 = acc[ai][0][m][1] * sin, u0 = acc[ai][1][m][0] * (sin * S8_H), u1 = acc[ai][1][m][1] * (sin * S8_H);
                u32x2_t w; w.x = pk4_fp8(silu_f(g0[0]) * u0[0], silu_f(g0[1]) * u0[1], silu_f(g0[2]) * u0[2], silu_f(g0[3]) * u0[3]);
                w.y = pk4_fp8(silu_f(g1[0]) * u1[0], silu_f(g1[1]) * u1[1], silu_f(g1[2]) * u1[2], silu_f(g1[3]) * u1[3]);
                *(u32x2_t*)(H + (size_t)row * ldh + col0) = w; }
    }
};
struct EpiMoeDown {
    static constexpr bool PERM = true, AFTER_DRAIN = false;
    bf16_t* O; const float* gw; float sin;
    f32x4* part; gu32* flag; PG8_LAS unsigned* wcnt;
    __device__ __forceinline__ void operator()(const f32x4 (&acc)[2][2][4][2], const Unit& u, int wr, int wc, int fr, int fq) const {
        const int row0 = u.pm * BM + wr * 64 + fr, col0 = (u.pn & 7) * BM + wc * 32 + 8 * fq;
        f32x4* pp = part + ((size_t)(u.slot * 8 + wr * 4 + wc) * 32) * 64 + (fq * 16 + fr);
        if (u.ks == 1) {
#pragma unroll
            for (int ai = 0; ai < 2; ++ai)
#pragma unroll
                for (int bj = 0; bj < 2; ++bj)
#pragma unroll
                    for (int m = 0; m < 4; ++m)
#pragma unroll
                        for (int n = 0; n < 2; ++n) pp[(((ai * 2 + bj) * 4 + m) * 2 + n) * 64] = acc[ai][bj][m][n];
            asm volatile("s_waitcnt vmcnt(0)" ::: "memory");
            if (fq * 16 + fr == 0) { const unsigned old = __hip_atomic_fetch_add(wcnt, 1u, __ATOMIC_RELAXED, __HIP_MEMORY_SCOPE_WORKGROUP);
                if (old == 7u) { __builtin_amdgcn_fence(__ATOMIC_RELEASE, "agent"); asm volatile("s_waitcnt vmcnt(0)" ::: "memory"); __hip_atomic_store(flag + u.slot, 1u, RLX_AGENT); } }
            return; }
        if (u.ks == 2) {
            if (fq * 16 + fr == 0) { unsigned sp = 0; while (__hip_atomic_load(flag + u.slot, RLX_AGENT) == 0u && ++sp < (1u << 22)) __builtin_amdgcn_s_sleep(1); }
            __builtin_amdgcn_fence(__ATOMIC_ACQUIRE, "agent"); asm volatile("s_waitcnt vmcnt(0)" ::: "memory");
#pragma unroll
            for (int ai = 0; ai < 2; ++ai)
#pragma unroll
                for (int m = 0; m < 4; ++m) { const int row = row0 + ai * HALF + m * 16; const float s = gw[row] * sin; bf16_t* rowp = O + (size_t)row * DM + col0;
#pragma unroll
                    for (int bj = 0; bj < 2; ++bj) { const f32x4 v0 = (acc[ai][bj][m][0] + pp[(((ai * 2 + bj) * 4 + m) * 2 + 0) * 64]) * s, v1 = (acc[ai][bj][m][1] + pp[(((ai * 2 + bj) * 4 + m) * 2 + 1) * 64]) * s;
                        u32x4 w; w.x = cvt_pk_bf16(v0[0], v0[1]); w.y = cvt_pk_bf16(v0[2], v0[3]); w.z = cvt_pk_bf16(v1[0], v1[1]); w.w = cvt_pk_bf16(v1[2], v1[3]);
                        *(u32x4*)(rowp + bj * HALF) = w; }
                    asm volatile("" ::: "memory"); }
            return; }
#pragma unroll
        for (int ai = 0; ai < 2; ++ai)
#pragma unroll
            for (int m = 0; m < 4; ++m) { const int row = row0 + ai * HALF + m * 16; const float s = gw[row] * sin; bf16_t* rowp = O + (size_t)row * DM + col0;
#pragma unroll
                for (int bj = 0; bj < 2; ++bj) { const f32x4 v0 = acc[ai][bj][m][0] * s, v1 = acc[ai][bj][m][1] * s;
                    u32x4 w; w.x = cvt_pk_bf16(v0[0], v0[1]); w.y = cvt_pk_bf16(v0[2], v0[3]); w.z = cvt_pk_bf16(v1[0], v1[1]); w.w = cvt_pk_bf16(v1[2], v1[3]);
                    *(u32x4*)(rowp + bj * HALF) = w; } }
    }
};
struct MoeOrder {
    static constexpr bool SPLITK = false;
    StaticOrder so; const PG8_LAS int* tile_e; int nct; int rev = 0;
    __device__ __forceinline__ bool next(int i, Unit& u) const { if (!so.next(i, u)) return false; if (rev) u.pm = so.nM - 1 - u.pm; u.pn += __builtin_amdgcn_readfirstlane(tile_e[u.pm]) * nct; return true; }
    __device__ __forceinline__ void a_ready(const Unit&) const {}
    __device__ __forceinline__ void done(const Unit&) const {}
};
struct MoeDownOrder {
    static constexpr bool SPLITK = true;
    StaticOrder so; const PG8_LAS int* tile_e; int nct, nM, nl, R, c, ntf; gu32* arr; LAS unsigned* wc;
    __device__ __forceinline__ bool next(int i, Unit& u) const {
        if (i < R) { (void)so.next(i, u); u.pm = nM - 1 - u.pm; }
        else if (i == R && c < nl * 16) { u.pm = c >> 4; u.pn = c & 7; const int h = (c >> 3) & 1; u.kt0 = h * (ntf >> 1); u.nt = ntf >> 1; u.ks = 1 + h; u.slot = (c >> 4) * 8 + (c & 7); }
        else return false;
        if (i < R) { u.kt0 = 0; u.nt = ntf; u.ks = 0; }
        u.aux = i; u.pn += __builtin_amdgcn_readfirstlane(tile_e[u.pm]) * nct; return true; }
    __device__ __forceinline__ void a_ready(const Unit&) const {}
    __device__ __forceinline__ void done(const Unit& u) const {
        if (u.aux == R - 1) { asm volatile("s_waitcnt vmcnt(0)" ::: "memory");
            if (mk_lane() == 0) { const unsigned old = __hip_atomic_fetch_add(wc, 1u, __ATOMIC_RELAXED, __HIP_MEMORY_SCOPE_WORKGROUP);
                if (old == 7u) { __builtin_amdgcn_fence(__ATOMIC_RELEASE, "agent"); asm volatile("s_waitcnt vmcnt(0)" ::: "memory"); (void)__hip_atomic_fetch_add(arr, 1u, RLX_AGENT); } } } }
};
}

#if defined(PROBE_LO)
#define PSPAN_BEGIN(C, id) do { if ((id) == PROBE_LO && blockIdx.x == 0 && (C).wave == 0 && mk_lane() == 0) { const unsigned long long t_ = __builtin_amdgcn_s_memrealtime(); (C).MISC[20] = (unsigned)t_; (C).MISC[21] = (unsigned)(t_ >> 32); } } while (0)
#define PSPAN_END(C, id) do { if ((id) == PROBE_LO && blockIdx.x == 0 && (C).wave == 0 && mk_lane() == 0) { const unsigned long long t_ = __builtin_amdgcn_s_memrealtime() - (((unsigned long long)(C).MISC[21] << 32) | (C).MISC[20]); (C).MISC[22] += (unsigned)t_; } } while (0)
#else
#define PSPAN_BEGIN(C, id) do {} while (0)
#define PSPAN_END(C, id) do {} while (0)
#endif
struct Params { const float* in[35]; float* out; unsigned char* ws; int ph_lo, ph_hi; };
typedef const __attribute__((address_space(4))) Params* KP;

#define PIN(i) ((const float*)(const GAS float*)(P->in[i]))
#define POUT ((float*)(GAS float*)(P->out))
struct Ctx {
    LAS unsigned char* lds; volatile LAS unsigned* MISC; GAS unsigned char* ws; gu32* ctl;
    int tid, lane, wave, blk, G;
};

__device__ __forceinline__ void tr_tile(const float* __restrict__ src, int ld, bf16* dst, int K, int k0, int n0, int drow0, int lane) {
    const int c4 = lane & 15, r = lane >> 4;
    const float* sp = src + (size_t)(k0 + 16 * r) * ld + n0 + 4 * c4;
    f32x4 x[16];
#pragma unroll
    for (int i = 0; i < 16; ++i) x[i] = __builtin_nontemporal_load((const f32x4*)(sp + (size_t)i * ld));
    bf16* dp = dst + (size_t)(drow0 + 4 * c4) * K + k0 + 16 * r;
#pragma unroll
    for (int q = 0; q < 4; ++q)
#pragma unroll
        for (int hf = 0; hf < 2; ++hf) { v4u o; o.x = pk2(x[8 * hf + 0][q], x[8 * hf + 1][q]); o.y = pk2(x[8 * hf + 2][q], x[8 * hf + 3][q]); o.z = pk2(x[8 * hf + 4][q], x[8 * hf + 5][q]); o.w = pk2(x[8 * hf + 6][q], x[8 * hf + 7][q]);
            *(GAS v4u*)(dp + (size_t)q * K + 8 * hf) = o; }
}
__device__ __forceinline__ void tr_tile8(const float* __restrict__ src, int ld, unsigned char* dst, int K, int k0, int n0, int drow0, int lane, float sc) {
    const int c4 = lane & 15, r = lane >> 4;
    const float* sp = src + (size_t)(k0 + 16 * r) * ld + n0 + 4 * c4;
    f32x4 x[16];
#pragma unroll
    for (int i = 0; i < 16; ++i) x[i] = __builtin_nontemporal_load((const f32x4*)(sp + (size_t)i * ld)) * sc;
    unsigned char* dp = dst + (size_t)(drow0 + 4 * c4) * K + k0 + 16 * r;
#pragma unroll
    for (int q = 0; q < 4; ++q) { v4u o; o.x = pk4_fp8(x[0][q], x[1][q], x[2][q], x[3][q]); o.y = pk4_fp8(x[4][q], x[5][q], x[6][q], x[7][q]); o.z = pk4_fp8(x[8][q], x[9][q], x[10][q], x[11][q]); o.w = pk4_fp8(x[12][q], x[13][q], x[14][q], x[15][q]);
        *(GAS v4u*)(dp + (size_t)q * K) = o; }
}
__device__ __forceinline__ void tr_plain(const float* src, int ld, int K, int N, bf16* dst, int item, int lane) {
    const int nblk = N / 64, kb = item / nblk, nb = item % nblk;
    tr_tile(src, ld, dst, K, 64 * kb, 64 * nb, 64 * nb, lane);
}
__device__ __forceinline__ void tr_inter(const float* src, int K, int N, bf16* dst, int half, int item, int lane) {
    const int nblk = N / 64, kb = item / nblk, nb = item % nblk, n0 = 64 * nb;
    tr_tile(src, N, dst, K, 64 * kb, n0, (n0 >> 7) * 256 + half * 128 + (n0 & 127), lane);
}

__device__ __forceinline__ void p0_ada(const Ctx& C, KP P) {
    const int u = C.blk, l = u / 96, n0 = (u % 96) * 128;
    LAS float* sc = (LAS float*)C.lds; LAS float* part = (LAS float*)(C.lds + 32768);
    const float* cin = PIN(1);
    for (int i = C.tid; i < 4 * DM; i += NTHR) sc[i] = silu_f(cin[i]);
    __syncthreads();
    const int sub = C.lane >> 5, c4 = C.lane & 31, w = C.wave;
    const float* Wp = PIN(3) + ((size_t)l * DM + 256 * w + sub) * (6 * DM) + n0 + 4 * c4;
    f32x4 acc[4];
#pragma unroll
    for (int b = 0; b < 4; ++b) acc[b] = (f32x4){0.f, 0.f, 0.f, 0.f};
#pragma unroll 8
    for (int i = 0; i < 128; ++i) { const f32x4 wv = *(const f32x4*)(Wp + (size_t)(2 * i) * (6 * DM)); const int k = 256 * w + 2 * i + sub;
#pragma unroll
        for (int b = 0; b < 4; ++b) acc[b] += wv * sc[b * DM + k]; }
#pragma unroll
    for (int b = 0; b < 4; ++b)
#pragma unroll
        for (int q = 0; q < 4; ++q) acc[b][q] += __shfl_xor(acc[b][q], 32);
    if (C.lane < 32) {
#pragma unroll
        for (int b = 0; b < 4; ++b)
#pragma unroll
            for (int q = 0; q < 4; ++q) part[(w * 4 + b) * 128 + 4 * c4 + q] = acc[b][q]; }
    __syncthreads();
    { const int b = C.tid >> 7, n = C.tid & 127; float s = PIN(4)[l * (6 * DM) + n0 + n];
#pragma unroll
      for (int ww = 0; ww < 8; ++ww) s += part[(ww * 4 + b) * 128 + n];
      ((float*)(C.ws + WS_MOD))[(size_t)(l * 4 + b) * (6 * DM) + n0 + n] = s; }
    __syncthreads();
}

__device__ __forceinline__ void p0_ssm(const Ctx& C, KP P) {
    const int u = C.blk - 192, l = u >> 5, g = u & 31, lg = l * 32 + g;
    LAS f32x2_t* Pw = (LAS f32x2_t*)C.lds;
    LAS f32x2_t* Bb = (LAS f32x2_t*)(C.lds + 8704);
    LAS f32x2_t* Cc = (LAS f32x2_t*)(C.lds + 8704 + 8192);
    LAS float* Kl = (LAS float*)(C.lds + 8704 + 16384);
    const float dt = expf(PIN(12)[lg]);
    if (C.tid < 64) { const int p = C.tid; const float ar = PIN(10)[lg * 64 + p], ai = PIN(11)[lg * 64 + p];
        for (int j = 0; j <= 16; ++j) { const float mag = expf(ar * dt * (float)j); double rev = (double)ai * (double)dt * (double)j * 0.15915494309189533577; rev -= rint(rev);
            float s, c; sincos2pi(rev, s, c); Pw[j * 64 + p] = (f32x2_t){mag * c, mag * s}; }
        const f32x2_t lb = Pw[64 + p]; const float nx = lb.x - 1.f, ny = lb.y, den = ar * ar + ai * ai;
        const float cx = (nx * ar + ny * ai) / den, cy = (ny * ar - nx * ai) / den;
        for (int h = 0; h < 16; ++h) { const float br = PIN(13)[(lg * 64 + p) * 16 + h], bi = PIN(14)[(lg * 64 + p) * 16 + h]; Bb[p * 16 + h] = (f32x2_t){cx * br - cy * bi, cx * bi + cy * br}; }
        ((f32x2_t*)(C.ws + WS_A16))[lg * 64 + p] = Pw[16 * 64 + p]; }
    for (int i = C.tid; i < 1024; i += NTHR) Cc[i] = (f32x2_t){PIN(15)[lg * 1024 + i], PIN(16)[lg * 1024 + i]};
    __syncthreads();
    for (int e = C.tid; e < 4096; e += NTHR) { const int j = e >> 8, hp = (e >> 4) & 15, h = e & 15; float s = 0.f;
        for (int p = 0; p < 64; ++p) { const f32x2_t c = Cc[hp * 64 + p], pw = Pw[j * 64 + p], bb = Bb[p * 16 + h]; const float zx = c.x * pw.x - c.y * pw.y, zy = c.x * pw.y + c.y * pw.x; s += zx * bb.x - zy * bb.y; }
        if (j == 0 && hp == h) s += PIN(17)[l * 512 + g * 16 + h];
        Kl[e] = s; }
    __syncthreads();
    bf16* M2 = (bf16*)(C.ws + WS_M2) + (size_t)lg * 128 * 256;
    for (int pc = C.tid; pc < 4096; pc += NTHR) { const int n = pc >> 5, k0 = (pc & 31) * 8, p = n >> 1, ri = n & 1, s = k0 >> 4, h0 = k0 & 15; const f32x2_t pw = Pw[(15 - s) * 64 + p]; float v[8];
#pragma unroll
        for (int j = 0; j < 8; ++j) { const f32x2_t bb = Bb[p * 16 + h0 + j]; v[j] = ri ? (pw.x * bb.y + pw.y * bb.x) : (pw.x * bb.x - pw.y * bb.y); }
        v4u o; o.x = pk2(v[0], v[1]); o.y = pk2(v[2], v[3]); o.z = pk2(v[4], v[5]); o.w = pk2(v[6], v[7]); *(GAS v4u*)(M2 + (size_t)n * 256 + k0) = o; }
    bf16* M13 = (bf16*)(C.ws + WS_M13) + (size_t)lg * 256 * 384;
    for (int pc = C.tid; pc < 12288; pc += NTHR) { const int n = pc / 48, k0 = (pc % 48) * 8, i = n >> 4, hp = n & 15; float v[8];
        if (k0 < 256) { const int s = k0 >> 4, h0 = k0 & 15;
#pragma unroll
            for (int j = 0; j < 8; ++j) v[j] = (i >= s) ? Kl[((i - s) * 16 + hp) * 16 + h0 + j] : 0.f; }
        else {
#pragma unroll
            for (int j = 0; j < 8; ++j) { const int kk = k0 - 256 + j, p = kk >> 1, ri = kk & 1; const f32x2_t c = Cc[hp * 64 + p], pw = Pw[(i + 1) * 64 + p]; const float zx = c.x * pw.x - c.y * pw.y, zy = c.x * pw.y + c.y * pw.x; v[j] = ri ? -zy : zx; } }
        v4u o; o.x = pk2(v[0], v[1]); o.y = pk2(v[2], v[3]); o.z = pk2(v[4], v[5]); o.w = pk2(v[6], v[7]); *(GAS v4u*)(M13 + (size_t)n * 384 + k0) = o; }
    __syncthreads();
}

__device__ __forceinline__ void p0_prologue(const Ctx& C, KP P) {
    if (C.blk < 192) p0_ada(C, P); else p0_ssm(C, P);
    { const int* pos = (const int*)PIN(2); float* rope = (float*)(C.ws + WS_ROPE);
      for (int idx = C.blk * NTHR + C.tid; idx < TOK * 8; idx += C.G * NTHR) { const int t = idx >> 3, i = idx & 7;
          const double invf = exp(-(double)i * (13.122363377404328 / 8.0)); double rev = (double)pos[t] * invf * 0.15915494309189533577; rev -= rint(rev);
          float s, c; sincos2pi(rev, s, c); rope[t * 16 + i] = c; rope[t * 16 + 8 + i] = s; } }
    const int gw = C.blk * NWAVES + C.wave, NGW = C.G * NWAVES, lane = C.lane;
    constexpr int I_IN = 32 * 92, I_OUT = 32 * 32, I_GLU = 8 * 8, I_F13 = 32 * 88, I_F2 = 88 * 32, I_M13 = 32 * 112, I_M2 = 112 * 32;
    constexpr int NITEMS = 2 * I_IN + 2 * I_OUT + 2 * I_GLU + 2 * I_F13 + I_F2;
#pragma unroll 1
    for (int it = gw; it < NITEMS; it += NGW) {
        int r = it;
        if (r < 2 * I_IN) { const int l = r / I_IN; r -= l * I_IN; tr_plain(PIN(8) + (size_t)l * DM * INW, INW, DM, PW, (bf16*)(C.ws + WS_WIN) + (size_t)l * PW * DM, r, lane); continue; } r -= 2 * I_IN;
        if (r < 2 * I_OUT) { const int l = r / I_OUT; r -= l * I_OUT; tr_plain(PIN(9) + (size_t)l * DM * DM, DM, DM, DM, (bf16*)(C.ws + WS_WOUT) + (size_t)l * DM * DM, r, lane); continue; } r -= 2 * I_OUT;
        if (r < 2 * I_GLU) { const int l = r / I_GLU; r -= l * I_GLU; tr_plain(PIN(18) + (size_t)l * 512 * 512, 512, 512, 512, (bf16*)(C.ws + WS_WGLU) + (size_t)l * 512 * 512, r, lane); continue; } r -= 2 * I_GLU;
        if (r < 2 * I_F13) { const int half = r / I_F13; r -= half * I_F13;
            if (DENSE_FP8 >= 1) { const int nblk = DFF / 64, kb = r / nblk, n0 = 64 * (r % nblk); tr_tile8(half ? PIN(29) : PIN(28), DFF, (unsigned char*)(C.ws + WS_WUP), DM, 64 * kb, n0, (n0 >> 7) * 256 + half * 128 + (n0 & 127), lane, S8_W13); }
            else tr_inter(half ? PIN(29) : PIN(28), DM, DFF, (bf16*)(C.ws + WS_WUP), half, r, lane);
            continue; } r -= 2 * I_F13;
        if (r < I_F2) { if (DENSE_FP8 >= 2) { const int nblk = DM / 64, kb = r / nblk, n0 = 64 * (r % nblk); tr_tile8(PIN(30), DM, (unsigned char*)(C.ws + WS_WDN), DFF, 64 * kb, n0, n0, lane, S8_W2); }
            else tr_plain(PIN(30), DM, DFF, DM, (bf16*)(C.ws + WS_WDN), r, lane); }
    }
}

constexpr int MOE_CVT_TILES = 16 * (32 * 112) + 8 * (112 * 32), MOE_CVT_CHUNKS = MOE_CVT_TILES / 16;
__device__ __forceinline__ void moe_cvt_tile(const Ctx& C, KP P, int r, int lane) {
    constexpr int I_M13 = 32 * 112, I_M2 = 112 * 32;
    if (r < 16 * I_M13) { const int q = r / I_M13, e = q >> 1, half = q & 1; r -= q * I_M13; const int nblk = DFE / 64, kb = r / nblk, n0 = 64 * (r % nblk);
        tr_tile8((half ? PIN(33) : PIN(32)) + (size_t)e * DM * DFE, DFE, (unsigned char*)(C.ws + WS_MUP) + (size_t)e * 2 * DFE * DM, DM, 64 * kb, n0, (n0 >> 7) * 256 + half * 128 + (n0 & 127), lane, S8_W13); }
    else { r -= 16 * I_M13; const int e = r / I_M2; r -= e * I_M2; const int nblk = DM / 64, kb = r / nblk, n0 = 64 * (r % nblk);
        tr_tile8(PIN(34) + (size_t)e * DFE * DM, DM, (unsigned char*)(C.ws + WS_MDN) + (size_t)e * DM * DFE, DFE, 64 * kb, n0, n0, lane, S8_W2); }
}
__device__ __forceinline__ void moe_cvt_fill(const Ctx& C, KP P, int k, bool all) {
    gu32* arr = C.ctl + CW_ARR + 64 * k; gu32* head = C.ctl + CW_CVQ;
    if (!all && C.wave == 0 && C.lane == 0) (void)__hip_atomic_fetch_add(arr, 1u, RLX_AGENT);
    for (;;) {
        if (C.wave == 0 && C.lane == 0) { unsigned q = 0xffffffffu; if (all || __hip_atomic_load(arr, RLX_AGENT) < (unsigned)C.G) q = __hip_atomic_fetch_add(head, 1u, RLX_AGENT); C.MISC[24] = q; }
        __syncthreads();
        const unsigned q = (unsigned)__builtin_amdgcn_readfirstlane((int)C.MISC[24]);
        __syncthreads();
        if (q >= (unsigned)MOE_CVT_CHUNKS) break;
        { const int tb = (MOE_CVT_CHUNKS - 1 - (int)q) * 16 + C.wave * 2;
          moe_cvt_tile(C, P, tb, C.lane); moe_cvt_tile(C, P, tb + 1, C.lane); }
    }
}

template <bool WITH_GAB, bool OUT8 = false>
__device__ __forceinline__ void norm_phase(const Ctx& C, const float* __restrict__ src, const float* __restrict__ nw, const float* __restrict__ mod_shift, const float* __restrict__ mod_scale, const float* __restrict__ w12  ) {
    LAS float* W12T = (LAS float*)C.lds;
    if (WITH_GAB) { for (int idx = C.tid; idx < DM * 12; idx += NTHR) { const int k = idx / 12, j = idx % 12; W12T[j * DM + k] = w12[(size_t)k * INW + C_GA + j]; } __syncthreads(); }
    bf16* HN = (bf16*)(C.ws + WS_HN); float* GAB = (float*)(C.ws + WS_GAB);
    const int lane = C.lane;
    f32x4 nwv[8];
#pragma unroll
    for (int j = 0; j < 8; ++j) nwv[j] = *(const f32x4*)(nw + 4 * lane + 256 * j);
    f32x4 vn[2][8];
#pragma unroll
    for (int u = 0; u < 2; ++u)
#pragma unroll
        for (int j = 0; j < 8; ++j) vn[u][j] = *(const f32x4*)(src + (size_t)(C.blk * 64 + C.wave * 8 + u) * DM + 4 * lane + 256 * j);
    int nlim = 4; asm volatile("" : "+s"(nlim));
#pragma unroll 1
    for (int i = 0; i < nlim; ++i) { const int t0 = C.blk * 64 + C.wave * 8 + 2 * i; const int b = t0 >> 12;
        f32x4 v[2][8]; float ss0 = 0.f, ss1 = 0.f;
#pragma unroll
        for (int j = 0; j < 8; ++j) { v[0][j] = vn[0][j]; v[1][j] = vn[1][j];
            ss0 += (v[0][j].x * v[0][j].x + v[0][j].y * v[0][j].y) + (v[0][j].z * v[0][j].z + v[0][j].w * v[0][j].w); ss1 += (v[1][j].x * v[1][j].x + v[1][j].y * v[1][j].y) + (v[1][j].z * v[1][j].z + v[1][j].w * v[1][j].w); }
        if (i + 1 < nlim) {
#pragma unroll
            for (int u = 0; u < 2; ++u)
#pragma unroll
                for (int j = 0; j < 8; ++j) vn[u][j] = *(const f32x4*)(src + (size_t)(t0 + 2 + u) * DM + 4 * lane + 256 * j); }
        const float r0 = rsqrtf(wave_sum(ss0) * (1.f / DM) + EPS), r1 = rsqrtf(wave_sum(ss1) * (1.f / DM) + EPS);
        const float* sh = mod_shift + (size_t)b * 6 * DM; const float* scp = mod_scale + (size_t)b * 6 * DM;
#pragma unroll
        for (int j = 0; j < 8; ++j) { const f32x4 s1 = *(const f32x4*)(scp + 4 * lane + 256 * j), s0 = *(const f32x4*)(sh + 4 * lane + 256 * j); const f32x4 m1 = nwv[j] * (s1 + 1.f);
            v[0][j] = v[0][j] * r0 * m1 + s0; v[1][j] = v[1][j] * r1 * m1 + s0;
#pragma unroll
            for (int u = 0; u < 2; ++u) {
                if (OUT8) *(GAS unsigned*)((unsigned char*)HN + (size_t)(t0 + u) * DM + 4 * lane + 256 * j) = pk4_fp8(v[u][j].x * S8_HN, v[u][j].y * S8_HN, v[u][j].z * S8_HN, v[u][j].w * S8_HN);
                else { u32x2_t o; o.x = pk2(v[u][j].x, v[u][j].y); o.y = pk2(v[u][j].z, v[u][j].w); *(GAS u32x2_t*)(HN + (size_t)(t0 + u) * DM + 4 * lane + 256 * j) = o; } } }
        if (WITH_GAB) { unsigned wb = 16u * (unsigned)lane; asm volatile("" : "+v"(wb));
            const LAS float* W12L = (const LAS float*)(size_t)wb;
#pragma unroll
            for (int jj = 0; jj < 12; ++jj) { float a0 = 0.f, a1 = 0.f;
#pragma unroll
                for (int j = 0; j < 8; ++j) { const f32x4 wv = *(const LAS f32x4*)(W12L + jj * DM + 256 * j);
                    a0 += (v[0][j].x * wv.x + v[0][j].y * wv.y) + (v[0][j].z * wv.z + v[0][j].w * wv.w); a1 += (v[1][j].x * wv.x + v[1][j].y * wv.y) + (v[1][j].z * wv.z + v[1][j].w * wv.w); }
                a0 = wave_sum(a0); a1 = wave_sum(a1); if (lane == 0) { GAB[(size_t)t0 * 12 + jj] = a0; GAB[(size_t)(t0 + 1) * 12 + jj] = a1; } } }
    }
    __syncthreads();
}

__device__ __forceinline__ void rope_pass(const Ctx& C) {
    bf16* PROJ = (bf16*)(C.ws + WS_PROJ); const float* rope = (const float*)(C.ws + WS_ROPE);
    for (int idx = C.blk * NTHR + C.tid; idx < TOK * 24; idx += C.G * NTHR) { const int t = idx / 24, v = idx % 24;
        bf16* p = PROJ + (size_t)t * PW + (v < 12 ? C_DQ + v * 64 : C_DK + (v - 12) * 64);
        const u32x4_t a = *(const u32x4_t*)p, b = *(const u32x4_t*)(p + 8);
        const f32x4 c0 = *(const f32x4*)(rope + t * 16), c1 = *(const f32x4*)(rope + t * 16 + 4), s0 = *(const f32x4*)(rope + t * 16 + 8), s1 = *(const f32x4*)(rope + t * 16 + 12);
        const float t1[8] = {bflo(a.x), bfhi(a.x), bflo(a.y), bfhi(a.y), bflo(a.z), bfhi(a.z), bflo(a.w), bfhi(a.w)};
        const float t2[8] = {bflo(b.x), bfhi(b.x), bflo(b.y), bfhi(b.y), bflo(b.z), bfhi(b.z), bflo(b.w), bfhi(b.w)};
        const float cs[8] = {c0.x, c0.y, c0.z, c0.w, c1.x, c1.y, c1.z, c1.w}, sn[8] = {s0.x, s0.y, s0.z, s0.w, s1.x, s1.y, s1.z, s1.w};
        float o1[8], o2[8];
#pragma unroll
        for (int i = 0; i < 8; ++i) { o1[i] = t1[i] * cs[i] - t2[i] * sn[i]; o2[i] = t2[i] * cs[i] + t1[i] * sn[i]; }
        u32x4_t oa, ob; oa.x = pk2(o1[0], o1[1]); oa.y = pk2(o1[2], o1[3]); oa.z = pk2(o1[4], o1[5]); oa.w = pk2(o1[6], o1[7]);
        ob.x = pk2(o2[0], o2[1]); ob.y = pk2(o2[2], o2[3]); ob.z = pk2(o2[4], o2[5]); ob.w = pk2(o2[6], o2[7]);
        *(u32x4_t*)p = oa; *(u32x4_t*)(p + 8) = ob; }
}

#define SSM_BAR() asm volatile("s_waitcnt lgkmcnt(0)\n\ts_barrier" ::: "memory")
__device__ __forceinline__ void ssm_gemm_a(const Ctx& C, int l) {
    const bf16* PROJ = (const bf16*)(C.ws + WS_PROJ); float* XC = (float*)(C.ws + WS_XC);
    const int lane = C.lane, fr = lane & 15, quad = lane >> 4, tid = C.tid;
    for (int bu = C.blk; bu < 256; bu += C.G) { const int g = bu >> 3, rt = (bu & 7) * 8 + C.wave, r = 16 * rt + fr, tok = (r >> 8) * SQ + (r & 255) * 16;
        const bf16* arow = PROJ + (size_t)(tok + (quad >> 1)) * PW + C_U + g * 16 + 8 * (quad & 1);
        const bf16* bsrc = (const bf16*)(C.ws + WS_M2) + ((size_t)(l * 32 + g) * 128 + 16 * (tid >> 6) + fr) * 256 + 8 * quad;
        f32x4 acc[8];
#pragma unroll
        for (int nt = 0; nt < 8; ++nt) acc[nt] = (f32x4){0.f, 0.f, 0.f, 0.f};
        u32x4_t rb = *(const u32x4_t*)bsrc; bf16x8 an = *(const bf16x8*)arow;
        *(LAS u32x4_t*)(C.lds + tid * 16) = rb;
        SSM_BAR();
#pragma unroll 1
        for (int ks = 0; ks < 8; ++ks) { const bf16x8 a = an; const LAS unsigned char* cur = C.lds + (ks & 1) * 8192;
            if (ks + 1 < 8) { rb = *(const u32x4_t*)(bsrc + 32 * (ks + 1)); an = *(const bf16x8*)(arow + (size_t)(2 * (ks + 1)) * PW); }
#pragma unroll
            for (int nt = 0; nt < 8; ++nt) { const bf16x8 b = *(const LAS bf16x8*)(cur + (nt * 64 + lane) * 16); acc[nt] = __builtin_amdgcn_mfma_f32_16x16x32_bf16(a, b, acc[nt], 0, 0, 0); }
            if (ks + 1 < 8) *(LAS u32x4_t*)(C.lds + ((ks + 1) & 1) * 8192 + tid * 16) = rb;
            SSM_BAR(); }
#pragma unroll
        for (int nt = 0; nt < 8; ++nt)
#pragma unroll
            for (int j = 0; j < 4; ++j) XC[((size_t)(16 * rt + 4 * quad + j) * 32 + g) * 128 + 16 * nt + fr] = acc[nt][j];
    }
}

__device__ __forceinline__ void ssm_gemm_b(const Ctx& C, int l) {
    const bf16* PROJ = (const bf16*)(C.ws + WS_PROJ); const bf16* XS = (const bf16*)(C.ws + WS_XS); bf16* YG = (bf16*)(C.ws + WS_YGELU);
    const int lane = C.lane, fr = lane & 15, quad = lane >> 4, tid = C.tid;
    for (int bu = C.blk; bu < 256; bu += C.G) { const int g = bu >> 3, rt = (bu & 7) * 8 + C.wave, r = 16 * rt + fr, tok = (r >> 8) * SQ + (r & 255) * 16;
        const bf16* arow = PROJ + (size_t)(tok + (quad >> 1)) * PW + C_U + g * 16 + 8 * (quad & 1);
        const bf16* xrow = XS + ((size_t)r * 32 + g) * 128 + 8 * quad;
        const bf16* bsrc = (const bf16*)(C.ws + WS_M13) + ((size_t)(l * 32 + g) * 256 + 16 * (tid >> 6) + fr) * 384 + 8 * quad;
        f32x4 acc[16];
#pragma unroll
        for (int nt = 0; nt < 16; ++nt) acc[nt] = (f32x4){0.f, 0.f, 0.f, 0.f};
        u32x4_t rb0 = *(const u32x4_t*)bsrc, rb1 = *(const u32x4_t*)(bsrc + 128 * 384); bf16x8 an = *(const bf16x8*)arow;
        *(LAS u32x4_t*)(C.lds + tid * 16) = rb0; *(LAS u32x4_t*)(C.lds + 8192 + tid * 16) = rb1;
        SSM_BAR();
#pragma unroll 1
        for (int ks = 0; ks < 12; ++ks) { const bf16x8 a = an; const LAS unsigned char* cur = C.lds + (ks & 1) * 16384;
            if (ks + 1 < 12) { rb0 = *(const u32x4_t*)(bsrc + 32 * (ks + 1)); rb1 = *(const u32x4_t*)(bsrc + 128 * 384 + 32 * (ks + 1));
                an = (ks + 1 < 8) ? *(const bf16x8*)(arow + (size_t)(2 * (ks + 1)) * PW) : *(const bf16x8*)(xrow + 32 * (ks + 1 - 8)); }
#pragma unroll
            for (int nt = 0; nt < 16; ++nt) { const bf16x8 b = *(const LAS bf16x8*)(cur + (nt * 64 + lane) * 16); acc[nt] = __builtin_amdgcn_mfma_f32_16x16x32_bf16(a, b, acc[nt], 0, 0, 0); }
            if (ks + 1 < 12) { *(LAS u32x4_t*)(C.lds + ((ks + 1) & 1) * 16384 + tid * 16) = rb0; *(LAS u32x4_t*)(C.lds + ((ks + 1) & 1) * 16384 + 8192 + tid * 16) = rb1; }
            SSM_BAR(); }
#pragma unroll
        for (int j = 0; j < 4; ++j) { const int rr = 16 * rt + 4 * quad + j; const size_t tb = (size_t)((rr >> 8) * SQ + (rr & 255) * 16);
#pragma unroll
            for (int nt = 0; nt < 16; ++nt) YG[(tb + nt) * 512 + g * 16 + fr] = (bf16)f2bf(gelu_tanh_f(acc[nt][j])); }
    }
}

__device__ __forceinline__ void ssm_scan(const Ctx& C, int l, int sblk  ) {
    const int idx = sblk * NTHR + C.tid, b = idx >> 11, g = (idx >> 6) & 31, p = idx & 63;
    const f32x2_t a = ((const f32x2_t*)(C.ws + WS_A16))[(l * 32 + g) * 64 + p];
    const f32x2_t* xc = (const f32x2_t*)(C.ws + WS_XC) + ((size_t)(b * 256) * 32 + g) * 64 + p; unsigned* xs = (unsigned*)(C.ws + WS_XS) + ((size_t)(b * 256) * 32 + g) * 64 + p;
    float xr = 0.f, xi = 0.f;
    for (int c0 = 0; c0 < 256; c0 += 8) { f32x2_t in[8];
#pragma unroll
        for (int q = 0; q < 8; ++q) in[q] = xc[(size_t)(c0 + q) * 2048];
#pragma unroll
        for (int q = 0; q < 8; ++q) { xs[(size_t)(c0 + q) * 2048] = pk2(xr, xi); const float nr = a.x * xr - a.y * xi + in[q].x, ni = a.x * xi + a.y * xr + in[q].y; xr = nr; xi = ni; } }
}

constexpr int GL_QT = 0, GL_KT = 33792, GL_VT = 67584, GL_AM = 101376, GL_QK = 118784, GL_SM = 136192;
__device__ __forceinline__ void gdn_prep_unit(const Ctx& C, KP P, int l, int unit) {
    const int b = unit / 384, h = (unit / 64) % 6, ch = unit & 63, tok0 = b * SQ + ch * 64, tid = C.tid, lane = C.lane, wave = C.wave;
    LAS float* QT = (LAS float*)(C.lds + GL_QT); LAS float* KT = (LAS float*)(C.lds + GL_KT); LAS float* VT = (LAS float*)(C.lds + GL_VT);
    LAS float* AM = (LAS float*)(C.lds + GL_AM); LAS float* QKM = (LAS float*)(C.lds + GL_QK);
    unsigned smb = GL_SM; asm volatile("" : "+v"(smb));
    LAS float* gc = (LAS float*)(size_t)smb; LAS float* beta = gc + 64; LAS float* eg = gc + 128; LAS float* ek = gc + 192;
    const bf16* PROJ = (const bf16*)(C.ws + WS_PROJ); const float* convw = PIN(24) + (size_t)l * 4 * 2304;
    GAS unsigned char* UB = C.ws + WS_GU + (size_t)unit * GDN_UNIT_BYTES;
    PSPAN_BEGIN(C, 110);
    if (tid < 384) { const int cg = tid % 48, seg = tid / 48, which = cg >> 4, d0 = (cg & 15) * 8, chn = which * 768 + h * 128 + d0, sp0 = ch * 64 + 8 * seg - 3;
        const bf16* src = PROJ + ((size_t)(b * SQ) + sp0) * PW + C_GQ + chn;
        u32x4_t raw[11];
#pragma unroll
        for (int r = 0; r < 11; ++r) raw[r] = (r >= 3 || sp0 + r >= 0) ? *(const u32x4_t*)(src + (ptrdiff_t)r * PW) : (u32x4_t){0u, 0u, 0u, 0u};
        f32x4 wv[4][2];
#pragma unroll
        for (int tap = 0; tap < 4; ++tap) { wv[tap][0] = *(const f32x4*)(convw + tap * 2304 + chn); wv[tap][1] = *(const f32x4*)(convw + tap * 2304 + chn + 4); }
        LAS float* T = (LAS float*)(C.lds + which * 33792) + (8 * seg) * 132 + d0;
#pragma unroll
        for (int i = 0; i < 8; ++i) { f32x4 a0 = (f32x4){0.f, 0.f, 0.f, 0.f}, a1 = a0;
#pragma unroll
            for (int tap = 0; tap < 4; ++tap) { const u32x4_t w = raw[i + tap];
                a0 += wv[tap][0] * (f32x4){bflo(w.x), bfhi(w.x), bflo(w.y), bfhi(w.y)}; a1 += wv[tap][1] * (f32x4){bflo(w.z), bfhi(w.z), bflo(w.w), bfhi(w.w)}; }
            *(LAS f32x4*)(T + i * 132) = (f32x4){silu_f(a0.x), silu_f(a0.y), silu_f(a0.z), silu_f(a0.w)}; *(LAS f32x4*)(T + i * 132 + 4) = (f32x4){silu_f(a1.x), silu_f(a1.y), silu_f(a1.z), silu_f(a1.w)}; } }
    __syncthreads();
    PSPAN_END(C, 110); PSPAN_BEGIN(C, 111);
#pragma unroll
    for (int ii = 0; ii < 8; ++ii) { const int i = wave * 8 + ii;
        { const float a = QT[i * 132 + lane], c = QT[i * 132 + 64 + lane]; const float sc = rsqrtf(wave_sum(a * a + c * c) + EPS) * 0.08838834764831845f; QT[i * 132 + lane] = a * sc; QT[i * 132 + 64 + lane] = c * sc; }
        { const float a = KT[i * 132 + lane], c = KT[i * 132 + 64 + lane]; const float sc = rsqrtf(wave_sum(a * a + c * c) + EPS); KT[i * 132 + lane] = a * sc; KT[i * 132 + 64 + lane] = c * sc; } }
    if (wave == 0) { const float* GAB = (const float*)(C.ws + WS_GAB) + (size_t)(tok0 + lane) * 12;
        const float av = GAB[h], bv = GAB[6 + h]; const float x = av + PIN(26)[l * 6 + h]; const float sp = (x > 20.f) ? x : log1pf(__expf(x));
        float g = -__expf(PIN(25)[l * 6 + h]) * sp;
#pragma unroll
        for (int o = 1; o < 64; o <<= 1) { const float t = __shfl_up(g, o); if (lane >= o) g += t; }
        const float glast = __shfl(g, 63);
        gc[lane] = g; beta[lane] = sigmoid_f(bv); eg[lane] = __expf(g); ek[lane] = __expf(glast - g);
        if (lane == 0) *(float*)(UB + 57344 + 32768) = __expf(glast); }
    __syncthreads();
    PSPAN_END(C, 111); PSPAN_BEGIN(C, 112);
    for (int z = tid; z < 6 * 256; z += NTHR) { const int t = z >> 8, e = z & 255, ti = (t >= 3) ? (t >= 5 ? 2 : 1) : 0, tj = (t >= 3) ? (t >= 5 ? 3 : t - 1) : t + 1;
        QKM[(16 * ti + (e >> 4)) * 68 + 16 * tj + (e & 15)] = 0.f; }
    { const int fr = lane & 15, quad = lane >> 4;
#pragma unroll 1
      for (int job = wave; job < 20; job += NWAVES) { const int mat = job / 10, t = job % 10, ti = (t >= 6) ? 3 : (t >= 3) ? 2 : (t >= 1) ? 1 : 0, tj = t - ti * (ti + 1) / 2; LAS float* OUT = mat ? QKM : AM;
          const LAS float* ap = (mat ? QT : KT) + (16 * ti + fr) * 132 + quad; const LAS float* bp = KT + (16 * tj + fr) * 132 + quad;
          f32x4 a0 = (f32x4){0.f, 0.f, 0.f, 0.f}, a1 = a0, a2 = a0, a3 = a0;
#pragma unroll
          for (int kk = 0; kk < 32; kk += 4) { a0 = __builtin_amdgcn_mfma_f32_16x16x4f32(ap[4 * kk], bp[4 * kk], a0, 0, 0, 0); a1 = __builtin_amdgcn_mfma_f32_16x16x4f32(ap[4 * kk + 4], bp[4 * kk + 4], a1, 0, 0, 0);
              a2 = __builtin_amdgcn_mfma_f32_16x16x4f32(ap[4 * kk + 8], bp[4 * kk + 8], a2, 0, 0, 0); a3 = __builtin_amdgcn_mfma_f32_16x16x4f32(ap[4 * kk + 12], bp[4 * kk + 12], a3, 0, 0, 0); }
          const f32x4 acc = (a0 + a1) + (a2 + a3);
#pragma unroll
          for (int j = 0; j < 4; ++j) { const int i = 16 * ti + 4 * quad + j, jj = 16 * tj + fr; float v = 0.f;
              if (mat == 0) { if (i > jj) v = beta[i] * acc[j] * __expf(gc[i] - gc[jj]); } else { if (i >= jj) v = acc[j] * __expf(gc[i] - gc[jj]); }
              OUT[i * 68 + jj] = v; } } }
    __syncthreads();
    PSPAN_END(C, 112); PSPAN_BEGIN(C, 113);
    { LAS float* TM = (LAS float*)(C.lds + GL_SM + 1024);
      const int fr = lane & 15, quad = lane >> 4;
      f32x4 acc[2][4];
#pragma unroll
      for (int r = 0; r < 4; ++r)
#pragma unroll
          for (int jq = 0; jq < 4; ++jq) { const int i = 16 * r + 4 * quad + jq; const float bi = beta[i];
              acc[0][r][jq] = VT[i * 132 + 16 * wave + fr] * bi; acc[1][r][jq] = KT[i * 132 + 16 * wave + fr] * bi * eg[i]; }
      if (wave == 0) { const int r = lane >> 4, c = lane & 15; const LAS float* Ar = AM + (16 * r) * 68 + 16 * r; float t[16];
#pragma unroll
          for (int i2 = 0; i2 < 16; ++i2) { float sacc = (i2 == c) ? 1.f : 0.f;
#pragma unroll
              for (int j2 = 0; j2 < i2; ++j2) sacc -= Ar[i2 * 68 + j2] * t[j2];
              t[i2] = sacc; TM[(r * 16 + i2) * 16 + c] = sacc; } }
      __syncthreads();
      f32x4 X[2][4];
#pragma unroll
      for (int r = 0; r < 4; ++r) {
#pragma unroll
          for (int q = 0; q < r; ++q) { const f32x4 a = *(const LAS f32x4*)(AM + (16 * r + fr) * 68 + 16 * q + 4 * quad);
#pragma unroll
              for (int jq = 0; jq < 4; ++jq) { acc[0][r] = __builtin_amdgcn_mfma_f32_16x16x4f32(-a[jq], X[0][q][jq], acc[0][r], 0, 0, 0); acc[1][r] = __builtin_amdgcn_mfma_f32_16x16x4f32(-a[jq], X[1][q][jq], acc[1][r], 0, 0, 0); } }
          const f32x4 tt = *(const LAS f32x4*)(TM + (r * 16 + fr) * 16 + 4 * quad);
          X[0][r] = (f32x4){0.f, 0.f, 0.f, 0.f}; X[1][r] = X[0][r];
#pragma unroll
          for (int jq = 0; jq < 4; ++jq) { X[0][r] = __builtin_amdgcn_mfma_f32_16x16x4f32(tt[jq], acc[0][r][jq], X[0][r], 0, 0, 0); X[1][r] = __builtin_amdgcn_mfma_f32_16x16x4f32(tt[jq], acc[1][r][jq], X[1][r], 0, 0, 0); }
          *(f32x4*)((float*)(UB + 57344) + ((((wave * 4 + r) * 4 + quad) * 16 + fr) * 4)) = X[0][r];
#pragma unroll
          for (int jq = 0; jq < 4; ++jq) VT[(16 * r + 4 * quad + jq) * 132 + 16 * wave + fr] = X[1][r][jq]; } }
    __syncthreads();
    PSPAN_END(C, 113); PSPAN_BEGIN(C, 114);
    for (int pc = tid; pc < 3584; pc += NTHR) { const int ln = pc & 63, row = ln & 15, quad = ln >> 4; float v[8];
        if (pc < 2048) { const int tile = (pc >> 6) & 15, mt = tile >> 2, s = tile & 3, i = 16 * mt + row, cb = 32 * s + 4 * quad; const LAS float* src = (pc < 1024 ? VT : QT) + i * 132 + cb; const float sc = (pc < 1024) ? 1.f : eg[i];
            const f32x4 a = *(const LAS f32x4*)src, c = *(const LAS f32x4*)(src + 16);
            v[0] = a.x * sc; v[1] = a.y * sc; v[2] = a.z * sc; v[3] = a.w * sc; v[4] = c.x * sc; v[5] = c.y * sc; v[6] = c.z * sc; v[7] = c.w * sc; }
        else if (pc < 3072) { const int tile = (pc - 2048) >> 6, dt = tile >> 1, s2 = tile & 1, d = 16 * dt + row;
#pragma unroll
            for (int j = 0; j < 8; ++j) { const int jj = 32 * s2 + 4 * quad + (j & 3) + 16 * (j >> 2); v[j] = KT[jj * 132 + d] * ek[jj]; } }
        else { const int tile = (pc - 3072) >> 6, mt = tile >> 1, s2 = tile & 1, i = 16 * mt + row; const LAS float* src = QKM + i * 68 + 32 * s2 + 4 * quad;
            const f32x4 a = *(const LAS f32x4*)src, c = *(const LAS f32x4*)(src + 16);
            v[0] = a.x; v[1] = a.y; v[2] = a.z; v[3] = a.w; v[4] = c.x; v[5] = c.y; v[6] = c.z; v[7] = c.w; }
        v4u o; o.x = pk2(v[0], v[1]); o.y = pk2(v[2], v[3]); o.z = pk2(v[4], v[5]); o.w = pk2(v[6], v[7]); *(GAS v4u*)(UB + (size_t)pc * 16) = o; }
    __syncthreads();
    PSPAN_END(C, 114);
}

#define GDN_BAR() asm volatile("s_waitcnt lgkmcnt(0)\n\ts_barrier" ::: "memory")
template <int PAR>
__device__ __forceinline__ void gdn_step_c(const Ctx& C, int n, const GAS unsigned char* UB, float* OG, int slice, f32x4 (&S)[8], f32x4 (&uu)[4], float& ue) {
    const int lane = C.lane, col = lane & 15, quad = lane >> 4;
    const LAS unsigned char* cur = C.lds + PAR * 57344;
    f32x4 u4[4];
#pragma unroll
    for (int mt = 0; mt < 4; ++mt) u4[mt] = uu[mt];
    const float egl = ue;
    if (n + 2 < 64) { const GAS unsigned char* un = UB + (size_t)(n + 2) * GDN_UNIT_BYTES + 57344;
#pragma unroll
        for (int mt = 0; mt < 4; ++mt) uu[mt] = *(const GAS f32x4*)(un + (size_t)((((slice * 4 + mt) * 4 + quad) * 16 + col) * 16));
        ue = *(const GAS float*)(un + 32768); }
    bf16x8 sb[4];
#pragma unroll
    for (int s = 0; s < 4; ++s) sb[s] = pack8(S[2 * s], S[2 * s + 1]);
    f32x4 vn[4];
#pragma unroll
    for (int mt = 0; mt < 4; ++mt) { f32x4 ws = (f32x4){0.f, 0.f, 0.f, 0.f};
#pragma unroll
        for (int s = 0; s < 4; ++s) { const bf16x8 a = *(const LAS bf16x8*)(cur + ((mt * 4 + s) * 64 + lane) * 16); ws = __builtin_amdgcn_mfma_f32_16x16x32_bf16(a, sb[s], ws, 0, 0, 0); }
        vn[mt] = u4[mt] - ws; }
    bf16x8 vb[2]; vb[0] = pack8(vn[0], vn[1]); vb[1] = pack8(vn[2], vn[3]);
#pragma unroll
    for (int d = 0; d < 8; ++d) { f32x4 sd = S[d] * egl;
#pragma unroll
        for (int s2 = 0; s2 < 2; ++s2) { const bf16x8 a = *(const LAS bf16x8*)(cur + 32768 + ((d * 2 + s2) * 64 + lane) * 16); sd = __builtin_amdgcn_mfma_f32_16x16x32_bf16(a, vb[s2], sd, 0, 0, 0); }
        S[d] = sd; }
#pragma unroll
    for (int mt = 0; mt < 4; ++mt) { f32x4 o = (f32x4){0.f, 0.f, 0.f, 0.f};
#pragma unroll
        for (int s = 0; s < 4; ++s) { const bf16x8 a = *(const LAS bf16x8*)(cur + 16384 + ((mt * 4 + s) * 64 + lane) * 16); o = __builtin_amdgcn_mfma_f32_16x16x32_bf16(a, sb[s], o, 0, 0, 0); }
#pragma unroll
        for (int s2 = 0; s2 < 2; ++s2) { const bf16x8 a = *(const LAS bf16x8*)(cur + 49152 + ((mt * 2 + s2) * 64 + lane) * 16); o = __builtin_amdgcn_mfma_f32_16x16x32_bf16(a, vb[s2], o, 0, 0, 0); }
#pragma unroll
        for (int j = 0; j < 4; ++j) OG[(size_t)(n * 64 + 16 * mt + 4 * quad + j) * 768] = o[j]; }
}
template <int PAR>
__device__ __forceinline__ void gdn_step_l(const Ctx& C, int n, const GAS unsigned char* UB, int lt, u32x4_t (&rr)[14]) {
    if (n + 1 < 64) {
#pragma unroll
        for (int k = 0; k < 14; ++k) *(LAS u32x4_t*)(C.lds + (1 - PAR) * 57344 + (size_t)(lt + 256 * k) * 16) = rr[k]; }
    if (n + 3 < 64) { const GAS unsigned char* un = UB + (size_t)(n + 3) * GDN_UNIT_BYTES;
#pragma unroll
        for (int k = 0; k < 14; ++k) rr[k] = *(const GAS u32x4_t*)(un + (size_t)(lt + 256 * k) * 16); }
}
__device__ __forceinline__ void gdn_seq(const Ctx& C, int gi) {
    const int bh = gi >> 1, b = bh / 6, h = bh % 6, lane = C.lane, col = lane & 15, quad = lane >> 4;
    const GAS unsigned char* UB = C.ws + WS_GU + (size_t)(bh * 64) * GDN_UNIT_BYTES;
    if (C.wave < 4) {
        const int slice = (gi & 1) * 4 + C.wave;
        float* OG = (float*)(C.ws + WS_OGDN) + (size_t)(b * SQ) * 768 + h * 128 + slice * 16 + col;
        f32x4 S[8], uu0[4], uu1[4]; float ue0, ue1;
#pragma unroll
        for (int d = 0; d < 8; ++d) S[d] = (f32x4){0.f, 0.f, 0.f, 0.f};
#pragma unroll
        for (int mt = 0; mt < 4; ++mt) { uu0[mt] = *(const GAS f32x4*)(UB + 57344 + (size_t)((((slice * 4 + mt) * 4 + quad) * 16 + col) * 16)); uu1[mt] = *(const GAS f32x4*)(UB + GDN_UNIT_BYTES + 57344 + (size_t)((((slice * 4 + mt) * 4 + quad) * 16 + col) * 16)); }
        ue0 = *(const GAS float*)(UB + 57344 + 32768); ue1 = *(const GAS float*)(UB + GDN_UNIT_BYTES + 57344 + 32768);
        GDN_BAR();
#pragma unroll 1
        for (int n = 0; n < 64; n += 2) {
            gdn_step_c<0>(C, n, UB, OG, slice, S, uu0, ue0); GDN_BAR();
            gdn_step_c<1>(C, n + 1, UB, OG, slice, S, uu1, ue1); GDN_BAR();
        }
    } else {
        const int lt = C.tid - 256; u32x4_t ra[14], rb[14];
#pragma unroll
        for (int k = 0; k < 14; ++k) { const u32x4_t v = *(const GAS u32x4_t*)(UB + (size_t)(lt + 256 * k) * 16); *(LAS u32x4_t*)(C.lds + (size_t)(lt + 256 * k) * 16) = v; }
#pragma unroll
        for (int k = 0; k < 14; ++k) { ra[k] = *(const GAS u32x4_t*)(UB + GDN_UNIT_BYTES + (size_t)(lt + 256 * k) * 16); rb[k] = *(const GAS u32x4_t*)(UB + 2 * (size_t)GDN_UNIT_BYTES + (size_t)(lt + 256 * k) * 16); }
        GDN_BAR();
#pragma unroll 1
        for (int n = 0; n < 64; n += 2) {
            gdn_step_l<0>(C, n, UB, lt, ra); GDN_BAR();
            gdn_step_l<1>(C, n + 1, UB, lt, rb); GDN_BAR();
        }
    }
}

__device__ __forceinline__ void attn_queue(const Ctx& C, int l) {
    const attn_body::bf16* PROJ = (const attn_body::bf16*)(C.ws + WS_PROJ); attn_body::bf16* ATTO = (attn_body::bf16*)(C.ws + WS_ATTO);
    if (C.tid == 0) C.MISC[18] = 0u;
    for (;;) {
        if (C.tid == 0) { unsigned d = C.MISC[18], q = 0xffffffffu; const unsigned x0 = xb_xcc_id() & 7u;
            for (; d < 8u; ++d) { const unsigned x = (x0 + d) & 7u; const unsigned t = __hip_atomic_fetch_add(C.ctl + CW_QUEUE + 64 * (l * 8 + (int)x), 1u, RLX_AGENT); if (t < 192u) { q = (x << 8) | t; break; } }
            C.MISC[18] = d; C.MISC[16] = q; }
        __syncthreads();
        const unsigned q = (unsigned)__builtin_amdgcn_readfirstlane((int)C.MISC[16]);
        __syncthreads();
        if (q == 0xffffffffu) break;
        const int x = (int)(q >> 8), t = (int)(q & 255u), g = t >> 6, r = t & 63, qb = 15 - (r >> 2), bh = x * 3 + g, b = bh / 6, vh = (bh % 6) * 4 + (r & 3);
        const attn_body::bf16* base = PROJ + (size_t)(b * SQ) * PW;
        attn_body::attn_unit<8>(qb, base + C_DQ + (vh >> 1) * 64, base + C_DK + (vh >> 1) * 64, base + C_DV + (vh >> 2) * 128 + (vh & 1) * 64, ATTO + (size_t)(b * SQ) * 1536 + vh * 64, (char*)C.lds, C.wave);
    }
}

__device__ __forceinline__ volatile LAS unsigned* misc_at(int i) { unsigned a = (unsigned)(MISC_OFF + 4 * i); asm volatile("" : "+v"(a)); return (volatile LAS unsigned*)(size_t)a; }
__device__ __forceinline__ void attn_queue128(const Ctx& C, int l) {
    const attn_body::bf16* PROJ = (const attn_body::bf16*)(C.ws + WS_PROJ); attn_body::bf16* ATTO = (attn_body::bf16*)(C.ws + WS_ATTO);
    if (C.tid == 0) *misc_at(18) = 0u;
    for (;;) {
        if (C.tid == 0) { unsigned d = *misc_at(18), q = 0xffffffffu; const unsigned x0 = xb_xcc_id() & 7u;
            for (; d < 8u; ++d) { const unsigned x = (x0 + d) & 7u; const unsigned t = __hip_atomic_fetch_add(C.ctl + CW_QUEUE + 64 * (l * 8 + (int)x), 1u, RLX_AGENT); if (t < 96u) { q = (x << 8) | t; break; } }
            *misc_at(18) = d; *misc_at(16) = q; }
        __syncthreads();
        const unsigned q = (unsigned)__builtin_amdgcn_readfirstlane((int)*misc_at(16));
        __syncthreads();
        if (q == 0xffffffffu) break;
        const int x = (int)(q >> 8), t = (int)(q & 255u), g = t >> 5, r = t & 31, qb = 15 - (r >> 1), bh = x * 3 + g, b = bh / 6, hm = (bh % 6) * 2 + (r & 1);
        const attn_body::bf16* base = PROJ + (size_t)(b * SQ) * PW;
        attn_body::attn_unit128<8>(qb, base + C_DQ + hm * 64, base + C_DK + hm * 64, base + C_DV + (hm >> 1) * 128, ATTO + (size_t)(b * SQ) * 1536 + hm * 128, (char*)C.lds, C.wave);
    }
}

__device__ __forceinline__ void scan_publish(const Ctx& C, int l) {
    asm volatile("s_waitcnt vmcnt(0)" ::: "memory"); __syncthreads();
    if (C.tid == 0) { __builtin_amdgcn_fence(__ATOMIC_RELEASE, "agent"); asm volatile("s_waitcnt vmcnt(0)" ::: "memory"); (void)__hip_atomic_fetch_add(C.ctl + CW_SCAN + 64 * l, 1u, RLX_AGENT); }
}
__device__ __forceinline__ void scan_wait(const Ctx& C, int l) {
    if (C.tid == 0) { unsigned sp = 0; while (__hip_atomic_load(C.ctl + CW_SCAN + 64 * l, RLX_AGENT) < 16u && ++sp < (1u << 22)) __builtin_amdgcn_s_sleep(2);
        __builtin_amdgcn_fence(__ATOMIC_ACQUIRE, "agent"); asm volatile("s_waitcnt vmcnt(0)" ::: "memory"); }
    __syncthreads();
}

__device__ __forceinline__ void post_mix(const Ctx& C, KP P, int l) {
    const int lane = C.lane; const bf16* ATTO = (const bf16*)(C.ws + WS_ATTO); const float* OG = (const float*)(C.ws + WS_OGDN); const bf16* PROJ = (const bf16*)(C.ws + WS_PROJ); bf16* YCAT = (bf16*)(C.ws + WS_YCAT);
    const float linit = 0.8f - 0.6f * expf(-0.3f * (float)l);
    const float lam = expf(wave_sum(PIN(19)[l * 64 + lane] * PIN(20)[l * 64 + lane])) - expf(wave_sum(PIN(21)[l * 64 + lane] * PIN(22)[l * 64 + lane])) + linit;
    const float sl0 = PIN(23)[l * 128 + 2 * lane] * (1.f - linit), sl1 = PIN(23)[l * 128 + 2 * lane + 1] * (1.f - linit);
    const float gn0 = PIN(27)[l * 128 + 2 * lane], gn1 = PIN(27)[l * 128 + 2 * lane + 1];
    const int tb = (C.blk < 128) ? 48 * C.blk : 6144 + 80 * (C.blk - 128), tn = (C.blk < 128) ? 48 : 80;
    for (int t0 = tb + 2 * C.wave; t0 < tb + tn; t0 += 2 * NWAVES) {
        unsigned o1[2][6], o2[2][6], zz[2][6]; f32x2_t og[2][6];
#pragma unroll
        for (int u = 0; u < 2; ++u)
#pragma unroll
            for (int h = 0; h < 6; ++h) { const int t = t0 + u; o1[u][h] = *(const unsigned*)(ATTO + (size_t)t * 1536 + (2 * h) * 128 + 2 * lane); o2[u][h] = *(const unsigned*)(ATTO + (size_t)t * 1536 + (2 * h + 1) * 128 + 2 * lane);
                og[u][h] = *(const f32x2_t*)(OG + (size_t)t * 768 + h * 128 + 2 * lane); zz[u][h] = *(const unsigned*)(PROJ + (size_t)t * PW + C_GZ + h * 128 + 2 * lane); }
#pragma unroll
        for (int u = 0; u < 2; ++u)
#pragma unroll
            for (int h = 0; h < 6; ++h) { const int t = t0 + u;
                { const float a = bflo(o1[u][h]) - lam * bflo(o2[u][h]), c = bfhi(o1[u][h]) - lam * bfhi(o2[u][h]); const float r = rsqrtf(wave_sum(a * a + c * c) * (1.f / 128.f) + EPS);
                  *(unsigned*)(YCAT + (size_t)t * DM + 512 + h * 128 + 2 * lane) = pk2(a * r * sl0, c * r * sl1); }
                { const f32x2_t o = og[u][h]; const float r = rsqrtf(wave_sum(o.x * o.x + o.y * o.y) * (1.f / 128.f) + EPS);
                  *(unsigned*)(YCAT + (size_t)t * DM + 1280 + h * 128 + 2 * lane) = pk2(o.x * r * gn0 * silu_f(bflo(zz[u][h])), o.y * r * gn1 * silu_f(bfhi(zz[u][h]))); } } }
}

__device__ __forceinline__ void norm_router_phase(const Ctx& C, KP P, const float* __restrict__ nw, const float* __restrict__ mod_shift, const float* __restrict__ mod_scale) {
    LAS float* WRT = (LAS float*)C.lds;
    LAS int* esel = (LAS int*)(C.lds + 65536); LAS int* rankl = esel + 128;
    const float* wr = PIN(31);
    for (int idx = C.tid; idx < DM * 8; idx += NTHR) { const int k = idx >> 3, e = idx & 7; WRT[e * DM + k] = wr[idx]; }
    __syncthreads();
    const float* src = (const float*)(C.ws + WS_HRES); unsigned char* HN8 = (unsigned char*)(C.ws + WS_HN); const int lane = C.lane;
    f32x4 nwv[8];
#pragma unroll
    for (int j = 0; j < 8; ++j) nwv[j] = *(const f32x4*)(nw + 4 * lane + 256 * j);
    f32x4 vn[8];
#pragma unroll
    for (int j = 0; j < 8; ++j) vn[j] = *(const f32x4*)(src + (size_t)(C.blk * 64 + C.wave * 8) * DM + 4 * lane + 256 * j);
    int nlim = 8; asm volatile("" : "+s"(nlim));
#pragma unroll 1
    for (int i = 0; i < nlim; ++i) { const int tl = C.wave * 8 + i, t = C.blk * 64 + tl, b = t >> 12;
        f32x4 v[8]; float ss = 0.f;
#pragma unroll
        for (int j = 0; j < 8; ++j) { v[j] = vn[j]; ss += (v[j].x * v[j].x + v[j].y * v[j].y) + (v[j].z * v[j].z + v[j].w * v[j].w); }
        if (i + 1 < nlim) {
#pragma unroll
            for (int j = 0; j < 8; ++j) vn[j] = *(const f32x4*)(src + (size_t)(t + 1) * DM + 4 * lane + 256 * j); }
        const float r = rsqrtf(wave_sum(ss) * (1.f / DM) + EPS);
        const float* sh = mod_shift + (size_t)b * 6 * DM; const float* scp = mod_scale + (size_t)b * 6 * DM;
#pragma unroll
        for (int j = 0; j < 8; ++j) { const f32x4 s1 = *(const f32x4*)(scp + 4 * lane + 256 * j), s0 = *(const f32x4*)(sh + 4 * lane + 256 * j);
            v[j] = v[j] * r * nwv[j] * (s1 + 1.f) + s0;
            *(GAS unsigned*)(HN8 + (size_t)t * DM + 4 * lane + 256 * j) = pk4_fp8(v[j].x * S8_HN, v[j].y * S8_HN, v[j].z * S8_HN, v[j].w * S8_HN); }
        float lg[8];
        unsigned wb = 16u * (unsigned)lane; asm volatile("" : "+v"(wb)); const LAS float* WRL = (const LAS float*)(size_t)wb;
#pragma unroll
        for (int e = 0; e < 8; ++e) { float a = 0.f;
#pragma unroll
            for (int j = 0; j < 8; ++j) { const f32x4 wv = *(const LAS f32x4*)(WRL + e * DM + 256 * j); a += (v[j].x * wv.x + v[j].y * wv.y) + (v[j].z * wv.z + v[j].w * wv.w); }
            lg[e] = wave_sum(a); }
        int e0 = 0; float v0 = lg[0];
#pragma unroll
        for (int e = 1; e < 8; ++e) if (lg[e] > v0) { v0 = lg[e]; e0 = e; }
        int e1 = -1; float v1 = -INFINITY;
#pragma unroll
        for (int e = 0; e < 8; ++e) if (e != e0 && lg[e] > v1) { v1 = lg[e]; e1 = e; }
        const float g0 = 1.f / (1.f + __expf(v1 - v0)), g1 = 1.f - g0;
        if (lane == 0) { esel[2 * tl] = e0; esel[2 * tl + 1] = e1; ((int*)(C.ws + WS_TOKE))[2 * t] = e0; ((int*)(C.ws + WS_TOKE))[2 * t + 1] = e1; ((float*)(C.ws + WS_TOKG))[2 * t] = g0; ((float*)(C.ws + WS_TOKG))[2 * t + 1] = g1; }
    }
    __syncthreads();
    if (C.tid < 8) { int cnt = 0; for (int i = 0; i < 128; ++i) if (esel[i] == C.tid) rankl[i] = cnt++; ((int*)(C.ws + WS_CNT))[C.blk * 8 + C.tid] = cnt; }
    __syncthreads();
    if (C.tid < 128) ((int*)(C.ws + WS_RANK))[(size_t)C.blk * 128 + C.tid] = rankl[C.tid];
    __syncthreads();
}

__device__ __forceinline__ void route_phase(const Ctx& C) {
    LAS int* tot = (LAS int*)C.lds; LAS int* pre = tot + 8; LAS int* base = tot + 16;
    const int* CNT = (const int*)(C.ws + WS_CNT);
    LAS int* part = tot + 32;
    if (C.tid < 256) { const int bb = C.tid; const int4 ca = *(const int4*)(CNT + bb * 8), cb = *(const int4*)(CNT + bb * 8 + 4); const int cv[8] = {ca.x, ca.y, ca.z, ca.w, cb.x, cb.y, cb.z, cb.w};
#pragma unroll
        for (int e = 0; e < 8; ++e) { int s = cv[e], m = (bb < C.blk) ? cv[e] : 0;
#pragma unroll
            for (int o = 1; o < 64; o <<= 1) { s += __shfl_xor(s, o); m += __shfl_xor(m, o); }
            if (C.lane == 0) { part[C.wave * 16 + e] = s; part[C.wave * 16 + 8 + e] = m; } } }
    __syncthreads();
    if (C.tid < 8) { tot[C.tid] = part[C.tid] + part[16 + C.tid] + part[32 + C.tid] + part[48 + C.tid]; pre[C.tid] = part[8 + C.tid] + part[24 + C.tid] + part[40 + C.tid] + part[56 + C.tid]; }
    __syncthreads();
    if (C.tid == 0) { int run = 0; int* TILE = (int*)(C.ws + WS_TILE);
        for (int e = 0; e < 8; ++e) { base[e] = run; const int nt = (tot[e] + 255) >> 8; if (C.blk == 0) for (int q = 0; q < nt; ++q) TILE[1 + (run >> 8) + q] = e; run += nt << 8; }
        if (C.blk == 0) TILE[0] = run >> 8; }
    __syncthreads();
    const int* TOKE = (const int*)(C.ws + WS_TOKE); const float* TOKG = (const float*)(C.ws + WS_TOKG); const int* RANK = (const int*)(C.ws + WS_RANK);
    int* POS = (int*)(C.ws + WS_POS); float* GW = (float*)(C.ws + WS_GW); const unsigned char* HN8 = (const unsigned char*)(C.ws + WS_HN); unsigned char* AS8 = (unsigned char*)(C.ws + WS_AS);
    for (int i = 0; i < 8; ++i) { const int t = C.blk * 64 + C.wave * 8 + i;
        const int e0 = TOKE[2 * t], e1 = TOKE[2 * t + 1]; const int p0 = base[e0] + pre[e0] + RANK[2 * t], p1 = base[e1] + pre[e1] + RANK[2 * t + 1];
        if (C.lane == 0) { POS[2 * t] = p0; POS[2 * t + 1] = p1; GW[p0] = TOKG[2 * t]; GW[p1] = TOKG[2 * t + 1]; }
#pragma unroll
        for (int j = 0; j < 2; ++j) { const u32x4_t v = *(const u32x4_t*)(HN8 + (size_t)t * DM + 16 * C.lane + 1024 * j); *(u32x4_t*)(AS8 + (size_t)p0 * DM + 16 * C.lane + 1024 * j) = v; *(u32x4_t*)(AS8 + (size_t)p1 * DM + 16 * C.lane + 1024 * j) = v; } }
    __syncthreads();
}

__device__ __forceinline__ void ctr_wait(const Ctx& C, gu32* w, unsigned n) {
    if (C.tid == 0) { unsigned sp = 0; while (__hip_atomic_load(w, RLX_AGENT) < n && ++sp < (1u << 22)) __builtin_amdgcn_s_sleep(2);
        __builtin_amdgcn_fence(__ATOMIC_ACQUIRE, "agent"); asm volatile("s_waitcnt vmcnt(0)" ::: "memory"); }
    __syncthreads();
}
constexpr int FIN_W1 = 4;
template <int LATE>
__device__ __forceinline__ void final_pass(const Ctx& C, KP P, int late_row, int first, int step) {
    const float* HR = (const float*)(C.ws + WS_HRES); const bf16* YS = (const bf16*)(C.ws + WS_AS); const int* POS = (const int*)(C.ws + WS_POS);
    const float* gate2 = (const float*)(C.ws + WS_MOD) + (size_t)(1 * 4) * 6 * DM + 5 * DM; const float* nf = PIN(7); const int lane = C.lane;
    for (int it = first; it < TOK / 2; it += step) {
        const int t0 = 2 * (int)it; const int b = t0 >> 12; const int4 pp = *(const int4*)(POS + 2 * t0);
        const int pmin = __builtin_amdgcn_readfirstlane(min(min(pp.x, pp.y), min(pp.z, pp.w)));
        if ((pmin < late_row) == (LATE == 1)) {
        f32x4 v[2][8]; float ss0 = 0.f, ss1 = 0.f;
#pragma unroll
        for (int j = 0; j < 8; ++j) { const int c = 4 * lane + 256 * j; const f32x4 g = *(const f32x4*)(gate2 + (size_t)b * 6 * DM + c);
            const f32x4 ha = *(const f32x4*)(HR + (size_t)t0 * DM + c), hb = *(const f32x4*)(HR + (size_t)(t0 + 1) * DM + c);
            const u32x2_t a0 = *(const u32x2_t*)(YS + (size_t)pp.x * DM + c), a1 = *(const u32x2_t*)(YS + (size_t)pp.y * DM + c), b0 = *(const u32x2_t*)(YS + (size_t)pp.z * DM + c), b1 = *(const u32x2_t*)(YS + (size_t)pp.w * DM + c);
            const f32x4 ya = (f32x4){bflo(a0.x) + bflo(a1.x), bfhi(a0.x) + bfhi(a1.x), bflo(a0.y) + bflo(a1.y), bfhi(a0.y) + bfhi(a1.y)};
            const f32x4 yb = (f32x4){bflo(b0.x) + bflo(b1.x), bfhi(b0.x) + bfhi(b1.x), bflo(b0.y) + bflo(b1.y), bfhi(b0.y) + bfhi(b1.y)};
            v[0][j] = ha + g * ya; v[1][j] = hb + g * yb;
            ss0 += (v[0][j].x * v[0][j].x + v[0][j].y * v[0][j].y) + (v[0][j].z * v[0][j].z + v[0][j].w * v[0][j].w); ss1 += (v[1][j].x * v[1][j].x + v[1][j].y * v[1][j].y) + (v[1][j].z * v[1][j].z + v[1][j].w * v[1][j].w); }
        const float r0 = rsqrtf(wave_sum(ss0) * (1.f / DM) + EPS), r1 = rsqrtf(wave_sum(ss1) * (1.f / DM) + EPS);
#pragma unroll
        for (int j = 0; j < 8; ++j) { const int c = 4 * lane + 256 * j; const f32x4 w = *(const f32x4*)(nf + c); *(f32x4*)(POUT + (size_t)t0 * DM + c) = v[0][j] * r0 * w; *(f32x4*)(POUT + (size_t)(t0 + 1) * DM + c) = v[1][j] * r1 * w; } }
    }
}
__device__ __forceinline__ void final_phase(const Ctx& C, KP P) {
    const int late_row = (__builtin_amdgcn_readfirstlane(((const int*)(C.ws + WS_TILE))[0]) & 31) * 256;
    const int nb = late_row >> 4;
    if (C.blk >= nb) { ctr_wait(C, C.ctl + CW_FIN, (unsigned)C.G);
        if (C.wave < FIN_W1) final_pass<0>(C, P, late_row, (C.blk - nb) * FIN_W1 + C.wave, (C.G - nb) * FIN_W1); }
    else { ctr_wait(C, C.ctl + CW_FIN + 64, (unsigned)C.G); final_pass<1>(C, P, late_row, C.blk * NWAVES + C.wave, nb * NWAVES); }
}

#ifndef MK_N_LAUNCHES
#define MK_N_LAUNCHES 1
#endif
constexpr int N_PHASES = 24;

#if defined(PROBE_LO)
#define PROBE_BEGIN(k) do { if ((k) == PROBE_LO && blockIdx.x == 0 && C0.wave == 0 && mk_lane() == 0) { const unsigned long long t_ = __builtin_amdgcn_s_memrealtime(); C0.MISC[20] = (unsigned)t_; C0.MISC[21] = (unsigned)(t_ >> 32); } } while (0)
#define PROBE_END(k) do { if ((k) == PROBE_HI && blockIdx.x == 0 && C0.wave == 0 && mk_lane() == 0) { const unsigned long long t_ = __builtin_amdgcn_s_memrealtime() - (((unsigned long long)C0.MISC[21] << 32) | C0.MISC[20]); C0.MISC[22] = (unsigned)t_; } } while (0)
#else
#define PROBE_BEGIN(k) do {} while (0)
#define PROBE_END(k) do {} while (0)
#endif
template <int L>
__device__ __forceinline__ void layer_phases(const Ctx& C0, KP P0, int lo, int hi) {
#define IN(k) (lo <= (k) && (k) < hi)
#define SEAM_FILL(k) do { if (IN(k) && IN((k) + 1)) { PHASE_ENV moe_cvt_fill(C, P, (k), false); } } while (0)
#define SEAM(k) do { if (IN(k) && IN((k) + 1)) { GAS unsigned char* w_ = C0.ws; asm volatile("" : "+s"(w_)); XcdBarrier b_; b_.bar = (unsigned*)(w_ + WS_CTL) + CW_BAR + (MK_N_LAUNCHES == 1 ? 0 : lo) * XCD_BAR_WORDS; b_.x = xb_xcc_id(); b_.st = C0.MISC + 8; b_.lead = (C0.wave == 0 && mk_lane() == 0); xcd_barrier(b_); } PROBE_END(k); } while (0)
    constexpr int PB = 1 + 11 * L;
#define PHASE_ENV Ctx C = C0; KP P = P0; asm volatile("" : "+s"(C.ws), "+s"(P)); GAS unsigned char* ws = C.ws; C.ctl = (gu32*)(ws + WS_CTL); \
    C.lane = mk_lane(); asm volatile("" : "+v"(C.lane)); C.tid = C.wave * 64 + C.lane; \
    const float* MOD = (const float*)(ws + WS_MOD) + (size_t)(L * 4) * 6 * DM; float* HRES = (float*)(ws + WS_HRES); bf16* HN = (bf16*)(ws + WS_HN); bf16* PROJ = (bf16*)(ws + WS_PROJ); bf16* YCAT = (bf16*)(ws + WS_YCAT); \
    (void)MOD; (void)HRES; (void)HN; (void)PROJ; (void)YCAT; (void)P;
    PROBE_BEGIN(PB + 0); if (IN(PB + 0)) { PHASE_ENV norm_phase<true>(C, L == 0 ? PIN(0) : HRES, PIN(5) + L * DM, MOD + 0 * DM, MOD + 1 * DM, PIN(8) + (size_t)L * DM * INW); }
    SEAM(PB + 0);
    PROBE_BEGIN(PB + 1); if (IN(PB + 1)) { PHASE_ENV pg8::Gemm g{HN, (const bf16*)(ws + WS_WIN) + (size_t)L * PW * DM, TOK, PW, DM}; pg8::StaticOrder S; S.init(TOK, PW, C.G, C.blk); pg8::EpiProj E{PROJ};
        pg8::gemm_phase<pg8::EpiProj, pg8::StaticOrder, true, true>(C.lds, g, S, E, C.wave); }
    SEAM_FILL(PB + 1); SEAM(PB + 1);
    PROBE_BEGIN(PB + 2); if (IN(PB + 2)) { PHASE_ENV rope_pass(C); ssm_gemm_a(C, L);
#pragma unroll 1
        for (int u = C.blk; u < 1536; u += C.G) gdn_prep_unit(C, P, L, u); }
    SEAM(PB + 2);
    PROBE_BEGIN(PB + 3); if (IN(PB + 3)) { PHASE_ENV if (C.blk < 48) { PSPAN_BEGIN(C, 100); gdn_seq(C, C.blk); PSPAN_END(C, 100); __syncthreads(); } else if (C.blk >= C.G - 16) { ssm_scan(C, L, C.blk - (C.G - 16)); scan_publish(C, L); } attn_queue128(C, L); }
    if (IN(PB + 3)) { PHASE_ENV scan_wait(C, L); ssm_gemm_b(C, L); }
    SEAM_FILL(PB + 3); SEAM(PB + 3);
    PROBE_BEGIN(PB + 4); if (IN(PB + 4)) { PHASE_ENV
        { pg8::Gemm g{(const bf16*)(ws + WS_YGELU), (const bf16*)(ws + WS_WGLU) + (size_t)L * 512 * 512, TOK, 512, 512}; pg8::StaticOrder S; S.init(TOK, 512, C.G, C.blk); pg8::EpiGlu E{(const bf16*)(ws + WS_YGELU), YCAT};
          pg8::gemm_phase<pg8::EpiGlu, pg8::StaticOrder, true, true>(C.lds, g, S, E, C.wave); }
        post_mix(C, P, L); }
    SEAM(PB + 4);
    PROBE_BEGIN(PB + 6); if (IN(PB + 6)) { PHASE_ENV pg8::Gemm g{YCAT, (const bf16*)(ws + WS_WOUT) + (size_t)L * DM * DM, TOK, DM, DM}; pg8::StaticOrder S; S.init(TOK, DM, C.G, C.blk); pg8::EpiRes E{L == 0 ? PIN(0) : HRES, HRES, MOD + 2 * DM, 1.f};
        pg8::gemm_phase<pg8::EpiRes, pg8::StaticOrder, true, true>(C.lds, g, S, E, C.wave); }
    SEAM(PB + 6);
    if (L == 0) {
        PROBE_BEGIN(PB + 7); if (IN(PB + 7)) { PHASE_ENV norm_phase<false, (DENSE_FP8 >= 1)>(C, HRES, PIN(6) + L * DM, MOD + 3 * DM, MOD + 4 * DM, nullptr); }
        SEAM(PB + 7);
        SEAM(PB + 8);
        PROBE_BEGIN(PB + 9); if (IN(PB + 9)) { PHASE_ENV pg8::StaticOrder S; S.init(TOK, 2 * DFF, C.G, C.blk);
            if (DENSE_FP8 == 2) { pg8::Gemm g{HN, (const bf16*)(ws + WS_WUP), TOK, 2 * DFF, DM / 2}; pg8::EpiSwiglu8 E{(unsigned char*)(ws + WS_H), DFF, 2 * DFF / 256, 1.f / (S8_HN * S8_W13)}; pg8::gemm_phase<pg8::EpiSwiglu8, pg8::StaticOrder, true, true, true>(C.lds, g, S, E, C.wave); }
            else if (DENSE_FP8 == 1) { pg8::Gemm g{HN, (const bf16*)(ws + WS_WUP), TOK, 2 * DFF, DM / 2}; pg8::EpiSwiglu E{(bf16*)(ws + WS_H), DFF, 2 * DFF / 256, 1.f / (S8_HN * S8_W13)}; pg8::gemm_phase<pg8::EpiSwiglu, pg8::StaticOrder, true, true, true>(C.lds, g, S, E, C.wave); }
            else { pg8::Gemm g{HN, (const bf16*)(ws + WS_WUP), TOK, 2 * DFF, DM}; pg8::EpiSwiglu E{(bf16*)(ws + WS_H), DFF, 2 * DFF / 256, 1.f}; pg8::gemm_phase<pg8::EpiSwiglu, pg8::StaticOrder, true, true>(C.lds, g, S, E, C.wave); } }
        SEAM(PB + 9);
        PROBE_BEGIN(PB + 10); if (IN(PB + 10)) { PHASE_ENV pg8::StaticOrder S; S.init(TOK, DM, C.G, C.blk);
            if (DENSE_FP8 == 2) { pg8::Gemm g{(const bf16*)(ws + WS_H), (const bf16*)(ws + WS_WDN), TOK, DM, DFF / 2}; pg8::EpiRes E{HRES, HRES, MOD + 5 * DM, 1.f / (S8_H * S8_W2)}; pg8::gemm_phase<pg8::EpiRes, pg8::StaticOrder, true, true, true>(C.lds, g, S, E, C.wave); }
            else { pg8::Gemm g{(const bf16*)(ws + WS_H), (const bf16*)(ws + WS_WDN), TOK, DM, DFF}; pg8::EpiRes E{HRES, HRES, MOD + 5 * DM, 1.f}; pg8::gemm_phase<pg8::EpiRes, pg8::StaticOrder, true, true>(C.lds, g, S, E, C.wave); } }
        SEAM(PB + 10);
    } else {
        PROBE_BEGIN(PB + 7); if (IN(PB + 7)) { PHASE_ENV norm_router_phase(C, P, PIN(6) + L * DM, MOD + 3 * DM, MOD + 4 * DM); }
        SEAM(PB + 7);
        PROBE_BEGIN(PB + 8); if (IN(PB + 8)) { PHASE_ENV moe_cvt_fill(C, P, 0, true); route_phase(C); }
        SEAM(PB + 8);
        PROBE_BEGIN(PB + 9); if (IN(PB + 9)) { PHASE_ENV LAS int* TL = (LAS int*)(C.lds + TILE_OFF); for (int i = C.tid; i <= MOE_TILES_MAX; i += NTHR) TL[i] = ((const int*)(ws + WS_TILE))[i]; __syncthreads(); const int R = __builtin_amdgcn_readfirstlane(TL[0]);
            pg8::Gemm g{(const bf16*)(ws + WS_AS), (const bf16*)(ws + WS_MUP), R * 256, 2 * DFE, DM / 2}; pg8::MoeOrder S; S.so.init(R * 256, 2 * DFE, C.G, C.blk); S.tile_e = TL + 1; S.nct = 2 * DFE / 256;
            pg8::EpiSwiglu8 E{(unsigned char*)(ws + WS_H), DFE, 2 * DFE / 256, 1.f / (S8_HN * S8_W13)};
            pg8::gemm_phase<pg8::EpiSwiglu8, pg8::MoeOrder, true, true, true>(C.lds, g, S, E, C.wave); }
        SEAM(PB + 9);
        PROBE_BEGIN(PB + 10); if (IN(PB + 10)) { PHASE_ENV LAS int* TL = (LAS int*)(C.lds + TILE_OFF); for (int i = C.tid; i <= MOE_TILES_MAX; i += NTHR) TL[i] = ((const int*)(ws + WS_TILE))[i]; __syncthreads(); const int R = __builtin_amdgcn_readfirstlane(TL[0]);
            pg8::Gemm g{(const bf16*)(ws + WS_H), (const bf16*)(ws + WS_MDN), R * 256, DM, DFE / 2}; pg8::MoeDownOrder S; S.nM = R; S.nl = R & 31; S.R = R >> 5; S.c = C.blk; S.so.init((R - S.nl) * 256, DM, C.G, C.blk); S.tile_e = TL + 1; S.nct = DM / 256; S.ntf = DFE / 128;
            S.arr = (gu32*)(ws + WS_CTL) + CW_FIN; S.wc = (LAS unsigned*)(C.lds + MISC_OFF) + 28;
            pg8::EpiMoeDown E{(bf16*)(ws + WS_AS), (const float*)(ws + WS_GW), 1.f / (S8_H * S8_W2), (f32x4*)(ws + WS_XC), (gu32*)(ws + WS_CTL) + CW_FIN + 256, (LAS unsigned*)(C.lds + MISC_OFF) + 29};
            pg8::gemm_phase<pg8::EpiMoeDown, pg8::MoeDownOrder, true, true, true>(C.lds, g, S, E, C.wave);
            asm volatile("s_waitcnt vmcnt(0)" ::: "memory"); __syncthreads();
            if (C.wave == 0 && mk_lane() == 0) { __builtin_amdgcn_fence(__ATOMIC_RELEASE, "agent"); asm volatile("s_waitcnt vmcnt(0)" ::: "memory"); (void)__hip_atomic_fetch_add((gu32*)(ws + WS_CTL) + CW_FIN + 64, 1u, RLX_AGENT); } }
        PROBE_END(PB + 10);
    }
#undef IN
#undef SEAM
#undef PHASE_ENV
}

__global__ void __launch_bounds__(NTHR, 2) mk_fwd(Params P) {
    extern __shared__ __attribute__((aligned(16))) unsigned char lds[];
    KP KPp = (KP)__builtin_amdgcn_kernarg_segment_ptr();
    Ctx C; C.lds = (LAS unsigned char*)lds; C.MISC = (volatile LAS unsigned*)(C.lds + MISC_OFF); C.ws = (GAS unsigned char*)KPp->ws; C.ctl = (gu32*)(C.ws + WS_CTL);
    C.tid = threadIdx.x; C.lane = C.tid & 63; C.wave = __builtin_amdgcn_readfirstlane(C.tid >> 6); C.blk = blockIdx.x; C.G = 256;
    for (int u = C.tid; u < (LDS_BYTES - TILE_OFF) / 4; u += NTHR) ((LAS unsigned*)(C.lds + TILE_OFF))[u] = 0u;
    __syncthreads();
    const int lo = KPp->ph_lo, hi = KPp->ph_hi;
    (void)xcd_barrier_post((unsigned*)(C.ctl + CW_BAR) + (MK_N_LAUNCHES == 1 ? 0 : lo) * XCD_BAR_WORDS, C.MISC + 8);
    { const Ctx& C0 = C; PROBE_BEGIN(0); }
    if (lo <= 0 && 0 < hi) { Ctx Cp = C; KP Pp = KPp; asm volatile("" : "+s"(Cp.ws), "+s"(Pp)); Cp.lane = mk_lane(); asm volatile("" : "+v"(Cp.lane)); Cp.tid = Cp.wave * 64 + Cp.lane; p0_prologue(Cp, Pp); if (1 < hi) { XcdBarrier b_; b_.bar = (unsigned*)(Cp.ws + WS_CTL) + CW_BAR + (MK_N_LAUNCHES == 1 ? 0 : lo) * XCD_BAR_WORDS; b_.x = xb_xcc_id(); b_.st = C.MISC + 8; b_.lead = (C.wave == 0 && mk_lane() == 0); xcd_barrier(b_); } }
    { const Ctx& C0 = C; PROBE_END(0); }
    layer_phases<0>(C, KPp, lo, hi);
    layer_phases<1>(C, KPp, lo, hi);
    { const Ctx& C0 = C; PROBE_BEGIN(23); }
    if (lo <= 23 && 23 < hi) { Ctx Cp = C; KP Pp = KPp; asm volatile("" : "+s"(Cp.ws), "+s"(Pp)); Cp.lane = mk_lane(); asm volatile("" : "+v"(Cp.lane)); Cp.tid = Cp.wave * 64 + Cp.lane; final_phase(Cp, Pp); }
    { const Ctx& C0 = C; PROBE_END(23); }
#if defined(PROBE_LO)
    if (blockIdx.x == 0 && C.wave == 0 && mk_lane() == 0) { const unsigned long long t0_ = __builtin_amdgcn_s_memrealtime(), w_ = (unsigned long long)C.MISC[22] * PROBE_MULT; while (__builtin_amdgcn_s_memrealtime() - t0_ < w_) __builtin_amdgcn_s_sleep(8); }
#endif
}

extern "C" void kernel_launch(void* const* d_in, const int* in_sizes, int n_in, void* d_out, int out_size, void* d_ws, size_t ws_size, hipStream_t stream) {
    static int grid = 0;
    if (grid == 0) {
        if (n_in != 35 || in_sizes[0] != TOK * DM || out_size != TOK * DM || ws_size < WS_END) { fprintf(stderr, "kernel_launch: unexpected problem: n_in %d in0 %d out %d ws %zu (need %zu)\n", n_in, n_in > 0 ? in_sizes[0] : -1, out_size, ws_size, (size_t)WS_END); grid = -1; return; }
        int dev = 0, cus = 0, per_cu = 0;
        if (hipGetDevice(&dev) != hipSuccess || hipDeviceGetAttribute(&cus, hipDeviceAttributeMultiprocessorCount, dev) != hipSuccess) { grid = -1; return; }
        if (hipFuncSetAttribute((const void*)mk_fwd, hipFuncAttributeMaxDynamicSharedMemorySize, LDS_BYTES) != hipSuccess) { fprintf(stderr, "kernel_launch: hipFuncSetAttribute failed\n"); grid = -1; return; }
        if (hipOccupancyMaxActiveBlocksPerMultiprocessor(&per_cu, (const void*)mk_fwd, NTHR, LDS_BYTES) != hipSuccess || per_cu < 1) fprintf(stderr, "kernel_launch: occupancy query says %d\n", per_cu);
        (void)hipGetLastError();
        grid = 256;
        if (cus < 256) { fprintf(stderr, "kernel_launch: device has %d CUs, this kernel needs 256\n", cus); grid = -1; return; }
    }
    if (grid < 0) return;
    if (hipMemsetAsync((char*)d_ws + WS_CTL, 0, CTL_ZERO_BYTES, stream) != hipSuccess) return;
    Params p{};
    for (int i = 0; i < 35; ++i) p.in[i] = (const float*)d_in[i];
    p.out = (float*)d_out; p.ws = (unsigned char*)d_ws;
#if MK_N_LAUNCHES == 1
    p.ph_lo = 0; p.ph_hi = N_PHASES;
    hipLaunchKernelGGL(mk_fwd, dim3(grid), dim3(NTHR), LDS_BYTES, stream, p);
#else
    for (int k = 0; k < N_PHASES; ++k) { p.ph_lo = k; p.ph_hi = k + 1; hipLaunchKernelGGL(mk_fwd, dim3(grid), dim3(NTHR), LDS_BYTES, stream, p); }
#endif
}
```

```cpp
#include <hip/hip_runtime.h>
#include <hip/hip_bf16.h>
#include <cstdio>
#include <cstdint>
#include <cmath>
__device__ __forceinline__ int mk_lane() { int l = (int)__builtin_amdgcn_mbcnt_hi(~0u, __builtin_amdgcn_mbcnt_lo(~0u, 0u)); asm volatile("" : "+v"(l)); return l; }
namespace pg8 {
#define PG8_LAS __attribute__((address_space(3)))
typedef unsigned short bf16_t;
typedef short bf16x8 __attribute__((ext_vector_type(8)));
typedef float f32x4 __attribute__((ext_vector_type(4)));
typedef unsigned u32x4 __attribute__((ext_vector_type(4)));
constexpr int BM = 256, BK = 64, HALF = 128, HTB = HALF * BK * 2  , STAGE_BYTES = 8 * HTB, NXCD = 8, WGM = 8;

__host__ __device__ __forceinline__ int lds_byte(int r, int c) { const int st = (r >> 4) * 2 + (c >> 5), rr = r & 15, cc = c & 31, ob = rr * 64 + cc * 2; return st * 1024 + (ob ^ (((ob >> 9) & 1) << 5)); }
__host__ __device__ __forceinline__ void stage_rc(int b, int& R, int& C) { const int st = b / 1024, sb = b % 1024, swz = sb ^ (((sb >> 9) & 1) << 5); R = (st >> 1) * 16 + swz / 64; C = (st & 1) * 32 + (swz % 64) / 2; }
__host__ __device__ __forceinline__ int perm32(int rho) { const int n = rho >> 4, i = rho & 15; return 8 * (i >> 2) + 4 * n + (i & 3); }

struct Unit { int pm, pn, aux = 0, kt0 = 0, nt = 0, ks = 0, slot = 0; };
struct Gemm { const bf16_t* A; const bf16_t* Bt; int M, N, K; };

struct StaticOrder {
    static constexpr bool SPLITK = false;
    int nM, nN, nwg, G, c;
    __host__ __device__ void init(int M, int N, int G_, int c_) { nM = M / BM; nN = N / BM; nwg = nM * nN; G = G_; c = c_; }
    __host__ __device__ bool next(int i, Unit& u) const {
        const long L = (long)i * G + c; if (L >= nwg) return false;
        int wgid = (int)L; { const int q = nwg / NXCD, r = nwg % NXCD, xcd = wgid % NXCD, off = wgid / NXCD; wgid = (xcd < r ? xcd * (q + 1) : r * (q + 1) + (xcd - r) * q) + off; }
        const int nig = WGM * nN, gid = wgid / nig, fm = gid * WGM, gsz = (nM - fm) < WGM ? (nM - fm) : WGM;
        u.pm = fm + ((wgid % nig) % gsz); u.pn = (wgid % nig) / gsz; return true;
    }
    __device__ __forceinline__ void a_ready(const Unit&) const {}
    __device__ __forceinline__ void done(const Unit&) const {}
};

__device__ __forceinline__ unsigned cvt_pk_bf16(float lo, float hi) { unsigned r; asm volatile("v_cvt_pk_bf16_f32 %0, %1, %2" : "=v"(r) : "v"(lo), "v"(hi)); return r; }
typedef float f32x2 __attribute__((ext_vector_type(2)));
__device__ __forceinline__ f32x2 gelu_pk(f32x2 v) {
    const f32x2 av = __builtin_elementwise_abs(v), d = av * 0.2316418882f + 1.0f;
    f32x2 t; t.x = __builtin_amdgcn_rcpf(d.x); t.y = __builtin_amdgcn_rcpf(d.y);
    f32x2 q = t * 0.5307027145f + (-0.7265760135f); q = q * t + 0.7107068705f; q = q * t + (-0.142248368f); q = q * t + 0.127414796f; q = q * t;
    const f32x2 s = (v * v) * (-0.72134752044f);
    f32x2 e; e.x = __builtin_amdgcn_exp2f(s.x); e.y = __builtin_amdgcn_exp2f(s.y);
    const f32x2 m = v * (q * e), r = v - m;
    f32x2 o; o.x = v.x < 0.f ? m.x : r.x; o.y = v.y < 0.f ? m.y : r.y; return o;
}

template <int ACT  > struct EpiBf16 {
    static constexpr bool PERM = true, AFTER_DRAIN = false; static_assert(ACT == 0 || ACT == 1, "EpiBf16: ACT is 0 (none) or 1 (gelu_pk)");
    bf16_t* O; int ldc; const float* bias; int split_cols; size_t split_stride; float scale0;
    __device__ __forceinline__ void operator()(const f32x4 (&acc)[2][2][4][2], const Unit& u, int wr, int wc, int fr, int fq) const {
        const int row0 = u.pm * BM + wr * 64 + fr; int colt = u.pn * BM; bf16_t* base = O;
        float sc = 1.f; if (split_cols) { const int t = colt / split_cols; base += (size_t)t * split_stride; colt -= t * split_cols; if (t == 0) sc = scale0; }
        const int col0 = colt + wc * 32 + 8 * fq, bcol0 = u.pn * BM + wc * 32 + 8 * fq;
        f32x4 bv[2][2];
#pragma unroll
        for (int bj = 0; bj < 2; ++bj)
#pragma unroll
            for (int n = 0; n < 2; ++n) bv[bj][n] = bias ? *(const f32x4*)(bias + bcol0 + bj * HALF + 4 * n) : (f32x4){0.f, 0.f, 0.f, 0.f};
#pragma unroll
        for (int ai = 0; ai < 2; ++ai)
#pragma unroll
            for (int m = 0; m < 4; ++m) { bf16_t* rowp = base + (size_t)(row0 + ai * HALF + m * 16) * ldc + col0;
#pragma unroll
                for (int bj = 0; bj < 2; ++bj) { f32x4 v0 = acc[ai][bj][m][0] + bv[bj][0], v1 = acc[ai][bj][m][1] + bv[bj][1];
                    if (ACT == 1) { f32x2 a = gelu_pk((f32x2){v0[0], v0[1]}), b = gelu_pk((f32x2){v0[2], v0[3]}), c = gelu_pk((f32x2){v1[0], v1[1]}), d = gelu_pk((f32x2){v1[2], v1[3]});
                        v0 = (f32x4){a.x, a.y, b.x, b.y}; v1 = (f32x4){c.x, c.y, d.x, d.y}; }
                    v0 = v0 * sc; v1 = v1 * sc; u32x4 w; w.x = cvt_pk_bf16(v0[0], v0[1]); w.y = cvt_pk_bf16(v0[2], v0[3]); w.z = cvt_pk_bf16(v1[0], v1[1]); w.w = cvt_pk_bf16(v1[2], v1[3]);
                    *(u32x4*)(rowp + bj * HALF) = w; } }
    }
};

typedef int v8i_t __attribute__((ext_vector_type(8))); typedef int v4i_t __attribute__((ext_vector_type(4)));
__device__ __forceinline__ v8i_t cat8(const bf16x8& a, const bf16x8& b) { return __builtin_shufflevector(__builtin_bit_cast(v4i_t, a), __builtin_bit_cast(v4i_t, b), 0, 1, 2, 3, 4, 5, 6, 7); }
template <class Epi, class Sched, bool ALIGN_EPI = false, bool SP2 = false, bool FP8 = false>
__device__ __forceinline__ void gemm_phase(PG8_LAS unsigned char* lds, const Gemm g, const Sched& S, const Epi& E, const int wv  ) {
    const int lane = mk_lane(), wid = wv, tid = wv * 64 + lane, wr = wid >> 2, wc = wid & 3, fr = lane & 15, fq = lane >> 4;
    const int K = g.K, nt = K / BK;
    unsigned voffA[2], voffB[2];
#pragma unroll
    for (int i = 0; i < 2; ++i) { int R, C; stage_rc(tid * 16 + i * 8192, R, C); const int Rb = Epi::PERM ? ((R & ~31) + perm32(R & 31)) : R;
        voffA[i] = (unsigned)(R * K + C) * 2u; voffB[i] = (unsigned)(Rb * K + C) * 2u; }
    const size_t kstep = (size_t)(BK * 2);
    const size_t hstep = (size_t)HALF * K * 2;
    const size_t tstep = 2 * hstep;
    const unsigned ldsw = (unsigned)wid * 1024u;
    const int aoff = lds_byte(wr * 64 + fr, fq * 8), boff = lds_byte(wc * 32 + fr, fq * 8);
#define PG8_SA(b, h) (((b) * 2 + (h)) * HTB)
#define PG8_SB(b, h) ((4 + (b) * 2 + (h)) * HTB)
#define PG8_STAGE(bufoff, gbase, voff) do { _Pragma("unroll") for (int _i = 0; _i < 2; ++_i) \
        __builtin_amdgcn_global_load_lds((const unsigned*)((const char*)(gbase) + (voff)[_i]), (PG8_LAS unsigned*)(lds + (bufoff) + ldsw + _i * 8192), 16, 0, 0); } while (0)
#define PG8_LDA(dst, b, h) do { _Pragma("unroll") for (int m = 0; m < 4; ++m) _Pragma("unroll") for (int k = 0; k < 2; ++k) dst[m][k] = *(const PG8_LAS bf16x8*)(lds + PG8_SA(b, h) + aoff + m * 2048 + k * 1024); } while (0)
#define PG8_LDB(dst, b, h) do { _Pragma("unroll") for (int n = 0; n < 2; ++n) _Pragma("unroll") for (int k = 0; k < 2; ++k) dst[n][k] = *(const PG8_LAS bf16x8*)(lds + PG8_SB(b, h) + boff + n * 2048 + k * 1024); } while (0)
#define PG8_MMA(ai, bj, At, Bt) do { __builtin_amdgcn_s_setprio(1); \
        if constexpr (FP8) { asm volatile("s_nop 1" ::: ); _Pragma("unroll") for (int m = 0; m < 4; ++m) _Pragma("unroll") for (int n = 0; n < 2; ++n) \
            asm volatile("v_mfma_scale_f32_16x16x128_f8f6f4 %0, %1, %2, %0, %3, %3 op_sel_hi:[0,0,0]" : "+v"(acc[ai][bj][m][n]) : "v"(cat8(Bt[n][0], Bt[n][1])), "v"(cat8(At[m][0], At[m][1])), "v"(sc_one)); } \
        else { _Pragma("unroll") for (int m = 0; m < 4; ++m) _Pragma("unroll") for (int n = 0; n < 2; ++n) _Pragma("unroll") for (int k = 0; k < 2; ++k) \
            acc[ai][bj][m][n] = __builtin_amdgcn_mfma_f32_16x16x32_bf16(Bt[n][k], At[m][k], acc[ai][bj][m][n], 0, 0, 0); } \
        __builtin_amdgcn_s_setprio(0); } while (0)
#define PG8_WAIT_V(n) asm volatile("s_waitcnt vmcnt(" #n ")" ::: "memory")
#define PG8_WAIT_L(n) asm volatile("s_waitcnt lgkmcnt(" #n ")" ::: "memory")
#define PG8_BAR __builtin_amdgcn_s_barrier()
#define PG8_SCHED __builtin_amdgcn_sched_barrier(0)
    Unit cur, nxt; int ui = 0;
    if (!S.next(0, cur)) return;
    unsigned sc_one = 0x7f7f7f7fu; asm volatile("" : "+v"(sc_one));
    (void)sc_one;
    f32x4 acc[2][2][4][2];
#pragma unroll
    for (int a = 0; a < 2; ++a)
#pragma unroll
        for (int b = 0; b < 2; ++b)
#pragma unroll
            for (int m = 0; m < 4; ++m)
#pragma unroll
                for (int n = 0; n < 2; ++n) acc[a][b][m][n] = (f32x4){0.f, 0.f, 0.f, 0.f};
    bf16x8 At[4][2], B0[2][2], B1[2][2];
    const char* cA = (const char*)g.A + (size_t)cur.pm * tstep; const char* cB = (const char*)g.Bt + (size_t)cur.pn * tstep;
    if constexpr (Sched::SPLITK) { cA += (size_t)cur.kt0 * kstep; cB += (size_t)cur.kt0 * kstep; }
    S.a_ready(cur);
    if constexpr (SP2) {
        PG8_STAGE(PG8_SB(0, 0), cB, voffB); PG8_STAGE(PG8_SB(0, 1), cB + hstep, voffB); PG8_STAGE(PG8_SA(0, 0), cA, voffA); PG8_STAGE(PG8_SA(0, 1), cA + hstep, voffA);
        if (wr == 1) PG8_BAR;
        PG8_WAIT_V(2); PG8_BAR;
        PG8_STAGE(PG8_SB(1, 0), cB + kstep, voffB); PG8_STAGE(PG8_SA(1, 0), cA + kstep, voffA); PG8_STAGE(PG8_SB(1, 1), cB + hstep + kstep, voffB);
        PG8_WAIT_V(6); PG8_BAR;
    } else {
        PG8_STAGE(PG8_SB(0, 0), cB, voffB); PG8_STAGE(PG8_SA(0, 0), cA, voffA); PG8_STAGE(PG8_SB(0, 1), cB + hstep, voffB); PG8_STAGE(PG8_SA(0, 1), cA + hstep, voffA);
        if (wr == 1) PG8_BAR;
        PG8_WAIT_V(4); PG8_BAR;
        PG8_STAGE(PG8_SB(1, 0), cB + kstep, voffB); PG8_STAGE(PG8_SA(1, 0), cA + kstep, voffA); PG8_STAGE(PG8_SB(1, 1), cB + hstep + kstep, voffB);
        PG8_WAIT_V(6); PG8_BAR;
    }
    for (;;) {
        const bool has_next = S.next(ui + 1, nxt);
        const char* nA = has_next ? (const char*)g.A + (size_t)nxt.pm * tstep : cA; const char* nB = has_next ? (const char*)g.Bt + (size_t)nxt.pn * tstep : cB;
        if constexpr (Sched::SPLITK) { if (has_next) { nA += (size_t)nxt.kt0 * kstep; nB += (size_t)nxt.kt0 * kstep; } }
        const int cnt = Sched::SPLITK ? cur.nt : nt;
        for (int t = 0; t < cnt; t += 2) {
            const bool last = (t == cnt - 2);
            const char* a1 = cA + (size_t)(t + 1) * kstep;
            const char* a2 = last ? nA : cA + (size_t)(t + 2) * kstep; const char* b2 = last ? nB : cB + (size_t)(t + 2) * kstep;
            const char* a3 = a2 + kstep; const char* b3 = b2 + kstep;
            if (last && has_next) S.a_ready(nxt);
            if constexpr (SP2) {
            PG8_LDB(B0, 0, 0); PG8_LDB(B1, 0, 1); PG8_SCHED; PG8_LDA(At, 0, 0); PG8_STAGE(PG8_SA(1, 1), a1 + hstep, voffA);
            PG8_WAIT_V(8); PG8_WAIT_L(0); PG8_BAR; PG8_MMA(0, 0, At, B0); PG8_MMA(0, 1, At, B1); PG8_BAR; PG8_SCHED;
            PG8_LDA(At, 0, 1); PG8_STAGE(PG8_SB(0, 0), b2, voffB); PG8_STAGE(PG8_SB(0, 1), b2 + hstep, voffB); PG8_STAGE(PG8_SA(0, 0), a2, voffA);
            PG8_WAIT_V(8); PG8_WAIT_L(0); PG8_BAR; PG8_MMA(1, 0, At, B0); PG8_MMA(1, 1, At, B1); PG8_BAR; PG8_SCHED;
            PG8_LDB(B0, 1, 0); PG8_LDB(B1, 1, 1); PG8_SCHED; PG8_LDA(At, 1, 0); PG8_STAGE(PG8_SA(0, 1), a2 + hstep, voffA);
            PG8_WAIT_V(8); PG8_WAIT_L(0); PG8_BAR; PG8_MMA(0, 0, At, B0); PG8_MMA(0, 1, At, B1); PG8_BAR; PG8_SCHED;
            PG8_LDA(At, 1, 1); PG8_STAGE(PG8_SB(1, 0), b3, voffB); PG8_STAGE(PG8_SB(1, 1), b3 + hstep, voffB); PG8_STAGE(PG8_SA(1, 0), a3, voffA);
            PG8_WAIT_V(8); PG8_WAIT_L(0); PG8_BAR; PG8_MMA(1, 0, At, B0); PG8_MMA(1, 1, At, B1); PG8_BAR; PG8_SCHED;
            } else {
            PG8_LDB(B0, 0, 0); PG8_SCHED; PG8_LDA(At, 0, 0); PG8_STAGE(PG8_SA(1, 1), a1 + hstep, voffA);
            PG8_WAIT_L(8); PG8_BAR; PG8_WAIT_L(0); PG8_MMA(0, 0, At, B0); PG8_BAR; PG8_SCHED;
            PG8_LDB(B1, 0, 1); PG8_STAGE(PG8_SB(0, 0), b2, voffB);
            PG8_BAR; PG8_WAIT_L(0); PG8_MMA(0, 1, At, B1); PG8_BAR;
            PG8_LDA(At, 0, 1); PG8_STAGE(PG8_SA(0, 0), a2, voffA);
            PG8_BAR; PG8_WAIT_L(0); PG8_MMA(1, 0, At, B0); PG8_BAR; PG8_SCHED;
            PG8_STAGE(PG8_SB(0, 1), b2 + hstep, voffB);
            PG8_WAIT_V(6); PG8_BAR; PG8_MMA(1, 1, At, B1); PG8_BAR;
            PG8_LDB(B0, 1, 0); PG8_SCHED; PG8_LDA(At, 1, 0); PG8_STAGE(PG8_SA(0, 1), a2 + hstep, voffA);
            PG8_WAIT_L(8); PG8_BAR; PG8_WAIT_L(0); PG8_MMA(0, 0, At, B0); PG8_BAR; PG8_SCHED;
            PG8_LDB(B1, 1, 1); PG8_STAGE(PG8_SB(1, 0), b3, voffB);
            PG8_BAR; PG8_WAIT_L(0); PG8_MMA(0, 1, At, B1); PG8_BAR;
            PG8_LDA(At, 1, 1); PG8_STAGE(PG8_SA(1, 0), a3, voffA);
            PG8_BAR; PG8_WAIT_L(0); PG8_MMA(1, 0, At, B0); PG8_BAR; PG8_SCHED;
            PG8_STAGE(PG8_SB(1, 1), b3 + hstep, voffB);
            PG8_WAIT_V(6); PG8_BAR; PG8_MMA(1, 1, At, B1); PG8_BAR;
            }
        }
        if constexpr (FP8) asm volatile("s_nop 15\n\ts_nop 15" ::: );
        if constexpr (ALIGN_EPI) { if (wr == 0) PG8_BAR; }
        if constexpr (!Epi::AFTER_DRAIN) { E(acc, cur, wr, wc, fr, fq); S.done(cur); }
        if (!has_next) break;
#pragma unroll
        for (int a = 0; a < 2; ++a)
#pragma unroll
            for (int b = 0; b < 2; ++b)
#pragma unroll
                for (int m = 0; m < 4; ++m)
#pragma unroll
                    for (int n = 0; n < 2; ++n) acc[a][b][m][n] = (f32x4){0.f, 0.f, 0.f, 0.f};
        cur = nxt; cA = nA; cB = nB; ++ui;
        if constexpr (ALIGN_EPI) { if (wr == 1) PG8_BAR; }
    }
    PG8_WAIT_V(0);
    if constexpr (!ALIGN_EPI) { if (wr == 0) PG8_BAR; }
    PG8_BAR;
    if constexpr (Epi::AFTER_DRAIN) { E.fused(acc, cur, wr, wc, fr, fq, lds, wid, lane); S.done(cur); }
#undef PG8_SA
#undef PG8_SB
#undef PG8_STAGE
#undef PG8_LDA
#undef PG8_LDB
#undef PG8_MMA
#undef PG8_WAIT_V
#undef PG8_WAIT_L
#undef PG8_BAR
#undef PG8_SCHED
}
}
#include <hip/hip_bf16.h>
#include <cmath>
namespace attn_body {
using bf16=__hip_bfloat16;
using bf16x8=__attribute__((ext_vector_type(8)))short;
using s16x4=__attribute__((ext_vector_type(4)))short;
using f32x16=__attribute__((ext_vector_type(16)))float;
using u32x4=__attribute__((ext_vector_type(4)))unsigned;
constexpr int SEQ=4096,D=64,PITCH=5888,OPITCH=1536;
constexpr int NW=8,QBLK=32,QB=QBLK*NW,KVBLK=64,NQB=SEQ/QB;
constexpr int ATTN_UNIT_ROWS=QB;
__device__ __forceinline__ int crow(int r,int hi){return (r&3)+8*(r>>2)+4*hi;}
#define SBAR() __builtin_amdgcn_sched_barrier(0)
__device__ __forceinline__ void cmask(f32x16&p0,f32x16&p1,int jb,int qrel,int hi){
  const float NEG=-INFINITY; int kb=64*jb+4*hi;
  #pragma unroll
  for(int r=0;r<16;++r){int kv=kb+(r&3)+8*(r>>2); if(kv>qrel)p0[r]=NEG; if(kv+32>qrel)p1[r]=NEG;}
}

constexpr int NSLOT=3, SLOTB=8192;
constexpr int LDS_K=0, LDS_V=NSLOT*SLOTB, LDS_WS=2*NSLOT*SLOTB, LDS_OST=LDS_WS+NW*64*4, LDS_BYTES=LDS_OST+NW*4096;
constexpr float C2=0.125f*1.4426950408889634f;
__device__ __forceinline__ void glds16(const void*gsrc,unsigned lds_dst){unsigned keep;
  asm volatile("s_mov_b32 %0, m0\n\ts_mov_b32 m0, %2\n\ts_nop 0\n\tglobal_load_lds_dwordx4 %1, off\n\ts_mov_b32 m0, %0":"=&s"(keep):"v"(gsrc),"s"(lds_dst):"memory");}
__device__ __forceinline__ void glds16s(const void*sbase,unsigned voff,unsigned lds_dst){unsigned keep;
  asm volatile("s_mov_b32 %0, m0\n\ts_mov_b32 m0, %3\n\ts_nop 0\n\tglobal_load_lds_dwordx4 %1, %2\n\ts_mov_b32 m0, %0":"=&s"(keep):"v"(voff),"s"(sbase),"s"(lds_dst):"memory");}
__device__ __forceinline__ float max3f(float a,float b,float c){float r;asm("v_max3_f32 %0, %1, %2, %3":"=v"(r):"v"(a),"v"(b),"v"(c));return r;}
__device__ __forceinline__ float max2f(float a,float b){float r;asm("v_max_f32_e32 %0, %1, %2":"=v"(r):"v"(a),"v"(b));return r;}
__device__ __forceinline__ float fadd_s(float a,float b){float r;asm("v_add_f32_e32 %0, %1, %2":"=v"(r):"v"(a),"v"(b));return r;}
__device__ __forceinline__ float fsub_s(float a,float b){float r;asm("v_sub_f32_e32 %0, %1, %2":"=v"(r):"v"(a),"v"(b));return r;}
typedef float f32x2_t __attribute__((ext_vector_type(2))); typedef __bf16 bf16x2_t __attribute__((ext_vector_type(2)));
__device__ __forceinline__ unsigned cvtpk_s(float lo,float hi){f32x2_t v={lo,hi};bf16x2_t b=__builtin_convertvector(v,bf16x2_t);return __builtin_bit_cast(unsigned,b);}
#define WAIT_BAR(N) asm volatile("s_waitcnt vmcnt(" #N ") lgkmcnt(0)\n\ts_barrier":::"memory")

__device__ __forceinline__ void qkt(f32x16&p0,f32x16&p1,const char*Kslot,const bf16x8*qr,const f32x16&negm,int r32,int hi){
  const char*kb=Kslot+hi*1024+r32*16;
  #pragma unroll
  for(int d0=0;d0<4;++d0){
    const bf16x8 b0=*reinterpret_cast<const bf16x8*>(kb+d0*2048);
    const bf16x8 b1=*reinterpret_cast<const bf16x8*>(kb+d0*2048+512);
    if(d0==0){p0=__builtin_amdgcn_mfma_f32_32x32x16_bf16(b0,qr[0],negm,0,0,0);p1=__builtin_amdgcn_mfma_f32_32x32x16_bf16(b1,qr[0],negm,0,0,0);}
    else{p0=__builtin_amdgcn_mfma_f32_32x32x16_bf16(b0,qr[d0],p0,0,0,0);p1=__builtin_amdgcn_mfma_f32_32x32x16_bf16(b1,qr[d0],p1,0,0,0);}}
}
typedef __attribute__((address_space(3))) const char* lds_cptr;
typedef short v4i16_t __attribute__((ext_vector_type(4)));
__device__ __forceinline__ void kload8(bf16x8*kf,lds_cptr kp){
  kf[0]=*(const __attribute__((address_space(3))) bf16x8*)(kp);      kf[1]=*(const __attribute__((address_space(3))) bf16x8*)(kp+512);
  kf[2]=*(const __attribute__((address_space(3))) bf16x8*)(kp+2048); kf[3]=*(const __attribute__((address_space(3))) bf16x8*)(kp+2560);
  kf[4]=*(const __attribute__((address_space(3))) bf16x8*)(kp+4096); kf[5]=*(const __attribute__((address_space(3))) bf16x8*)(kp+4608);
  kf[6]=*(const __attribute__((address_space(3))) bf16x8*)(kp+6144); kf[7]=*(const __attribute__((address_space(3))) bf16x8*)(kp+6656);
}
__device__ __forceinline__ void kload2(bf16x8*kf,lds_cptr kp,int j){ kf[2*j]=*(const __attribute__((address_space(3))) bf16x8*)(kp+j*2048); kf[2*j+1]=*(const __attribute__((address_space(3))) bf16x8*)(kp+j*2048+512); }
__device__ __forceinline__ s16x4 vtr(lds_cptr p){ return __builtin_bit_cast(s16x4,__builtin_amdgcn_ds_read_tr16_b64_v4i16((__attribute__((address_space(3))) v4i16_t*)p)); }
__device__ __forceinline__ float rowmax(const f32x16&p0,const f32x16&p1){
  float a=max3f(p0[0],p0[1],p1[0]),b=max3f(p0[2],p0[3],p1[1]);a=max3f(a,p1[2],p1[3]);
  #pragma unroll
  for(int r=4;r<16;r+=4){a=max3f(a,p0[r],p0[r+1]);b=max3f(b,p0[r+2],p0[r+3]);a=max3f(a,p1[r],p1[r+1]);b=max3f(b,p1[r+2],p1[r+3]);}
  const float m=max2f(a,b);
  auto rr=__builtin_amdgcn_permlane32_swap(__float_as_uint(m),__float_as_uint(m),false,false);
  return max2f(__uint_as_float(rr[0]),__uint_as_float(rr[1]));
}
__device__ __forceinline__ void pv(f32x16*o,int vb,bf16x8 pa0,bf16x8 pa1,bf16x8 pa2,bf16x8 pa3){
  #pragma unroll
  for(int d0=0;d0<2;++d0){s16x4 lo[4],hi[4];
    #pragma unroll
    for(int ks=0;ks<4;++ks){
      asm volatile("ds_read_b64_tr_b16 %0,%1 offset:%c2":"=&v"(lo[ks]):"v"(vb),"i"(d0*4096+ks*1024):"memory");
      asm volatile("ds_read_b64_tr_b16 %0,%1 offset:%c2":"=&v"(hi[ks]):"v"(vb),"i"(d0*4096+ks*1024+512):"memory");}
    asm volatile("s_waitcnt lgkmcnt(0)":::"memory");SBAR();
    #define PK(k) (bf16x8){lo[k][0],lo[k][1],lo[k][2],lo[k][3],hi[k][0],hi[k][1],hi[k][2],hi[k][3]}
    o[d0]=__builtin_amdgcn_mfma_f32_32x32x16_bf16(pa0,PK(0),o[d0],0,0,0);
    o[d0]=__builtin_amdgcn_mfma_f32_32x32x16_bf16(pa1,PK(1),o[d0],0,0,0);
    o[d0]=__builtin_amdgcn_mfma_f32_32x32x16_bf16(pa2,PK(2),o[d0],0,0,0);
    o[d0]=__builtin_amdgcn_mfma_f32_32x32x16_bf16(pa3,PK(3),o[d0],0,0,0);
    #undef PK
  }
}

#ifndef ATTN_STORE16
#define ATTN_STORE16(p,v) (*(u32x4*)(p)=(v))
#endif
template<int THRL> __device__ __forceinline__ void attn_unit(int qb,const bf16*Qh,const bf16*__restrict__ Kh,const bf16*__restrict__ Vh,bf16*Oh,char*shm,const int wv){
  const int lane=mk_lane(),r32=lane&31,hi=lane>>5; const int wid=wv;
  const int q0=qb*QB;
  const bf16*Qw=Qh+(long)(q0+wid*QBLK)*PITCH;
  const unsigned lds0=(unsigned)(uintptr_t)shm;
  float*wsf=(float*)(shm+LDS_WS)+wid*64;
  const bf16*ksrc=Kh+(long)lane*PITCH+wid*8;
  const bf16*vsrc=Vh+(long)(16*(wid&3)+(lane>>2))*PITCH+(wid>>2)*32+(lane&3)*8;
  const unsigned kdst=lds0+LDS_K+wid*1024, vdst=lds0+LDS_V+wid*1024;
  #define DMA_K(t,slot) glds16(ksrc+(long)(t)*KVBLK*PITCH,(unsigned)__builtin_amdgcn_readfirstlane(kdst+(slot)))
  #define DMA_V(t,slot) glds16(vsrc+(long)(t)*KVBLK*PITCH,(unsigned)__builtin_amdgcn_readfirstlane(vdst+(slot)))
  const int vb0=(int)(lds0+LDS_V)+((lane>>4)&1)*32+(lane&3)*8+(4*hi+((lane&15)>>2))*64;
  const char*Kbase=shm+LDS_K; bf16x8 kf[8];
  const lds_cptr shm3=(lds_cptr)shm; const lds_cptr kp0=shm3+LDS_K+hi*1024+r32*16; const lds_cptr vp0=shm3+LDS_V+((lane>>4)&1)*32+(lane&3)*8+(4*hi+((lane&15)>>2))*64;
  const int NT=(q0+QB)/KVBLK;
  DMA_K(0,0);DMA_V(0,0);DMA_K(1,SLOTB);
  bf16x8 qr[4];
  #pragma unroll
  for(int d0=0;d0<4;++d0)qr[d0]=*reinterpret_cast<const bf16x8*>(&Qw[(long)r32*PITCH+d0*16+hi*8]);
  float mhat=0.f,l_reg=0.f;f32x16 o[2];o[0]=f32x16{};o[1]=f32x16{};f32x16 negm=f32x16{};asm volatile("":"+v"(negm));
  const int qrel=wid*QBLK+r32;
  #define CMASK(P0,P1,t) do{int jb_=(t)-(NT-4); if(jb_>=0)cmask(P0,P1,jb_,qrel,hi);}while(0)
  bool resc=false;
  #define START(P0,P1) do{ const float rm=rowmax(P0,P1); resc=false; \
    { const float dl=rm; mhat=fadd_s(mhat,dl); \
      _Pragma("unroll") for(int r=0;r<16;++r){P0[r]=fsub_s(P0[r],dl);P1[r]=fsub_s(P1[r],dl);} \
      _Pragma("unroll") for(int r=0;r<16;++r)negm[r]=-mhat; asm volatile("":"+v"(negm)); } \
    _Pragma("unroll") for(int r=0;r<16;++r)P0[r]=__builtin_amdgcn_exp2f(P0[r]); }while(0)
  #define RESC() do{ if(resc){ asm volatile("s_waitcnt lgkmcnt(0)":::"memory"); \
      _Pragma("unroll") for(int d_=0;d_<2;++d_) _Pragma("unroll") for(int r=0;r<16;++r)o[d_][r]*=wsf[crow(r,hi)]; } }while(0)
  f32x16 pA0,pA1,pB0,pB1;
  int sl_prev=0,sl_cur=0,sl_next=SLOTB;
  #define ROT() do{sl_prev=sl_cur;sl_cur=sl_next;sl_next=(sl_next==(NSLOT-1)*SLOTB)?0:sl_next+SLOTB;}while(0)
  DMA_K(2,2*SLOTB);
  WAIT_BAR(3);
  qkt(pA0,pA1,Kbase,qr,negm,r32,hi);asm volatile("s_nop 15\n\ts_nop 7":"+v"(pA0),"+v"(pA1));CMASK(pA0,pA1,0);
  START(pA0,pA1);
  _Pragma("unroll") for(int r=0;r<16;++r)pA1[r]=__builtin_amdgcn_exp2f(pA1[r]);
  WAIT_BAR(0);
  DMA_K(3,0);DMA_V(1,SLOTB);
  ROT();
  kload8(kf,kp0+sl_cur);
  WAIT_BAR(2);
  s16x4 vlo[8],vhi[8]; u32x4 pw0,pw1,pw2,pw3;
  #define PKW(P,B) cvtpk_s(P[B],P[B+1])
  #define PAF(k) __builtin_bit_cast(bf16x8,pw##k)
  #define VFR(i) (bf16x8){vlo[i][0],vlo[i][1],vlo[i][2],vlo[i][3],vhi[i][0],vhi[i][1],vhi[i][2],vhi[i][3]}
  #define PIN(x) asm volatile("":"+v"(x))
  #define MX3(a,b,c) __builtin_fmaxf(__builtin_fmaxf((a),(b)),(c))
  #define GAPA(MF,A0,A1,A2,A3,W0,W1,PW) do{ MF; sacc+=A0; sacc+=A1; sacc+=A2; sacc+=A3; PIN(sacc); W0; W1; PIN(PW); SBAR(); }while(0)
  #define EX(v) __builtin_amdgcn_exp2f(v)
  #define GAPB(MF,X,B) do{ MF; X[B]=EX(X[B]); X[B+1]=EX(X[B+1]); X[B+2]=EX(X[B+2]); X[B+3]=EX(X[B+3]); PIN(X); SBAR(); }while(0)
  #define VRD(i) do{ vlo[i]=vtr(vp_+(((i)>>2)*4096+((i)&3)*1024)); vhi[i]=vtr(vp_+(((i)>>2)*4096+((i)&3)*1024+512)); }while(0)
  #define KRD(G,j) do{ if(G){ kload2(kf,kp0+sl_next,j); SBAR(); } }while(0)
  #define STEP(C0,C1,P0,P1,t,GK,GV,GL) do{ SBAR(); \
    const lds_cptr vp_=vp0+sl_prev; \
    VRD(0); SBAR(); float sacc=(P0[0]+P0[1]); \
    GAPA(C0=__builtin_amdgcn_mfma_f32_32x32x16_bf16(kf[0],qr[0],negm,0,0,0), P0[2],P0[3],P0[4],P0[5],     pw0[0]=PKW(P0,0), pw0[1]=PKW(P0,2), pw0); \
    VRD(4); SBAR(); GAPA(C1=__builtin_amdgcn_mfma_f32_32x32x16_bf16(kf[1],qr[0],negm,0,0,0), P0[6],P0[7],P0[8],P0[9],     pw0[2]=PKW(P0,4), pw0[3]=PKW(P0,6), pw0); \
    VRD(1); SBAR(); GAPA(C0=__builtin_amdgcn_mfma_f32_32x32x16_bf16(kf[2],qr[1],C0,0,0,0),   P0[10],P0[11],P0[12],P0[13], pw1[0]=PKW(P0,8), pw1[1]=PKW(P0,10), pw1); \
    VRD(5); SBAR(); GAPA(C1=__builtin_amdgcn_mfma_f32_32x32x16_bf16(kf[3],qr[1],C1,0,0,0),   P0[14],P0[15],P1[0],P1[1],   pw1[2]=PKW(P0,12),pw1[3]=PKW(P0,14), pw1); \
    VRD(2); SBAR(); GAPA(C0=__builtin_amdgcn_mfma_f32_32x32x16_bf16(kf[4],qr[2],C0,0,0,0),   P1[2],P1[3],P1[4],P1[5],     pw2[0]=PKW(P1,0), pw2[1]=PKW(P1,2), pw2); \
    VRD(6); SBAR(); GAPA(C1=__builtin_amdgcn_mfma_f32_32x32x16_bf16(kf[5],qr[2],C1,0,0,0),   P1[6],P1[7],P1[8],P1[9],     pw2[2]=PKW(P1,4), pw2[3]=PKW(P1,6), pw2); \
    VRD(3); SBAR(); GAPA(C0=__builtin_amdgcn_mfma_f32_32x32x16_bf16(kf[6],qr[3],C0,0,0,0),   P1[10],P1[11],P1[12],P1[13], pw3[0]=PKW(P1,8), pw3[1]=PKW(P1,10), pw3); \
    VRD(7); SBAR(); GAPA(C1=__builtin_amdgcn_mfma_f32_32x32x16_bf16(kf[7],qr[3],C1,0,0,0),   P1[14],P1[15],0.f,0.f,       pw3[2]=PKW(P1,12),pw3[3]=PKW(P1,14), pw3); \
    l_reg+=sacc; \
    if(GK){DMA_K((t)+3,sl_cur);} if(GV){DMA_V((t)+1,sl_next);} \
    CMASK(C0,C1,t); \
    { float a=MX3(C0[0],C0[1],C1[0]),b=MX3(C0[2],C0[3],C1[1]); a=MX3(a,C1[2],C1[3]); \
      _Pragma("unroll") for(int r=4;r<16;r+=4){a=MX3(a,C0[r],C0[r+1]);b=MX3(b,C0[r+2],C0[r+3]);a=MX3(a,C1[r],C1[r+1]);b=MX3(b,C1[r+2],C1[r+3]);} \
      float rm=__builtin_fmaxf(a,b); { auto rr=__builtin_amdgcn_permlane32_swap(__float_as_uint(rm),__float_as_uint(rm),false,false); rm=__builtin_fmaxf(__uint_as_float(rr[0]),__uint_as_float(rr[1])); } \
      resc=false; \
      if(__builtin_expect(__any(rm>(float)THRL),0)){ const float dl=__builtin_fmaxf(rm,0.f); mhat+=dl; \
        _Pragma("unroll") for(int r=0;r<16;++r){C0[r]-=dl;C1[r]-=dl;} \
        _Pragma("unroll") for(int r=0;r<16;++r)negm[r]=-mhat; asm volatile("":"+v"(negm)); \
        const float f=__builtin_amdgcn_exp2f(-dl); l_reg*=f; if(hi==0)wsf[r32]=f; resc=true; } } \
    SBAR(); \
    GAPB(o[0]=__builtin_amdgcn_mfma_f32_32x32x16_bf16(PAF(0),VFR(0),o[0],0,0,0), C0,0); \
    GAPB(o[1]=__builtin_amdgcn_mfma_f32_32x32x16_bf16(PAF(0),VFR(4),o[1],0,0,0), C0,4); \
    KRD(GL,0); GAPB(o[0]=__builtin_amdgcn_mfma_f32_32x32x16_bf16(PAF(1),VFR(1),o[0],0,0,0), C0,8); \
    KRD(GL,1); GAPB(o[1]=__builtin_amdgcn_mfma_f32_32x32x16_bf16(PAF(1),VFR(5),o[1],0,0,0), C0,12); \
    KRD(GL,2); GAPB(o[0]=__builtin_amdgcn_mfma_f32_32x32x16_bf16(PAF(2),VFR(2),o[0],0,0,0), C1,0); \
    KRD(GL,3); GAPB(o[1]=__builtin_amdgcn_mfma_f32_32x32x16_bf16(PAF(2),VFR(6),o[1],0,0,0), C1,4); \
    GAPB(o[0]=__builtin_amdgcn_mfma_f32_32x32x16_bf16(PAF(3),VFR(3),o[0],0,0,0), C1,8); \
    GAPB(o[1]=__builtin_amdgcn_mfma_f32_32x32x16_bf16(PAF(3),VFR(7),o[1],0,0,0), C1,12); \
    }while(0)
  int t=1;
  #undef CMASK
  #define CMASK(P0,P1,t) do{}while(0)
  for(;t+5<NT;t+=2){
    STEP(pB0,pB1,pA0,pA1,t,true,true,true);     WAIT_BAR(2); RESC(); ROT();
    STEP(pA0,pA1,pB0,pB1,t+1,true,true,true);   WAIT_BAR(2); RESC(); ROT();
  }
  #undef CMASK
  #define CMASK(P0,P1,t) do{int jb_=(t)-(NT-4); if(jb_>=0)cmask(P0,P1,jb_,qrel,hi);}while(0)
  #define ENDW(tt) do{ if((tt)+3<NT){WAIT_BAR(2);} else if((tt)+2<NT){WAIT_BAR(1);} else {WAIT_BAR(0);} }while(0)
  for(;t+1<NT;t+=2){
    STEP(pB0,pB1,pA0,pA1,t,(t+3<NT),(t+1<NT),(t+1<NT));       ENDW(t);   RESC(); ROT();
    STEP(pA0,pA1,pB0,pB1,t+1,(t+4<NT),(t+2<NT),(t+2<NT));     ENDW(t+1); RESC(); ROT();
  }
  STEP(pB0,pB1,pA0,pA1,NT-1,false,false,false); RESC();
  { float sacc=pB0[0]+pB0[1]; _Pragma("unroll") for(int r=2;r<16;++r)sacc+=pB0[r]; _Pragma("unroll") for(int r=0;r<16;++r)sacc+=pB1[r]; l_reg+=sacc;
    pw0=(u32x4){PKW(pB0,0),PKW(pB0,2),PKW(pB0,4),PKW(pB0,6)};pw1=(u32x4){PKW(pB0,8),PKW(pB0,10),PKW(pB0,12),PKW(pB0,14)};pw2=(u32x4){PKW(pB1,0),PKW(pB1,2),PKW(pB1,4),PKW(pB1,6)};pw3=(u32x4){PKW(pB1,8),PKW(pB1,10),PKW(pB1,12),PKW(pB1,14)};
    SBAR(); pv(o,vb0+sl_cur,PAF(0),PAF(1),PAF(2),PAF(3)); }
  #undef PKW
  #undef PAF
  #undef VFR
  #undef PIN
  #undef MX3
  #undef GAPA
  #undef GAPB
  #undef EX
  #undef VRD
  #undef KRD
  #undef STEP
  #undef ENDW
  {auto rr=__builtin_amdgcn_permlane32_swap(__float_as_uint(l_reg),__float_as_uint(l_reg),false,false);l_reg=__uint_as_float(rr[0])+__uint_as_float(rr[1]);}
  if(hi==0)wsf[32+r32]=l_reg;asm volatile("s_waitcnt lgkmcnt(0)":::"memory");
  float rli[16];
  #pragma unroll
  for(int r=0;r<16;++r)rli[r]=__builtin_amdgcn_rcpf(wsf[32+crow(r,hi)]);
  bf16*Ow=Oh+(long)(q0+wid*QBLK)*OPITCH;
  { bf16*stg=(bf16*)(shm+LDS_OST)+wid*2048;
    #pragma unroll
    for(int r=0;r<16;++r){const int orow=crow(r,hi);
      #pragma unroll
      for(int d0=0;d0<2;++d0)stg[orow*64+d0*32+r32]=__float2bfloat16(o[d0][r]*rli[r]);}
    asm volatile("s_waitcnt lgkmcnt(0)":::"memory");
    #pragma unroll
    for(int i=0;i<4;++i){const int row=i*8+(lane>>3),ch=lane&7; const u32x4 v=*(const u32x4*)(stg+row*64+ch*8); ATTN_STORE16(Ow+(long)row*OPITCH+ch*8,v);} }
  asm volatile("s_waitcnt lgkmcnt(0)\n\ts_barrier":::"memory");
  #undef DMA_K
  #undef DMA_V
  #undef CMASK
  #undef START
  #undef RESC
  #undef ROT
}
constexpr int LV_V=NSLOT*SLOTB, LV_WS=LV_V+NSLOT*2*SLOTB, LV_OST=LV_WS+NW*64*4, LV_BYTES=LV_OST+NW*8192;
__device__ __forceinline__ void pv4(f32x16*o,int vb,bf16x8 pa0,bf16x8 pa1,bf16x8 pa2,bf16x8 pa3){
  #pragma unroll
  for(int d0=0;d0<4;++d0){s16x4 lo[4],hi[4];
    #pragma unroll
    for(int ks=0;ks<4;++ks){
      asm volatile("ds_read_b64_tr_b16 %0,%1 offset:%c2":"=&v"(lo[ks]):"v"(vb),"i"(d0*4096+ks*1024):"memory");
      asm volatile("ds_read_b64_tr_b16 %0,%1 offset:%c2":"=&v"(hi[ks]):"v"(vb),"i"(d0*4096+ks*1024+512):"memory");}
    asm volatile("s_waitcnt lgkmcnt(0)":::"memory");SBAR();
    #define PK(k) (bf16x8){lo[k][0],lo[k][1],lo[k][2],lo[k][3],hi[k][0],hi[k][1],hi[k][2],hi[k][3]}
    o[d0]=__builtin_amdgcn_mfma_f32_32x32x16_bf16(pa0,PK(0),o[d0],0,0,0);
    o[d0]=__builtin_amdgcn_mfma_f32_32x32x16_bf16(pa1,PK(1),o[d0],0,0,0);
    o[d0]=__builtin_amdgcn_mfma_f32_32x32x16_bf16(pa2,PK(2),o[d0],0,0,0);
    o[d0]=__builtin_amdgcn_mfma_f32_32x32x16_bf16(pa3,PK(3),o[d0],0,0,0);
    #undef PK
  }
}
#ifndef ATTN_STORE16
#define ATTN_STORE16(p,v) (*(u32x4*)(p)=(v))
#endif
template<int THRL> __device__ __forceinline__ void attn_unit128(int qb,const bf16*Qh,const bf16*__restrict__ Kh,const bf16*__restrict__ Vh,bf16*Oh,char*shm,const int wv){
  const int lane=mk_lane(),r32=lane&31,hi=lane>>5; const int wid=wv;
  const int q0=qb*QB;
  const bf16*Qw=Qh+(long)(q0+wid*QBLK)*PITCH;
  const unsigned lds0=(unsigned)(uintptr_t)shm;
  float*wsf=(float*)(shm+LV_WS)+wid*64;
  const unsigned koff=(unsigned)((lane*PITCH+wid*8)*2), voff=(unsigned)(((16*(wid&3)+(lane>>2))*PITCH+(wid>>2)*32+(lane&3)*8)*2);
  const unsigned kdst=lds0+LDS_K+wid*1024, vdst=lds0+LV_V+wid*1024;
  #define DMA_K(t,slot) glds16s(Kh+(long)(t)*KVBLK*PITCH,koff,(unsigned)__builtin_amdgcn_readfirstlane(kdst+(slot)))
  #define DMA_V(t,slot) do{ glds16s(Vh+(long)(t)*KVBLK*PITCH,voff,(unsigned)__builtin_amdgcn_readfirstlane(vdst+2*(slot))); glds16s(Vh+64+(long)(t)*KVBLK*PITCH,voff,(unsigned)__builtin_amdgcn_readfirstlane(vdst+2*(slot)+8192)); }while(0)
  const char*Kbase=shm+LDS_K; bf16x8 kf[8];
  const lds_cptr shm3=(lds_cptr)shm; const lds_cptr kp0=shm3+LDS_K+hi*1024+r32*16; const lds_cptr vp0=shm3+LV_V+((lane>>4)&1)*32+(lane&3)*8+(4*hi+((lane&15)>>2))*64;
  const int NT=(q0+QB)/KVBLK;
  DMA_K(0,0);DMA_V(0,0);DMA_K(1,SLOTB);
  bf16x8 qr[4];
  #pragma unroll
  for(int d0=0;d0<4;++d0)qr[d0]=*reinterpret_cast<const bf16x8*>(&Qw[(long)r32*PITCH+d0*16+hi*8]);
  float mhat=0.f,l_reg=0.f;f32x16 o[4];o[0]=f32x16{};o[1]=f32x16{};o[2]=f32x16{};o[3]=f32x16{};const f32x16 zero16=f32x16{};
  const int qrel=wid*QBLK+r32;
  #define CMASK(P0,P1,t) do{int jb_=(t)-(NT-4); if(jb_>=0)cmask(P0,P1,jb_,qrel,hi);}while(0)
  bool resc=false;
  #define START(P0,P1) do{ const float rm=rowmax(P0,P1); resc=false; \
    { const float dl=rm; mhat=fadd_s(mhat,dl); \
      _Pragma("unroll") for(int r=0;r<16;++r){P0[r]=fsub_s(P0[r],dl);P1[r]=fsub_s(P1[r],dl);} \
      } \
    _Pragma("unroll") for(int r=0;r<16;++r)P0[r]=__builtin_amdgcn_exp2f(P0[r]); }while(0)
  #define RESC() do{ if(resc){ asm volatile("s_waitcnt lgkmcnt(0)":::"memory"); \
      _Pragma("unroll") for(int d_=0;d_<4;++d_) _Pragma("unroll") for(int r=0;r<16;++r)o[d_][r]*=wsf[crow(r,hi)]; } }while(0)
  f32x16 pA0,pA1,pB0,pB1;
  int sl_prev=0,sl_cur=0,sl_next=SLOTB;
  #define ROT() do{sl_prev=sl_cur;sl_cur=sl_next;sl_next=(sl_next==(NSLOT-1)*SLOTB)?0:sl_next+SLOTB;}while(0)
  DMA_K(2,2*SLOTB);
  WAIT_BAR(4);
  qkt(pA0,pA1,Kbase,qr,zero16,r32,hi);asm volatile("s_nop 15\n\ts_nop 7":"+v"(pA0),"+v"(pA1));CMASK(pA0,pA1,0);
  START(pA0,pA1);
  _Pragma("unroll") for(int r=0;r<16;++r)pA1[r]=__builtin_amdgcn_exp2f(pA1[r]);
  WAIT_BAR(0);
  DMA_K(3,0);DMA_V(1,SLOTB);
  ROT();
  kload8(kf,kp0+sl_cur);
  WAIT_BAR(3);
  s16x4 vq0lo,vq0hi,vq1lo,vq1hi,vq2lo,vq2hi; u32x4 pw0,pw1,pw2,pw3;
  #define PKW(P,B) cvtpk_s(P[B],P[B+1])
  #define PAF(k) __builtin_bit_cast(bf16x8,pw##k)
  #define VFQ(B) (bf16x8){B##lo[0],B##lo[1],B##lo[2],B##lo[3],B##hi[0],B##hi[1],B##hi[2],B##hi[3]}
  #define PIN(x) asm volatile("":"+v"(x))
  #define MX3(a,b,c) __builtin_fmaxf(__builtin_fmaxf((a),(b)),(c))
  #define GAPA(MF,A0,A1,A2,A3,W0,W1,PW) do{ MF; sacc+=A0; sacc+=A1; sacc+=A2; sacc+=A3; PIN(sacc); W0; W1; PIN(PW); SBAR(); }while(0)
  #define EX(v) __builtin_amdgcn_exp2f(v)
  #define GAPB(MF,X,B) do{ MF; X[B]=EX(X[B]); X[B+1]=EX(X[B+1]); PIN(X); SBAR(); }while(0)
  #define VRD(B,i) do{ B##lo=vtr(vp_+(((i)>>2)*4096+((i)&3)*1024)); B##hi=vtr(vp_+(((i)>>2)*4096+((i)&3)*1024+512)); SBAR(); }while(0)
  #define KRD(G,j) do{ if(G){ kload2(kf,kp0+sl_next,j); SBAR(); } }while(0)
  #define STEP(C0,C1,P0,P1,t,GK,GV,GL) do{ SBAR(); \
    const lds_cptr vp_=vp0+2*sl_prev; \
    float sacc=(P0[0]+P0[1]); \
    GAPA(C0=__builtin_amdgcn_mfma_f32_32x32x16_bf16(kf[0],qr[0],zero16,0,0,0), P0[2],P0[3],P0[4],P0[5],     pw0[0]=PKW(P0,0), pw0[1]=PKW(P0,2), pw0); \
    GAPA(C1=__builtin_amdgcn_mfma_f32_32x32x16_bf16(kf[1],qr[0],zero16,0,0,0), P0[6],P0[7],P0[8],P0[9],     pw0[2]=PKW(P0,4), pw0[3]=PKW(P0,6), pw0); \
    GAPA(C0=__builtin_amdgcn_mfma_f32_32x32x16_bf16(kf[2],qr[1],C0,0,0,0),   P0[10],P0[11],P0[12],P0[13], pw1[0]=PKW(P0,8), pw1[1]=PKW(P0,10), pw1); \
    GAPA(C1=__builtin_amdgcn_mfma_f32_32x32x16_bf16(kf[3],qr[1],C1,0,0,0),   P0[14],P0[15],P1[0],P1[1],   pw1[2]=PKW(P0,12),pw1[3]=PKW(P0,14), pw1); \
    GAPA(C0=__builtin_amdgcn_mfma_f32_32x32x16_bf16(kf[4],qr[2],C0,0,0,0),   P1[2],P1[3],P1[4],P1[5],     pw2[0]=PKW(P1,0), pw2[1]=PKW(P1,2), pw2); \
    GAPA(C1=__builtin_amdgcn_mfma_f32_32x32x16_bf16(kf[5],qr[2],C1,0,0,0),   P1[6],P1[7],P1[8],P1[9],     pw2[2]=PKW(P1,4), pw2[3]=PKW(P1,6), pw2); \
    VRD(vq0,0); GAPA(C0=__builtin_amdgcn_mfma_f32_32x32x16_bf16(kf[6],qr[3],C0,0,0,0),   P1[10],P1[11],P1[12],P1[13], pw3[0]=PKW(P1,8), pw3[1]=PKW(P1,10), pw3); \
    VRD(vq1,4); GAPA(C1=__builtin_amdgcn_mfma_f32_32x32x16_bf16(kf[7],qr[3],C1,0,0,0),   P1[14],P1[15],0.f,0.f,       pw3[2]=PKW(P1,12),pw3[3]=PKW(P1,14), pw3); \
    l_reg+=sacc; \
    _Pragma("unroll") for(int r=0;r<16;++r){C0[r]-=mhat;C1[r]-=mhat;} \
    if(GK){DMA_K((t)+3,sl_cur);} if(GV){DMA_V((t)+1,sl_next);} \
    CMASK(C0,C1,t); \
    { float a=MX3(C0[0],C0[1],C1[0]),b=MX3(C0[2],C0[3],C1[1]); a=MX3(a,C1[2],C1[3]); \
      _Pragma("unroll") for(int r=4;r<16;r+=4){a=MX3(a,C0[r],C0[r+1]);b=MX3(b,C0[r+2],C0[r+3]);a=MX3(a,C1[r],C1[r+1]);b=MX3(b,C1[r+2],C1[r+3]);} \
      float rm=__builtin_fmaxf(a,b); { auto rr=__builtin_amdgcn_permlane32_swap(__float_as_uint(rm),__float_as_uint(rm),false,false); rm=__builtin_fmaxf(__uint_as_float(rr[0]),__uint_as_float(rr[1])); } \
      resc=false; \
      if(__builtin_expect(__any(rm>(float)THRL),0)){ const float dl=__builtin_fmaxf(rm,0.f); mhat+=dl; \
        _Pragma("unroll") for(int r=0;r<16;++r){C0[r]-=dl;C1[r]-=dl;} \
        const float f=__builtin_amdgcn_exp2f(-dl); l_reg*=f; if(hi==0)wsf[r32]=f; resc=true; } } \
    SBAR(); \
    VRD(vq2,8); GAPB(o[0]=__builtin_amdgcn_mfma_f32_32x32x16_bf16(PAF(0),VFQ(vq0),o[0],0,0,0), C0,0); \
    VRD(vq0,12); GAPB(o[1]=__builtin_amdgcn_mfma_f32_32x32x16_bf16(PAF(0),VFQ(vq1),o[1],0,0,0), C0,2); \
    VRD(vq1,1); GAPB(o[2]=__builtin_amdgcn_mfma_f32_32x32x16_bf16(PAF(0),VFQ(vq2),o[2],0,0,0), C0,4); \
    VRD(vq2,5); GAPB(o[3]=__builtin_amdgcn_mfma_f32_32x32x16_bf16(PAF(0),VFQ(vq0),o[3],0,0,0), C0,6); \
    VRD(vq0,9); GAPB(o[0]=__builtin_amdgcn_mfma_f32_32x32x16_bf16(PAF(1),VFQ(vq1),o[0],0,0,0), C0,8); \
    VRD(vq1,13); GAPB(o[1]=__builtin_amdgcn_mfma_f32_32x32x16_bf16(PAF(1),VFQ(vq2),o[1],0,0,0), C0,10); \
    VRD(vq2,2); GAPB(o[2]=__builtin_amdgcn_mfma_f32_32x32x16_bf16(PAF(1),VFQ(vq0),o[2],0,0,0), C0,12); \
    VRD(vq0,6); GAPB(o[3]=__builtin_amdgcn_mfma_f32_32x32x16_bf16(PAF(1),VFQ(vq1),o[3],0,0,0), C0,14); \
    VRD(vq1,10); GAPB(o[0]=__builtin_amdgcn_mfma_f32_32x32x16_bf16(PAF(2),VFQ(vq2),o[0],0,0,0), C1,0); \
    VRD(vq2,14); GAPB(o[1]=__builtin_amdgcn_mfma_f32_32x32x16_bf16(PAF(2),VFQ(vq0),o[1],0,0,0), C1,2); \
    VRD(vq0,3); GAPB(o[2]=__builtin_amdgcn_mfma_f32_32x32x16_bf16(PAF(2),VFQ(vq1),o[2],0,0,0), C1,4); \
    VRD(vq1,7); GAPB(o[3]=__builtin_amdgcn_mfma_f32_32x32x16_bf16(PAF(2),VFQ(vq2),o[3],0,0,0), C1,6); \
    VRD(vq2,11); KRD(GL,0); GAPB(o[0]=__builtin_amdgcn_mfma_f32_32x32x16_bf16(PAF(3),VFQ(vq0),o[0],0,0,0), C1,8); \
    VRD(vq0,15); KRD(GL,1); GAPB(o[1]=__builtin_amdgcn_mfma_f32_32x32x16_bf16(PAF(3),VFQ(vq1),o[1],0,0,0), C1,10); \
    KRD(GL,2); GAPB(o[2]=__builtin_amdgcn_mfma_f32_32x32x16_bf16(PAF(3),VFQ(vq2),o[2],0,0,0), C1,12); \
    KRD(GL,3); GAPB(o[3]=__builtin_amdgcn_mfma_f32_32x32x16_bf16(PAF(3),VFQ(vq0),o[3],0,0,0), C1,14); \
    }while(0)
  int t=1;
  #undef CMASK
  #define CMASK(P0,P1,t) do{}while(0)
  for(;t+5<NT;t+=2){
    STEP(pB0,pB1,pA0,pA1,t,true,true,true);     WAIT_BAR(3); RESC(); ROT();
    STEP(pA0,pA1,pB0,pB1,t+1,true,true,true);   WAIT_BAR(3); RESC(); ROT();
  }
  #undef CMASK
  #define CMASK(P0,P1,t) do{int jb_=(t)-(NT-4); if(jb_>=0)cmask(P0,P1,jb_,qrel,hi);}while(0)
  #define ENDW(tt) do{ if((tt)+3<NT){WAIT_BAR(3);} else if((tt)+2<NT){WAIT_BAR(2);} else {WAIT_BAR(0);} }while(0)
  for(;t+1<NT;t+=2){
    STEP(pB0,pB1,pA0,pA1,t,(t+3<NT),(t+1<NT),(t+1<NT));       ENDW(t);   RESC(); ROT();
    STEP(pA0,pA1,pB0,pB1,t+1,(t+4<NT),(t+2<NT),(t+2<NT));     ENDW(t+1); RESC(); ROT();
  }
  STEP(pB0,pB1,pA0,pA1,NT-1,false,false,false); RESC();
  { float sacc=pB0[0]+pB0[1]; _Pragma("unroll") for(int r=2;r<16;++r)sacc+=pB0[r]; _Pragma("unroll") for(int r=0;r<16;++r)sacc+=pB1[r]; l_reg+=sacc;
    pw0=(u32x4){PKW(pB0,0),PKW(pB0,2),PKW(pB0,4),PKW(pB0,6)};pw1=(u32x4){PKW(pB0,8),PKW(pB0,10),PKW(pB0,12),PKW(pB0,14)};pw2=(u32x4){PKW(pB1,0),PKW(pB1,2),PKW(pB1,4),PKW(pB1,6)};pw3=(u32x4){PKW(pB1,8),PKW(pB1,10),PKW(pB1,12),PKW(pB1,14)};
    SBAR(); pv4(o,(int)(lds0+LV_V)+((lane>>4)&1)*32+(lane&3)*8+(4*hi+((lane&15)>>2))*64+2*sl_cur,PAF(0),PAF(1),PAF(2),PAF(3)); }
  #undef PKW
  #undef PAF
  #undef VFQ
  #undef PIN
  #undef MX3
  #undef GAPA
  #undef GAPB
  #undef EX
  #undef VRD
  #undef KRD
  #undef STEP
  #undef ENDW
  {auto rr=__builtin_amdgcn_permlane32_swap(__float_as_uint(l_reg),__float_as_uint(l_reg),false,false);l_reg=__uint_as_float(rr[0])+__uint_as_float(rr[1]);}
  if(hi==0)wsf[32+r32]=l_reg;asm volatile("s_waitcnt lgkmcnt(0)":::"memory");
  float rli[16];
  #pragma unroll
  for(int r=0;r<16;++r)rli[r]=__builtin_amdgcn_rcpf(wsf[32+crow(r,hi)]);
  bf16*Ow=Oh+(long)(q0+wid*QBLK)*OPITCH;
  { bf16*stg=(bf16*)(shm+LV_OST)+wid*4096;
    #pragma unroll
    for(int r=0;r<16;++r){const int orow=crow(r,hi);
      #pragma unroll
      for(int d0=0;d0<4;++d0)stg[orow*128+d0*32+r32]=__float2bfloat16(o[d0][r]*rli[r]);}
    asm volatile("s_waitcnt lgkmcnt(0)":::"memory");
    #pragma unroll
    for(int i=0;i<8;++i){const int row=i*4+(lane>>4),ch=lane&15; const u32x4 v=*(const u32x4*)(stg+row*128+ch*8); ATTN_STORE16(Ow+(long)row*OPITCH+ch*8,v);} }
  asm volatile("s_waitcnt lgkmcnt(0)\n\ts_barrier":::"memory");
  #undef DMA_K
  #undef DMA_V
  #undef CMASK
  #undef START
  #undef RESC
  #undef ROT
}
constexpr int ATTN_LDS_BYTES=LDS_BYTES;
#undef SBAR
#undef WAIT_BAR
}
#define GAS __attribute__((address_space(1)))
#define LAS __attribute__((address_space(3)))
typedef unsigned short bf16;
typedef unsigned v4u __attribute__((ext_vector_type(4)));
typedef float f32x4 __attribute__((ext_vector_type(4)));
typedef short bf16x8 __attribute__((ext_vector_type(8)));
typedef GAS unsigned gu32;
typedef GAS unsigned long long gu64;
#define RLX_AGENT __ATOMIC_RELAXED, __HIP_MEMORY_SCOPE_AGENT
#define LDS_WAIT() asm volatile("s_waitcnt lgkmcnt(0)" ::: "memory")
#define VM_WAIT() asm volatile("s_waitcnt vmcnt(0)" ::: "memory")
__device__ __forceinline__ unsigned long long rt() { return __builtin_amdgcn_s_memrealtime(); }
__device__ __forceinline__ unsigned f2bf(float f) { unsigned u = __builtin_bit_cast(unsigned, f); return (u + 0x7fffu + ((u >> 16) & 1u)) >> 16; }
__device__ __forceinline__ unsigned pk2(float lo, float hi) { return attn_body::cvtpk_s(lo, hi); }

#define XB_TMO      128
#define XB_XCNT(j)  (256  + 64 * (j))
#define XB_XSUB(j)  (1280 + 64 * (j))
#define XB_XGEN(j)  (2304 + 64 * (j))
#define XB_TOP      3328
#define XB_TOPGEN   3392
#define XCD_BAR_WORDS 3456
#define XB_SPIN_CAP (1u << 18)

__device__ __forceinline__ unsigned xb_ld(unsigned* p)              { return __hip_atomic_load(p, __ATOMIC_RELAXED, __HIP_MEMORY_SCOPE_AGENT); }
__device__ __forceinline__ unsigned xb_add(unsigned* p, unsigned v) { return __hip_atomic_fetch_add(p, v, __ATOMIC_RELAXED, __HIP_MEMORY_SCOPE_AGENT); }
__device__ __forceinline__ unsigned xb_xcc_id() { return (unsigned)__builtin_amdgcn_s_getreg((3 << 11) | 20) & 0xFu; }
#define XB_SPIN(cond, bar) do { unsigned _sp = 0; while (cond) { __builtin_amdgcn_s_sleep(1); \
    if ((++_sp & 255u) == 0u) { if (xb_ld(&(bar)[XB_TMO])) break; if (_sp > XB_SPIN_CAP) { atomicAdd(&(bar)[XB_TMO], 1u); break; } } } } while (0)

struct XcdBarrier {
    unsigned* bar; unsigned x; bool lead;
    volatile LAS unsigned* st;
};

__device__ __forceinline__ XcdBarrier xcd_barrier_post(unsigned* bar, volatile LAS unsigned* st) {
    XcdBarrier b; b.bar = bar; b.x = xb_xcc_id(); b.st = st;
    if (threadIdx.x == 0) (void)xb_add(&bar[XB_XCNT(b.x)], 1u);
    return b;
}
__device__ __forceinline__ void xcd_barrier_complete(unsigned* bar, unsigned x, unsigned& nloc, unsigned& nx) {
    const unsigned G = gridDim.x * gridDim.y * gridDim.z;
    unsigned sum, cnt, mine, sp = 0u;
    for (;;) {
        sum = 0u; cnt = 0u; mine = 0u;
#pragma unroll
        for (unsigned j = 0; j < 16; ++j) { const unsigned c = xb_ld(&bar[XB_XCNT(j)]); sum += c; cnt += (c > 0u) ? 1u : 0u; mine = (j == x) ? c : mine; }
        if (sum == G) break;
        __builtin_amdgcn_s_sleep(1);
        if ((++sp & 255u) == 0u) { if (xb_ld(&bar[XB_TMO])) break; if (sp > XB_SPIN_CAP) { atomicAdd(&bar[XB_TMO], 1u); break; } }
    }
    nloc = mine > 0u ? mine : 1u; nx = cnt > 0u ? cnt : 1u;
}

__device__ __forceinline__ void xcd_barrier(const XcdBarrier& b) {
    asm volatile("s_waitcnt vmcnt(0)" ::: "memory");
    __syncthreads();
    if (b.lead) {
        unsigned* bar = b.bar;
        __builtin_amdgcn_s_waitcnt(0);
        unsigned nloc = b.st[0], nx = b.st[1];
        if (nloc == 0u) { xcd_barrier_complete(bar, b.x, nloc, nx); b.st[0] = nloc; b.st[1] = nx; }
        const unsigned old = xb_add(&bar[XB_XSUB(b.x)], 1u);
        const unsigned gen = old / nloc;
        if (old + 1u == (gen + 1u) * nloc) {
            __builtin_amdgcn_fence(__ATOMIC_RELEASE, "agent");
            asm volatile("s_waitcnt vmcnt(0)" ::: "memory");
            const unsigned og = xb_add(&bar[XB_TOP], 1u);
            const unsigned tg = og / nx;
            if (og + 1u == (tg + 1u) * nx) xb_add(&bar[XB_TOPGEN], 1u);
            else XB_SPIN(xb_ld(&bar[XB_TOPGEN]) == tg, bar);
            __builtin_amdgcn_fence(__ATOMIC_ACQUIRE, "agent");
            xb_add(&bar[XB_XGEN(b.x)], 1u);
            asm volatile("s_waitcnt vmcnt(0)" ::: "memory");
        } else {
            XB_SPIN(xb_ld(&bar[XB_XGEN(b.x)]) == gen, bar);
            __builtin_amdgcn_fence(__ATOMIC_ACQUIRE, "agent");
            asm volatile("s_waitcnt vmcnt(0)" ::: "memory");
        }
    }
    __syncthreads();
}

constexpr int NWAVES = 8, NTHR = 512;
constexpr int DM = 2048, NB = 4, SQ = 4096, TOK = NB * SQ;
constexpr int INW = 5900, PW = 5888;
constexpr int C_U = 0, C_DQ = 512, C_DK = 1280, C_DV = 2048, C_GQ = 2816, C_GZ = 5120, C_GA = 5888;
constexpr int DFF = 5632, DFE = 7168, NE = 8;
constexpr int MOE_ROWS = 2 * TOK + NE * 256, MOE_TILES_MAX = MOE_ROWS / 256;
constexpr float EPS = 1e-6f;
constexpr int GDN_UNIT_BYTES = 57344 + 32768 + 256;

constexpr size_t MiB = 1u << 20;
constexpr size_t WS_CTL = 0, CTL_ZERO_BYTES = 1 * MiB;
constexpr size_t WS_MOD = 1 * MiB;
constexpr size_t WS_ROPE = 2 * MiB;
constexpr size_t WS_GAB = 3 * MiB;
constexpr size_t WS_TOKE = 4 * MiB, WS_TOKG = WS_TOKE + 128 * 1024, WS_RANK = WS_TOKE + 256 * 1024, WS_POS = WS_TOKE + 384 * 1024, WS_CNT = WS_TOKE + 512 * 1024, WS_TILE = WS_TOKE + 640 * 1024;
constexpr size_t WS_GW = 5 * MiB;
constexpr size_t WS_M2 = 6 * MiB;
constexpr size_t WS_M13 = 10 * MiB;
constexpr size_t WS_A16 = 22 * MiB;
constexpr size_t WS_XC = 23 * MiB;
constexpr size_t WS_XS = 39 * MiB;
constexpr size_t WS_YGELU = 47 * MiB;
constexpr size_t WS_WIN = 64 * MiB;
constexpr size_t WS_WOUT = 110 * MiB;
constexpr size_t WS_WGLU = 126 * MiB;
constexpr size_t WS_WUP = 128 * MiB;
constexpr size_t WS_WDN = 172 * MiB;
constexpr size_t WS_MUP = 194 * MiB;
constexpr size_t WS_MDN = 642 * MiB;
constexpr size_t WS_HRES = 866 * MiB;
constexpr size_t WS_HN = 994 * MiB;
constexpr size_t WS_R = 1058 * MiB;
constexpr size_t WS_PROJ = WS_R, WS_YCAT = WS_R + 184 * MiB, WS_ATTO = WS_R + 248 * MiB, WS_OGDN = WS_R + 296 * MiB;
constexpr size_t WS_H = WS_R;
constexpr size_t WS_AS = 1534 * MiB;
constexpr size_t WS_GU = WS_AS;
constexpr size_t WS_END = 1670 * MiB;
static_assert((size_t)MOE_ROWS * DFE * 2 <= 476 * MiB && (size_t)MOE_ROWS * DM * 2 <= 136 * MiB && (size_t)1536 * GDN_UNIT_BYTES <= 136 * MiB, "ws map");
static_assert((size_t)TOK * PW * 2 <= 184 * MiB && (size_t)TOK * 768 * 4 <= 48 * MiB, "ws map 2");
constexpr int CW_BAR = 4096, CW_QUEUE = 8192, CW_CVQ = 9216, CW_ARR = 9280, CW_SCAN = 11008, CW_FIN = 12288;

constexpr int LDS_BYTES = 147456;
constexpr int RING_BYTES = 131072;
constexpr int TILE_OFF = 146432, MISC_OFF = 147200;

typedef unsigned u32x4_t __attribute__((ext_vector_type(4)));
typedef unsigned u32x2_t __attribute__((ext_vector_type(2)));
typedef float f32x2_t __attribute__((ext_vector_type(2)));

__device__ __forceinline__ float bf2f(unsigned short u) { return __uint_as_float((unsigned)u << 16); }
__device__ __forceinline__ float bflo(unsigned w) { return __uint_as_float(w << 16); }
__device__ __forceinline__ float bfhi(unsigned w) { return __uint_as_float(w & 0xffff0000u); }
__device__ __forceinline__ float wave_sum(float v) {
    v += __builtin_bit_cast(float, __builtin_amdgcn_update_dpp(0, __builtin_bit_cast(int, v), 0xB1, 0xF, 0xF, false));
    v += __builtin_bit_cast(float, __builtin_amdgcn_update_dpp(0, __builtin_bit_cast(int, v), 0x4E, 0xF, 0xF, false));
    v += __builtin_bit_cast(float, __builtin_amdgcn_update_dpp(0, __builtin_bit_cast(int, v), 0x141, 0xF, 0xF, false));
    v += __builtin_bit_cast(float, __builtin_amdgcn_update_dpp(0, __builtin_bit_cast(int, v), 0x140, 0xF, 0xF, false));
    v += __builtin_bit_cast(float, __builtin_amdgcn_update_dpp(0, __builtin_bit_cast(int, v), 0x142, 0xA, 0xF, false));
    v += __builtin_bit_cast(float, __builtin_amdgcn_update_dpp(0, __builtin_bit_cast(int, v), 0x143, 0xC, 0xF, false));
    return __builtin_bit_cast(float, __builtin_amdgcn_readlane(__builtin_bit_cast(int, v), 63));
}
__device__ __forceinline__ float sigmoid_f(float x) { return __builtin_amdgcn_rcpf(1.f + __expf(-x)); }
__device__ __forceinline__ float silu_f(float x) { return x * __builtin_amdgcn_rcpf(1.f + __expf(-x)); }
__device__ __forceinline__ float gelu_tanh_f(float y) { const float z = 0.7978845608028654f * (y + 0.044715f * y * y * y); const float e = __expf(2.f * z); const float th = 1.f - 2.f * __builtin_amdgcn_rcpf(e + 1.f); return 0.5f * y * (1.f + th); }
__device__ __forceinline__ bf16x8 pack8(const f32x4& a, const f32x4& b) {
    u32x4_t w; w.x = pk2(a[0], a[1]); w.y = pk2(a[2], a[3]); w.z = pk2(b[0], b[1]); w.w = pk2(b[2], b[3]);
    return __builtin_bit_cast(bf16x8, w);
}
__device__ __forceinline__ unsigned pk4_fp8(float a, float b, float c, float d) {
    a = __builtin_amdgcn_fmed3f(a, -448.f, 448.f); b = __builtin_amdgcn_fmed3f(b, -448.f, 448.f); c = __builtin_amdgcn_fmed3f(c, -448.f, 448.f); d = __builtin_amdgcn_fmed3f(d, -448.f, 448.f);
    int w = 0; w = __builtin_amdgcn_cvt_pk_fp8_f32(a, b, w, false); w = __builtin_amdgcn_cvt_pk_fp8_f32(c, d, w, true); return (unsigned)w;
}
#ifndef DENSE_FP8
#define DENSE_FP8 2
#endif
constexpr float S8_HN = 4.f, S8_W13 = 64.f, S8_H = 8.f, S8_W2 = 128.f;
__device__ __forceinline__ void sincos2pi(double r, float& s, float& c) {
    const double x = r * 6.283185307179586476925; const double x2 = x * x;
    double ss = 1.0, cc = 1.0;
#pragma unroll
    for (int k = 12; k >= 1; --k) { ss = 1.0 - x2 * ss / (double)((2 * k) * (2 * k + 1)); cc = 1.0 - x2 * cc / (double)((2 * k - 1) * (2 * k)); }
    s = (float)(x * ss); c = (float)cc;
}

namespace pg8 {
struct EpiProj {
    static constexpr bool PERM = true, AFTER_DRAIN = false;
    bf16_t* O;
    __device__ __forceinline__ void operator()(const f32x4 (&acc)[2][2][4][2], const Unit& u, int wr, int wc, int fr, int fq) const {
        const int row0 = u.pm * BM + wr * 64 + fr, col0 = u.pn * BM + wc * 32 + 8 * fq;
        const float sc = (u.pn >= 2 && u.pn <= 4) ? attn_body::C2 : 1.f;
#pragma unroll
        for (int ai = 0; ai < 2; ++ai)
#pragma unroll
            for (int m = 0; m < 4; ++m) { bf16_t* rowp = O + (size_t)(row0 + ai * HALF + m * 16) * PW + col0;
#pragma unroll
                for (int bj = 0; bj < 2; ++bj) { const f32x4 v0 = acc[ai][bj][m][0] * sc, v1 = acc[ai][bj][m][1] * sc;
                    u32x4 w; w.x = cvt_pk_bf16(v0[0], v0[1]); w.y = cvt_pk_bf16(v0[2], v0[3]); w.z = cvt_pk_bf16(v1[0], v1[1]); w.w = cvt_pk_bf16(v1[2], v1[3]);
                    *(u32x4*)(rowp + bj * HALF) = w; } }
    }
};
struct EpiGlu {
    static constexpr bool PERM = true, AFTER_DRAIN = false;
    const bf16_t* Y; bf16_t* O;
    __device__ __forceinline__ void operator()(const f32x4 (&acc)[2][2][4][2], const Unit& u, int wr, int wc, int fr, int fq) const {
        const int row0 = u.pm * BM + wr * 64 + fr, col0 = u.pn * BM + wc * 32 + 8 * fq;
#pragma unroll
        for (int ai = 0; ai < 2; ++ai)
#pragma unroll
            for (int m = 0; m < 4; ++m) { const int row = row0 + ai * HALF + m * 16;
#pragma unroll
                for (int bj = 0; bj < 2; ++bj) { const int col = col0 + bj * HALF;
                    const u32x4 yv = *(const u32x4*)(Y + (size_t)row * 512 + col);
                    const f32x4 a0 = acc[ai][bj][m][0], a1 = acc[ai][bj][m][1];
                    u32x4 w;
                    w.x = cvt_pk_bf16(bflo(yv.x) * sigmoid_f(a0[0]), bfhi(yv.x) * sigmoid_f(a0[1]));
                    w.y = cvt_pk_bf16(bflo(yv.y) * sigmoid_f(a0[2]), bfhi(yv.y) * sigmoid_f(a0[3]));
                    w.z = cvt_pk_bf16(bflo(yv.z) * sigmoid_f(a1[0]), bfhi(yv.z) * sigmoid_f(a1[1]));
                    w.w = cvt_pk_bf16(bflo(yv.w) * sigmoid_f(a1[2]), bfhi(yv.w) * sigmoid_f(a1[3]));
                    *(u32x4*)(O + (size_t)row * DM + col) = w; } }
    }
};
struct EpiRes {
    static constexpr bool PERM = false, AFTER_DRAIN = false;
    const float* res; float* out; const float* gate; float sin;
    __device__ __forceinline__ void operator()(const f32x4 (&acc)[2][2][4][2], const Unit& u, int wr, int wc, int fr, int fq) const {
        const int col0 = u.pn * BM + wc * 32 + 4 * fq;
#pragma unroll
        for (int ai = 0; ai < 2; ++ai)
#pragma unroll
            for (int m = 0; m < 4; ++m) { const int row = u.pm * BM + ai * HALF + wr * 64 + m * 16 + fr; const float* gp = gate + (size_t)(row >> 12) * (6 * DM); const size_t off = (size_t)row * DM;
#pragma unroll
                for (int bj = 0; bj < 2; ++bj)
#pragma unroll
                    for (int n = 0; n < 2; ++n) { const int col = col0 + bj * HALF + n * 16;
                        const f32x4 g = *(const f32x4*)(gp + col), r = *(const f32x4*)(res + off + col);
                        *(f32x4*)(out + off + col) = r + g * (acc[ai][bj][m][n] * sin); } }
    }
};
struct EpiSwiglu {
    static constexpr bool PERM = true, AFTER_DRAIN = false;
    bf16_t* H; int ldh; int nct; float sin;
    __device__ __forceinline__ void operator()(const f32x4 (&acc)[2][2][4][2], const Unit& u, int wr, int wc, int fr, int fq) const {
        const int pnl = u.pn % nct; const int row0 = u.pm * BM + wr * 64 + fr, col0 = pnl * HALF + wc * 32 + 8 * fq;
#pragma unroll
        for (int ai = 0; ai < 2; ++ai)
#pragma unroll
            for (int m = 0; m < 4; ++m) { const int row = row0 + ai * HALF + m * 16;
                const f32x4 g0 = acc[ai][0][m][0] * sin, g1 = acc[ai][0][m][1] * sin, u0 = acc[ai][1][m][0] * sin, u1 = acc[ai][1][m][1] * sin;
                u32x4 w;
                w.x = cvt_pk_bf16(silu_f(g0[0]) * u0[0], silu_f(g0[1]) * u0[1]); w.y = cvt_pk_bf16(silu_f(g0[2]) * u0[2], silu_f(g0[3]) * u0[3]);
                w.z = cvt_pk_bf16(silu_f(g1[0]) * u1[0], silu_f(g1[1]) * u1[1]); w.w = cvt_pk_bf16(silu_f(g1[2]) * u1[2], silu_f(g1[3]) * u1[3]);
                *(u32x4*)(H + (size_t)row * ldh + col0) = w; }
    }
};
struct EpiSwiglu8 {
    static constexpr bool PERM = true, AFTER_DRAIN = false;
    unsigned char* H; int ldh; int nct; float sin;
    __device__ __forceinline__ void operator()(const f32x4 (&acc)[2][2][4][2], const Unit& u, int wr, int wc, int fr, int fq) const {
        const int pnl = u.pn % nct; const int row0 = u.pm * BM + wr * 64 + fr, col0 = pnl * HALF + wc * 32 + 8 * fq;
#pragma unroll
        for (int ai = 0; ai < 2; ++ai)
#pragma unroll
            for (int m = 0; m < 4; ++m) { const int row = row0 + ai * HALF + m * 16;
                const f32x4 g0 = acc[ai][0][m][0] * sin, g1 = acc[ai][0][m][1] * sin, u0 = acc[ai][1][m][0] * (sin * S8_H), u1 = acc[ai][1][m][1] * (sin * S8_H);
                u32x2_t w; w.x = pk4_fp8(silu_f(g0[0]) * u0[0], silu_f(g0[1]) * u0[1], silu_f(g0[2]) * u0[2], silu_f(g0[3]) * u0[3]);
                w.y = pk4_fp8(silu_f(g1[0]) * u1[0], silu_f(g1[1]) * u1[1], silu_f(g1[2]) * u1[2], silu_f(g1[3]) * u1[3]);
                *(u32x2_t*)(H + (size_t)row * ldh + col0) = w; }
    }
};
struct EpiMoeDown {
    static constexpr bool PERM = true, AFTER_DRAIN = false;
    bf16_t* O; const float* gw; float sin;
    f32x4* part; gu32* flag; PG8_LAS unsigned* wcnt;
    __device__ __forceinline__ void operator()(const f32x4 (&acc)[2][2][4][2], const Unit& u, int wr, int wc, int fr, int fq) const {
        const int row0 = u.pm * BM + wr * 64 + fr, col0 = (u.pn & 7) * BM + wc * 32 + 8 * fq;
        f32x4* pp = part + ((size_t)(u.slot * 8 + wr * 4 + wc) * 32) * 64 + (fq * 16 + fr);
        if (u.ks == 1) {
#pragma unroll
            for (int ai = 0; ai < 2; ++ai)
#pragma unroll
                for (int bj = 0; bj < 2; ++bj)
#pragma unroll
                    for (int m = 0; m < 4; ++m)
#pragma unroll
                        for (int n = 0; n < 2; ++n) pp[(((ai * 2 + bj) * 4 + m) * 2 + n) * 64] = acc[ai][bj][m][n];
            asm volatile("s_waitcnt vmcnt(0)" ::: "memory");
            if (fq * 16 + fr == 0) { const unsigned old = __hip_atomic_fetch_add(wcnt, 1u, __ATOMIC_RELAXED, __HIP_MEMORY_SCOPE_WORKGROUP);
                if (old == 7u) { __builtin_amdgcn_fence(__ATOMIC_RELEASE, "agent"); asm volatile("s_waitcnt vmcnt(0)" ::: "memory"); __hip_atomic_store(flag + u.slot, 1u, RLX_AGENT); } }
            return; }
        if (u.ks == 2) {
            if (fq * 16 + fr == 0) { unsigned sp = 0; while (__hip_atomic_load(flag + u.slot, RLX_AGENT) == 0u && ++sp < (1u << 22)) __builtin_amdgcn_s_sleep(1); }
            __builtin_amdgcn_fence(__ATOMIC_ACQUIRE, "agent"); asm volatile("s_waitcnt vmcnt(0)" ::: "memory");
#pragma unroll
            for (int ai = 0; ai < 2; ++ai)
#pragma unroll
                for (int m = 0; m < 4; ++m) { const int row = row0 + ai * HALF + m * 16; const float s = gw[row] * sin; bf16_t* rowp = O + (size_t)row * DM + col0;
#pragma unroll
                    for (int bj = 0; bj < 2; ++bj) { const f32x4 v0 = (acc[ai][bj][m][0] + pp[(((ai * 2 + bj) * 4 + m) * 2 + 0) * 64]) * s, v1 = (acc[ai][bj][m][1] + pp[(((ai * 2 + bj) * 4 + m) * 2 + 1) * 64]) * s;
                        u32x4 w; w.x = cvt_pk_bf16(v0[0], v0[1]); w.y = cvt_pk_bf16(v0[2], v0[3]); w.z = cvt_pk_bf16(v1[0], v1[1]); w.w = cvt_pk_bf16(v1[2], v1[3]);
                        *(u32x4*)(rowp + bj * HALF) = w; }
                    asm volatile("" ::: "memory"); }
            return; }
#pragma unroll
        for (int ai = 0; ai < 2; ++ai)
#pragma unroll
            for (int m = 0; m < 4; ++m) { const int row = row0 + ai * HALF + m * 16; const float s = gw[row] * sin; bf16_t* rowp = O + (size_t)row * DM + col0;
#pragma unroll
                for (int bj = 0; bj < 2; ++bj) { const f32x4 v0 = acc[ai][bj][m][0] * s, v1 = acc[ai][bj][m][1] * s;
                    u32x4 w; w.x = cvt_pk_bf16(v0[0], v0[1]); w.y = cvt_pk_bf16(v0[2], v0[3]); w.z = cvt_pk_bf16(v1[0], v1[1]); w.w = cvt_pk_bf16(v1[2], v1[3]);
                    *(u32x4*)(rowp + bj * HALF) = w; } }
    }
};
struct MoeOrder {
    static constexpr bool SPLITK = false;
    StaticOrder so; const PG8_LAS int* tile_e; int nct; int rev = 0;
    __device__ __forceinline__ bool next(int i, Unit& u) const { if (!so.next(i, u)) return false; if (rev) u.pm = so.nM - 1 - u.pm; u.pn += __builtin_amdgcn_readfirstlane(tile_e[u.pm]) * nct; return true; }
    __device__ __forceinline__ void a_ready(const Unit&) const {}
    __device__ __forceinline__ void done(const Unit&) const {}
};
struct MoeDownOrder {
    static constexpr bool SPLITK = true;
    StaticOrder so; const PG8_LAS int* tile_e; int nct, nM, nl, R, c, ntf; gu32* arr; LAS unsigned* wc;
    __device__ __forceinline__ bool next(int i, Unit& u) const {
        if (i < R) { (void)so.next(i, u); u.pm = nM - 1 - u.pm; }
        else if (i == R && c < nl * 16) { u.pm = c >> 4; u.pn = c & 7; const int h = (c >> 3) & 1; u.kt0 = h * (ntf >> 1); u.nt = ntf >> 1; u.ks = 1 + h; u.slot = (c >> 4) * 8 + (c & 7); }
        else return false;
        if (i < R) { u.kt0 = 0; u.nt = ntf; u.ks = 0; }
        u.aux = i; u.pn += __builtin_amdgcn_readfirstlane(tile_e[u.pm]) * nct; return true; }
    __device__ __forceinline__ void a_ready(const Unit&) const {}
    __device__ __forceinline__ void done(const Unit& u) const {
        if (u.aux == R - 1) { asm volatile("s_waitcnt vmcnt(0)" ::: "memory");
            if (mk_lane() == 0) { const unsigned old = __hip_atomic_fetch_add(wc, 1u, __ATOMIC_RELAXED, __HIP_MEMORY_SCOPE_WORKGROUP);
                if (old == 7u) { __builtin_amdgcn_fence(__ATOMIC_RELEASE, "agent"); asm volatile("s_waitcnt vmcnt(0)" ::: "memory"); (void)__hip_atomic_fetch_add(arr, 1u, RLX_AGENT); } } } }
};
}

#if defined(PROBE_LO)
#define PSPAN_BEGIN(C, id) do { if ((id) == PROBE_LO && blockIdx.x == 0 && (C).wave == 0 && mk_lane() == 0) { const unsigned long long t_ = __builtin_amdgcn_s_memrealtime(); (C).MISC[20] = (unsigned)t_; (C).MISC[21] = (unsigned)(t_ >> 32); } } while (0)
#define PSPAN_END(C, id) do { if ((id) == PROBE_LO && blockIdx.x == 0 && (C).wave == 0 && mk_lane() == 0) { const unsigned long long t_ = __builtin_amdgcn_s_memrealtime() - (((unsigned long long)(C).MISC[21] << 32) | (C).MISC[20]); (C).MISC[22] += (unsigned)t_; } } while (0)
#else
#define PSPAN_BEGIN(C, id) do {} while (0)
#define PSPAN_END(C, id) do {} while (0)
#endif
struct Params { const float* in[35]; float* out; unsigned char* ws; int ph_lo, ph_hi; };
typedef const __attribute__((address_space(4))) Params* KP;

#define PIN(i) ((const float*)(const GAS float*)(P->in[i]))
#define POUT ((float*)(GAS float*)(P->out))
struct Ctx {
    LAS unsigned char* lds; volatile LAS unsigned* MISC; GAS unsigned char* ws; gu32* ctl;
    int tid, lane, wave, blk, G;
};

__device__ __forceinline__ void tr_tile(const float* __restrict__ src, int ld, bf16* dst, int K, int k0, int n0, int drow0, int lane) {
    const int c4 = lane & 15, r = lane >> 4;
    const float* sp = src + (size_t)(k0 + 16 * r) * ld + n0 + 4 * c4;
    f32x4 x[16];
#pragma unroll
    for (int i = 0; i < 16; ++i) x[i] = __builtin_nontemporal_load((const f32x4*)(sp + (size_t)i * ld));
    bf16* dp = dst + (size_t)(drow0 + 4 * c4) * K + k0 + 16 * r;
#pragma unroll
    for (int q = 0; q < 4; ++q)
#pragma unroll
        for (int hf = 0; hf < 2; ++hf) { v4u o; o.x = pk2(x[8 * hf + 0][q], x[8 * hf + 1][q]); o.y = pk2(x[8 * hf + 2][q], x[8 * hf + 3][q]); o.z = pk2(x[8 * hf + 4][q], x[8 * hf + 5][q]); o.w = pk2(x[8 * hf + 6][q], x[8 * hf + 7][q]);
            *(GAS v4u*)(dp + (size_t)q * K + 8 * hf) = o; }
}
__device__ __forceinline__ void tr_tile8(const float* __restrict__ src, int ld, unsigned char* dst, int K, int k0, int n0, int drow0, int lane, float sc) {
    const int c4 = lane & 15, r = lane >> 4;
    const float* sp = src + (size_t)(k0 + 16 * r) * ld + n0 + 4 * c4;
    f32x4 x[16];
#pragma unroll
    for (int i = 0; i < 16; ++i) x[i] = __builtin_nontemporal_load((const f32x4*)(sp + (size_t)i * ld)) * sc;
    unsigned char* dp = dst + (size_t)(drow0 + 4 * c4) * K + k0 + 16 * r;
#pragma unroll
    for (int q = 0; q < 4; ++q) { v4u o; o.x = pk4_fp8(x[0][q], x[1][q], x[2][q], x[3][q]); o.y = pk4_fp8(x[4][q], x[5][q], x[6][q], x[7][q]); o.z = pk4_fp8(x[8][q], x[9][q], x[10][q], x[11][q]); o.w = pk4_fp8(x[12][q], x[13][q], x[14][q], x[15][q]);
        *(GAS v4u*)(dp + (size_t)q * K) = o; }
}
__device__ __forceinline__ void tr_plain(const float* src, int ld, int K, int N, bf16* dst, int item, int lane) {
    const int nblk = N / 64, kb = item / nblk, nb = item % nblk;
    tr_tile(src, ld, dst, K, 64 * kb, 64 * nb, 64 * nb, lane);
}
__device__ __forceinline__ void tr_inter(const float* src, int K, int N, bf16* dst, int half, int item, int lane) {
    const int nblk = N / 64, kb = item / nblk, nb = item % nblk, n0 = 64 * nb;
    tr_tile(src, N, dst, K, 64 * kb, n0, (n0 >> 7) * 256 + half * 128 + (n0 & 127), lane);
}

__device__ __forceinline__ void p0_ada(const Ctx& C, KP P) {
    const int u = C.blk, l = u / 96, n0 = (u % 96) * 128;
    LAS float* sc = (LAS float*)C.lds; LAS float* part = (LAS float*)(C.lds + 32768);
    const float* cin = PIN(1);
    for (int i = C.tid; i < 4 * DM; i += NTHR) sc[i] = silu_f(cin[i]);
    __syncthreads();
    const int sub = C.lane >> 5, c4 = C.lane & 31, w = C.wave;
    const float* Wp = PIN(3) + ((size_t)l * DM + 256 * w + sub) * (6 * DM) + n0 + 4 * c4;
    f32x4 acc[4];
#pragma unroll
    for (int b = 0; b < 4; ++b) acc[b] = (f32x4){0.f, 0.f, 0.f, 0.f};
#pragma unroll 8
    for (int i = 0; i < 128; ++i) { const f32x4 wv = *(const f32x4*)(Wp + (size_t)(2 * i) * (6 * DM)); const int k = 256 * w + 2 * i + sub;
#pragma unroll
        for (int b = 0; b < 4; ++b) acc[b] += wv * sc[b * DM + k]; }
#pragma unroll
    for (int b = 0; b < 4; ++b)
#pragma unroll
        for (int q = 0; q < 4; ++q) acc[b][q] += __shfl_xor(acc[b][q], 32);
    if (C.lane < 32) {
#pragma unroll
        for (int b = 0; b < 4; ++b)
#pragma unroll
            for (int q = 0; q < 4; ++q) part[(w * 4 + b) * 128 + 4 * c4 + q] = acc[b][q]; }
    __syncthreads();
    { const int b = C.tid >> 7, n = C.tid & 127; float s = PIN(4)[l * (6 * DM) + n0 + n];
#pragma unroll
      for (int ww = 0; ww < 8; ++ww) s += part[(ww * 4 + b) * 128 + n];
      ((float*)(C.ws + WS_MOD))[(size_t)(l * 4 + b) * (6 * DM) + n0 + n] = s; }
    __syncthreads();
}

__device__ __forceinline__ void p0_ssm(const Ctx& C, KP P) {
    const int u = C.blk - 192, l = u >> 5, g = u & 31, lg = l * 32 + g;
    LAS f32x2_t* Pw = (LAS f32x2_t*)C.lds;
    LAS f32x2_t* Bb = (LAS f32x2_t*)(C.lds + 8704);
    LAS f32x2_t* Cc = (LAS f32x2_t*)(C.lds + 8704 + 8192);
    LAS float* Kl = (LAS float*)(C.lds + 8704 + 16384);
    const float dt = expf(PIN(12)[lg]);
    if (C.tid < 64) { const int p = C.tid; const float ar = PIN(10)[lg * 64 + p], ai = PIN(11)[lg * 64 + p];
        for (int j = 0; j <= 16; ++j) { const float mag = expf(ar * dt * (float)j); double rev = (double)ai * (double)dt * (double)j * 0.15915494309189533577; rev -= rint(rev);
            float s, c; sincos2pi(rev, s, c); Pw[j * 64 + p] = (f32x2_t){mag * c, mag * s}; }
        const f32x2_t lb = Pw[64 + p]; const float nx = lb.x - 1.f, ny = lb.y, den = ar * ar + ai * ai;
        const float cx = (nx * ar + ny * ai) / den, cy = (ny * ar - nx * ai) / den;
        for (int h = 0; h < 16; ++h) { const float br = PIN(13)[(lg * 64 + p) * 16 + h], bi = PIN(14)[(lg * 64 + p) * 16 + h]; Bb[p * 16 + h] = (f32x2_t){cx * br - cy * bi, cx * bi + cy * br}; }
        ((f32x2_t*)(C.ws + WS_A16))[lg * 64 + p] = Pw[16 * 64 + p]; }
    for (int i = C.tid; i < 1024; i += NTHR) Cc[i] = (f32x2_t){PIN(15)[lg * 1024 + i], PIN(16)[lg * 1024 + i]};
    __syncthreads();
    for (int e = C.tid; e < 4096; e += NTHR) { const int j = e >> 8, hp = (e >> 4) & 15, h = e & 15; float s = 0.f;
        for (int p = 0; p < 64; ++p) { const f32x2_t c = Cc[hp * 64 + p], pw = Pw[j * 64 + p], bb = Bb[p * 16 + h]; const float zx = c.x * pw.x - c.y * pw.y, zy = c.x * pw.y + c.y * pw.x; s += zx * bb.x - zy * bb.y; }
        if (j == 0 && hp == h) s += PIN(17)[l * 512 + g * 16 + h];
        Kl[e] = s; }
    __syncthreads();
    bf16* M2 = (bf16*)(C.ws + WS_M2) + (size_t)lg * 128 * 256;
    for (int pc = C.tid; pc < 4096; pc += NTHR) { const int n = pc >> 5, k0 = (pc & 31) * 8, p = n >> 1, ri = n & 1, s = k0 >> 4, h0 = k0 & 15; const f32x2_t pw = Pw[(15 - s) * 64 + p]; float v[8];
#pragma unroll
        for (int j = 0; j < 8; ++j) { const f32x2_t bb = Bb[p * 16 + h0 + j]; v[j] = ri ? (pw.x * bb.y + pw.y * bb.x) : (pw.x * bb.x - pw.y * bb.y); }
        v4u o; o.x = pk2(v[0], v[1]); o.y = pk2(v[2], v[3]); o.z = pk2(v[4], v[5]); o.w = pk2(v[6], v[7]); *(GAS v4u*)(M2 + (size_t)n * 256 + k0) = o; }
    bf16* M13 = (bf16*)(C.ws + WS_M13) + (size_t)lg * 256 * 384;
    for (int pc = C.tid; pc < 12288; pc += NTHR) { const int n = pc / 48, k0 = (pc % 48) * 8, i = n >> 4, hp = n & 15; float v[8];
        if (k0 < 256) { const int s = k0 >> 4, h0 = k0 & 15;
#pragma unroll
            for (int j = 0; j < 8; ++j) v[j] = (i >= s) ? Kl[((i - s) * 16 + hp) * 16 + h0 + j] : 0.f; }
        else {
#pragma unroll
            for (int j = 0; j < 8; ++j) { const int kk = k0 - 256 + j, p = kk >> 1, ri = kk & 1; const f32x2_t c = Cc[hp * 64 + p], pw = Pw[(i + 1) * 64 + p]; const float zx = c.x * pw.x - c.y * pw.y, zy = c.x * pw.y + c.y * pw.x; v[j] = ri ? -zy : zx; } }
        v4u o; o.x = pk2(v[0], v[1]); o.y = pk2(v[2], v[3]); o.z = pk2(v[4], v[5]); o.w = pk2(v[6], v[7]); *(GAS v4u*)(M13 + (size_t)n * 384 + k0) = o; }
    __syncthreads();
}

__device__ __forceinline__ void p0_prologue(const Ctx& C, KP P) {
    if (C.blk < 192) p0_ada(C, P); else p0_ssm(C, P);
    { const int* pos = (const int*)PIN(2); float* rope = (float*)(C.ws + WS_ROPE);
      for (int idx = C.blk * NTHR + C.tid; idx < TOK * 8; idx += C.G * NTHR) { const int t = idx >> 3, i = idx & 7;
          const double invf = exp(-(double)i * (13.122363377404328 / 8.0)); double rev = (double)pos[t] * invf * 0.15915494309189533577; rev -= rint(rev);
          float s, c; sincos2pi(rev, s, c); rope[t * 16 + i] = c; rope[t * 16 + 8 + i] = s; } }
    const int gw = C.blk * NWAVES + C.wave, NGW = C.G * NWAVES, lane = C.lane;
    constexpr int I_IN = 32 * 92, I_OUT = 32 * 32, I_GLU = 8 * 8, I_F13 = 32 * 88, I_F2 = 88 * 32, I_M13 = 32 * 112, I_M2 = 112 * 32;
    constexpr int NITEMS = 2 * I_IN + 2 * I_OUT + 2 * I_GLU + 2 * I_F13 + I_F2;
#pragma unroll 1
    for (int it = gw; it < NITEMS; it += NGW) {
        int r = it;
        if (r < 2 * I_IN) { const int l = r / I_IN; r -= l * I_IN; tr_plain(PIN(8) + (size_t)l * DM * INW, INW, DM, PW, (bf16*)(C.ws + WS_WIN) + (size_t)l * PW * DM, r, lane); continue; } r -= 2 * I_IN;
        if (r < 2 * I_OUT) { const int l = r / I_OUT; r -= l * I_OUT; tr_plain(PIN(9) + (size_t)l * DM * DM, DM, DM, DM, (bf16*)(C.ws + WS_WOUT) + (size_t)l * DM * DM, r, lane); continue; } r -= 2 * I_OUT;
        if (r < 2 * I_GLU) { const int l = r / I_GLU; r -= l * I_GLU; tr_plain(PIN(18) + (size_t)l * 512 * 512, 512, 512, 512, (bf16*)(C.ws + WS_WGLU) + (size_t)l * 512 * 512, r, lane); continue; } r -= 2 * I_GLU;
        if (r < 2 * I_F13) { const int half = r / I_F13; r -= half * I_F13;
            if (DENSE_FP8 >= 1) { const int nblk = DFF / 64, kb = r / nblk, n0 = 64 * (r % nblk); tr_tile8(half ? PIN(29) : PIN(28), DFF, (unsigned char*)(C.ws + WS_WUP), DM, 64 * kb, n0, (n0 >> 7) * 256 + half * 128 + (n0 & 127), lane, S8_W13); }
            else tr_inter(half ? PIN(29) : PIN(28), DM, DFF, (bf16*)(C.ws + WS_WUP), half, r, lane);
            continue; } r -= 2 * I_F13;
        if (r < I_F2) { if (DENSE_FP8 >= 2) { const int nblk = DM / 64, kb = r / nblk, n0 = 64 * (r % nblk); tr_tile8(PIN(30), DM, (unsigned char*)(C.ws + WS_WDN), DFF, 64 * kb, n0, n0, lane, S8_W2); }
            else tr_plain(PIN(30), DM, DFF, DM, (bf16*)(C.ws + WS_WDN), r, lane); }
    }
}

constexpr int MOE_CVT_TILES = 16 * (32 * 112) + 8 * (112 * 32), MOE_CVT_CHUNKS = MOE_CVT_TILES / 16;
struct CvtTile { const float* sp; unsigned char* dp; int ld, K; float sc; };
__device__ __forceinline__ void moe_cvt_addr(const Ctx& C, KP P, int r, int lane, CvtTile& t) {
    constexpr int I_M13 = 32 * 112, I_M2 = 112 * 32; const int c4 = lane & 15, rr = lane >> 4;
    if (r < 16 * I_M13) { const int q = r / I_M13, e = q >> 1, half = q & 1; r -= q * I_M13; const int nblk = DFE / 64, kb = 2 * (r / (2 * nblk)) + (r & 1), n0 = 64 * ((r % (2 * nblk)) >> 1);
        t.ld = DFE; t.K = DM; t.sc = S8_W13; t.sp = (half ? PIN(33) : PIN(32)) + (size_t)e * DM * DFE + (size_t)(64 * kb + 16 * rr) * DFE + n0 + 4 * c4;
        t.dp = (unsigned char*)(C.ws + WS_MUP) + (size_t)e * 2 * DFE * DM + (size_t)((n0 >> 7) * 256 + half * 128 + (n0 & 127) + 4 * c4) * DM + 64 * kb + 16 * rr; }
    else { r -= 16 * I_M13; const int e = r / I_M2; r -= e * I_M2; const int nblk = DM / 64, kb = 2 * (r / (2 * nblk)) + (r & 1), n0 = 64 * ((r % (2 * nblk)) >> 1);
        t.ld = DM; t.K = DFE; t.sc = S8_W2; t.sp = PIN(34) + (size_t)e * DFE * DM + (size_t)(64 * kb + 16 * rr) * DM + n0 + 4 * c4;
        t.dp = (unsigned char*)(C.ws + WS_MDN) + (size_t)e * DM * DFE + (size_t)(n0 + 4 * c4) * DFE + 64 * kb + 16 * rr; }
}
__device__ __forceinline__ void cvt_load(const CvtTile& t, f32x4 (&x)[16]) {
#pragma unroll
    for (int i = 0; i < 16; ++i) x[i] = __builtin_nontemporal_load((const f32x4*)(t.sp + (size_t)i * t.ld));
}
__device__ __forceinline__ void cvt_store(const CvtTile& t, const f32x4 (&x)[16]) {
    const float sc = t.sc;
#pragma unroll
    for (int q = 0; q < 4; ++q) { v4u o; o.x = pk4_fp8(x[0][q] * sc, x[1][q] * sc, x[2][q] * sc, x[3][q] * sc); o.y = pk4_fp8(x[4][q] * sc, x[5][q] * sc, x[6][q] * sc, x[7][q] * sc);
        o.z = pk4_fp8(x[8][q] * sc, x[9][q] * sc, x[10][q] * sc, x[11][q] * sc); o.w = pk4_fp8(x[12][q] * sc, x[13][q] * sc, x[14][q] * sc, x[15][q] * sc);
        *(GAS v4u*)(t.dp + (size_t)q * t.K) = o; }
}
__device__ __forceinline__ void moe_cvt_fill(const Ctx& C, KP P, int k) {
    gu32* arr = C.ctl + CW_ARR + 64 * k; gu32* head = C.ctl + CW_CVQ;
    if (C.wave == 0 && C.lane == 0) (void)__hip_atomic_fetch_add(arr, 1u, RLX_AGENT);
    for (;;) {
        if (C.wave == 0 && C.lane == 0) { unsigned q = 0xffffffffu; if (__hip_atomic_load(arr, RLX_AGENT) < (unsigned)C.G) q = __hip_atomic_fetch_add(head, 1u, RLX_AGENT); C.MISC[24] = q; }
        __syncthreads();
        const unsigned q = (unsigned)__builtin_amdgcn_readfirstlane((int)C.MISC[24]);
        __syncthreads();
        if (q >= (unsigned)MOE_CVT_CHUNKS) break;
        { const int tb = (MOE_CVT_CHUNKS - 1 - (int)q) * 16 + C.wave * 2;
          CvtTile a, b; moe_cvt_addr(C, P, tb, C.lane, a); moe_cvt_addr(C, P, tb + 1, C.lane, b); f32x4 xa[16], xb[16]; cvt_load(a, xa); cvt_load(b, xb); cvt_store(a, xa); cvt_store(b, xb); }
    }
}
__device__ __forceinline__ void moe_cvt_drain(const Ctx& C, KP P) {
    unsigned h = __hip_atomic_load(C.ctl + CW_CVQ, RLX_AGENT); h = (unsigned)__builtin_amdgcn_readfirstlane((int)h); if (h > (unsigned)MOE_CVT_CHUNKS) h = MOE_CVT_CHUNKS;
    const int s0 = (int)h * 16, npair = (MOE_CVT_TILES - s0) / 2, step = C.G * NWAVES; int p = C.blk * NWAVES + C.wave;
    if (p >= npair) return;
    CvtTile a, b; f32x4 xa[16], xb[16];
    moe_cvt_addr(C, P, MOE_CVT_TILES - 1 - (s0 + 2 * p), C.lane, a); moe_cvt_addr(C, P, MOE_CVT_TILES - 2 - (s0 + 2 * p), C.lane, b); cvt_load(a, xa); cvt_load(b, xb);
#pragma unroll 1
    for (;;) { const int pn = p + step; const bool more = pn < npair;
        cvt_store(a, xa); if (more) { moe_cvt_addr(C, P, MOE_CVT_TILES - 1 - (s0 + 2 * pn), C.lane, a); cvt_load(a, xa); }
        cvt_store(b, xb); if (!more) break; moe_cvt_addr(C, P, MOE_CVT_TILES - 2 - (s0 + 2 * pn), C.lane, b); cvt_load(b, xb);
        p = pn; }
}

template <bool WITH_GAB, bool OUT8 = false>
__device__ __forceinline__ void norm_phase(const Ctx& C, const float* __restrict__ src, const float* __restrict__ nw, const float* __restrict__ mod_shift, const float* __restrict__ mod_scale, const float* __restrict__ w12  ) {
    LAS float* W12T = (LAS float*)C.lds;
    if (WITH_GAB) { for (int idx = C.tid; idx < DM * 12; idx += NTHR) { const int k = idx / 12, j = idx % 12; W12T[j * DM + k] = w12[(size_t)k * INW + C_GA + j]; } __syncthreads(); }
    bf16* HN = (bf16*)(C.ws + WS_HN); float* GAB = (float*)(C.ws + WS_GAB);
    const int lane = C.lane;
    f32x4 nwv[8];
#pragma unroll
    for (int j = 0; j < 8; ++j) nwv[j] = *(const f32x4*)(nw + 4 * lane + 256 * j);
    f32x4 vn[2][8];
#pragma unroll
    for (int u = 0; u < 2; ++u)
#pragma unroll
        for (int j = 0; j < 8; ++j) vn[u][j] = *(const f32x4*)(src + (size_t)(C.blk * 64 + C.wave * 8 + u) * DM + 4 * lane + 256 * j);
    int nlim = 4; asm volatile("" : "+s"(nlim));
#pragma unroll 1
    for (int i = 0; i < nlim; ++i) { const int t0 = C.blk * 64 + C.wave * 8 + 2 * i; const int b = t0 >> 12;
        f32x4 v[2][8]; float ss0 = 0.f, ss1 = 0.f;
#pragma unroll
        for (int j = 0; j < 8; ++j) { v[0][j] = vn[0][j]; v[1][j] = vn[1][j];
            ss0 += (v[0][j].x * v[0][j].x + v[0][j].y * v[0][j].y) + (v[0][j].z * v[0][j].z + v[0][j].w * v[0][j].w); ss1 += (v[1][j].x * v[1][j].x + v[1][j].y * v[1][j].y) + (v[1][j].z * v[1][j].z + v[1][j].w * v[1][j].w); }
        if (i + 1 < nlim) {
#pragma unroll
            for (int u = 0; u < 2; ++u)
#pragma unroll
                for (int j = 0; j < 8; ++j) vn[u][j] = *(const f32x4*)(src + (size_t)(t0 + 2 + u) * DM + 4 * lane + 256 * j); }
        const float r0 = rsqrtf(wave_sum(ss0) * (1.f / DM) + EPS), r1 = rsqrtf(wave_sum(ss1) * (1.f / DM) + EPS);
        const float* sh = mod_shift + (size_t)b * 6 * DM; const float* scp = mod_scale + (size_t)b * 6 * DM;
#pragma unroll
        for (int j = 0; j < 8; ++j) { const f32x4 s1 = *(const f32x4*)(scp + 4 * lane + 256 * j), s0 = *(const f32x4*)(sh + 4 * lane + 256 * j); const f32x4 m1 = nwv[j] * (s1 + 1.f);
            v[0][j] = v[0][j] * r0 * m1 + s0; v[1][j] = v[1][j] * r1 * m1 + s0;
#pragma unroll
            for (int u = 0; u < 2; ++u) {
                if (OUT8) *(GAS unsigned*)((unsigned char*)HN + (size_t)(t0 + u) * DM + 4 * lane + 256 * j) = pk4_fp8(v[u][j].x * S8_HN, v[u][j].y * S8_HN, v[u][j].z * S8_HN, v[u][j].w * S8_HN);
                else { u32x2_t o; o.x = pk2(v[u][j].x, v[u][j].y); o.y = pk2(v[u][j].z, v[u][j].w); *(GAS u32x2_t*)(HN + (size_t)(t0 + u) * DM + 4 * lane + 256 * j) = o; } } }
        if (WITH_GAB) { unsigned wb = 16u * (unsigned)lane; asm volatile("" : "+v"(wb));
            const LAS float* W12L = (const LAS float*)(size_t)wb;
#pragma unroll
            for (int jj = 0; jj < 12; ++jj) { float a0 = 0.f, a1 = 0.f;
#pragma unroll
                for (int j = 0; j < 8; ++j) { const f32x4 wv = *(const LAS f32x4*)(W12L + jj * DM + 256 * j);
                    a0 += (v[0][j].x * wv.x + v[0][j].y * wv.y) + (v[0][j].z * wv.z + v[0][j].w * wv.w); a1 += (v[1][j].x * wv.x + v[1][j].y * wv.y) + (v[1][j].z * wv.z + v[1][j].w * wv.w); }
                a0 = wave_sum(a0); a1 = wave_sum(a1); if (lane == 0) { GAB[(size_t)t0 * 12 + jj] = a0; GAB[(size_t)(t0 + 1) * 12 + jj] = a1; } } }
    }
    __syncthreads();
}

__device__ __forceinline__ void rope_pass(const Ctx& C) {
    bf16* PROJ = (bf16*)(C.ws + WS_PROJ); const float* rope = (const float*)(C.ws + WS_ROPE);
    for (int idx = C.blk * NTHR + C.tid; idx < TOK * 24; idx += C.G * NTHR) { const int t = idx / 24, v = idx % 24;
        bf16* p = PROJ + (size_t)t * PW + (v < 12 ? C_DQ + v * 64 : C_DK + (v - 12) * 64);
        const u32x4_t a = *(const u32x4_t*)p, b = *(const u32x4_t*)(p + 8);
        const f32x4 c0 = *(const f32x4*)(rope + t * 16), c1 = *(const f32x4*)(rope + t * 16 + 4), s0 = *(const f32x4*)(rope + t * 16 + 8), s1 = *(const f32x4*)(rope + t * 16 + 12);
        const float t1[8] = {bflo(a.x), bfhi(a.x), bflo(a.y), bfhi(a.y), bflo(a.z), bfhi(a.z), bflo(a.w), bfhi(a.w)};
        const float t2[8] = {bflo(b.x), bfhi(b.x), bflo(b.y), bfhi(b.y), bflo(b.z), bfhi(b.z), bflo(b.w), bfhi(b.w)};
        const float cs[8] = {c0.x, c0.y, c0.z, c0.w, c1.x, c1.y, c1.z, c1.w}, sn[8] = {s0.x, s0.y, s0.z, s0.w, s1.x, s1.y, s1.z, s1.w};
        float o1[8], o2[8];
#pragma unroll
        for (int i = 0; i < 8; ++i) { o1[i] = t1[i] * cs[i] - t2[i] * sn[i]; o2[i] = t2[i] * cs[i] + t1[i] * sn[i]; }
        u32x4_t oa, ob; oa.x = pk2(o1[0], o1[1]); oa.y = pk2(o1[2], o1[3]); oa.z = pk2(o1[4], o1[5]); oa.w = pk2(o1[6], o1[7]);
        ob.x = pk2(o2[0], o2[1]); ob.y = pk2(o2[2], o2[3]); ob.z = pk2(o2[4], o2[5]); ob.w = pk2(o2[6], o2[7]);
        *(u32x4_t*)p = oa; *(u32x4_t*)(p + 8) = ob; }
}

#define SSM_BAR() asm volatile("s_waitcnt lgkmcnt(0)\n\ts_barrier" ::: "memory")
__device__ __forceinline__ void ssm_gemm_a(const Ctx& C, int l) {
    const bf16* PROJ = (const bf16*)(C.ws + WS_PROJ); float* XC = (float*)(C.ws + WS_XC);
    const int lane = C.lane, fr = lane & 15, quad = lane >> 4, tid = C.tid;
    for (int bu = C.blk; bu < 256; bu += C.G) { const int g = bu >> 3, rt = (bu & 7) * 8 + C.wave, r = 16 * rt + fr, tok = (r >> 8) * SQ + (r & 255) * 16;
        const bf16* arow = PROJ + (size_t)(tok + (quad >> 1)) * PW + C_U + g * 16 + 8 * (quad & 1);
        const bf16* bsrc = (const bf16*)(C.ws + WS_M2) + ((size_t)(l * 32 + g) * 128 + 16 * (tid >> 6) + fr) * 256 + 8 * quad;
        f32x4 acc[8];
#pragma unroll
        for (int nt = 0; nt < 8; ++nt) acc[nt] = (f32x4){0.f, 0.f, 0.f, 0.f};
        u32x4_t rb = *(const u32x4_t*)bsrc; bf16x8 an = *(const bf16x8*)arow;
        *(LAS u32x4_t*)(C.lds + tid * 16) = rb;
        SSM_BAR();
#pragma unroll 1
        for (int ks = 0; ks < 8; ++ks) { const bf16x8 a = an; const LAS unsigned char* cur = C.lds + (ks & 1) * 8192;
            if (ks + 1 < 8) { rb = *(const u32x4_t*)(bsrc + 32 * (ks + 1)); an = *(const bf16x8*)(arow + (size_t)(2 * (ks + 1)) * PW); }
#pragma unroll
            for (int nt = 0; nt < 8; ++nt) { const bf16x8 b = *(const LAS bf16x8*)(cur + (nt * 64 + lane) * 16); acc[nt] = __builtin_amdgcn_mfma_f32_16x16x32_bf16(a, b, acc[nt], 0, 0, 0); }
            if (ks + 1 < 8) *(LAS u32x4_t*)(C.lds + ((ks + 1) & 1) * 8192 + tid * 16) = rb;
            SSM_BAR(); }
#pragma unroll
        for (int nt = 0; nt < 8; ++nt)
#pragma unroll
            for (int j = 0; j < 4; ++j) XC[((size_t)(16 * rt + 4 * quad + j) * 32 + g) * 128 + 16 * nt + fr] = acc[nt][j];
    }
}

__device__ __forceinline__ void ssm_gemm_b(const Ctx& C, int l) {
    const bf16* PROJ = (const bf16*)(C.ws + WS_PROJ); const bf16* XS = (const bf16*)(C.ws + WS_XS); bf16* YG = (bf16*)(C.ws + WS_YGELU);
    const int lane = C.lane, fr = lane & 15, quad = lane >> 4, tid = C.tid;
    for (int bu = C.blk; bu < 256; bu += C.G) { const int g = bu >> 3, rt = (bu & 7) * 8 + C.wave, r = 16 * rt + fr, tok = (r >> 8) * SQ + (r & 255) * 16;
        const bf16* arow = PROJ + (size_t)(tok + (quad >> 1)) * PW + C_U + g * 16 + 8 * (quad & 1);
        const bf16* xrow = XS + ((size_t)r * 32 + g) * 128 + 8 * quad;
        const bf16* bsrc = (const bf16*)(C.ws + WS_M13) + ((size_t)(l * 32 + g) * 256 + 16 * (tid >> 6) + fr) * 384 + 8 * quad;
        f32x4 acc[16];
#pragma unroll
        for (int nt = 0; nt < 16; ++nt) acc[nt] = (f32x4){0.f, 0.f, 0.f, 0.f};
        u32x4_t rb0 = *(const u32x4_t*)bsrc, rb1 = *(const u32x4_t*)(bsrc + 128 * 384); bf16x8 an = *(const bf16x8*)arow;
        *(LAS u32x4_t*)(C.lds + tid * 16) = rb0; *(LAS u32x4_t*)(C.lds + 8192 + tid * 16) = rb1;
        SSM_BAR();
#pragma unroll 1
        for (int ks = 0; ks < 12; ++ks) { const bf16x8 a = an; const LAS unsigned char* cur = C.lds + (ks & 1) * 16384;
            if (ks + 1 < 12) { rb0 = *(const u32x4_t*)(bsrc + 32 * (ks + 1)); rb1 = *(const u32x4_t*)(bsrc + 128 * 384 + 32 * (ks + 1));
                an = (ks + 1 < 8) ? *(const bf16x8*)(arow + (size_t)(2 * (ks + 1)) * PW) : *(const bf16x8*)(xrow + 32 * (ks + 1 - 8)); }
#pragma unroll
            for (int nt = 0; nt < 16; ++nt) { const bf16x8 b = *(const LAS bf16x8*)(cur + (nt * 64 + lane) * 16); acc[nt] = __builtin_amdgcn_mfma_f32_16x16x32_bf16(a, b, acc[nt], 0, 0, 0); }
            if (ks + 1 < 12) { *(LAS u32x4_t*)(C.lds + ((ks + 1) & 1) * 16384 + tid * 16) = rb0; *(LAS u32x4_t*)(C.lds + ((ks + 1) & 1) * 16384 + 8192 + tid * 16) = rb1; }
            SSM_BAR(); }
#pragma unroll
        for (int j = 0; j < 4; ++j) { const int rr = 16 * rt + 4 * quad + j; const size_t tb = (size_t)((rr >> 8) * SQ + (rr & 255) * 16);
#pragma unroll
            for (int nt = 0; nt < 16; ++nt) YG[(tb + nt) * 512 + g * 16 + fr] = (bf16)f2bf(gelu_tanh_f(acc[nt][j])); }
    }
}

__device__ __forceinline__ void ssm_scan(const Ctx& C, int l, int sblk  ) {
    const int idx = sblk * NTHR + C.tid, b = idx >> 11, g = (idx >> 6) & 31, p = idx & 63;
    const f32x2_t a = ((const f32x2_t*)(C.ws + WS_A16))[(l * 32 + g) * 64 + p];
    const f32x2_t* xc = (const f32x2_t*)(C.ws + WS_XC) + ((size_t)(b * 256) * 32 + g) * 64 + p; unsigned* xs = (unsigned*)(C.ws + WS_XS) + ((size_t)(b * 256) * 32 + g) * 64 + p;
    float xr = 0.f, xi = 0.f;
    for (int c0 = 0; c0 < 256; c0 += 8) { f32x2_t in[8];
#pragma unroll
        for (int q = 0; q < 8; ++q) in[q] = xc[(size_t)(c0 + q) * 2048];
#pragma unroll
        for (int q = 0; q < 8; ++q) { xs[(size_t)(c0 + q) * 2048] = pk2(xr, xi); const float nr = a.x * xr - a.y * xi + in[q].x, ni = a.x * xi + a.y * xr + in[q].y; xr = nr; xi = ni; } }
}

constexpr int GL_QT = 0, GL_KT = 33792, GL_VT = 67584, GL_AM = 101376, GL_QK = 118784, GL_SM = 136192;
__device__ __forceinline__ void gdn_prep_unit(const Ctx& C, KP P, int l, int unit) {
    const int b = unit / 384, h = (unit / 64) % 6, ch = unit & 63, tok0 = b * SQ + ch * 64, tid = C.tid, lane = C.lane, wave = C.wave;
    LAS float* QT = (LAS float*)(C.lds + GL_QT); LAS float* KT = (LAS float*)(C.lds + GL_KT); LAS float* VT = (LAS float*)(C.lds + GL_VT);
    LAS float* AM = (LAS float*)(C.lds + GL_AM); LAS float* QKM = (LAS float*)(C.lds + GL_QK);
    unsigned smb = GL_SM; asm volatile("" : "+v"(smb));
    LAS float* gc = (LAS float*)(size_t)smb; LAS float* beta = gc + 64; LAS float* eg = gc + 128; LAS float* ek = gc + 192;
    const bf16* PROJ = (const bf16*)(C.ws + WS_PROJ); const float* convw = PIN(24) + (size_t)l * 4 * 2304;
    GAS unsigned char* UB = C.ws + WS_GU + (size_t)unit * GDN_UNIT_BYTES;
    PSPAN_BEGIN(C, 110);
    if (tid < 384) { const int cg = tid % 48, seg = tid / 48, which = cg >> 4, d0 = (cg & 15) * 8, chn = which * 768 + h * 128 + d0, sp0 = ch * 64 + 8 * seg - 3;
        const bf16* src = PROJ + ((size_t)(b * SQ) + sp0) * PW + C_GQ + chn;
        u32x4_t raw[11];
#pragma unroll
        for (int r = 0; r < 11; ++r) raw[r] = (r >= 3 || sp0 + r >= 0) ? *(const u32x4_t*)(src + (ptrdiff_t)r * PW) : (u32x4_t){0u, 0u, 0u, 0u};
        f32x4 wv[4][2];
#pragma unroll
        for (int tap = 0; tap < 4; ++tap) { wv[tap][0] = *(const f32x4*)(convw + tap * 2304 + chn); wv[tap][1] = *(const f32x4*)(convw + tap * 2304 + chn + 4); }
        LAS float* T = (LAS float*)(C.lds + which * 33792) + (8 * seg) * 132 + d0;
#pragma unroll
        for (int i = 0; i < 8; ++i) { f32x4 a0 = (f32x4){0.f, 0.f, 0.f, 0.f}, a1 = a0;
#pragma unroll
            for (int tap = 0; tap < 4; ++tap) { const u32x4_t w = raw[i + tap];
                a0 += wv[tap][0] * (f32x4){bflo(w.x), bfhi(w.x), bflo(w.y), bfhi(w.y)}; a1 += wv[tap][1] * (f32x4){bflo(w.z), bfhi(w.z), bflo(w.w), bfhi(w.w)}; }
            *(LAS f32x4*)(T + i * 132) = (f32x4){silu_f(a0.x), silu_f(a0.y), silu_f(a0.z), silu_f(a0.w)}; *(LAS f32x4*)(T + i * 132 + 4) = (f32x4){silu_f(a1.x), silu_f(a1.y), silu_f(a1.z), silu_f(a1.w)}; } }
    __syncthreads();
    PSPAN_END(C, 110); PSPAN_BEGIN(C, 111);
#pragma unroll
    for (int ii = 0; ii < 8; ++ii) { const int i = wave * 8 + ii;
        { const float a = QT[i * 132 + lane], c = QT[i * 132 + 64 + lane]; const float sc = rsqrtf(wave_sum(a * a + c * c) + EPS) * 0.08838834764831845f; QT[i * 132 + lane] = a * sc; QT[i * 132 + 64 + lane] = c * sc; }
        { const float a = KT[i * 132 + lane], c = KT[i * 132 + 64 + lane]; const float sc = rsqrtf(wave_sum(a * a + c * c) + EPS); KT[i * 132 + lane] = a * sc; KT[i * 132 + 64 + lane] = c * sc; } }
    if (wave == 0) { const float* GAB = (const float*)(C.ws + WS_GAB) + (size_t)(tok0 + lane) * 12;
        const float av = GAB[h], bv = GAB[6 + h]; const float x = av + PIN(26)[l * 6 + h]; const float sp = (x > 20.f) ? x : log1pf(__expf(x));
        float g = -__expf(PIN(25)[l * 6 + h]) * sp;
#pragma unroll
        for (int o = 1; o < 64; o <<= 1) { const float t = __shfl_up(g, o); if (lane >= o) g += t; }
        const float glast = __shfl(g, 63);
        gc[lane] = g; beta[lane] = sigmoid_f(bv); eg[lane] = __expf(g); ek[lane] = __expf(glast - g);
        if (lane == 0) *(float*)(UB + 57344 + 32768) = __expf(glast); }
    __syncthreads();
    PSPAN_END(C, 111); PSPAN_BEGIN(C, 112);
    for (int z = tid; z < 6 * 256; z += NTHR) { const int t = z >> 8, e = z & 255, ti = (t >= 3) ? (t >= 5 ? 2 : 1) : 0, tj = (t >= 3) ? (t >= 5 ? 3 : t - 1) : t + 1;
        QKM[(16 * ti + (e >> 4)) * 68 + 16 * tj + (e & 15)] = 0.f; }
    { const int fr = lane & 15, quad = lane >> 4;
#pragma unroll 1
      for (int job = wave; job < 20; job += NWAVES) { const int mat = job / 10, t = job % 10, ti = (t >= 6) ? 3 : (t >= 3) ? 2 : (t >= 1) ? 1 : 0, tj = t - ti * (ti + 1) / 2; LAS float* OUT = mat ? QKM : AM;
          const LAS float* ap = (mat ? QT : KT) + (16 * ti + fr) * 132 + quad; const LAS float* bp = KT + (16 * tj + fr) * 132 + quad;
          f32x4 a0 = (f32x4){0.f, 0.f, 0.f, 0.f}, a1 = a0, a2 = a0, a3 = a0;
#pragma unroll
          for (int kk = 0; kk < 32; kk += 4) { a0 = __builtin_amdgcn_mfma_f32_16x16x4f32(ap[4 * kk], bp[4 * kk], a0, 0, 0, 0); a1 = __builtin_amdgcn_mfma_f32_16x16x4f32(ap[4 * kk + 4], bp[4 * kk + 4], a1, 0, 0, 0);
              a2 = __builtin_amdgcn_mfma_f32_16x16x4f32(ap[4 * kk + 8], bp[4 * kk + 8], a2, 0, 0, 0); a3 = __builtin_amdgcn_mfma_f32_16x16x4f32(ap[4 * kk + 12], bp[4 * kk + 12], a3, 0, 0, 0); }
          const f32x4 acc = (a0 + a1) + (a2 + a3);
#pragma unroll
          for (int j = 0; j < 4; ++j) { const int i = 16 * ti + 4 * quad + j, jj = 16 * tj + fr; float v = 0.f;
              if (mat == 0) { if (i > jj) v = beta[i] * acc[j] * __expf(gc[i] - gc[jj]); } else { if (i >= jj) v = acc[j] * __expf(gc[i] - gc[jj]); }
              OUT[i * 68 + jj] = v; } } }
    __syncthreads();
    PSPAN_END(C, 112); PSPAN_BEGIN(C, 113);
    { LAS float* TM = (LAS float*)(C.lds + GL_SM + 1024);
      const int fr = lane & 15, quad = lane >> 4;
      f32x4 acc[2][4];
#pragma unroll
      for (int r = 0; r < 4; ++r)
#pragma unroll
          for (int jq = 0; jq < 4; ++jq) { const int i = 16 * r + 4 * quad + jq; const float bi = beta[i];
              acc[0][r][jq] = VT[i * 132 + 16 * wave + fr] * bi; acc[1][r][jq] = KT[i * 132 + 16 * wave + fr] * bi * eg[i]; }
      if (wave == 0) { const int r = lane >> 4, c = lane & 15; const LAS float* Ar = AM + (16 * r) * 68 + 16 * r; float t[16];
#pragma unroll
          for (int i2 = 0; i2 < 16; ++i2) { float sacc = (i2 == c) ? 1.f : 0.f;
#pragma unroll
              for (int j2 = 0; j2 < i2; ++j2) sacc -= Ar[i2 * 68 + j2] * t[j2];
              t[i2] = sacc; TM[(r * 16 + i2) * 16 + c] = sacc; } }
      __syncthreads();
      f32x4 X[2][4];
#pragma unroll
      for (int r = 0; r < 4; ++r) {
#pragma unroll
          for (int q = 0; q < r; ++q) { const f32x4 a = *(const LAS f32x4*)(AM + (16 * r + fr) * 68 + 16 * q + 4 * quad);
#pragma unroll
              for (int jq = 0; jq < 4; ++jq) { acc[0][r] = __builtin_amdgcn_mfma_f32_16x16x4f32(-a[jq], X[0][q][jq], acc[0][r], 0, 0, 0); acc[1][r] = __builtin_amdgcn_mfma_f32_16x16x4f32(-a[jq], X[1][q][jq], acc[1][r], 0, 0, 0); } }
          const f32x4 tt = *(const LAS f32x4*)(TM + (r * 16 + fr) * 16 + 4 * quad);
          X[0][r] = (f32x4){0.f, 0.f, 0.f, 0.f}; X[1][r] = X[0][r];
#pragma unroll
          for (int jq = 0; jq < 4; ++jq) { X[0][r] = __builtin_amdgcn_mfma_f32_16x16x4f32(tt[jq], acc[0][r][jq], X[0][r], 0, 0, 0); X[1][r] = __builtin_amdgcn_mfma_f32_16x16x4f32(tt[jq], acc[1][r][jq], X[1][r], 0, 0, 0); }
          *(f32x4*)((float*)(UB + 57344) + ((((wave * 4 + r) * 4 + quad) * 16 + fr) * 4)) = X[0][r];
#pragma unroll
          for (int jq = 0; jq < 4; ++jq) VT[(16 * r + 4 * quad + jq) * 132 + 16 * wave + fr] = X[1][r][jq]; } }
    __syncthreads();
    PSPAN_END(C, 113); PSPAN_BEGIN(C, 114);
    for (int pc = tid; pc < 3584; pc += NTHR) { const int ln = pc & 63, row = ln & 15, quad = ln >> 4; float v[8];
        if (pc < 2048) { const int tile = (pc >> 6) & 15, mt = tile >> 2, s = tile & 3, i = 16 * mt + row, cb = 32 * s + 4 * quad; const LAS float* src = (pc < 1024 ? VT : QT) + i * 132 + cb; const float sc = (pc < 1024) ? 1.f : eg[i];
            const f32x4 a = *(const LAS f32x4*)src, c = *(const LAS f32x4*)(src + 16);
            v[0] = a.x * sc; v[1] = a.y * sc; v[2] = a.z * sc; v[3] = a.w * sc; v[4] = c.x * sc; v[5] = c.y * sc; v[6] = c.z * sc; v[7] = c.w * sc; }
        else if (pc < 3072) { const int tile = (pc - 2048) >> 6, dt = tile >> 1, s2 = tile & 1, d = 16 * dt + row;
#pragma unroll
            for (int j = 0; j < 8; ++j) { const int jj = 32 * s2 + 4 * quad + (j & 3) + 16 * (j >> 2); v[j] = KT[jj * 132 + d] * ek[jj]; } }
        else { const int tile = (pc - 3072) >> 6, mt = tile >> 1, s2 = tile & 1, i = 16 * mt + row; const LAS float* src = QKM + i * 68 + 32 * s2 + 4 * quad;
            const f32x4 a = *(const LAS f32x4*)src, c = *(const LAS f32x4*)(src + 16);
            v[0] = a.x; v[1] = a.y; v[2] = a.z; v[3] = a.w; v[4] = c.x; v[5] = c.y; v[6] = c.z; v[7] = c.w; }
        v4u o; o.x = pk2(v[0], v[1]); o.y = pk2(v[2], v[3]); o.z = pk2(v[4], v[5]); o.w = pk2(v[6], v[7]); *(GAS v4u*)(UB + (size_t)pc * 16) = o; }
    __syncthreads();
    PSPAN_END(C, 114);
}

#define GDN_BAR() asm volatile("s_waitcnt lgkmcnt(0)\n\ts_barrier" ::: "memory")
template <int PAR>
__device__ __forceinline__ void gdn_step_c(const Ctx& C, int n, const GAS unsigned char* UB, float* OG, int slice, f32x4 (&S)[8], f32x4 (&uu)[4], float& ue) {
    const int lane = C.lane, col = lane & 15, quad = lane >> 4;
    const LAS unsigned char* cur = C.lds + PAR * 57344;
    f32x4 u4[4];
#pragma unroll
    for (int mt = 0; mt < 4; ++mt) u4[mt] = uu[mt];
    const float egl = ue;
    if (n + 2 < 64) { const GAS unsigned char* un = UB + (size_t)(n + 2) * GDN_UNIT_BYTES + 57344;
#pragma unroll
        for (int mt = 0; mt < 4; ++mt) uu[mt] = *(const GAS f32x4*)(un + (size_t)((((slice * 4 + mt) * 4 + quad) * 16 + col) * 16));
        ue = *(const GAS float*)(un + 32768); }
    bf16x8 sb[4];
#pragma unroll
    for (int s = 0; s < 4; ++s) sb[s] = pack8(S[2 * s], S[2 * s + 1]);
    f32x4 vn[4];
#pragma unroll
    for (int mt = 0; mt < 4; ++mt) { f32x4 ws = (f32x4){0.f, 0.f, 0.f, 0.f};
#pragma unroll
        for (int s = 0; s < 4; ++s) { const bf16x8 a = *(const LAS bf16x8*)(cur + ((mt * 4 + s) * 64 + lane) * 16); ws = __builtin_amdgcn_mfma_f32_16x16x32_bf16(a, sb[s], ws, 0, 0, 0); }
        vn[mt] = u4[mt] - ws; }
    bf16x8 vb[2]; vb[0] = pack8(vn[0], vn[1]); vb[1] = pack8(vn[2], vn[3]);
#pragma unroll
    for (int d = 0; d < 8; ++d) { f32x4 sd = S[d] * egl;
#pragma unroll
        for (int s2 = 0; s2 < 2; ++s2) { const bf16x8 a = *(const LAS bf16x8*)(cur + 32768 + ((d * 2 + s2) * 64 + lane) * 16); sd = __builtin_amdgcn_mfma_f32_16x16x32_bf16(a, vb[s2], sd, 0, 0, 0); }
        S[d] = sd; }
#pragma unroll
    for (int mt = 0; mt < 4; ++mt) { f32x4 o = (f32x4){0.f, 0.f, 0.f, 0.f};
#pragma unroll
        for (int s = 0; s < 4; ++s) { const bf16x8 a = *(const LAS bf16x8*)(cur + 16384 + ((mt * 4 + s) * 64 + lane) * 16); o = __builtin_amdgcn_mfma_f32_16x16x32_bf16(a, sb[s], o, 0, 0, 0); }
#pragma unroll
        for (int s2 = 0; s2 < 2; ++s2) { const bf16x8 a = *(const LAS bf16x8*)(cur + 49152 + ((mt * 2 + s2) * 64 + lane) * 16); o = __builtin_amdgcn_mfma_f32_16x16x32_bf16(a, vb[s2], o, 0, 0, 0); }
#pragma unroll
        for (int j = 0; j < 4; ++j) OG[(size_t)(n * 64 + 16 * mt + 4 * quad + j) * 768] = o[j]; }
}
template <int PAR>
__device__ __forceinline__ void gdn_step_l(const Ctx& C, int n, const GAS unsigned char* UB, int lt, u32x4_t (&rr)[14]) {
    if (n + 1 < 64) {
#pragma unroll
        for (int k = 0; k < 14; ++k) *(LAS u32x4_t*)(C.lds + (1 - PAR) * 57344 + (size_t)(lt + 256 * k) * 16) = rr[k]; }
    if (n + 3 < 64) { const GAS unsigned char* un = UB + (size_t)(n + 3) * GDN_UNIT_BYTES;
#pragma unroll
        for (int k = 0; k < 14; ++k) rr[k] = *(const GAS u32x4_t*)(un + (size_t)(lt + 256 * k) * 16); }
}
__device__ __forceinline__ void gdn_seq(const Ctx& C, int gi) {
    const int bh = gi >> 1, b = bh / 6, h = bh % 6, lane = C.lane, col = lane & 15, quad = lane >> 4;
    const GAS unsigned char* UB = C.ws + WS_GU + (size_t)(bh * 64) * GDN_UNIT_BYTES;
    if (C.wave < 4) {
        const int slice = (gi & 1) * 4 + C.wave;
        float* OG = (float*)(C.ws + WS_OGDN) + (size_t)(b * SQ) * 768 + h * 128 + slice * 16 + col;
        f32x4 S[8], uu0[4], uu1[4]; float ue0, ue1;
#pragma unroll
        for (int d = 0; d < 8; ++d) S[d] = (f32x4){0.f, 0.f, 0.f, 0.f};
#pragma unroll
        for (int mt = 0; mt < 4; ++mt) { uu0[mt] = *(const GAS f32x4*)(UB + 57344 + (size_t)((((slice * 4 + mt) * 4 + quad) * 16 + col) * 16)); uu1[mt] = *(const GAS f32x4*)(UB + GDN_UNIT_BYTES + 57344 + (size_t)((((slice * 4 + mt) * 4 + quad) * 16 + col) * 16)); }
        ue0 = *(const GAS float*)(UB + 57344 + 32768); ue1 = *(const GAS float*)(UB + GDN_UNIT_BYTES + 57344 + 32768);
        GDN_BAR();
#pragma unroll 1
        for (int n = 0; n < 64; n += 2) {
            gdn_step_c<0>(C, n, UB, OG, slice, S, uu0, ue0); GDN_BAR();
            gdn_step_c<1>(C, n + 1, UB, OG, slice, S, uu1, ue1); GDN_BAR();
        }
    } else {
        const int lt = C.tid - 256; u32x4_t ra[14], rb[14];
#pragma unroll
        for (int k = 0; k < 14; ++k) { const u32x4_t v = *(const GAS u32x4_t*)(UB + (size_t)(lt + 256 * k) * 16); *(LAS u32x4_t*)(C.lds + (size_t)(lt + 256 * k) * 16) = v; }
#pragma unroll
        for (int k = 0; k < 14; ++k) { ra[k] = *(const GAS u32x4_t*)(UB + GDN_UNIT_BYTES + (size_t)(lt + 256 * k) * 16); rb[k] = *(const GAS u32x4_t*)(UB + 2 * (size_t)GDN_UNIT_BYTES + (size_t)(lt + 256 * k) * 16); }
        GDN_BAR();
#pragma unroll 1
        for (int n = 0; n < 64; n += 2) {
            gdn_step_l<0>(C, n, UB, lt, ra); GDN_BAR();
            gdn_step_l<1>(C, n + 1, UB, lt, rb); GDN_BAR();
        }
    }
}

__device__ __forceinline__ void attn_queue(const Ctx& C, int l) {
    const attn_body::bf16* PROJ = (const attn_body::bf16*)(C.ws + WS_PROJ); attn_body::bf16* ATTO = (attn_body::bf16*)(C.ws + WS_ATTO);
    if (C.tid == 0) C.MISC[18] = 0u;
    for (;;) {
        if (C.tid == 0) { unsigned d = C.MISC[18], q = 0xffffffffu; const unsigned x0 = xb_xcc_id() & 7u;
            for (; d < 8u; ++d) { const unsigned x = (x0 + d) & 7u; const unsigned t = __hip_atomic_fetch_add(C.ctl + CW_QUEUE + 64 * (l * 8 + (int)x), 1u, RLX_AGENT); if (t < 192u) { q = (x << 8) | t; break; } }
            C.MISC[18] = d; C.MISC[16] = q; }
        __syncthreads();
        const unsigned q = (unsigned)__builtin_amdgcn_readfirstlane((int)C.MISC[16]);
        __syncthreads();
        if (q == 0xffffffffu) break;
        const int x = (int)(q >> 8), t = (int)(q & 255u), g = t >> 6, r = t & 63, qb = 15 - (r >> 2), bh = x * 3 + g, b = bh / 6, vh = (bh % 6) * 4 + (r & 3);
        const attn_body::bf16* base = PROJ + (size_t)(b * SQ) * PW;
        attn_body::attn_unit<8>(qb, base + C_DQ + (vh >> 1) * 64, base + C_DK + (vh >> 1) * 64, base + C_DV + (vh >> 2) * 128 + (vh & 1) * 64, ATTO + (size_t)(b * SQ) * 1536 + vh * 64, (char*)C.lds, C.wave);
    }
}

__device__ __forceinline__ volatile LAS unsigned* misc_at(int i) { unsigned a = (unsigned)(MISC_OFF + 4 * i); asm volatile("" : "+v"(a)); return (volatile LAS unsigned*)(size_t)a; }
__device__ __forceinline__ void attn_queue128(const Ctx& C, int l) {
    const attn_body::bf16* PROJ = (const attn_body::bf16*)(C.ws + WS_PROJ); attn_body::bf16* ATTO = (attn_body::bf16*)(C.ws + WS_ATTO);
    if (C.tid == 0) *misc_at(18) = 0u;
    for (;;) {
        if (C.tid == 0) { unsigned d = *misc_at(18), q = 0xffffffffu; const unsigned x0 = xb_xcc_id() & 7u;
            for (; d < 8u; ++d) { const unsigned x = (x0 + d) & 7u; const unsigned t = __hip_atomic_fetch_add(C.ctl + CW_QUEUE + 64 * (l * 8 + (int)x), 1u, RLX_AGENT); if (t < 96u) { q = (x << 8) | t; break; } }
            *misc_at(18) = d; *misc_at(16) = q; }
        __syncthreads();
        const unsigned q = (unsigned)__builtin_amdgcn_readfirstlane((int)*misc_at(16));
        __syncthreads();
        if (q == 0xffffffffu) break;
        const int x = (int)(q >> 8), t = (int)(q & 255u), g = t >> 5, r = t & 31, qb = 15 - (r >> 1), bh = x * 3 + g, b = bh / 6, hm = (bh % 6) * 2 + (r & 1);
        const attn_body::bf16* base = PROJ + (size_t)(b * SQ) * PW;
        attn_body::attn_unit128<8>(qb, base + C_DQ + hm * 64, base + C_DK + hm * 64, base + C_DV + (hm >> 1) * 128, ATTO + (size_t)(b * SQ) * 1536 + hm * 128, (char*)C.lds, C.wave);
    }
}

__device__ __forceinline__ void scan_publish(const Ctx& C, int l) {
    asm volatile("s_waitcnt vmcnt(0)" ::: "memory"); __syncthreads();
    if (C.tid == 0) { __builtin_amdgcn_fence(__ATOMIC_RELEASE, "agent"); asm volatile("s_waitcnt vmcnt(0)" ::: "memory"); (void)__hip_atomic_fetch_add(C.ctl + CW_SCAN + 64 * l, 1u, RLX_AGENT); }
}
__device__ __forceinline__ void scan_wait(const Ctx& C, int l) {
    if (C.tid == 0) { unsigned sp = 0; while (__hip_atomic_load(C.ctl + CW_SCAN + 64 * l, RLX_AGENT) < 16u && ++sp < (1u << 22)) __builtin_amdgcn_s_sleep(2);
        __builtin_amdgcn_fence(__ATOMIC_ACQUIRE, "agent"); asm volatile("s_waitcnt vmcnt(0)" ::: "memory"); }
    __syncthreads();
}

__device__ __forceinline__ void post_mix(const Ctx& C, KP P, int l) {
    const int lane = C.lane; const bf16* ATTO = (const bf16*)(C.ws + WS_ATTO); const float* OG = (const float*)(C.ws + WS_OGDN); const bf16* PROJ = (const bf16*)(C.ws + WS_PROJ); bf16* YCAT = (bf16*)(C.ws + WS_YCAT);
    const float linit = 0.8f - 0.6f * expf(-0.3f * (float)l);
    const float lam = expf(wave_sum(PIN(19)[l * 64 + lane] * PIN(20)[l * 64 + lane])) - expf(wave_sum(PIN(21)[l * 64 + lane] * PIN(22)[l * 64 + lane])) + linit;
    const float sl0 = PIN(23)[l * 128 + 2 * lane] * (1.f - linit), sl1 = PIN(23)[l * 128 + 2 * lane + 1] * (1.f - linit);
    const float gn0 = PIN(27)[l * 128 + 2 * lane], gn1 = PIN(27)[l * 128 + 2 * lane + 1];
    const int tb = (C.blk < 128) ? 48 * C.blk : 6144 + 80 * (C.blk - 128), tn = (C.blk < 128) ? 48 : 80;
    for (int t0 = tb + 2 * C.wave; t0 < tb + tn; t0 += 2 * NWAVES) {
        unsigned o1[2][6], o2[2][6], zz[2][6]; f32x2_t og[2][6];
#pragma unroll
        for (int u = 0; u < 2; ++u)
#pragma unroll
            for (int h = 0; h < 6; ++h) { const int t = t0 + u; o1[u][h] = *(const unsigned*)(ATTO + (size_t)t * 1536 + (2 * h) * 128 + 2 * lane); o2[u][h] = *(const unsigned*)(ATTO + (size_t)t * 1536 + (2 * h + 1) * 128 + 2 * lane);
                og[u][h] = *(const f32x2_t*)(OG + (size_t)t * 768 + h * 128 + 2 * lane); zz[u][h] = *(const unsigned*)(PROJ + (size_t)t * PW + C_GZ + h * 128 + 2 * lane); }
#pragma unroll
        for (int u = 0; u < 2; ++u)
#pragma unroll
            for (int h = 0; h < 6; ++h) { const int t = t0 + u;
                { const float a = bflo(o1[u][h]) - lam * bflo(o2[u][h]), c = bfhi(o1[u][h]) - lam * bfhi(o2[u][h]); const float r = rsqrtf(wave_sum(a * a + c * c) * (1.f / 128.f) + EPS);
                  *(unsigned*)(YCAT + (size_t)t * DM + 512 + h * 128 + 2 * lane) = pk2(a * r * sl0, c * r * sl1); }
                { const f32x2_t o = og[u][h]; const float r = rsqrtf(wave_sum(o.x * o.x + o.y * o.y) * (1.f / 128.f) + EPS);
                  *(unsigned*)(YCAT + (size_t)t * DM + 1280 + h * 128 + 2 * lane) = pk2(o.x * r * gn0 * silu_f(bflo(zz[u][h])), o.y * r * gn1 * silu_f(bfhi(zz[u][h]))); } } }
}

__device__ __forceinline__ void norm_router_phase(const Ctx& C, KP P, const float* __restrict__ nw, const float* __restrict__ mod_shift, const float* __restrict__ mod_scale) {
    LAS float* WRT = (LAS float*)C.lds;
    LAS int* esel = (LAS int*)(C.lds + 65536); LAS int* rankl = esel + 128;
    const float* wr = PIN(31);
    for (int idx = C.tid; idx < DM * 8; idx += NTHR) { const int k = idx >> 3, e = idx & 7; WRT[e * DM + k] = wr[idx]; }
    __syncthreads();
    const float* src = (const float*)(C.ws + WS_HRES); unsigned char* HN8 = (unsigned char*)(C.ws + WS_HN); const int lane = C.lane;
    f32x4 nwv[8];
#pragma unroll
    for (int j = 0; j < 8; ++j) nwv[j] = *(const f32x4*)(nw + 4 * lane + 256 * j);
    f32x4 vn[8];
#pragma unroll
    for (int j = 0; j < 8; ++j) vn[j] = *(const f32x4*)(src + (size_t)(C.blk * 64 + C.wave * 8) * DM + 4 * lane + 256 * j);
    int nlim = 8; asm volatile("" : "+s"(nlim));
#pragma unroll 1
    for (int i = 0; i < nlim; ++i) { const int tl = C.wave * 8 + i, t = C.blk * 64 + tl, b = t >> 12;
        f32x4 v[8]; float ss = 0.f;
#pragma unroll
        for (int j = 0; j < 8; ++j) { v[j] = vn[j]; ss += (v[j].x * v[j].x + v[j].y * v[j].y) + (v[j].z * v[j].z + v[j].w * v[j].w); }
        if (i + 1 < nlim) {
#pragma unroll
            for (int j = 0; j < 8; ++j) vn[j] = *(const f32x4*)(src + (size_t)(t + 1) * DM + 4 * lane + 256 * j); }
        const float r = rsqrtf(wave_sum(ss) * (1.f / DM) + EPS);
        const float* sh = mod_shift + (size_t)b * 6 * DM; const float* scp = mod_scale + (size_t)b * 6 * DM;
#pragma unroll
        for (int j = 0; j < 8; ++j) { const f32x4 s1 = *(const f32x4*)(scp + 4 * lane + 256 * j), s0 = *(const f32x4*)(sh + 4 * lane + 256 * j);
            v[j] = v[j] * r * nwv[j] * (s1 + 1.f) + s0;
            *(GAS unsigned*)(HN8 + (size_t)t * DM + 4 * lane + 256 * j) = pk4_fp8(v[j].x * S8_HN, v[j].y * S8_HN, v[j].z * S8_HN, v[j].w * S8_HN); }
        float lg[8];
        unsigned wb = 16u * (unsigned)lane; asm volatile("" : "+v"(wb)); const LAS float* WRL = (const LAS float*)(size_t)wb;
#pragma unroll
        for (int e = 0; e < 8; ++e) { float a = 0.f;
#pragma unroll
            for (int j = 0; j < 8; ++j) { const f32x4 wv = *(const LAS f32x4*)(WRL + e * DM + 256 * j); a += (v[j].x * wv.x + v[j].y * wv.y) + (v[j].z * wv.z + v[j].w * wv.w); }
            lg[e] = wave_sum(a); }
        int e0 = 0; float v0 = lg[0];
#pragma unroll
        for (int e = 1; e < 8; ++e) if (lg[e] > v0) { v0 = lg[e]; e0 = e; }
        int e1 = -1; float v1 = -INFINITY;
#pragma unroll
        for (int e = 0; e < 8; ++e) if (e != e0 && lg[e] > v1) { v1 = lg[e]; e1 = e; }
        const float g0 = 1.f / (1.f + __expf(v1 - v0)), g1 = 1.f - g0;
        if (lane == 0) { esel[2 * tl] = e0; esel[2 * tl + 1] = e1; ((int*)(C.ws + WS_TOKE))[2 * t] = e0; ((int*)(C.ws + WS_TOKE))[2 * t + 1] = e1; ((float*)(C.ws + WS_TOKG))[2 * t] = g0; ((float*)(C.ws + WS_TOKG))[2 * t + 1] = g1; }
    }
    __syncthreads();
    if (C.tid < 8) { int cnt = 0; for (int i = 0; i < 128; ++i) if (esel[i] == C.tid) rankl[i] = cnt++; ((int*)(C.ws + WS_CNT))[C.blk * 8 + C.tid] = cnt; }
    __syncthreads();
    if (C.tid < 128) ((int*)(C.ws + WS_RANK))[(size_t)C.blk * 128 + C.tid] = rankl[C.tid];
    __syncthreads();
}

__device__ __forceinline__ void route_phase(const Ctx& C) {
    LAS int* tot = (LAS int*)C.lds; LAS int* pre = tot + 8; LAS int* base = tot + 16;
    const int* CNT = (const int*)(C.ws + WS_CNT);
    LAS int* part = tot + 32;
    if (C.tid < 256) { const int bb = C.tid; const int4 ca = *(const int4*)(CNT + bb * 8), cb = *(const int4*)(CNT + bb * 8 + 4); const int cv[8] = {ca.x, ca.y, ca.z, ca.w, cb.x, cb.y, cb.z, cb.w};
#pragma unroll
        for (int e = 0; e < 8; ++e) { int s = cv[e], m = (bb < C.blk) ? cv[e] : 0;
#pragma unroll
            for (int o = 1; o < 64; o <<= 1) { s += __shfl_xor(s, o); m += __shfl_xor(m, o); }
            if (C.lane == 0) { part[C.wave * 16 + e] = s; part[C.wave * 16 + 8 + e] = m; } } }
    __syncthreads();
    if (C.tid < 8) { tot[C.tid] = part[C.tid] + part[16 + C.tid] + part[32 + C.tid] + part[48 + C.tid]; pre[C.tid] = part[8 + C.tid] + part[24 + C.tid] + part[40 + C.tid] + part[56 + C.tid]; }
    __syncthreads();
    if (C.tid == 0) { int run = 0; int* TILE = (int*)(C.ws + WS_TILE);
        for (int e = 0; e < 8; ++e) { base[e] = run; const int nt = (tot[e] + 255) >> 8; if (C.blk == 0) for (int q = 0; q < nt; ++q) TILE[1 + (run >> 8) + q] = e; run += nt << 8; }
        if (C.blk == 0) TILE[0] = run >> 8; }
    __syncthreads();
    const int* TOKE = (const int*)(C.ws + WS_TOKE); const float* TOKG = (const float*)(C.ws + WS_TOKG); const int* RANK = (const int*)(C.ws + WS_RANK);
    int* POS = (int*)(C.ws + WS_POS); float* GW = (float*)(C.ws + WS_GW); const unsigned char* HN8 = (const unsigned char*)(C.ws + WS_HN); unsigned char* AS8 = (unsigned char*)(C.ws + WS_AS);
    for (int i = 0; i < 8; ++i) { const int t = C.blk * 64 + C.wave * 8 + i;
        const int e0 = TOKE[2 * t], e1 = TOKE[2 * t + 1]; const int p0 = base[e0] + pre[e0] + RANK[2 * t], p1 = base[e1] + pre[e1] + RANK[2 * t + 1];
        if (C.lane == 0) { POS[2 * t] = p0; POS[2 * t + 1] = p1; GW[p0] = TOKG[2 * t]; GW[p1] = TOKG[2 * t + 1]; }
#pragma unroll
        for (int j = 0; j < 2; ++j) { const u32x4_t v = *(const u32x4_t*)(HN8 + (size_t)t * DM + 16 * C.lane + 1024 * j); *(u32x4_t*)(AS8 + (size_t)p0 * DM + 16 * C.lane + 1024 * j) = v; *(u32x4_t*)(AS8 + (size_t)p1 * DM + 16 * C.lane + 1024 * j) = v; } }
    __syncthreads();
}

__device__ __forceinline__ void ctr_wait(const Ctx& C, gu32* w, unsigned n) {
    if (C.tid == 0) { unsigned sp = 0; while (__hip_atomic_load(w, RLX_AGENT) < n && ++sp < (1u << 22)) __builtin_amdgcn_s_sleep(2);
        __builtin_amdgcn_fence(__ATOMIC_ACQUIRE, "agent"); asm volatile("s_waitcnt vmcnt(0)" ::: "memory"); }
    __syncthreads();
}
constexpr int FIN_W1 = 4;
template <int LATE>
__device__ __forceinline__ void final_pass(const Ctx& C, KP P, int late_row, int first, int step) {
    const float* HR = (const float*)(C.ws + WS_HRES); const bf16* YS = (const bf16*)(C.ws + WS_AS); const int* POS = (const int*)(C.ws + WS_POS);
    const float* gate2 = (const float*)(C.ws + WS_MOD) + (size_t)(1 * 4) * 6 * DM + 5 * DM; const float* nf = PIN(7); const int lane = C.lane;
    for (int it = first; it < TOK / 2; it += step) {
        const int t0 = 2 * (int)it; const int b = t0 >> 12; const int4 pp = *(const int4*)(POS + 2 * t0);
        const int pmin = __builtin_amdgcn_readfirstlane(min(min(pp.x, pp.y), min(pp.z, pp.w)));
        if ((pmin < late_row) == (LATE == 1)) {
        f32x4 v[2][8]; float ss0 = 0.f, ss1 = 0.f;
#pragma unroll
        for (int j = 0; j < 8; ++j) { const int c = 4 * lane + 256 * j; const f32x4 g = *(const f32x4*)(gate2 + (size_t)b * 6 * DM + c);
            const f32x4 ha = *(const f32x4*)(HR + (size_t)t0 * DM + c), hb = *(const f32x4*)(HR + (size_t)(t0 + 1) * DM + c);
            const u32x2_t a0 = *(const u32x2_t*)(YS + (size_t)pp.x * DM + c), a1 = *(const u32x2_t*)(YS + (size_t)pp.y * DM + c), b0 = *(const u32x2_t*)(YS + (size_t)pp.z * DM + c), b1 = *(const u32x2_t*)(YS + (size_t)pp.w * DM + c);
            const f32x4 ya = (f32x4){bflo(a0.x) + bflo(a1.x), bfhi(a0.x) + bfhi(a1.x), bflo(a0.y) + bflo(a1.y), bfhi(a0.y) + bfhi(a1.y)};
            const f32x4 yb = (f32x4){bflo(b0.x) + bflo(b1.x), bfhi(b0.x) + bfhi(b1.x), bflo(b0.y) + bflo(b1.y), bfhi(b0.y) + bfhi(b1.y)};
            v[0][j] = ha + g * ya; v[1][j] = hb + g * yb;
            ss0 += (v[0][j].x * v[0][j].x + v[0][j].y * v[0][j].y) + (v[0][j].z * v[0][j].z + v[0][j].w * v[0][j].w); ss1 += (v[1][j].x * v[1][j].x + v[1][j].y * v[1][j].y) + (v[1][j].z * v[1][j].z + v[1][j].w * v[1][j].w); }
        const float r0 = rsqrtf(wave_sum(ss0) * (1.f / DM) + EPS), r1 = rsqrtf(wave_sum(ss1) * (1.f / DM) + EPS);
#pragma unroll
        for (int j = 0; j < 8; ++j) { const int c = 4 * lane + 256 * j; const f32x4 w = *(const f32x4*)(nf + c); *(f32x4*)(POUT + (size_t)t0 * DM + c) = v[0][j] * r0 * w; *(f32x4*)(POUT + (size_t)(t0 + 1) * DM + c) = v[1][j] * r1 * w; } }
    }
}
__device__ __forceinline__ void final_phase(const Ctx& C, KP P) {
    const int late_row = (__builtin_amdgcn_readfirstlane(((const int*)(C.ws + WS_TILE))[0]) & 31) * 256;
    const int nb = late_row >> 4;
    if (C.blk >= nb) { ctr_wait(C, C.ctl + CW_FIN, (unsigned)C.G);
        if (C.wave < FIN_W1) final_pass<0>(C, P, late_row, (C.blk - nb) * FIN_W1 + C.wave, (C.G - nb) * FIN_W1); }
    else { ctr_wait(C, C.ctl + CW_FIN + 64, (unsigned)C.G); final_pass<1>(C, P, late_row, C.blk * NWAVES + C.wave, nb * NWAVES); }
}

#ifndef MK_N_LAUNCHES
#define MK_N_LAUNCHES 1
#endif
constexpr int N_PHASES = 24;

#if defined(PROBE_LO)
#define PROBE_BEGIN(k) do { if ((k) == PROBE_LO && blockIdx.x == 0 && C0.wave == 0 && mk_lane() == 0) { const unsigned long long t_ = __builtin_amdgcn_s_memrealtime(); C0.MISC[20] = (unsigned)t_; C0.MISC[21] = (unsigned)(t_ >> 32); } } while (0)
#define PROBE_END(k) do { if ((k) == PROBE_HI && blockIdx.x == 0 && C0.wave == 0 && mk_lane() == 0) { const unsigned long long t_ = __builtin_amdgcn_s_memrealtime() - (((unsigned long long)C0.MISC[21] << 32) | C0.MISC[20]); C0.MISC[22] = (unsigned)t_; } } while (0)
#else
#define PROBE_BEGIN(k) do {} while (0)
#define PROBE_END(k) do {} while (0)
#endif
template <int L>
__device__ __forceinline__ void layer_phases(const Ctx& C0, KP P0, int lo, int hi) {
#define IN(k) (lo <= (k) && (k) < hi)
#define SEAM_FILL(k) do { if (IN(k) && IN((k) + 1)) { PHASE_ENV moe_cvt_fill(C, P, (k)); } } while (0)
#define SEAM(k) do { if (IN(k) && IN((k) + 1)) { GAS unsigned char* w_ = C0.ws; asm volatile("" : "+s"(w_)); XcdBarrier b_; b_.bar = (unsigned*)(w_ + WS_CTL) + CW_BAR + (MK_N_LAUNCHES == 1 ? 0 : lo) * XCD_BAR_WORDS; b_.x = xb_xcc_id(); b_.st = C0.MISC + 8; b_.lead = (C0.wave == 0 && mk_lane() == 0); xcd_barrier(b_); } PROBE_END(k); } while (0)
    constexpr int PB = 1 + 11 * L;
#define PHASE_ENV Ctx C = C0; KP P = P0; asm volatile("" : "+s"(C.ws), "+s"(P)); GAS unsigned char* ws = C.ws; C.ctl = (gu32*)(ws + WS_CTL); \
    C.lane = mk_lane(); asm volatile("" : "+v"(C.lane)); C.tid = C.wave * 64 + C.lane; \
    const float* MOD = (const float*)(ws + WS_MOD) + (size_t)(L * 4) * 6 * DM; float* HRES = (float*)(ws + WS_HRES); bf16* HN = (bf16*)(ws + WS_HN); bf16* PROJ = (bf16*)(ws + WS_PROJ); bf16* YCAT = (bf16*)(ws + WS_YCAT); \
    (void)MOD; (void)HRES; (void)HN; (void)PROJ; (void)YCAT; (void)P;
    PROBE_BEGIN(PB + 0); if (IN(PB + 0)) { PHASE_ENV norm_phase<true>(C, L == 0 ? PIN(0) : HRES, PIN(5) + L * DM, MOD + 0 * DM, MOD + 1 * DM, PIN(8) + (size_t)L * DM * INW); }
    SEAM(PB + 0);
    PROBE_BEGIN(PB + 1); if (IN(PB + 1)) { PHASE_ENV pg8::Gemm g{HN, (const bf16*)(ws + WS_WIN) + (size_t)L * PW * DM, TOK, PW, DM}; pg8::StaticOrder S; S.init(TOK, PW, C.G, C.blk); pg8::EpiProj E{PROJ};
        pg8::gemm_phase<pg8::EpiProj, pg8::StaticOrder, true, true>(C.lds, g, S, E, C.wave); }
    SEAM_FILL(PB + 1); SEAM(PB + 1);
    PROBE_BEGIN(PB + 2); if (IN(PB + 2)) { PHASE_ENV rope_pass(C); ssm_gemm_a(C, L);
#pragma unroll 1
        for (int u = C.blk; u < 1536; u += C.G) gdn_prep_unit(C, P, L, u); }
    SEAM(PB + 2);
    PROBE_BEGIN(PB + 3); if (IN(PB + 3)) { PHASE_ENV if (C.blk < 48) { PSPAN_BEGIN(C, 100); gdn_seq(C, C.blk); PSPAN_END(C, 100); __syncthreads(); } else if (C.blk >= C.G - 16) { ssm_scan(C, L, C.blk - (C.G - 16)); scan_publish(C, L); } attn_queue128(C, L); }
    if (IN(PB + 3)) { PHASE_ENV scan_wait(C, L); ssm_gemm_b(C, L); }
    SEAM_FILL(PB + 3); SEAM(PB + 3);
    PROBE_BEGIN(PB + 4); if (IN(PB + 4)) { PHASE_ENV
        { pg8::Gemm g{(const bf16*)(ws + WS_YGELU), (const bf16*)(ws + WS_WGLU) + (size_t)L * 512 * 512, TOK, 512, 512}; pg8::StaticOrder S; S.init(TOK, 512, C.G, C.blk); pg8::EpiGlu E{(const bf16*)(ws + WS_YGELU), YCAT};
          pg8::gemm_phase<pg8::EpiGlu, pg8::StaticOrder, true, true>(C.lds, g, S, E, C.wave); }
        post_mix(C, P, L); }
    SEAM(PB + 4);
    PROBE_BEGIN(PB + 6); if (IN(PB + 6)) { PHASE_ENV pg8::Gemm g{YCAT, (const bf16*)(ws + WS_WOUT) + (size_t)L * DM * DM, TOK, DM, DM}; pg8::StaticOrder S; S.init(TOK, DM, C.G, C.blk); pg8::EpiRes E{L == 0 ? PIN(0) : HRES, HRES, MOD + 2 * DM, 1.f};
        pg8::gemm_phase<pg8::EpiRes, pg8::StaticOrder, true, true>(C.lds, g, S, E, C.wave); }
    SEAM(PB + 6);
    if (L == 0) {
        PROBE_BEGIN(PB + 7); if (IN(PB + 7)) { PHASE_ENV norm_phase<false, (DENSE_FP8 >= 1)>(C, HRES, PIN(6) + L * DM, MOD + 3 * DM, MOD + 4 * DM, nullptr); }
        SEAM(PB + 7);
        SEAM(PB + 8);
        PROBE_BEGIN(PB + 9); if (IN(PB + 9)) { PHASE_ENV pg8::StaticOrder S; S.init(TOK, 2 * DFF, C.G, C.blk);
            if (DENSE_FP8 == 2) { pg8::Gemm g{HN, (const bf16*)(ws + WS_WUP), TOK, 2 * DFF, DM / 2}; pg8::EpiSwiglu8 E{(unsigned char*)(ws + WS_H), DFF, 2 * DFF / 256, 1.f / (S8_HN * S8_W13)}; pg8::gemm_phase<pg8::EpiSwiglu8, pg8::StaticOrder, true, true, true>(C.lds, g, S, E, C.wave); }
            else if (DENSE_FP8 == 1) { pg8::Gemm g{HN, (const bf16*)(ws + WS_WUP), TOK, 2 * DFF, DM / 2}; pg8::EpiSwiglu E{(bf16*)(ws + WS_H), DFF, 2 * DFF / 256, 1.f / (S8_HN * S8_W13)}; pg8::gemm_phase<pg8::EpiSwiglu, pg8::StaticOrder, true, true, true>(C.lds, g, S, E, C.wave); }
            else { pg8::Gemm g{HN, (const bf16*)(ws + WS_WUP), TOK, 2 * DFF, DM}; pg8::EpiSwiglu E{(bf16*)(ws + WS_H), DFF, 2 * DFF / 256, 1.f}; pg8::gemm_phase<pg8::EpiSwiglu, pg8::StaticOrder, true, true>(C.lds, g, S, E, C.wave); } }
        SEAM(PB + 9);
        PROBE_BEGIN(PB + 10); if (IN(PB + 10)) { PHASE_ENV pg8::StaticOrder S; S.init(TOK, DM, C.G, C.blk);
            if (DENSE_FP8 == 2) { pg8::Gemm g{(const bf16*)(ws + WS_H), (const bf16*)(ws + WS_WDN), TOK, DM, DFF / 2}; pg8::EpiRes E{HRES, HRES, MOD + 5 * DM, 1.f / (S8_H * S8_W2)}; pg8::gemm_phase<pg8::EpiRes, pg8::StaticOrder, true, true, true>(C.lds, g, S, E, C.wave); }
            else { pg8::Gemm g{(const bf16*)(ws + WS_H), (const bf16*)(ws + WS_WDN), TOK, DM, DFF}; pg8::EpiRes E{HRES, HRES, MOD + 5 * DM, 1.f}; pg8::gemm_phase<pg8::EpiRes, pg8::StaticOrder, true, true>(C.lds, g, S, E, C.wave); } }
        SEAM(PB + 10);
    } else {
        PROBE_BEGIN(PB + 7); if (IN(PB + 7)) { PHASE_ENV norm_router_phase(C, P, PIN(6) + L * DM, MOD + 3 * DM, MOD + 4 * DM); }
        SEAM(PB + 7);
        PROBE_BEGIN(PB + 8); if (IN(PB + 8)) { PHASE_ENV moe_cvt_drain(C, P); route_phase(C); }
        SEAM(PB + 8);
        PROBE_BEGIN(PB + 9); if (IN(PB + 9)) { PHASE_ENV LAS int* TL = (LAS int*)(C.lds + TILE_OFF); for (int i = C.tid; i <= MOE_TILES_MAX; i += NTHR) TL[i] = ((const int*)(ws + WS_TILE))[i]; __syncthreads(); const int R = __builtin_amdgcn_readfirstlane(TL[0]);
            pg8::Gemm g{(const bf16*)(ws + WS_AS), (const bf16*)(ws + WS_MUP), R * 256, 2 * DFE, DM / 2}; pg8::MoeOrder S; S.so.init(R * 256, 2 * DFE, C.G, C.blk); S.tile_e = TL + 1; S.nct = 2 * DFE / 256;
            pg8::EpiSwiglu8 E{(unsigned char*)(ws + WS_H), DFE, 2 * DFE / 256, 1.f / (S8_HN * S8_W13)};
            pg8::gemm_phase<pg8::EpiSwiglu8, pg8::MoeOrder, true, true, true>(C.lds, g, S, E, C.wave); }
        SEAM(PB + 9);
        PROBE_BEGIN(PB + 10); if (IN(PB + 10)) { PHASE_ENV LAS int* TL = (LAS int*)(C.lds + TILE_OFF); for (int i = C.tid; i <= MOE_TILES_MAX; i += NTHR) TL[i] = ((const int*)(ws + WS_TILE))[i]; __syncthreads(); const int R = __builtin_amdgcn_readfirstlane(TL[0]);
            pg8::Gemm g{(const bf16*)(ws + WS_H), (const bf16*)(ws + WS_MDN), R * 256, DM, DFE / 2}; pg8::MoeDownOrder S; S.nM = R; S.nl = R & 31; S.R = R >> 5; S.c = C.blk; S.so.init((R - S.nl) * 256, DM, C.G, C.blk); S.tile_e = TL + 1; S.nct = DM / 256; S.ntf = DFE / 128;
            S.arr = (gu32*)(ws + WS_CTL) + CW_FIN; S.wc = (LAS unsigned*)(C.lds + MISC_OFF) + 28;
            pg8::EpiMoeDown E{(bf16*)(ws + WS_AS), (const float*)(ws + WS_GW), 1.f / (S8_H * S8_W2), (f32x4*)(ws + WS_XC), (gu32*)(ws + WS_CTL) + CW_FIN + 256, (LAS unsigned*)(C.lds + MISC_OFF) + 29};
            pg8::gemm_phase<pg8::EpiMoeDown, pg8::MoeDownOrder, true, true, true>(C.lds, g, S, E, C.wave);
            asm volatile("s_waitcnt vmcnt(0)" ::: "memory"); __syncthreads();
            if (C.wave == 0 && mk_lane() == 0) { __builtin_amdgcn_fence(__ATOMIC_RELEASE, "agent"); asm volatile("s_waitcnt vmcnt(0)" ::: "memory"); (void)__hip_atomic_fetch_add((gu32*)(ws + WS_CTL) + CW_FIN + 64, 1u, RLX_AGENT); } }
        PROBE_END(PB + 10);
    }
#undef IN
#undef SEAM
#undef PHASE_ENV
}

__global__ void __launch_bounds__(NTHR, 2) mk_fwd(Params P) {
    extern __shared__ __attribute__((aligned(16))) unsigned char lds[];
    KP KPp = (KP)__builtin_amdgcn_kernarg_segment_ptr();
    Ctx C; C.lds = (LAS unsigned char*)lds; C.MISC = (volatile LAS unsigned*)(C.lds + MISC_OFF); C.ws = (GAS unsigned char*)KPp->ws; C.ctl = (gu32*)(C.ws + WS_CTL);
    C.tid = threadIdx.x; C.lane = C.tid & 63; C.wave = __builtin_amdgcn_readfirstlane(C.tid >> 6); C.blk = blockIdx.x; C.G = 256;
    for (int u = C.tid; u < (LDS_BYTES - TILE_OFF) / 4; u += NTHR) ((LAS unsigned*)(C.lds + TILE_OFF))[u] = 0u;
    __syncthreads();
    const int lo = KPp->ph_lo, hi = KPp->ph_hi;
    (void)xcd_barrier_post((unsigned*)(C.ctl + CW_BAR) + (MK_N_LAUNCHES == 1 ? 0 : lo) * XCD_BAR_WORDS, C.MISC + 8);
    { const Ctx& C0 = C; PROBE_BEGIN(0); }
    if (lo <= 0 && 0 < hi) { Ctx Cp = C; KP Pp = KPp; asm volatile("" : "+s"(Cp.ws), "+s"(Pp)); Cp.lane = mk_lane(); asm volatile("" : "+v"(Cp.lane)); Cp.tid = Cp.wave * 64 + Cp.lane; p0_prologue(Cp, Pp); if (1 < hi) { XcdBarrier b_; b_.bar = (unsigned*)(Cp.ws + WS_CTL) + CW_BAR + (MK_N_LAUNCHES == 1 ? 0 : lo) * XCD_BAR_WORDS; b_.x = xb_xcc_id(); b_.st = C.MISC + 8; b_.lead = (C.wave == 0 && mk_lane() == 0); xcd_barrier(b_); } }
    { const Ctx& C0 = C; PROBE_END(0); }
    layer_phases<0>(C, KPp, lo, hi);
    layer_phases<1>(C, KPp, lo, hi);
    { const Ctx& C0 = C; PROBE_BEGIN(23); }
    if (lo <= 23 && 23 < hi) { Ctx Cp = C; KP Pp = KPp; asm volatile("" : "+s"(Cp.ws), "+s"(Pp)); Cp.lane = mk_lane(); asm volatile("" : "+v"(Cp.lane)); Cp.tid = Cp.wave * 64 + Cp.lane; final_phase(Cp, Pp); }
    { const Ctx& C0 = C; PROBE_END(23); }
#if defined(PROBE_LO)
    if (blockIdx.x == 0 && C.wave == 0 && mk_lane() == 0) { const unsigned long long t0_ = __builtin_amdgcn_s_memrealtime(), w_ = (unsigned long long)C.MISC[22] * PROBE_MULT; while (__builtin_amdgcn_s_memrealtime() - t0_ < w_) __builtin_amdgcn_s_sleep(8); }
#endif
}

extern "C" void kernel_launch(void* const* d_in, const int* in_sizes, int n_in, void* d_out, int out_size, void* d_ws, size_t ws_size, hipStream_t stream) {
    static int grid = 0;
    if (grid == 0) {
        if (n_in != 35 || in_sizes[0] != TOK * DM || out_size != TOK * DM || ws_size < WS_END) { fprintf(stderr, "kernel_launch: unexpected problem: n_in %d in0 %d out %d ws %zu (need %zu)\n", n_in, n_in > 0 ? in_sizes[0] : -1, out_size, ws_size, (size_t)WS_END); grid = -1; return; }
        int dev = 0, cus = 0, per_cu = 0;
        if (hipGetDevice(&dev) != hipSuccess || hipDeviceGetAttribute(&cus, hipDeviceAttributeMultiprocessorCount, dev) != hipSuccess) { grid = -1; return; }
        if (hipFuncSetAttribute((const void*)mk_fwd, hipFuncAttributeMaxDynamicSharedMemorySize, LDS_BYTES) != hipSuccess) { fprintf(stderr, "kernel_launch: hipFuncSetAttribute failed\n"); grid = -1; return; }
        if (hipOccupancyMaxActiveBlocksPerMultiprocessor(&per_cu, (const void*)mk_fwd, NTHR, LDS_BYTES) != hipSuccess || per_cu < 1) fprintf(stderr, "kernel_launch: occupancy query says %d\n", per_cu);
        (void)hipGetLastError();
        grid = 256;
        if (cus < 256) { fprintf(stderr, "kernel_launch: device has %d CUs, this kernel needs 256\n", cus); grid = -1; return; }
    }
    if (grid < 0) return;
    if (hipMemsetAsync((char*)d_ws + WS_CTL, 0, CTL_ZERO_BYTES, stream) != hipSuccess) return;
    Params p{};
    for (int i = 0; i < 35; ++i) p.in[i] = (const float*)d_in[i];
    p.out = (float*)d_out; p.ws = (unsigned char*)d_ws;
#if MK_N_LAUNCHES == 1
    p.ph_lo = 0; p.ph_hi = N_PHASES;
    hipLaunchKernelGGL(mk_fwd, dim3(grid), dim3(NTHR), LDS_BYTES, stream, p);
#else
    for (int k = 0; k < N_PHASES; ++k) { p.ph_lo = k; p.ph_hi = k + 1; hipLaunchKernelGGL(mk_fwd, dim3(grid), dim3(NTHR), LDS_BYTES, stream, p); }
#endif
}
```

```cpp
#include <hip/hip_runtime.h>
#include <hip/hip_bf16.h>
#include <cstdio>
#include <cstdint>
#include <cmath>
__device__ __forceinline__ int mk_lane() { int l = (int)__builtin_amdgcn_mbcnt_hi(~0u, __builtin_amdgcn_mbcnt_lo(~0u, 0u)); asm volatile("" : "+v"(l)); return l; }
namespace pg8 {
#define PG8_LAS __attribute__((address_space(3)))
typedef unsigned short bf16_t;
typedef short bf16x8 __attribute__((ext_vector_type(8)));
typedef float f32x4 __attribute__((ext_vector_type(4)));
typedef unsigned u32x4 __attribute__((ext_vector_type(4)));
constexpr int BM = 256, BK = 64, HALF = 128, HTB = HALF * BK * 2  , STAGE_BYTES = 8 * HTB, NXCD = 8, WGM = 8;

__host__ __device__ __forceinline__ int lds_byte(int r, int c) { const int st = (r >> 4) * 2 + (c >> 5), rr = r & 15, cc = c & 31, ob = rr * 64 + cc * 2; return st * 1024 + (ob ^ (((ob >> 9) & 1) << 5)); }
__host__ __device__ __forceinline__ void stage_rc(int b, int& R, int& C) { const int st = b / 1024, sb = b % 1024, swz = sb ^ (((sb >> 9) & 1) << 5); R = (st >> 1) * 16 + swz / 64; C = (st & 1) * 32 + (swz % 64) / 2; }
__host__ __device__ __forceinline__ int perm32(int rho) { const int n = rho >> 4, i = rho & 15; return 8 * (i >> 2) + 4 * n + (i & 3); }

struct Unit { int pm, pn, aux = 0, kt0 = 0, nt = 0, ks = 0, slot = 0; };
struct Gemm { const bf16_t* A; const bf16_t* Bt; int M, N, K; };

struct StaticOrder {
    static constexpr bool SPLITK = false;
    int nM, nN, nwg, G, c;
    __host__ __device__ void init(int M, int N, int G_, int c_) { nM = M / BM; nN = N / BM; nwg = nM * nN; G = G_; c = c_; }
    __host__ __device__ bool next(int i, Unit& u) const {
        const long L = (long)i * G + c; if (L >= nwg) return false;
        int wgid = (int)L; { const int q = nwg / NXCD, r = nwg % NXCD, xcd = wgid % NXCD, off = wgid / NXCD; wgid = (xcd < r ? xcd * (q + 1) : r * (q + 1) + (xcd - r) * q) + off; }
        const int nig = WGM * nN, gid = wgid / nig, fm = gid * WGM, gsz = (nM - fm) < WGM ? (nM - fm) : WGM;
        u.pm = fm + ((wgid % nig) % gsz); u.pn = (wgid % nig) / gsz; return true;
    }
    __device__ __forceinline__ void a_ready(const Unit&) const {}
    __device__ __forceinline__ void done(const Unit&) const {}
};

__device__ __forceinline__ unsigned cvt_pk_bf16(float lo, float hi) { unsigned r; asm volatile("v_cvt_pk_bf16_f32 %0, %1, %2" : "=v"(r) : "v"(lo), "v"(hi)); return r; }
typedef float f32x2 __attribute__((ext_vector_type(2)));
__device__ __forceinline__ f32x2 gelu_pk(f32x2 v) {
    const f32x2 av = __builtin_elementwise_abs(v), d = av * 0.2316418882f + 1.0f;
    f32x2 t; t.x = __builtin_amdgcn_rcpf(d.x); t.y = __builtin_amdgcn_rcpf(d.y);
    f32x2 q = t * 0.5307027145f + (-0.7265760135f); q = q * t + 0.7107068705f; q = q * t + (-0.142248368f); q = q * t + 0.127414796f; q = q * t;
    const f32x2 s = (v * v) * (-0.72134752044f);
    f32x2 e; e.x = __builtin_amdgcn_exp2f(s.x); e.y = __builtin_amdgcn_exp2f(s.y);
    const f32x2 m = v * (q * e), r = v - m;
    f32x2 o; o.x = v.x < 0.f ? m.x : r.x; o.y = v.y < 0.f ? m.y : r.y; return o;
}

template <int ACT  > struct EpiBf16 {
    static constexpr bool PERM = true, AFTER_DRAIN = false; static_assert(ACT == 0 || ACT == 1, "EpiBf16: ACT is 0 (none) or 1 (gelu_pk)");
    bf16_t* O; int ldc; const float* bias; int split_cols; size_t split_stride; float scale0;
    __device__ __forceinline__ void operator()(const f32x4 (&acc)[2][2][4][2], const Unit& u, int wr, int wc, int fr, int fq) const {
        const int row0 = u.pm * BM + wr * 64 + fr; int colt = u.pn * BM; bf16_t* base = O;
        float sc = 1.f; if (split_cols) { const int t = colt / split_cols; base += (size_t)t * split_stride; colt -= t * split_cols; if (t == 0) sc = scale0; }
        const int col0 = colt + wc * 32 + 8 * fq, bcol0 = u.pn * BM + wc * 32 + 8 * fq;
        f32x4 bv[2][2];
#pragma unroll
        for (int bj = 0; bj < 2; ++bj)
#pragma unroll
            for (int n = 0; n < 2; ++n) bv[bj][n] = bias ? *(const f32x4*)(bias + bcol0 + bj * HALF + 4 * n) : (f32x4){0.f, 0.f, 0.f, 0.f};
#pragma unroll
        for (int ai = 0; ai < 2; ++ai)
#pragma unroll
            for (int m = 0; m < 4; ++m) { bf16_t* rowp = base + (size_t)(row0 + ai * HALF + m * 16) * ldc + col0;
#pragma unroll
                for (int bj = 0; bj < 2; ++bj) { f32x4 v0 = acc[ai][bj][m][0] + bv[bj][0], v1 = acc[ai][bj][m][1] + bv[bj][1];
                    if (ACT == 1) { f32x2 a = gelu_pk((f32x2){v0[0], v0[1]}), b = gelu_pk((f32x2){v0[2], v0[3]}), c = gelu_pk((f32x2){v1[0], v1[1]}), d = gelu_pk((f32x2){v1[2], v1[3]});
                        v0 = (f32x4){a.x, a.y, b.x, b.y}; v1 = (f32x4){c.x, c.y, d.x, d.y}; }
                    v0 = v0 * sc; v1 = v1 * sc; u32x4 w; w.x = cvt_pk_bf16(v0[0], v0[1]); w.y = cvt_pk_bf16(v0[2], v0[3]); w.z = cvt_pk_bf16(v1[0], v1[1]); w.w = cvt_pk_bf16(v1[2], v1[3]);
                    *(u32x4*)(rowp + bj * HALF) = w; } }
    }
};

typedef int v8i_t __attribute__((ext_vector_type(8))); typedef int v4i_t __attribute__((ext_vector_type(4)));
__device__ __forceinline__ v8i_t cat8(const bf16x8& a, const bf16x8& b) { return __builtin_shufflevector(__builtin_bit_cast(v4i_t, a), __builtin_bit_cast(v4i_t, b), 0, 1, 2, 3, 4, 5, 6, 7); }
template <class Epi, class Sched, bool ALIGN_EPI = false, bool SP2 = false, bool FP8 = false>
__device__ __forceinline__ void gemm_phase(PG8_LAS unsigned char* lds, const Gemm g, const Sched& S, const Epi& E, const int wv  ) {
    const int lane = mk_lane(), wid = wv, tid = wv * 64 + lane, wr = wid >> 2, wc = wid & 3, fr = lane & 15, fq = lane >> 4;
    const int K = g.K, nt = K / BK;
    unsigned voffA[2], voffB[2];
#pragma unroll
    for (int i = 0; i < 2; ++i) { int R, C; stage_rc(tid * 16 + i * 8192, R, C); const int Rb = Epi::PERM ? ((R & ~31) + perm32(R & 31)) : R;
        voffA[i] = (unsigned)(R * K + C) * 2u; voffB[i] = (unsigned)(Rb * K + C) * 2u; }
    const size_t kstep = (size_t)(BK * 2);
    const size_t hstep = (size_t)HALF * K * 2;
    const size_t tstep = 2 * hstep;
    const unsigned ldsw = (unsigned)wid * 1024u;
    const int aoff = lds_byte(wr * 64 + fr, fq * 8), boff = lds_byte(wc * 32 + fr, fq * 8);
#define PG8_SA(b, h) (((b) * 2 + (h)) * HTB)
#define PG8_SB(b, h) ((4 + (b) * 2 + (h)) * HTB)
#define PG8_STAGE(bufoff, gbase, voff) do { _Pragma("unroll") for (int _i = 0; _i < 2; ++_i) \
        __builtin_amdgcn_global_load_lds((const unsigned*)((const char*)(gbase) + (voff)[_i]), (PG8_LAS unsigned*)(lds + (bufoff) + ldsw + _i * 8192), 16, 0, 0); } while (0)
#define PG8_LDA(dst, b, h) do { _Pragma("unroll") for (int m = 0; m < 4; ++m) _Pragma("unroll") for (int k = 0; k < 2; ++k) dst[m][k] = *(const PG8_LAS bf16x8*)(lds + PG8_SA(b, h) + aoff + m * 2048 + k * 1024); } while (0)
#define PG8_LDB(dst, b, h) do { _Pragma("unroll") for (int n = 0; n < 2; ++n) _Pragma("unroll") for (int k = 0; k < 2; ++k) dst[n][k] = *(const PG8_LAS bf16x8*)(lds + PG8_SB(b, h) + boff + n * 2048 + k * 1024); } while (0)
#define PG8_MMA(ai, bj, At, Bt) do { __builtin_amdgcn_s_setprio(1); \
        if constexpr (FP8) { asm volatile("s_nop 1" ::: ); _Pragma("unroll") for (int m = 0; m < 4; ++m) _Pragma("unroll") for (int n = 0; n < 2; ++n) \
            asm volatile("v_mfma_scale_f32_16x16x128_f8f6f4 %0, %1, %2, %0, %3, %3 op_sel_hi:[0,0,0]" : "+v"(acc[ai][bj][m][n]) : "v"(cat8(Bt[n][0], Bt[n][1])), "v"(cat8(At[m][0], At[m][1])), "v"(sc_one)); } \
        else { _Pragma("unroll") for (int m = 0; m < 4; ++m) _Pragma("unroll") for (int n = 0; n < 2; ++n) _Pragma("unroll") for (int k = 0; k < 2; ++k) \
            acc[ai][bj][m][n] = __builtin_amdgcn_mfma_f32_16x16x32_bf16(Bt[n][k], At[m][k], acc[ai][bj][m][n], 0, 0, 0); } \
        __builtin_amdgcn_s_setprio(0); } while (0)
#define PG8_WAIT_V(n) asm volatile("s_waitcnt vmcnt(" #n ")" ::: "memory")
#define PG8_WAIT_L(n) asm volatile("s_waitcnt lgkmcnt(" #n ")" ::: "memory")
#define PG8_BAR __builtin_amdgcn_s_barrier()
#define PG8_SCHED __builtin_amdgcn_sched_barrier(0)
    Unit cur, nxt; int ui = 0;
    if (!S.next(0, cur)) return;
    unsigned sc_one = 0x7f7f7f7fu; asm volatile("" : "+v"(sc_one));
    (void)sc_one;
    f32x4 acc[2][2][4][2];
#pragma unroll
    for (int a = 0; a < 2; ++a)
#pragma unroll
        for (int b = 0; b < 2; ++b)
#pragma unroll
            for (int m = 0; m < 4; ++m)
#pragma unroll
                for (int n = 0; n < 2; ++n) acc[a][b][m][n] = (f32x4){0.f, 0.f, 0.f, 0.f};
    bf16x8 At[4][2], B0[2][2], B1[2][2];
    const char* cA = (const char*)g.A + (size_t)cur.pm * tstep; const char* cB = (const char*)g.Bt + (size_t)cur.pn * tstep;
    if constexpr (Sched::SPLITK) { cA += (size_t)cur.kt0 * kstep; cB += (size_t)cur.kt0 * kstep; }
    S.a_ready(cur);
    if constexpr (SP2) {
        PG8_STAGE(PG8_SB(0, 0), cB, voffB); PG8_STAGE(PG8_SB(0, 1), cB + hstep, voffB); PG8_STAGE(PG8_SA(0, 0), cA, voffA); PG8_STAGE(PG8_SA(0, 1), cA + hstep, voffA);
        if (wr == 1) PG8_BAR;
        PG8_WAIT_V(2); PG8_BAR;
        PG8_STAGE(PG8_SB(1, 0), cB + kstep, voffB); PG8_STAGE(PG8_SA(1, 0), cA + kstep, voffA); PG8_STAGE(PG8_SB(1, 1), cB + hstep + kstep, voffB);
        PG8_WAIT_V(6); PG8_BAR;
    } else {
        PG8_STAGE(PG8_SB(0, 0), cB, voffB); PG8_STAGE(PG8_SA(0, 0), cA, voffA); PG8_STAGE(PG8_SB(0, 1), cB + hstep, voffB); PG8_STAGE(PG8_SA(0, 1), cA + hstep, voffA);
        if (wr == 1) PG8_BAR;
        PG8_WAIT_V(4); PG8_BAR;
        PG8_STAGE(PG8_SB(1, 0), cB + kstep, voffB); PG8_STAGE(PG8_SA(1, 0), cA + kstep, voffA); PG8_STAGE(PG8_SB(1, 1), cB + hstep + kstep, voffB);
        PG8_WAIT_V(6); PG8_BAR;
    }
    for (;;) {
        const bool has_next = S.next(ui + 1, nxt);
        const char* nA = has_next ? (const char*)g.A + (size_t)nxt.pm * tstep : cA; const char* nB = has_next ? (const char*)g.Bt + (size_t)nxt.pn * tstep : cB;
        if constexpr (Sched::SPLITK) { if (has_next) { nA += (size_t)nxt.kt0 * kstep; nB += (size_t)nxt.kt0 * kstep; } }
        const int cnt = Sched::SPLITK ? cur.nt : nt;
        for (int t = 0; t < cnt; t += 2) {
            const bool last = (t == cnt - 2);
            const char* a1 = cA + (size_t)(t + 1) * kstep;
            const char* a2 = last ? nA : cA + (size_t)(t + 2) * kstep; const char* b2 = last ? nB : cB + (size_t)(t + 2) * kstep;
            const char* a3 = a2 + kstep; const char* b3 = b2 + kstep;
            if (last && has_next) S.a_ready(nxt);
            if constexpr (SP2) {
            PG8_LDB(B0, 0, 0); PG8_LDB(B1, 0, 1); PG8_SCHED; PG8_LDA(At, 0, 0); PG8_STAGE(PG8_SA(1, 1), a1 + hstep, voffA);
            PG8_WAIT_V(8); PG8_WAIT_L(0); PG8_BAR; PG8_MMA(0, 0, At, B0); PG8_MMA(0, 1, At, B1); PG8_BAR; PG8_SCHED;
            PG8_LDA(At, 0, 1); PG8_STAGE(PG8_SB(0, 0), b2, voffB); PG8_STAGE(PG8_SB(0, 1), b2 + hstep, voffB); PG8_STAGE(PG8_SA(0, 0), a2, voffA);
            PG8_WAIT_V(8); PG8_WAIT_L(0); PG8_BAR; PG8_MMA(1, 0, At, B0); PG8_MMA(1, 1, At, B1); PG8_BAR; PG8_SCHED;
            PG8_LDB(B0, 1, 0); PG8_LDB(B1, 1, 1); PG8_SCHED; PG8_LDA(At, 1, 0); PG8_STAGE(PG8_SA(0, 1), a2 + hstep, voffA);
            PG8_WAIT_V(8); PG8_WAIT_L(0); PG8_BAR; PG8_MMA(0, 0, At, B0); PG8_MMA(0, 1, At, B1); PG8_BAR; PG8_SCHED;
            PG8_LDA(At, 1, 1); PG8_STAGE(PG8_SB(1, 0), b3, voffB); PG8_STAGE(PG8_SB(1, 1), b3 + hstep, voffB); PG8_STAGE(PG8_SA(1, 0), a3, voffA);
            PG8_WAIT_V(8); PG8_WAIT_L(0); PG8_BAR; PG8_MMA(1, 0, At, B0); PG8_MMA(1, 1, At, B1); PG8_BAR; PG8_SCHED;
            } else {
            PG8_LDB(B0, 0, 0); PG8_SCHED; PG8_LDA(At, 0, 0); PG8_STAGE(PG8_SA(1, 1), a1 + hstep, voffA);
            PG8_WAIT_L(8); PG8_BAR; PG8_WAIT_L(0); PG8_MMA(0, 0, At, B0); PG8_BAR; PG8_SCHED;
            PG8_LDB(B1, 0, 1); PG8_STAGE(PG8_SB(0, 0), b2, voffB);
            PG8_BAR; PG8_WAIT_L(0); PG8_MMA(0, 1, At, B1); PG8_BAR;
            PG8_LDA(At, 0, 1); PG8_STAGE(PG8_SA(0, 0), a2, voffA);
            PG8_BAR; PG8_WAIT_L(0); PG8_MMA(1, 0, At, B0); PG8_BAR; PG8_SCHED;
            PG8_STAGE(PG8_SB(0, 1), b2 + hstep, voffB);
            PG8_WAIT_V(6); PG8_BAR; PG8_MMA(1, 1, At, B1); PG8_BAR;
            PG8_LDB(B0, 1, 0); PG8_SCHED; PG8_LDA(At, 1, 0); PG8_STAGE(PG8_SA(0, 1), a2 + hstep, voffA);
            PG8_WAIT_L(8); PG8_BAR; PG8_WAIT_L(0); PG8_MMA(0, 0, At, B0); PG8_BAR; PG8_SCHED;
            PG8_LDB(B1, 1, 1); PG8_STAGE(PG8_SB(1, 0), b3, voffB);
            PG8_BAR; PG8_WAIT_L(0); PG8_MMA(0, 1, At, B1); PG8_BAR;
            PG8_LDA(At, 1, 1); PG8_STAGE(PG8_SA(1, 0), a3, voffA);
            PG8_BAR; PG8_WAIT_L(0); PG8_MMA(1, 0, At, B0); PG8_BAR; PG8_SCHED;
            PG8_STAGE(PG8_SB(1, 1), b3 + hstep, voffB);
            PG8_WAIT_V(6); PG8_BAR; PG8_MMA(1, 1, At, B1); PG8_BAR;
            }
        }
        if constexpr (FP8) asm volatile("s_nop 15\n\ts_nop 15" ::: );
        if constexpr (ALIGN_EPI) { if (wr == 0) PG8_BAR; }
        if constexpr (!Epi::AFTER_DRAIN) { E(acc, cur, wr, wc, fr, fq); S.done(cur); }
        if (!has_next) break;
#pragma unroll
        for (int a = 0; a < 2; ++a)
#pragma unroll
            for (int b = 0; b < 2; ++b)
#pragma unroll
                for (int m = 0; m < 4; ++m)
#pragma unroll
                    for (int n = 0; n < 2; ++n) acc[a][b][m][n] = (f32x4){0.f, 0.f, 0.f, 0.f};
        cur = nxt; cA = nA; cB = nB; ++ui;
        if constexpr (ALIGN_EPI) { if (wr == 1) PG8_BAR; }
    }
    PG8_WAIT_V(0);
    if constexpr (!ALIGN_EPI) { if (wr == 0) PG8_BAR; }
    PG8_BAR;
    if constexpr (Epi::AFTER_DRAIN) { E.fused(acc, cur, wr, wc, fr, fq, lds, wid, lane); S.done(cur); }
#undef PG8_SA
#undef PG8_SB
#undef PG8_STAGE
#undef PG8_LDA
#undef PG8_LDB
#undef PG8_MMA
#undef PG8_WAIT_V
#undef PG8_WAIT_L
#undef PG8_BAR
#undef PG8_SCHED
}
}
#include <hip/hip_bf16.h>
#include <cmath>
namespace attn_body {
using bf16=__hip_bfloat16;
using bf16x8=__attribute__((ext_vector_type(8)))short;
using s16x4=__attribute__((ext_vector_type(4)))short;
using f32x16=__attribute__((ext_vector_type(16)))float;
using u32x4=__attribute__((ext_vector_type(4)))unsigned;
constexpr int SEQ=4096,D=64,PITCH=5888,OPITCH=1536;
constexpr int NW=8,QBLK=32,QB=QBLK*NW,KVBLK=64,NQB=SEQ/QB;
constexpr int ATTN_UNIT_ROWS=QB;
__device__ __forceinline__ int crow(int r,int hi){return (r&3)+8*(r>>2)+4*hi;}
#define SBAR() __builtin_amdgcn_sched_barrier(0)
__device__ __forceinline__ void cmask(f32x16&p0,f32x16&p1,int jb,int qrel,int hi){
  const float NEG=-INFINITY; int kb=64*jb+4*hi;
  #pragma unroll
  for(int r=0;r<16;++r){int kv=kb+(r&3)+8*(r>>2); if(kv>qrel)p0[r]=NEG; if(kv+32>qrel)p1[r]=NEG;}
}

constexpr int NSLOT=3, SLOTB=8192;
constexpr int LDS_K=0, LDS_V=NSLOT*SLOTB, LDS_WS=2*NSLOT*SLOTB, LDS_OST=LDS_WS+NW*64*4, LDS_BYTES=LDS_OST+NW*4096;
constexpr float C2=0.125f*1.4426950408889634f;
__device__ __forceinline__ void glds16(const void*gsrc,unsigned lds_dst){unsigned keep;
  asm volatile("s_mov_b32 %0, m0\n\ts_mov_b32 m0, %2\n\ts_nop 0\n\tglobal_load_lds_dwordx4 %1, off\n\ts_mov_b32 m0, %0":"=&s"(keep):"v"(gsrc),"s"(lds_dst):"memory");}
__device__ __forceinline__ void glds16s(const void*sbase,unsigned voff,unsigned lds_dst){unsigned keep;
  asm volatile("s_mov_b32 %0, m0\n\ts_mov_b32 m0, %3\n\ts_nop 0\n\tglobal_load_lds_dwordx4 %1, %2\n\ts_mov_b32 m0, %0":"=&s"(keep):"v"(voff),"s"(sbase),"s"(lds_dst):"memory");}
__device__ __forceinline__ float max3f(float a,float b,float c){float r;asm("v_max3_f32 %0, %1, %2, %3":"=v"(r):"v"(a),"v"(b),"v"(c));return r;}
__device__ __forceinline__ float max2f(float a,float b){float r;asm("v_max_f32_e32 %0, %1, %2":"=v"(r):"v"(a),"v"(b));return r;}
__device__ __forceinline__ float fadd_s(float a,float b){float r;asm("v_add_f32_e32 %0, %1, %2":"=v"(r):"v"(a),"v"(b));return r;}
__device__ __forceinline__ float fsub_s(float a,float b){float r;asm("v_sub_f32_e32 %0, %1, %2":"=v"(r):"v"(a),"v"(b));return r;}
typedef float f32x2_t __attribute__((ext_vector_type(2))); typedef __bf16 bf16x2_t __attribute__((ext_vector_type(2)));
__device__ __forceinline__ unsigned cvtpk_s(float lo,float hi){f32x2_t v={lo,hi};bf16x2_t b=__builtin_convertvector(v,bf16x2_t);return __builtin_bit_cast(unsigned,b);}
#define WAIT_BAR(N) asm volatile("s_waitcnt vmcnt(" #N ") lgkmcnt(0)\n\ts_barrier":::"memory")

__device__ __forceinline__ void qkt(f32x16&p0,f32x16&p1,const char*Kslot,const bf16x8*qr,const f32x16&negm,int r32,int hi){
  const char*kb=Kslot+hi*1024+r32*16;
  #pragma unroll
  for(int d0=0;d0<4;++d0){
    const bf16x8 b0=*reinterpret_cast<const bf16x8*>(kb+d0*2048);
    const bf16x8 b1=*reinterpret_cast<const bf16x8*>(kb+d0*2048+512);
    if(d0==0){p0=__builtin_amdgcn_mfma_f32_32x32x16_bf16(b0,qr[0],negm,0,0,0);p1=__builtin_amdgcn_mfma_f32_32x32x16_bf16(b1,qr[0],negm,0,0,0);}
    else{p0=__builtin_amdgcn_mfma_f32_32x32x16_bf16(b0,qr[d0],p0,0,0,0);p1=__builtin_amdgcn_mfma_f32_32x32x16_bf16(b1,qr[d0],p1,0,0,0);}}
}
typedef __attribute__((address_space(3))) const char* lds_cptr;
typedef short v4i16_t __attribute__((ext_vector_type(4)));
__device__ __forceinline__ void kload8(bf16x8*kf,lds_cptr kp){
  kf[0]=*(const __attribute__((address_space(3))) bf16x8*)(kp);      kf[1]=*(const __attribute__((address_space(3))) bf16x8*)(kp+512);
  kf[2]=*(const __attribute__((address_space(3))) bf16x8*)(kp+2048); kf[3]=*(const __attribute__((address_space(3))) bf16x8*)(kp+2560);
  kf[4]=*(const __attribute__((address_space(3))) bf16x8*)(kp+4096); kf[5]=*(const __attribute__((address_space(3))) bf16x8*)(kp+4608);
  kf[6]=*(const __attribute__((address_space(3))) bf16x8*)(kp+6144); kf[7]=*(const __attribute__((address_space(3))) bf16x8*)(kp+6656);
}
__device__ __forceinline__ void kload2(bf16x8*kf,lds_cptr kp,int j){ kf[2*j]=*(const __attribute__((address_space(3))) bf16x8*)(kp+j*2048); kf[2*j+1]=*(const __attribute__((address_space(3))) bf16x8*)(kp+j*2048+512); }
__device__ __forceinline__ s16x4 vtr(lds_cptr p){ return __builtin_bit_cast(s16x4,__builtin_amdgcn_ds_read_tr16_b64_v4i16((__attribute__((address_space(3))) v4i16_t*)p)); }
__device__ __forceinline__ float rowmax(const f32x16&p0,const f32x16&p1){
  float a=max3f(p0[0],p0[1],p1[0]),b=max3f(p0[2],p0[3],p1[1]);a=max3f(a,p1[2],p1[3]);
  #pragma unroll
  for(int r=4;r<16;r+=4){a=max3f(a,p0[r],p0[r+1]);b=max3f(b,p0[r+2],p0[r+3]);a=max3f(a,p1[r],p1[r+1]);b=max3f(b,p1[r+2],p1[r+3]);}
  const float m=max2f(a,b);
  auto rr=__builtin_amdgcn_permlane32_swap(__float_as_uint(m),__float_as_uint(m),false,false);
  return max2f(__uint_as_float(rr[0]),__uint_as_float(rr[1]));
}
__device__ __forceinline__ void pv(f32x16*o,int vb,bf16x8 pa0,bf16x8 pa1,bf16x8 pa2,bf16x8 pa3){
  #pragma unroll
  for(int d0=0;d0<2;++d0){s16x4 lo[4],hi[4];
    #pragma unroll
    for(int ks=0;ks<4;++ks){
      asm volatile("ds_read_b64_tr_b16 %0,%1 offset:%c2":"=&v"(lo[ks]):"v"(vb),"i"(d0*4096+ks*1024):"memory");
      asm volatile("ds_read_b64_tr_b16 %0,%1 offset:%c2":"=&v"(hi[ks]):"v"(vb),"i"(d0*4096+ks*1024+512):"memory");}
    asm volatile("s_waitcnt lgkmcnt(0)":::"memory");SBAR();
    #define PK(k) (bf16x8){lo[k][0],lo[k][1],lo[k][2],lo[k][3],hi[k][0],hi[k][1],hi[k][2],hi[k][3]}
    o[d0]=__builtin_amdgcn_mfma_f32_32x32x16_bf16(pa0,PK(0),o[d0],0,0,0);
    o[d0]=__builtin_amdgcn_mfma_f32_32x32x16_bf16(pa1,PK(1),o[d0],0,0,0);
    o[d0]=__builtin_amdgcn_mfma_f32_32x32x16_bf16(pa2,PK(2),o[d0],0,0,0);
    o[d0]=__builtin_amdgcn_mfma_f32_32x32x16_bf16(pa3,PK(3),o[d0],0,0,0);
    #undef PK
  }
}

#ifndef ATTN_STORE16
#define ATTN_STORE16(p,v) (*(u32x4*)(p)=(v))
#endif
template<int THRL> __device__ __forceinline__ void attn_unit(int qb,const bf16*Qh,const bf16*__restrict__ Kh,const bf16*__restrict__ Vh,bf16*Oh,char*shm,const int wv){
  const int lane=mk_lane(),r32=lane&31,hi=lane>>5; const int wid=wv;
  const int q0=qb*QB;
  const bf16*Qw=Qh+(long)(q0+wid*QBLK)*PITCH;
  const unsigned lds0=(unsigned)(uintptr_t)shm;
  float*wsf=(float*)(shm+LDS_WS)+wid*64;
  const bf16*ksrc=Kh+(long)lane*PITCH+wid*8;
  const bf16*vsrc=Vh+(long)(16*(wid&3)+(lane>>2))*PITCH+(wid>>2)*32+(lane&3)*8;
  const unsigned kdst=lds0+LDS_K+wid*1024, vdst=lds0+LDS_V+wid*1024;
  #define DMA_K(t,slot) glds16(ksrc+(long)(t)*KVBLK*PITCH,(unsigned)__builtin_amdgcn_readfirstlane(kdst+(slot)))
  #define DMA_V(t,slot) glds16(vsrc+(long)(t)*KVBLK*PITCH,(unsigned)__builtin_amdgcn_readfirstlane(vdst+(slot)))
  const int vb0=(int)(lds0+LDS_V)+((lane>>4)&1)*32+(lane&3)*8+(4*hi+((lane&15)>>2))*64;
  const char*Kbase=shm+LDS_K; bf16x8 kf[8];
  const lds_cptr shm3=(lds_cptr)shm; const lds_cptr kp0=shm3+LDS_K+hi*1024+r32*16; const lds_cptr vp0=shm3+LDS_V+((lane>>4)&1)*32+(lane&3)*8+(4*hi+((lane&15)>>2))*64;
  const int NT=(q0+QB)/KVBLK;
  DMA_K(0,0);DMA_V(0,0);DMA_K(1,SLOTB);
  bf16x8 qr[4];
  #pragma unroll
  for(int d0=0;d0<4;++d0)qr[d0]=*reinterpret_cast<const bf16x8*>(&Qw[(long)r32*PITCH+d0*16+hi*8]);
  float mhat=0.f,l_reg=0.f;f32x16 o[2];o[0]=f32x16{};o[1]=f32x16{};f32x16 negm=f32x16{};asm volatile("":"+v"(negm));
  const int qrel=wid*QBLK+r32;
  #define CMASK(P0,P1,t) do{int jb_=(t)-(NT-4); if(jb_>=0)cmask(P0,P1,jb_,qrel,hi);}while(0)
  bool resc=false;
  #define START(P0,P1) do{ const float rm=rowmax(P0,P1); resc=false; \
    { const float dl=rm; mhat=fadd_s(mhat,dl); \
      _Pragma("unroll") for(int r=0;r<16;++r){P0[r]=fsub_s(P0[r],dl);P1[r]=fsub_s(P1[r],dl);} \
      _Pragma("unroll") for(int r=0;r<16;++r)negm[r]=-mhat; asm volatile("":"+v"(negm)); } \
    _Pragma("unroll") for(int r=0;r<16;++r)P0[r]=__builtin_amdgcn_exp2f(P0[r]); }while(0)
  #define RESC() do{ if(resc){ asm volatile("s_waitcnt lgkmcnt(0)":::"memory"); \
      _Pragma("unroll") for(int d_=0;d_<2;++d_) _Pragma("unroll") for(int r=0;r<16;++r)o[d_][r]*=wsf[crow(r,hi)]; } }while(0)
  f32x16 pA0,pA1,pB0,pB1;
  int sl_prev=0,sl_cur=0,sl_next=SLOTB;
  #define ROT() do{sl_prev=sl_cur;sl_cur=sl_next;sl_next=(sl_next==(NSLOT-1)*SLOTB)?0:sl_next+SLOTB;}while(0)
  DMA_K(2,2*SLOTB);
  WAIT_BAR(3);
  qkt(pA0,pA1,Kbase,qr,negm,r32,hi);asm volatile("s_nop 15\n\ts_nop 7":"+v"(pA0),"+v"(pA1));CMASK(pA0,pA1,0);
  START(pA0,pA1);
  _Pragma("unroll") for(int r=0;r<16;++r)pA1[r]=__builtin_amdgcn_exp2f(pA1[r]);
  WAIT_BAR(0);
  DMA_K(3,0);DMA_V(1,SLOTB);
  ROT();
  kload8(kf,kp0+sl_cur);
  WAIT_BAR(2);
  s16x4 vlo[8],vhi[8]; u32x4 pw0,pw1,pw2,pw3;
  #define PKW(P,B) cvtpk_s(P[B],P[B+1])
  #define PAF(k) __builtin_bit_cast(bf16x8,pw##k)
  #define VFR(i) (bf16x8){vlo[i][0],vlo[i][1],vlo[i][2],vlo[i][3],vhi[i][0],vhi[i][1],vhi[i][2],vhi[i][3]}
  #define PIN(x) asm volatile("":"+v"(x))
  #define MX3(a,b,c) __builtin_fmaxf(__builtin_fmaxf((a),(b)),(c))
  #define GAPA(MF,A0,A1,A2,A3,W0,W1,PW) do{ MF; sacc+=A0; sacc+=A1; sacc+=A2; sacc+=A3; PIN(sacc); W0; W1; PIN(PW); SBAR(); }while(0)
  #define EX(v) __builtin_amdgcn_exp2f(v)
  #define GAPB(MF,X,B) do{ MF; X[B]=EX(X[B]); X[B+1]=EX(X[B+1]); X[B+2]=EX(X[B+2]); X[B+3]=EX(X[B+3]); PIN(X); SBAR(); }while(0)
  #define VRD(i) do{ vlo[i]=vtr(vp_+(((i)>>2)*4096+((i)&3)*1024)); vhi[i]=vtr(vp_+(((i)>>2)*4096+((i)&3)*1024+512)); }while(0)
  #define KRD(G,j) do{ if(G){ kload2(kf,kp0+sl_next,j); SBAR(); } }while(0)
  #define STEP(C0,C1,P0,P1,t,GK,GV,GL) do{ SBAR(); \
    const lds_cptr vp_=vp0+sl_prev; \
    VRD(0); SBAR(); float sacc=(P0[0]+P0[1]); \
    GAPA(C0=__builtin_amdgcn_mfma_f32_32x32x16_bf16(kf[0],qr[0],negm,0,0,0), P0[2],P0[3],P0[4],P0[5],     pw0[0]=PKW(P0,0), pw0[1]=PKW(P0,2), pw0); \
    VRD(4); SBAR(); GAPA(C1=__builtin_amdgcn_mfma_f32_32x32x16_bf16(kf[1],qr[0],negm,0,0,0), P0[6],P0[7],P0[8],P0[9],     pw0[2]=PKW(P0,4), pw0[3]=PKW(P0,6), pw0); \
    VRD(1); SBAR(); GAPA(C0=__builtin_amdgcn_mfma_f32_32x32x16_bf16(kf[2],qr[1],C0,0,0,0),   P0[10],P0[11],P0[12],P0[13], pw1[0]=PKW(P0,8), pw1[1]=PKW(P0,10), pw1); \
    VRD(5); SBAR(); GAPA(C1=__builtin_amdgcn_mfma_f32_32x32x16_bf16(kf[3],qr[1],C1,0,0,0),   P0[14],P0[15],P1[0],P1[1],   pw1[2]=PKW(P0,12),pw1[3]=PKW(P0,14), pw1); \
    VRD(2); SBAR(); GAPA(C0=__builtin_amdgcn_mfma_f32_32x32x16_bf16(kf[4],qr[2],C0,0,0,0),   P1[2],P1[3],P1[4],P1[5],     pw2[0]=PKW(P1,0), pw2[1]=PKW(P1,2), pw2); \
    VRD(6); SBAR(); GAPA(C1=__builtin_amdgcn_mfma_f32_32x32x16_bf16(kf[5],qr[2],C1,0,0,0),   P1[6],P1[7],P1[8],P1[9],     pw2[2]=PKW(P1,4), pw2[3]=PKW(P1,6), pw2); \
    VRD(3); SBAR(); GAPA(C0=__builtin_amdgcn_mfma_f32_32x32x16_bf16(kf[6],qr[3],C0,0,0,0),   P1[10],P1[11],P1[12],P1[13], pw3[0]=PKW(P1,8), pw3[1]=PKW(P1,10), pw3); \
    VRD(7); SBAR(); GAPA(C1=__builtin_amdgcn_mfma_f32_32x32x16_bf16(kf[7],qr[3],C1,0,0,0),   P1[14],P1[15],0.f,0.f,       pw3[2]=PKW(P1,12),pw3[3]=PKW(P1,14), pw3); \
    l_reg+=sacc; \
    if(GK){DMA_K((t)+3,sl_cur);} if(GV){DMA_V((t)+1,sl_next);} \
    CMASK(C0,C1,t); \
    { float a=MX3(C0[0],C0[1],C1[0]),b=MX3(C0[2],C0[3],C1[1]); a=MX3(a,C1[2],C1[3]); \
      _Pragma("unroll") for(int r=4;r<16;r+=4){a=MX3(a,C0[r],C0[r+1]);b=MX3(b,C0[r+2],C0[r+3]);a=MX3(a,C1[r],C1[r+1]);b=MX3(b,C1[r+2],C1[r+3]);} \
      float rm=__builtin_fmaxf(a,b); { auto rr=__builtin_amdgcn_permlane32_swap(__float_as_uint(rm),__float_as_uint(rm),false,false); rm=__builtin_fmaxf(__uint_as_float(rr[0]),__uint_as_float(rr[1])); } \
      resc=false; \
      if(__builtin_expect(__any(rm>(float)THRL),0)){ const float dl=__builtin_fmaxf(rm,0.f); mhat+=dl; \
        _Pragma("unroll") for(int r=0;r<16;++r){C0[r]-=dl;C1[r]-=dl;} \
        _Pragma("unroll") for(int r=0;r<16;++r)negm[r]=-mhat; asm volatile("":"+v"(negm)); \
        const float f=__builtin_amdgcn_exp2f(-dl); l_reg*=f; if(hi==0)wsf[r32]=f; resc=true; } } \
    SBAR(); \
    GAPB(o[0]=__builtin_amdgcn_mfma_f32_32x32x16_bf16(PAF(0),VFR(0),o[0],0,0,0), C0,0); \
    GAPB(o[1]=__builtin_amdgcn_mfma_f32_32x32x16_bf16(PAF(0),VFR(4),o[1],0,0,0), C0,4); \
    KRD(GL,0); GAPB(o[0]=__builtin_amdgcn_mfma_f32_32x32x16_bf16(PAF(1),VFR(1),o[0],0,0,0), C0,8); \
    KRD(GL,1); GAPB(o[1]=__builtin_amdgcn_mfma_f32_32x32x16_bf16(PAF(1),VFR(5),o[1],0,0,0), C0,12); \
    KRD(GL,2); GAPB(o[0]=__builtin_amdgcn_mfma_f32_32x32x16_bf16(PAF(2),VFR(2),o[0],0,0,0), C1,0); \
    KRD(GL,3); GAPB(o[1]=__builtin_amdgcn_mfma_f32_32x32x16_bf16(PAF(2),VFR(6),o[1],0,0,0), C1,4); \
    GAPB(o[0]=__builtin_amdgcn_mfma_f32_32x32x16_bf16(PAF(3),VFR(3),o[0],0,0,0), C1,8); \
    GAPB(o[1]=__builtin_amdgcn_mfma_f32_32x32x16_bf16(PAF(3),VFR(7),o[1],0,0,0), C1,12); \
    }while(0)
  int t=1;
  #undef CMASK
  #define CMASK(P0,P1,t) do{}while(0)
  for(;t+5<NT;t+=2){
    STEP(pB0,pB1,pA0,pA1,t,true,true,true);     WAIT_BAR(2); RESC(); ROT();
    STEP(pA0,pA1,pB0,pB1,t+1,true,true,true);   WAIT_BAR(2); RESC(); ROT();
  }
  #undef CMASK
  #define CMASK(P0,P1,t) do{int jb_=(t)-(NT-4); if(jb_>=0)cmask(P0,P1,jb_,qrel,hi);}while(0)
  #define ENDW(tt) do{ if((tt)+3<NT){WAIT_BAR(2);} else if((tt)+2<NT){WAIT_BAR(1);} else {WAIT_BAR(0);} }while(0)
  for(;t+1<NT;t+=2){
    STEP(pB0,pB1,pA0,pA1,t,(t+3<NT),(t+1<NT),(t+1<NT));       ENDW(t);   RESC(); ROT();
    STEP(pA0,pA1,pB0,pB1,t+1,(t+4<NT),(t+2<NT),(t+2<NT));     ENDW(t+1); RESC(); ROT();
  }
  STEP(pB0,pB1,pA0,pA1,NT-1,false,false,false); RESC();
  { float sacc=pB0[0]+pB0[1]; _Pragma("unroll") for(int r=2;r<16;++r)sacc+=pB0[r]; _Pragma("unroll") for(int r=0;r<16;++r)sacc+=pB1[r]; l_reg+=sacc;
    pw0=(u32x4){PKW(pB0,0),PKW(pB0,2),PKW(pB0,4),PKW(pB0,6)};pw1=(u32x4){PKW(pB0,8),PKW(pB0,10),PKW(pB0,12),PKW(pB0,14)};pw2=(u32x4){PKW(pB1,0),PKW(pB1,2),PKW(pB1,4),PKW(pB1,6)};pw3=(u32x4){PKW(pB1,8),PKW(pB1,10),PKW(pB1,12),PKW(pB1,14)};
    SBAR(); pv(o,vb0+sl_cur,PAF(0),PAF(1),PAF(2),PAF(3)); }
  #undef PKW
  #undef PAF
  #undef VFR
  #undef PIN
  #undef MX3
  #undef GAPA
  #undef GAPB
  #undef EX
  #undef VRD
  #undef KRD
  #undef STEP
  #undef ENDW
  {auto rr=__builtin_amdgcn_permlane32_swap(__float_as_uint(l_reg),__float_as_uint(l_reg),false,false);l_reg=__uint_as_float(rr[0])+__uint_as_float(rr[1]);}
  if(hi==0)wsf[32+r32]=l_reg;asm volatile("s_waitcnt lgkmcnt(0)":::"memory");
  float rli[16];
  #pragma unroll
  for(int r=0;r<16;++r)rli[r]=__builtin_amdgcn_rcpf(wsf[32+crow(r,hi)]);
  bf16*Ow=Oh+(long)(q0+wid*QBLK)*OPITCH;
  { bf16*stg=(bf16*)(shm+LDS_OST)+wid*2048;
    #pragma unroll
    for(int r=0;r<16;++r){const int orow=crow(r,hi);
      #pragma unroll
      for(int d0=0;d0<2;++d0)stg[orow*64+d0*32+r32]=__float2bfloat16(o[d0][r]*rli[r]);}
    asm volatile("s_waitcnt lgkmcnt(0)":::"memory");
    #pragma unroll
    for(int i=0;i<4;++i){const int row=i*8+(lane>>3),ch=lane&7; const u32x4 v=*(const u32x4*)(stg+row*64+ch*8); ATTN_STORE16(Ow+(long)row*OPITCH+ch*8,v);} }
  asm volatile("s_waitcnt lgkmcnt(0)\n\ts_barrier":::"memory");
  #undef DMA_K
  #undef DMA_V
  #undef CMASK
  #undef START
  #undef RESC
  #undef ROT
}
constexpr int LV_V=NSLOT*SLOTB, LV_WS=LV_V+NSLOT*2*SLOTB, LV_OST=LV_WS+NW*64*4, LV_BYTES=LV_OST+NW*8192;
__device__ __forceinline__ void pv4(f32x16*o,int vb,bf16x8 pa0,bf16x8 pa1,bf16x8 pa2,bf16x8 pa3){
  #pragma unroll
  for(int d0=0;d0<4;++d0){s16x4 lo[4],hi[4];
    #pragma unroll
    for(int ks=0;ks<4;++ks){
      asm volatile("ds_read_b64_tr_b16 %0,%1 offset:%c2":"=&v"(lo[ks]):"v"(vb),"i"(d0*4096+ks*1024):"memory");
      asm volatile("ds_read_b64_tr_b16 %0,%1 offset:%c2":"=&v"(hi[ks]):"v"(vb),"i"(d0*4096+ks*1024+512):"memory");}
    asm volatile("s_waitcnt lgkmcnt(0)":::"memory");SBAR();
    #define PK(k) (bf16x8){lo[k][0],lo[k][1],lo[k][2],lo[k][3],hi[k][0],hi[k][1],hi[k][2],hi[k][3]}
    o[d0]=__builtin_amdgcn_mfma_f32_32x32x16_bf16(pa0,PK(0),o[d0],0,0,0);
    o[d0]=__builtin_amdgcn_mfma_f32_32x32x16_bf16(pa1,PK(1),o[d0],0,0,0);
    o[d0]=__builtin_amdgcn_mfma_f32_32x32x16_bf16(pa2,PK(2),o[d0],0,0,0);
    o[d0]=__builtin_amdgcn_mfma_f32_32x32x16_bf16(pa3,PK(3),o[d0],0,0,0);
    #undef PK
  }
}
#ifndef ATTN_STORE16
#define ATTN_STORE16(p,v) (*(u32x4*)(p)=(v))
#endif
template<int THRL> __device__ __forceinline__ void attn_unit128(int qb,const bf16*Qh,const bf16*__restrict__ Kh,const bf16*__restrict__ Vh,bf16*Oh,char*shm,const int wv){
  const int lane=mk_lane(),r32=lane&31,hi=lane>>5; const int wid=wv;
  const int q0=qb*QB;
  const bf16*Qw=Qh+(long)(q0+wid*QBLK)*PITCH;
  const unsigned lds0=(unsigned)(uintptr_t)shm;
  float*wsf=(float*)(shm+LV_WS)+wid*64;
  const unsigned koff=(unsigned)((lane*PITCH+wid*8)*2), voff=(unsigned)(((16*(wid&3)+(lane>>2))*PITCH+(wid>>2)*32+(lane&3)*8)*2);
  const unsigned kdst=lds0+LDS_K+wid*1024, vdst=lds0+LV_V+wid*1024;
  #define DMA_K(t,slot) glds16s(Kh+(long)(t)*KVBLK*PITCH,koff,(unsigned)__builtin_amdgcn_readfirstlane(kdst+(slot)))
  #define DMA_V(t,slot) do{ glds16s(Vh+(long)(t)*KVBLK*PITCH,voff,(unsigned)__builtin_amdgcn_readfirstlane(vdst+2*(slot))); glds16s(Vh+64+(long)(t)*KVBLK*PITCH,voff,(unsigned)__builtin_amdgcn_readfirstlane(vdst+2*(slot)+8192)); }while(0)
  const char*Kbase=shm+LDS_K; bf16x8 kf[8];
  const lds_cptr shm3=(lds_cptr)shm; const lds_cptr kp0=shm3+LDS_K+hi*1024+r32*16; const lds_cptr vp0=shm3+LV_V+((lane>>4)&1)*32+(lane&3)*8+(4*hi+((lane&15)>>2))*64;
  const int NT=(q0+QB)/KVBLK;
  DMA_K(0,0);DMA_V(0,0);DMA_K(1,SLOTB);
  bf16x8 qr[4];
  #pragma unroll
  for(int d0=0;d0<4;++d0)qr[d0]=*reinterpret_cast<const bf16x8*>(&Qw[(long)r32*PITCH+d0*16+hi*8]);
  float mhat=0.f,l_reg=0.f;f32x16 o[4];o[0]=f32x16{};o[1]=f32x16{};o[2]=f32x16{};o[3]=f32x16{};const f32x16 zero16=f32x16{};
  const int qrel=wid*QBLK+r32;
  #define CMASK(P0,P1,t) do{int jb_=(t)-(NT-4); if(jb_>=0)cmask(P0,P1,jb_,qrel,hi);}while(0)
  bool resc=false;
  #define START(P0,P1) do{ const float rm=rowmax(P0,P1); resc=false; \
    { const float dl=rm; mhat=fadd_s(mhat,dl); \
      _Pragma("unroll") for(int r=0;r<16;++r){P0[r]=fsub_s(P0[r],dl);P1[r]=fsub_s(P1[r],dl);} \
      } \
    _Pragma("unroll") for(int r=0;r<16;++r)P0[r]=__builtin_amdgcn_exp2f(P0[r]); }while(0)
  #define RESC() do{ if(resc){ asm volatile("s_waitcnt lgkmcnt(0)":::"memory"); \
      _Pragma("unroll") for(int d_=0;d_<4;++d_) _Pragma("unroll") for(int r=0;r<16;++r)o[d_][r]*=wsf[crow(r,hi)]; } }while(0)
  f32x16 pA0,pA1,pB0,pB1;
  int sl_prev=0,sl_cur=0,sl_next=SLOTB;
  #define ROT() do{sl_prev=sl_cur;sl_cur=sl_next;sl_next=(sl_next==(NSLOT-1)*SLOTB)?0:sl_next+SLOTB;}while(0)
  DMA_K(2,2*SLOTB);
  WAIT_BAR(4);
  qkt(pA0,pA1,Kbase,qr,zero16,r32,hi);asm volatile("s_nop 15\n\ts_nop 7":"+v"(pA0),"+v"(pA1));CMASK(pA0,pA1,0);
  START(pA0,pA1);
  _Pragma("unroll") for(int r=0;r<16;++r)pA1[r]=__builtin_amdgcn_exp2f(pA1[r]);
  WAIT_BAR(0);
  DMA_K(3,0);DMA_V(1,SLOTB);
  ROT();
  kload8(kf,kp0+sl_cur);
  WAIT_BAR(3);
  s16x4 vq0lo,vq0hi,vq1lo,vq1hi,vq2lo,vq2hi; u32x4 pw0,pw1,pw2,pw3;
  #define PKW(P,B) cvtpk_s(P[B],P[B+1])
  #define PAF(k) __builtin_bit_cast(bf16x8,pw##k)
  #define VFQ(B) (bf16x8){B##lo[0],B##lo[1],B##lo[2],B##lo[3],B##hi[0],B##hi[1],B##hi[2],B##hi[3]}
  #define PIN(x) asm volatile("":"+v"(x))
  #define MX3(a,b,c) __builtin_fmaxf(__builtin_fmaxf((a),(b)),(c))
  #define GAPA(MF,A0,A1,A2,A3,W0,W1,PW) do{ MF; sacc+=A0; sacc+=A1; sacc+=A2; sacc+=A3; PIN(sacc); W0; W1; PIN(PW); SBAR(); }while(0)
  #define EX(v) __builtin_amdgcn_exp2f(v)
  #define GAPB(MF,X,B) do{ MF; X[B]=EX(X[B]); X[B+1]=EX(X[B+1]); PIN(X); SBAR(); }while(0)
  #define VRD(B,i) do{ B##lo=vtr(vp_+(((i)>>2)*4096+((i)&3)*1024)); B##hi=vtr(vp_+(((i)>>2)*4096+((i)&3)*1024+512)); SBAR(); }while(0)
  #define KRD(G,j) do{ if(G){ kload2(kf,kp0+sl_next,j); SBAR(); } }while(0)
  #define STEP(C0,C1,P0,P1,t,GK,GV,GL) do{ SBAR(); \
    const lds_cptr vp_=vp0+2*sl_prev; \
    float sacc=(P0[0]+P0[1]); \
    GAPA(C0=__builtin_amdgcn_mfma_f32_32x32x16_bf16(kf[0],qr[0],zero16,0,0,0), P0[2],P0[3],P0[4],P0[5],     pw0[0]=PKW(P0,0), pw0[1]=PKW(P0,2), pw0); \
    GAPA(C1=__builtin_amdgcn_mfma_f32_32x32x16_bf16(kf[1],qr[0],zero16,0,0,0), P0[6],P0[7],P0[8],P0[9],     pw0[2]=PKW(P0,4), pw0[3]=PKW(P0,6), pw0); \
    GAPA(C0=__builtin_amdgcn_mfma_f32_32x32x16_bf16(kf[2],qr[1],C0,0,0,0),   P0[10],P0[11],P0[12],P0[13], pw1[0]=PKW(P0,8), pw1[1]=PKW(P0,10), pw1); \
    GAPA(C1=__builtin_amdgcn_mfma_f32_32x32x16_bf16(kf[3],qr[1],C1,0,0,0),   P0[14],P0[15],P1[0],P1[1],   pw1[2]=PKW(P0,12),pw1[3]=PKW(P0,14), pw1); \
    GAPA(C0=__builtin_amdgcn_mfma_f32_32x32x16_bf16(kf[4],qr[2],C0,0,0,0),   P1[2],P1[3],P1[4],P1[5],     pw2[0]=PKW(P1,0), pw2[1]=PKW(P1,2), pw2); \
    GAPA(C1=__builtin_amdgcn_mfma_f32_32x32x16_bf16(kf[5],qr[2],C1,0,0,0),   P1[6],P1[7],P1[8],P1[9],     pw2[2]=PKW(P1,4), pw2[3]=PKW(P1,6), pw2); \
    VRD(vq0,0); GAPA(C0=__builtin_amdgcn_mfma_f32_32x32x16_bf16(kf[6],qr[3],C0,0,0,0),   P1[10],P1[11],P1[12],P1[13], pw3[0]=PKW(P1,8), pw3[1]=PKW(P1,10), pw3); \
    VRD(vq1,4); GAPA(C1=__builtin_amdgcn_mfma_f32_32x32x16_bf16(kf[7],qr[3],C1,0,0,0),   P1[14],P1[15],0.f,0.f,       pw3[2]=PKW(P1,12),pw3[3]=PKW(P1,14), pw3); \
    l_reg+=sacc; \
    _Pragma("unroll") for(int r=0;r<16;++r){C0[r]-=mhat;C1[r]-=mhat;} \
    if(GK){DMA_K((t)+3,sl_cur);} if(GV){DMA_V((t)+1,sl_next);} \
    CMASK(C0,C1,t); \
    { float a=MX3(C0[0],C0[1],C1[0]),b=MX3(C0[2],C0[3],C1[1]); a=MX3(a,C1[2],C1[3]); \
      _Pragma("unroll") for(int r=4;r<16;r+=4){a=MX3(a,C0[r],C0[r+1]);b=MX3(b,C0[r+2],C0[r+3]);a=MX3(a,C1[r],C1[r+1]);b=MX3(b,C1[r+2],C1[r+3]);} \
      float rm=__builtin_fmaxf(a,b); { auto rr=__builtin_amdgcn_permlane32_swap(__float_as_uint(rm),__float_as_uint(rm),false,false); rm=__builtin_fmaxf(__uint_as_float(rr[0]),__uint_as_float(rr[1])); } \
      resc=false; \
      if(__builtin_expect(__any(rm>(float)THRL),0)){ const float dl=__builtin_fmaxf(rm,0.f); mhat+=dl; \
        _Pragma("unroll") for(int r=0;r<16;++r){C0[r]-=dl;C1[r]-=dl;} \
        const float f=__builtin_amdgcn_exp2f(-dl); l_reg*=f; if(hi==0)wsf[r32]=f; resc=true; } } \
    SBAR(); \
    VRD(vq2,8); GAPB(o[0]=__builtin_amdgcn_mfma_f32_32x32x16_bf16(PAF(0),VFQ(vq0),o[0],0,0,0), C0,0); \
    VRD(vq0,12); GAPB(o[1]=__builtin_amdgcn_mfma_f32_32x32x16_bf16(PAF(0),VFQ(vq1),o[1],0,0,0), C0,2); \
    VRD(vq1,1); GAPB(o[2]=__builtin_amdgcn_mfma_f32_32x32x16_bf16(PAF(0),VFQ(vq2),o[2],0,0,0), C0,4); \
    VRD(vq2,5); GAPB(o[3]=__builtin_amdgcn_mfma_f32_32x32x16_bf16(PAF(0),VFQ(vq0),o[3],0,0,0), C0,6); \
    VRD(vq0,9); GAPB(o[0]=__builtin_amdgcn_mfma_f32_32x32x16_bf16(PAF(1),VFQ(vq1),o[0],0,0,0), C0,8); \
    VRD(vq1,13); GAPB(o[1]=__builtin_amdgcn_mfma_f32_32x32x16_bf16(PAF(1),VFQ(vq2),o[1],0,0,0), C0,10); \
    VRD(vq2,2); GAPB(o[2]=__builtin_amdgcn_mfma_f32_32x32x16_bf16(PAF(1),VFQ(vq0),o[2],0,0,0), C0,12); \
    VRD(vq0,6); GAPB(o[3]=__builtin_amdgcn_mfma_f32_32x32x16_bf16(PAF(1),VFQ(vq1),o[3],0,0,0), C0,14); \
    VRD(vq1,10); GAPB(o[0]=__builtin_amdgcn_mfma_f32_32x32x16_bf16(PAF(2),VFQ(vq2),o[0],0,0,0), C1,0); \
    VRD(vq2,14); GAPB(o[1]=__builtin_amdgcn_mfma_f32_32x32x16_bf16(PAF(2),VFQ(vq0),o[1],0,0,0), C1,2); \
    VRD(vq0,3); GAPB(o[2]=__builtin_amdgcn_mfma_f32_32x32x16_bf16(PAF(2),VFQ(vq1),o[2],0,0,0), C1,4); \
    VRD(vq1,7); GAPB(o[3]=__builtin_amdgcn_mfma_f32_32x32x16_bf16(PAF(2),VFQ(vq2),o[3],0,0,0), C1,6); \
    VRD(vq2,11); KRD(GL,0); GAPB(o[0]=__builtin_amdgcn_mfma_f32_32x32x16_bf16(PAF(3),VFQ(vq0),o[0],0,0,0), C1,8); \
    VRD(vq0,15); KRD(GL,1); GAPB(o[1]=__builtin_amdgcn_mfma_f32_32x32x16_bf16(PAF(3),VFQ(vq1),o[1],0,0,0), C1,10); \
    KRD(GL,2); GAPB(o[2]=__builtin_amdgcn_mfma_f32_32x32x16_bf16(PAF(3),VFQ(vq2),o[2],0,0,0), C1,12); \
    KRD(GL,3); GAPB(o[3]=__builtin_amdgcn_mfma_f32_32x32x16_bf16(PAF(3),VFQ(vq0),o[3],0,0,0), C1,14); \
    }while(0)
  int t=1;
  #undef CMASK
  #define CMASK(P0,P1,t) do{}while(0)
  for(;t+5<NT;t+=2){
    STEP(pB0,pB1,pA0,pA1,t,true,true,true);     WAIT_BAR(3); RESC(); ROT();
    STEP(pA0,pA1,pB0,pB1,t+1,true,true,true);   WAIT_BAR(3); RESC(); ROT();
  }
  #undef CMASK
  #define CMASK(P0,P1,t) do{int jb_=(t)-(NT-4); if(jb_>=0)cmask(P0,P1,jb_,qrel,hi);}while(0)
  #define ENDW(tt) do{ if((tt)+3<NT){WAIT_BAR(3);} else if((tt)+2<NT){WAIT_BAR(2);} else {WAIT_BAR(0);} }while(0)
  for(;t+1<NT;t+=2){
    STEP(pB0,pB1,pA0,pA1,t,(t+3<NT),(t+1<NT),(t+1<NT));       ENDW(t);   RESC(); ROT();
    STEP(pA0,pA1,pB0,pB1,t+1,(t+4<NT),(t+2<NT),(t+2<NT));     ENDW(t+1); RESC(); ROT();
  }
  STEP(pB0,pB1,pA0,pA1,NT-1,false,false,false); RESC();
  { float sacc=pB0[0]+pB0[1]; _Pragma("unroll") for(int r=2;r<16;++r)sacc+=pB0[r]; _Pragma("unroll") for(int r=0;r<16;++r)sacc+=pB1[r]; l_reg+=sacc;
    pw0=(u32x4){PKW(pB0,0),PKW(pB0,2),PKW(pB0,4),PKW(pB0,6)};pw1=(u32x4){PKW(pB0,8),PKW(pB0,10),PKW(pB0,12),PKW(pB0,14)};pw2=(u32x4){PKW(pB1,0),PKW(pB1,2),PKW(pB1,4),PKW(pB1,6)};pw3=(u32x4){PKW(pB1,8),PKW(pB1,10),PKW(pB1,12),PKW(pB1,14)};
    SBAR(); pv4(o,(int)(lds0+LV_V)+((lane>>4)&1)*32+(lane&3)*8+(4*hi+((lane&15)>>2))*64+2*sl_cur,PAF(0),PAF(1),PAF(2),PAF(3)); }
  #undef PKW
  #undef PAF
  #undef VFQ
  #undef PIN
  #undef MX3
  #undef GAPA
  #undef GAPB
  #undef EX
  #undef VRD
  #undef KRD
  #undef STEP
  #undef ENDW
  {auto rr=__builtin_amdgcn_permlane32_swap(__float_as_uint(l_reg),__float_as_uint(l_reg),false,false);l_reg=__uint_as_float(rr[0])+__uint_as_float(rr[1]);}
  if(hi==0)wsf[32+r32]=l_reg;asm volatile("s_waitcnt lgkmcnt(0)":::"memory");
  float rli[16];
  #pragma unroll
  for(int r=0;r<16;++r)rli[r]=__builtin_amdgcn_rcpf(wsf[32+crow(r,hi)]);
  bf16*Ow=Oh+(long)(q0+wid*QBLK)*OPITCH;
  { bf16*stg=(bf16*)(shm+LV_OST)+wid*4096;
    #pragma unroll
    for(int r=0;r<16;++r){const int orow=crow(r,hi);
      #pragma unroll
      for(int d0=0;d0<4;++d0)stg[orow*128+d0*32+r32]=__float2bfloat16(o[d0][r]*rli[r]);}
    asm volatile("s_waitcnt lgkmcnt(0)":::"memory");
    #pragma unroll
    for(int i=0;i<8;++i){const int row=i*4+(lane>>4),ch=lane&15; const u32x4 v=*(const u32x4*)(stg+row*128+ch*8); ATTN_STORE16(Ow+(long)row*OPITCH+ch*8,v);} }
  asm volatile("s_waitcnt lgkmcnt(0)\n\ts_barrier":::"memory");
  #undef DMA_K
  #undef DMA_V
  #undef CMASK
  #undef START
  #undef RESC
  #undef ROT
}
constexpr int ATTN_LDS_BYTES=LDS_BYTES;
#undef SBAR
#undef WAIT_BAR
}
#define GAS __attribute__((address_space(1)))
#define LAS __attribute__((address_space(3)))
typedef unsigned short bf16;
typedef unsigned v4u __attribute__((ext_vector_type(4)));
typedef float f32x4 __attribute__((ext_vector_type(4)));
typedef short bf16x8 __attribute__((ext_vector_type(8)));
typedef GAS unsigned gu32;
typedef GAS unsigned long long gu64;
#define RLX_AGENT __ATOMIC_RELAXED, __HIP_MEMORY_SCOPE_AGENT
#define LDS_WAIT() asm volatile("s_waitcnt lgkmcnt(0)" ::: "memory")
#define VM_WAIT() asm volatile("s_waitcnt vmcnt(0)" ::: "memory")
__device__ __forceinline__ unsigned long long rt() { return __builtin_amdgcn_s_memrealtime(); }
__device__ __forceinline__ unsigned f2bf(float f) { unsigned u = __builtin_bit_cast(unsigned, f); return (u + 0x7fffu + ((u >> 16) & 1u)) >> 16; }
__device__ __forceinline__ unsigned pk2(float lo, float hi) { return attn_body::cvtpk_s(lo, hi); }

#define XB_TMO      128
#define XB_XCNT(j)  (256  + 64 * (j))
#define XB_XSUB(j)  (1280 + 64 * (j))
#define XB_XGEN(j)  (2304 + 64 * (j))
#define XB_TOP      3328
#define XB_TOPGEN   3392
#define XCD_BAR_WORDS 3456
#define XB_SPIN_CAP (1u << 18)

__device__ __forceinline__ unsigned xb_ld(unsigned* p)              { return __hip_atomic_load(p, __ATOMIC_RELAXED, __HIP_MEMORY_SCOPE_AGENT); }
__device__ __forceinline__ unsigned xb_add(unsigned* p, unsigned v) { return __hip_atomic_fetch_add(p, v, __ATOMIC_RELAXED, __HIP_MEMORY_SCOPE_AGENT); }
__device__ __forceinline__ unsigned xb_xcc_id() { return (unsigned)__builtin_amdgcn_s_getreg((3 << 11) | 20) & 0xFu; }
#define XB_SPIN(cond, bar) do { unsigned _sp = 0; while (cond) { __builtin_amdgcn_s_sleep(1); \
    if ((++_sp & 255u) == 0u) { if (xb_ld(&(bar)[XB_TMO])) break; if (_sp > XB_SPIN_CAP) { atomicAdd(&(bar)[XB_TMO], 1u); break; } } } } while (0)

struct XcdBarrier {
    unsigned* bar; unsigned x; bool lead;
    volatile LAS unsigned* st;
};

__device__ __forceinline__ XcdBarrier xcd_barrier_post(unsigned* bar, volatile LAS unsigned* st) {
    XcdBarrier b; b.bar = bar; b.x = xb_xcc_id(); b.st = st;
    if (threadIdx.x == 0) (void)xb_add(&bar[XB_XCNT(b.x)], 1u);
    return b;
}
__device__ __forceinline__ void xcd_barrier_complete(unsigned* bar, unsigned x, unsigned& nloc, unsigned& nx) {
    const unsigned G = gridDim.x * gridDim.y * gridDim.z;
    unsigned sum, cnt, mine, sp = 0u;
    for (;;) {
        sum = 0u; cnt = 0u; mine = 0u;
#pragma unroll
        for (unsigned j = 0; j < 16; ++j) { const unsigned c = xb_ld(&bar[XB_XCNT(j)]); sum += c; cnt += (c > 0u) ? 1u : 0u; mine = (j == x) ? c : mine; }
        if (sum == G) break;
        __builtin_amdgcn_s_sleep(1);
        if ((++sp & 255u) == 0u) { if (xb_ld(&bar[XB_TMO])) break; if (sp > XB_SPIN_CAP) { atomicAdd(&bar[XB_TMO], 1u); break; } }
    }
    nloc = mine > 0u ? mine : 1u; nx = cnt > 0u ? cnt : 1u;
}

__device__ __forceinline__ void xcd_barrier(const XcdBarrier& b) {
    asm volatile("s_waitcnt vmcnt(0)" ::: "memory");
    __syncthreads();
    if (b.lead) {
        unsigned* bar = b.bar;
        __builtin_amdgcn_s_waitcnt(0);
        unsigned nloc = b.st[0], nx = b.st[1];
        if (nloc == 0u) { xcd_barrier_complete(bar, b.x, nloc, nx); b.st[0] = nloc; b.st[1] = nx; }
        const unsigned old = xb_add(&bar[XB_XSUB(b.x)], 1u);
        const unsigned gen = old / nloc;
        if (old + 1u == (gen + 1u) * nloc) {
            __builtin_amdgcn_fence(__ATOMIC_RELEASE, "agent");
            asm volatile("s_waitcnt vmcnt(0)" ::: "memory");
            const unsigned og = xb_add(&bar[XB_TOP], 1u);
            const unsigned tg = og / nx;
            if (og + 1u == (tg + 1u) * nx) xb_add(&bar[XB_TOPGEN], 1u);
            else XB_SPIN(xb_ld(&bar[XB_TOPGEN]) == tg, bar);
            __builtin_amdgcn_fence(__ATOMIC_ACQUIRE, "agent");
            xb_add(&bar[XB_XGEN(b.x)], 1u);
            asm volatile("s_waitcnt vmcnt(0)" ::: "memory");
        } else {
            XB_SPIN(xb_ld(&bar[XB_XGEN(b.x)]) == gen, bar);
            __builtin_amdgcn_fence(__ATOMIC_ACQUIRE, "agent");
            asm volatile("s_waitcnt vmcnt(0)" ::: "memory");
        }
    }
    __syncthreads();
}

constexpr int NWAVES = 8, NTHR = 512;
constexpr int DM = 2048, NB = 4, SQ = 4096, TOK = NB * SQ;
constexpr int INW = 5900, PW = 5888;
constexpr int C_U = 0, C_DQ = 512, C_DK = 1280, C_DV = 2048, C_GQ = 2816, C_GZ = 5120, C_GA = 5888;
constexpr int DFF = 5632, DFE = 7168, NE = 8;
constexpr int MOE_ROWS = 2 * TOK + NE * 256, MOE_TILES_MAX = MOE_ROWS / 256;
constexpr float EPS = 1e-6f;
constexpr int GDN_UNIT_BYTES = 57344 + 32768 + 256;

constexpr size_t MiB = 1u << 20;
constexpr size_t WS_CTL = 0, CTL_ZERO_BYTES = 1 * MiB;
constexpr size_t WS_MOD = 1 * MiB;
constexpr size_t WS_ROPE = 2 * MiB;
constexpr size_t WS_GAB = 3 * MiB;
constexpr size_t WS_TOKE = 4 * MiB, WS_TOKG = WS_TOKE + 128 * 1024, WS_RANK = WS_TOKE + 256 * 1024, WS_POS = WS_TOKE + 384 * 1024, WS_CNT = WS_TOKE + 512 * 1024, WS_TILE = WS_TOKE + 640 * 1024;
constexpr size_t WS_GW = 5 * MiB;
constexpr size_t WS_M2 = 6 * MiB;
constexpr size_t WS_M13 = 10 * MiB;
constexpr size_t WS_A16 = 22 * MiB;
constexpr size_t WS_XC = 23 * MiB;
constexpr size_t WS_XS = 39 * MiB;
constexpr size_t WS_YGELU = 47 * MiB;
constexpr size_t WS_WIN = 64 * MiB;
constexpr size_t WS_WOUT = 110 * MiB;
constexpr size_t WS_WGLU = 126 * MiB;
constexpr size_t WS_WUP = 128 * MiB;
constexpr size_t WS_WDN = 172 * MiB;
constexpr size_t WS_MUP = 194 * MiB;
constexpr size_t WS_MDN = 642 * MiB;
constexpr size_t WS_HRES = 866 * MiB;
constexpr size_t WS_HN = 994 * MiB;
constexpr size_t WS_R = 1058 * MiB;
constexpr size_t WS_PROJ = WS_R, WS_YCAT = WS_R + 184 * MiB, WS_ATTO = WS_R + 248 * MiB, WS_OGDN = WS_R + 296 * MiB;
constexpr size_t WS_H = WS_R;
constexpr size_t WS_AS = 1534 * MiB;
constexpr size_t WS_GU = WS_AS;
constexpr size_t WS_END = 1670 * MiB;
static_assert((size_t)MOE_ROWS * DFE * 2 <= 476 * MiB && (size_t)MOE_ROWS * DM * 2 <= 136 * MiB && (size_t)1536 * GDN_UNIT_BYTES <= 136 * MiB, "ws map");
static_assert((size_t)TOK * PW * 2 <= 184 * MiB && (size_t)TOK * 768 * 4 <= 48 * MiB, "ws map 2");
constexpr int CW_BAR = 4096, CW_QUEUE = 8192, CW_CVQ = 9216, CW_ARR = 9280, CW_SCAN = 11008, CW_FIN = 12288, CW_ADA = 12800;

constexpr int LDS_BYTES = 147456;
constexpr int RING_BYTES = 131072;
constexpr int TILE_OFF = 146432, MISC_OFF = 147200;

typedef unsigned u32x4_t __attribute__((ext_vector_type(4)));
typedef unsigned u32x2_t __attribute__((ext_vector_type(2)));
typedef float f32x2_t __attribute__((ext_vector_type(2)));

__device__ __forceinline__ float bf2f(unsigned short u) { return __uint_as_float((unsigned)u << 16); }
__device__ __forceinline__ float bflo(unsigned w) { return __uint_as_float(w << 16); }
__device__ __forceinline__ float bfhi(unsigned w) { return __uint_as_float(w & 0xffff0000u); }
__device__ __forceinline__ float wave_sum(float v) {
    v += __builtin_bit_cast(float, __builtin_amdgcn_update_dpp(0, __builtin_bit_cast(int, v), 0xB1, 0xF, 0xF, false));
    v += __builtin_bit_cast(float, __builtin_amdgcn_update_dpp(0, __builtin_bit_cast(int, v), 0x4E, 0xF, 0xF, false));
    v += __builtin_bit_cast(float, __builtin_amdgcn_update_dpp(0, __builtin_bit_cast(int, v), 0x141, 0xF, 0xF, false));
    v += __builtin_bit_cast(float, __builtin_amdgcn_update_dpp(0, __builtin_bit_cast(int, v), 0x140, 0xF, 0xF, false));
    v += __builtin_bit_cast(float, __builtin_amdgcn_update_dpp(0, __builtin_bit_cast(int, v), 0x142, 0xA, 0xF, false));
    v += __builtin_bit_cast(float, __builtin_amdgcn_update_dpp(0, __builtin_bit_cast(int, v), 0x143, 0xC, 0xF, false));
    return __builtin_bit_cast(float, __builtin_amdgcn_readlane(__builtin_bit_cast(int, v), 63));
}
__device__ __forceinline__ float sigmoid_f(float x) { return __builtin_amdgcn_rcpf(1.f + __expf(-x)); }
__device__ __forceinline__ float silu_f(float x) { return x * __builtin_amdgcn_rcpf(1.f + __expf(-x)); }
__device__ __forceinline__ float gelu_tanh_f(float y) { const float z = 0.7978845608028654f * (y + 0.044715f * y * y * y); const float e = __expf(2.f * z); const float th = 1.f - 2.f * __builtin_amdgcn_rcpf(e + 1.f); return 0.5f * y * (1.f + th); }
__device__ __forceinline__ bf16x8 pack8(const f32x4& a, const f32x4& b) {
    u32x4_t w; w.x = pk2(a[0], a[1]); w.y = pk2(a[2], a[3]); w.z = pk2(b[0], b[1]); w.w = pk2(b[2], b[3]);
    return __builtin_bit_cast(bf16x8, w);
}
__device__ __forceinline__ unsigned pk4_fp8(float a, float b, float c, float d) {
    a = __builtin_amdgcn_fmed3f(a, -448.f, 448.f); b = __builtin_amdgcn_fmed3f(b, -448.f, 448.f); c = __builtin_amdgcn_fmed3f(c, -448.f, 448.f); d = __builtin_amdgcn_fmed3f(d, -448.f, 448.f);
    int w = 0; w = __builtin_amdgcn_cvt_pk_fp8_f32(a, b, w, false); w = __builtin_amdgcn_cvt_pk_fp8_f32(c, d, w, true); return (unsigned)w;
}
#ifndef DENSE_FP8
#define DENSE_FP8 2
#endif
constexpr float S8_HN = 4.f, S8_W13 = 64.f, S8_H = 8.f, S8_W2 = 128.f;
__device__ __forceinline__ void sincos2pi(double r, float& s, float& c) {
    const double x = r * 6.283185307179586476925; const double x2 = x * x;
    double ss = 1.0, cc = 1.0;
#pragma unroll
    for (int k = 12; k >= 1; --k) { ss = 1.0 - x2 * ss / (double)((2 * k) * (2 * k + 1)); cc = 1.0 - x2 * cc / (double)((2 * k - 1) * (2 * k)); }
    s = (float)(x * ss); c = (float)cc;
}

namespace pg8 {
struct EpiProj {
    static constexpr bool PERM = true, AFTER_DRAIN = false;
    bf16_t* O;
    __device__ __forceinline__ void operator()(const f32x4 (&acc)[2][2][4][2], const Unit& u, int wr, int wc, int fr, int fq) const {
        const int row0 = u.pm * BM + wr * 64 + fr, col0 = u.pn * BM + wc * 32 + 8 * fq;
        const float sc = (u.pn >= 2 && u.pn <= 4) ? attn_body::C2 : 1.f;
#pragma unroll
        for (int ai = 0; ai < 2; ++ai)
#pragma unroll
            for (int m = 0; m < 4; ++m) { bf16_t* rowp = O + (size_t)(row0 + ai * HALF + m * 16) * PW + col0;
#pragma unroll
                for (int bj = 0; bj < 2; ++bj) { const f32x4 v0 = acc[ai][bj][m][0] * sc, v1 = acc[ai][bj][m][1] * sc;
                    u32x4 w; w.x = cvt_pk_bf16(v0[0], v0[1]); w.y = cvt_pk_bf16(v0[2], v0[3]); w.z = cvt_pk_bf16(v1[0], v1[1]); w.w = cvt_pk_bf16(v1[2], v1[3]);
                    *(u32x4*)(rowp + bj * HALF) = w; } }
    }
};
struct EpiGlu {
    static constexpr bool PERM = true, AFTER_DRAIN = false;
    const bf16_t* Y; bf16_t* O;
    __device__ __forceinline__ void operator()(const f32x4 (&acc)[2][2][4][2], const Unit& u, int wr, int wc, int fr, int fq) const {
        const int row0 = u.pm * BM + wr * 64 + fr, col0 = u.pn * BM + wc * 32 + 8 * fq;
#pragma unroll
        for (int ai = 0; ai < 2; ++ai)
#pragma unroll
            for (int m = 0; m < 4; ++m) { const int row = row0 + ai * HALF + m * 16;
#pragma unroll
                for (int bj = 0; bj < 2; ++bj) { const int col = col0 + bj * HALF;
                    const u32x4 yv = *(const u32x4*)(Y + (size_t)row * 512 + col);
                    const f32x4 a0 = acc[ai][bj][m][0], a1 = acc[ai][bj][m][1];
                    u32x4 w;
                    w.x = cvt_pk_bf16(bflo(yv.x) * sigmoid_f(a0[0]), bfhi(yv.x) * sigmoid_f(a0[1]));
                    w.y = cvt_pk_bf16(bflo(yv.y) * sigmoid_f(a0[2]), bfhi(yv.y) * sigmoid_f(a0[3]));
                    w.z = cvt_pk_bf16(bflo(yv.z) * sigmoid_f(a1[0]), bfhi(yv.z) * sigmoid_f(a1[1]));
                    w.w = cvt_pk_bf16(bflo(yv.w) * sigmoid_f(a1[2]), bfhi(yv.w) * sigmoid_f(a1[3]));
                    *(u32x4*)(O + (size_t)row * DM + col) = w; } }
    }
};
struct EpiRes {
    static constexpr bool PERM = false, AFTER_DRAIN = false;
    const float* res; float* out; const float* gate; float sin;
    __device__ __forceinline__ void operator()(const f32x4 (&acc)[2][2][4][2], const Unit& u, int wr, int wc, int fr, int fq) const {
        const int col0 = u.pn * BM + wc * 32 + 4 * fq;
#pragma unroll
        for (int ai = 0; ai < 2; ++ai)
#pragma unroll
            for (int m = 0; m < 4; ++m) { const int row = u.pm * BM + ai * HALF + wr * 64 + m * 16 + fr; const float* gp = gate + (size_t)(row >> 12) * (6 * DM); const size_t off = (size_t)row * DM;
#pragma unroll
                for (int bj = 0; bj < 2; ++bj)
#pragma unroll
                    for (int n = 0; n < 2; ++n) { const int col = col0 + bj * HALF + n * 16;
                        const f32x4 g = *(const f32x4*)(gp + col), r = *(const f32x4*)(res + off + col);
                        *(f32x4*)(out + off + col) = r + g * (acc[ai][bj][m][n] * sin); } }
    }
};
struct EpiSwiglu {
    static constexpr bool PERM = true, AFTER_DRAIN = false;
    bf16_t* H; int ldh; int nct; float sin;
    __device__ __forceinline__ void operator()(const f32x4 (&acc)[2][2][4][2], const Unit& u, int wr, int wc, int fr, int fq) const {
        const int pnl = u.pn % nct; const int row0 = u.pm * BM + wr * 64 + fr, col0 = pnl * HALF + wc * 32 + 8 * fq;
#pragma unroll
        for (int ai = 0; ai < 2; ++ai)
#pragma unroll
            for (int m = 0; m < 4; ++m) { const int row = row0 + ai * HALF + m * 16;
                const f32x4 g0 = acc[ai][0][m][0] * sin, g1 = acc[ai][0][m][1] * sin, u0 = acc[ai][1][m][0] * sin, u1 = acc[ai][1][m][1] * sin;
                u32x4 w;
                w.x = cvt_pk_bf16(silu_f(g0[0]) * u0[0], silu_f(g0[1]) * u0[1]); w.y = cvt_pk_bf16(silu_f(g0[2]) * u0[2], silu_f(g0[3]) * u0[3]);
                w.z = cvt_pk_bf16(silu_f(g1[0]) * u1[0], silu_f(g1[1]) * u1[1]); w.w = cvt_pk_bf16(silu_f(g1[2]) * u1[2], silu_f(g1[3]) * u1[3]);
                *(u32x4*)(H + (size_t)row * ldh + col0) = w; }
    }
};
struct EpiSwiglu8 {
    static constexpr bool PERM = true, AFTER_DRAIN = false;
    unsigned char* H; int ldh; int nct; float sin;
    __device__ __forceinline__ void operator()(const f32x4 (&acc)[2][2][4][2], const Unit& u, int wr, int wc, int fr, int fq) const {
        const int pnl = u.pn % nct; const int row0 = u.pm * BM + wr * 64 + fr, col0 = pnl * HALF + wc * 32 + 8 * fq;
#pragma unroll
        for (int ai = 0; ai < 2; ++ai)
#pragma unroll
            for (int m = 0; m < 4; ++m) { const int row = row0 + ai * HALF + m * 16;
                const f32x4 g0 = acc[ai][0][m][0] * sin, g1 = acc[ai][0][m][1] * sin, u0 = acc[ai][1][m][0] * (sin * S8_H), u1 = acc[ai][1][m][1] * (sin * S8_H);
                u32x2_t w; w.x = pk4_fp8(silu_f(g0[0]) * u0[0], silu_f(g0[1]) * u0[1], silu_f(g0[2]) * u0[2], silu_f(g0[3]) * u0[3]);
                w.y = pk4_fp8(silu_f(g1[0]) * u1[0], silu_f(g1[1]) * u1[1], silu_f(g1[2]) * u1[2], silu_f(g1[3]) * u1[3]);
                *(u32x2_t*)(H + (size_t)row * ldh + col0) = w; }
    }
};
struct EpiMoeDown {
    static constexpr bool PERM = true, AFTER_DRAIN = false;
    bf16_t* O; const float* gw; float sin;
    f32x4* part; gu32* flag; PG8_LAS unsigned* wcnt;
    __device__ __forceinline__ void operator()(const f32x4 (&acc)[2][2][4][2], const Unit& u, int wr, int wc, int fr, int fq) const {
        const int row0 = u.pm * BM + wr * 64 + fr, col0 = (u.pn & 7) * BM + wc * 32 + 8 * fq;
        f32x4* pp = part + ((size_t)(u.slot * 8 + wr * 4 + wc) * 32) * 64 + (fq * 16 + fr);
        if (u.ks == 1) {
#pragma unroll
            for (int ai = 0; ai < 2; ++ai)
#pragma unroll
                for (int bj = 0; bj < 2; ++bj)
#pragma unroll
                    for (int m = 0; m < 4; ++m)
#pragma unroll
                        for (int n = 0; n < 2; ++n) pp[(((ai * 2 + bj) * 4 + m) * 2 + n) * 64] = acc[ai][bj][m][n];
            asm volatile("s_waitcnt vmcnt(0)" ::: "memory");
            if (fq * 16 + fr == 0) { const unsigned old = __hip_atomic_fetch_add(wcnt, 1u, __ATOMIC_RELAXED, __HIP_MEMORY_SCOPE_WORKGROUP);
                if (old == 7u) { __builtin_amdgcn_fence(__ATOMIC_RELEASE, "agent"); asm volatile("s_waitcnt vmcnt(0)" ::: "memory"); __hip_atomic_store(flag + u.slot, 1u, RLX_AGENT); } }
            return; }
        if (u.ks == 2) {
            if (fq * 16 + fr == 0) { unsigned sp = 0; while (__hip_atomic_load(flag + u.slot, RLX_AGENT) == 0u && ++sp < (1u << 22)) __builtin_amdgcn_s_sleep(1); }
            __builtin_amdgcn_fence(__ATOMIC_ACQUIRE, "agent"); asm volatile("s_waitcnt vmcnt(0)" ::: "memory");
#pragma unroll
            for (int ai = 0; ai < 2; ++ai)
#pragma unroll
                for (int m = 0; m < 4; ++m) { const int row = row0 + ai * HALF + m * 16; const float s = gw[row] * sin; bf16_t* rowp = O + (size_t)row * DM + col0;
#pragma unroll
                    for (int bj = 0; bj < 2; ++bj) { const f32x4 v0 = (acc[ai][bj][m][0] + pp[(((ai * 2 + bj) * 4 + m) * 2 + 0) * 64]) * s, v1 = (acc[ai][bj][m][1] + pp[(((ai * 2 + bj) * 4 + m) * 2 + 1) * 64]) * s;
                        u32x4 w; w.x = cvt_pk_bf16(v0[0], v0[1]); w.y = cvt_pk_bf16(v0[2], v0[3]); w.z = cvt_pk_bf16(v1[0], v1[1]); w.w = cvt_pk_bf16(v1[2], v1[3]);
                        *(u32x4*)(rowp + bj * HALF) = w; }
                    asm volatile("" ::: "memory"); }
            return; }
#pragma unroll
        for (int ai = 0; ai < 2; ++ai)
#pragma unroll
            for (int m = 0; m < 4; ++m) { const int row = row0 + ai * HALF + m * 16; const float s = gw[row] * sin; bf16_t* rowp = O + (size_t)row * DM + col0;
#pragma unroll
                for (int bj = 0; bj < 2; ++bj) { const f32x4 v0 = acc[ai][bj][m][0] * s, v1 = acc[ai][bj][m][1] * s;
                    u32x4 w; w.x = cvt_pk_bf16(v0[0], v0[1]); w.y = cvt_pk_bf16(v0[2], v0[3]); w.z = cvt_pk_bf16(v1[0], v1[1]); w.w = cvt_pk_bf16(v1[2], v1[3]);
                    *(u32x4*)(rowp + bj * HALF) = w; } }
    }
};
struct MoeOrder {
    static constexpr bool SPLITK = false;
    StaticOrder so; const PG8_LAS int* tile_e; int nct; int rev = 0;
    __device__ __forceinline__ bool next(int i, Unit& u) const { if (!so.next(i, u)) return false; if (rev) u.pm = so.nM - 1 - u.pm; u.pn += __builtin_amdgcn_readfirstlane(tile_e[u.pm]) * nct; return true; }
    __device__ __forceinline__ void a_ready(const Unit&) const {}
    __device__ __forceinline__ void done(const Unit&) const {}
};
struct MoeDownOrder {
    static constexpr bool SPLITK = true;
    StaticOrder so; const PG8_LAS int* tile_e; int nct, nM, nl, R, c, ntf; gu32* arr; LAS unsigned* wc;
    __device__ __forceinline__ bool next(int i, Unit& u) const {
        if (i < R) { (void)so.next(i, u); u.pm = nM - 1 - u.pm; }
        else if (i == R && c < nl * 16) { u.pm = c >> 4; u.pn = c & 7; const int h = (c >> 3) & 1; u.kt0 = h * (ntf >> 1); u.nt = ntf >> 1; u.ks = 1 + h; u.slot = (c >> 4) * 8 + (c & 7); }
        else return false;
        if (i < R) { u.kt0 = 0; u.nt = ntf; u.ks = 0; }
        u.aux = i; u.pn += __builtin_amdgcn_readfirstlane(tile_e[u.pm]) * nct; return true; }
    __device__ __forceinline__ void a_ready(const Unit&) const {}
    __device__ __forceinline__ void done(const Unit& u) const {
        if (u.aux == R - 1) { asm volatile("s_waitcnt vmcnt(0)" ::: "memory");
            if (mk_lane() == 0) { const unsigned old = __hip_atomic_fetch_add(wc, 1u, __ATOMIC_RELAXED, __HIP_MEMORY_SCOPE_WORKGROUP);
                if (old == 7u) { __builtin_amdgcn_fence(__ATOMIC_RELEASE, "agent"); asm volatile("s_waitcnt vmcnt(0)" ::: "memory"); (void)__hip_atomic_fetch_add(arr, 1u, RLX_AGENT); } } } }
};
}

#if defined(PROBE_LO)
#define PSPAN_BEGIN(C, id) do { if ((id) == PROBE_LO && blockIdx.x == 0 && (C).wave == 0 && mk_lane() == 0) { const unsigned long long t_ = __builtin_amdgcn_s_memrealtime(); (C).MISC[20] = (unsigned)t_; (C).MISC[21] = (unsigned)(t_ >> 32); } } while (0)
#define PSPAN_END(C, id) do { if ((id) == PROBE_LO && blockIdx.x == 0 && (C).wave == 0 && mk_lane() == 0) { const unsigned long long t_ = __builtin_amdgcn_s_memrealtime() - (((unsigned long long)(C).MISC[21] << 32) | (C).MISC[20]); (C).MISC[22] += (unsigned)t_; } } while (0)
#else
#define PSPAN_BEGIN(C, id) do {} while (0)
#define PSPAN_END(C, id) do {} while (0)
#endif
struct Params { const float* in[35]; float* out; unsigned char* ws; int ph_lo, ph_hi; };
typedef const __attribute__((address_space(4))) Params* KP;

#define PIN(i) ((const float*)(const GAS float*)(P->in[i]))
#define POUT ((float*)(GAS float*)(P->out))
struct Ctx {
    LAS unsigned char* lds; volatile LAS unsigned* MISC; GAS unsigned char* ws; gu32* ctl;
    int tid, lane, wave, blk, G;
};

__device__ __forceinline__ void tr_tile(const float* __restrict__ src, int ld, bf16* dst, int K, int k0, int n0, int drow0, int lane) {
    const int c4 = lane & 15, r = lane >> 4;
    const float* sp = src + (size_t)(k0 + 16 * r) * ld + n0 + 4 * c4;
    f32x4 x[16];
#pragma unroll
    for (int i = 0; i < 16; ++i) x[i] = __builtin_nontemporal_load((const f32x4*)(sp + (size_t)i * ld));
    bf16* dp = dst + (size_t)(drow0 + 4 * c4) * K + k0 + 16 * r;
#pragma unroll
    for (int q = 0; q < 4; ++q)
#pragma unroll
        for (int hf = 0; hf < 2; ++hf) { v4u o; o.x = pk2(x[8 * hf + 0][q], x[8 * hf + 1][q]); o.y = pk2(x[8 * hf + 2][q], x[8 * hf + 3][q]); o.z = pk2(x[8 * hf + 4][q], x[8 * hf + 5][q]); o.w = pk2(x[8 * hf + 6][q], x[8 * hf + 7][q]);
            *(GAS v4u*)(dp + (size_t)q * K + 8 * hf) = o; }
}
__device__ __forceinline__ void tr_tile8(const float* __restrict__ src, int ld, unsigned char* dst, int K, int k0, int n0, int drow0, int lane, float sc) {
    const int c4 = lane & 15, r = lane >> 4;
    const float* sp = src + (size_t)(k0 + 16 * r) * ld + n0 + 4 * c4;
    f32x4 x[16];
#pragma unroll
    for (int i = 0; i < 16; ++i) x[i] = __builtin_nontemporal_load((const f32x4*)(sp + (size_t)i * ld)) * sc;
    unsigned char* dp = dst + (size_t)(drow0 + 4 * c4) * K + k0 + 16 * r;
#pragma unroll
    for (int q = 0; q < 4; ++q) { v4u o; o.x = pk4_fp8(x[0][q], x[1][q], x[2][q], x[3][q]); o.y = pk4_fp8(x[4][q], x[5][q], x[6][q], x[7][q]); o.z = pk4_fp8(x[8][q], x[9][q], x[10][q], x[11][q]); o.w = pk4_fp8(x[12][q], x[13][q], x[14][q], x[15][q]);
        *(GAS v4u*)(dp + (size_t)q * K) = o; }
}
__device__ __forceinline__ void tr_plain(const float* src, int ld, int K, int N, bf16* dst, int item, int lane) {
    const int nblk = N / 64, kb = item / nblk, nb = item % nblk;
    tr_tile(src, ld, dst, K, 64 * kb, 64 * nb, 64 * nb, lane);
}
__device__ __forceinline__ void tr_inter(const float* src, int K, int N, bf16* dst, int half, int item, int lane) {
    const int nblk = N / 64, kb = item / nblk, nb = item % nblk, n0 = 64 * nb;
    tr_tile(src, N, dst, K, 64 * kb, n0, (n0 >> 7) * 256 + half * 128 + (n0 & 127), lane);
}

__device__ __forceinline__ void p0_ada(const Ctx& C, KP P) {
    const int u = C.blk, l = u / 96, ks = (u % 96) / 12, slab = (u % 96) % 12, n0 = slab * 1024, k0 = ks * 256, lane = C.lane, w = C.wave;
    LAS float* sc = (LAS float*)C.lds; LAS float* part = (LAS float*)(C.lds + 4096);
    const float* cin = PIN(1);
    for (int i = C.tid; i < 4 * 256; i += NTHR) sc[i] = silu_f(cin[(i >> 8) * DM + k0 + (i & 255)]);
    __syncthreads();
    const float* Wp = PIN(3) + ((size_t)l * DM + k0 + 32 * w) * (6 * DM) + n0 + 4 * lane;
    f32x4 acc[4][4];
#pragma unroll
    for (int b = 0; b < 4; ++b)
#pragma unroll
        for (int g = 0; g < 4; ++g) acc[b][g] = (f32x4){0.f, 0.f, 0.f, 0.f};
#pragma unroll 4
    for (int i = 0; i < 32; ++i) { f32x4 wv[4];
#pragma unroll
        for (int g = 0; g < 4; ++g) wv[g] = __builtin_nontemporal_load((const f32x4*)(Wp + (size_t)i * (6 * DM) + 256 * g));
#pragma unroll
        for (int b = 0; b < 4; ++b) { const float sv = sc[b * 256 + 32 * w + i];
#pragma unroll
            for (int g = 0; g < 4; ++g) acc[b][g] += wv[g] * sv; } }
#pragma unroll
    for (int b = 0; b < 4; ++b)
#pragma unroll
        for (int g = 0; g < 4; ++g) *(LAS f32x4*)(part + (w * 4 + b) * 1024 + 256 * g + 4 * lane) = acc[b][g];
    __syncthreads();
    float* PART = (float*)(C.ws + WS_XC);
    { float* dst = PART + ((size_t)((l * 12 + slab) * 8 + ks)) * 4096;
      for (int idx = C.tid; idx < 4096; idx += NTHR) { float sum = 0.f;
#pragma unroll
          for (int ww = 0; ww < 8; ++ww) sum += part[ww * 4096 + idx];
          dst[idx] = sum; } }
    asm volatile("s_waitcnt vmcnt(0)" ::: "memory"); __syncthreads();
    if (C.tid == 0) { __builtin_amdgcn_fence(__ATOMIC_RELEASE, "agent"); asm volatile("s_waitcnt vmcnt(0)" ::: "memory");
        const unsigned old = __hip_atomic_fetch_add(C.ctl + CW_ADA + (l * 12 + slab), 1u, RLX_AGENT);
        if (old == 7u) { __builtin_amdgcn_fence(__ATOMIC_ACQUIRE, "agent"); asm volatile("s_waitcnt vmcnt(0)" ::: "memory"); }
        C.MISC[24] = old; }
    __syncthreads();
    const unsigned old = (unsigned)__builtin_amdgcn_readfirstlane((int)C.MISC[24]);
    __syncthreads();
    if (old == 7u) { const float* src = PART + ((size_t)((l * 12 + slab) * 8)) * 4096; const float* bias = PIN(4) + l * (6 * DM) + n0;
        for (int idx = C.tid; idx < 4096; idx += NTHR) { const int b = idx >> 10, n = idx & 1023; float sum = bias[n];
#pragma unroll
            for (int q = 0; q < 8; ++q) sum += src[(size_t)q * 4096 + idx];
            ((float*)(C.ws + WS_MOD))[(size_t)(l * 4 + b) * (6 * DM) + n0 + n] = sum; } }
    __syncthreads();
}

__device__ __forceinline__ void p0_ssm(const Ctx& C, KP P) {
    const int u = C.blk - 192, l = u >> 5, g = u & 31, lg = l * 32 + g;
    LAS f32x2_t* Pw = (LAS f32x2_t*)C.lds;
    LAS f32x2_t* Bb = (LAS f32x2_t*)(C.lds + 8704);
    LAS f32x2_t* Cc = (LAS f32x2_t*)(C.lds + 8704 + 8192);
    LAS float* Kl = (LAS float*)(C.lds + 8704 + 16384);
    const float dt = expf(PIN(12)[lg]);
    if (C.tid < 64) { const int p = C.tid; const float ar = PIN(10)[lg * 64 + p], ai = PIN(11)[lg * 64 + p];
        for (int j = 0; j <= 16; ++j) { const float mag = expf(ar * dt * (float)j); double rev = (double)ai * (double)dt * (double)j * 0.15915494309189533577; rev -= rint(rev);
            float s, c; sincos2pi(rev, s, c); Pw[j * 64 + p] = (f32x2_t){mag * c, mag * s}; }
        const f32x2_t lb = Pw[64 + p]; const float nx = lb.x - 1.f, ny = lb.y, den = ar * ar + ai * ai;
        const float cx = (nx * ar + ny * ai) / den, cy = (ny * ar - nx * ai) / den;
        for (int h = 0; h < 16; ++h) { const float br = PIN(13)[(lg * 64 + p) * 16 + h], bi = PIN(14)[(lg * 64 + p) * 16 + h]; Bb[p * 16 + h] = (f32x2_t){cx * br - cy * bi, cx * bi + cy * br}; }
        ((f32x2_t*)(C.ws + WS_A16))[lg * 64 + p] = Pw[16 * 64 + p]; }
    for (int i = C.tid; i < 1024; i += NTHR) Cc[i] = (f32x2_t){PIN(15)[lg * 1024 + i], PIN(16)[lg * 1024 + i]};
    __syncthreads();
    for (int e = C.tid; e < 4096; e += NTHR) { const int j = e >> 8, hp = (e >> 4) & 15, h = e & 15; float s = 0.f;
        for (int p = 0; p < 64; ++p) { const f32x2_t c = Cc[hp * 64 + p], pw = Pw[j * 64 + p], bb = Bb[p * 16 + h]; const float zx = c.x * pw.x - c.y * pw.y, zy = c.x * pw.y + c.y * pw.x; s += zx * bb.x - zy * bb.y; }
        if (j == 0 && hp == h) s += PIN(17)[l * 512 + g * 16 + h];
        Kl[e] = s; }
    __syncthreads();
    bf16* M2 = (bf16*)(C.ws + WS_M2) + (size_t)lg * 128 * 256;
    for (int pc = C.tid; pc < 4096; pc += NTHR) { const int n = pc >> 5, k0 = (pc & 31) * 8, p = n >> 1, ri = n & 1, s = k0 >> 4, h0 = k0 & 15; const f32x2_t pw = Pw[(15 - s) * 64 + p]; float v[8];
#pragma unroll
        for (int j = 0; j < 8; ++j) { const f32x2_t bb = Bb[p * 16 + h0 + j]; v[j] = ri ? (pw.x * bb.y + pw.y * bb.x) : (pw.x * bb.x - pw.y * bb.y); }
        v4u o; o.x = pk2(v[0], v[1]); o.y = pk2(v[2], v[3]); o.z = pk2(v[4], v[5]); o.w = pk2(v[6], v[7]); *(GAS v4u*)(M2 + (size_t)n * 256 + k0) = o; }
    bf16* M13 = (bf16*)(C.ws + WS_M13) + (size_t)lg * 256 * 384;
    for (int pc = C.tid; pc < 12288; pc += NTHR) { const int n = pc / 48, k0 = (pc % 48) * 8, i = n >> 4, hp = n & 15; float v[8];
        if (k0 < 256) { const int s = k0 >> 4, h0 = k0 & 15;
#pragma unroll
            for (int j = 0; j < 8; ++j) v[j] = (i >= s) ? Kl[((i - s) * 16 + hp) * 16 + h0 + j] : 0.f; }
        else {
#pragma unroll
            for (int j = 0; j < 8; ++j) { const int kk = k0 - 256 + j, p = kk >> 1, ri = kk & 1; const f32x2_t c = Cc[hp * 64 + p], pw = Pw[(i + 1) * 64 + p]; const float zx = c.x * pw.x - c.y * pw.y, zy = c.x * pw.y + c.y * pw.x; v[j] = ri ? -zy : zx; } }
        v4u o; o.x = pk2(v[0], v[1]); o.y = pk2(v[2], v[3]); o.z = pk2(v[4], v[5]); o.w = pk2(v[6], v[7]); *(GAS v4u*)(M13 + (size_t)n * 384 + k0) = o; }
    __syncthreads();
}

__device__ __forceinline__ void p0_prologue(const Ctx& C, KP P) {
    if (C.blk < 192) p0_ada(C, P); else p0_ssm(C, P);
    { const int* pos = (const int*)PIN(2); float* rope = (float*)(C.ws + WS_ROPE);
      for (int idx = C.blk * NTHR + C.tid; idx < TOK * 8; idx += C.G * NTHR) { const int t = idx >> 3, i = idx & 7;
          const double invf = exp(-(double)i * (13.122363377404328 / 8.0)); double rev = (double)pos[t] * invf * 0.15915494309189533577; rev -= rint(rev);
          float s, c; sincos2pi(rev, s, c); rope[t * 16 + i] = c; rope[t * 16 + 8 + i] = s; } }
    const int gw = C.blk * NWAVES + C.wave, NGW = C.G * NWAVES, lane = C.lane;
    constexpr int I_IN = 32 * 92, I_OUT = 32 * 32, I_GLU = 8 * 8, I_F13 = 32 * 88, I_F2 = 88 * 32, I_M13 = 32 * 112, I_M2 = 112 * 32;
    constexpr int NITEMS = 2 * I_IN + 2 * I_OUT + 2 * I_GLU + 2 * I_F13 + I_F2;
#pragma unroll 1
    for (int it = gw; it < NITEMS; it += NGW) {
        int r = it;
        if (r < 2 * I_IN) { const int l = r / I_IN; r -= l * I_IN; tr_plain(PIN(8) + (size_t)l * DM * INW, INW, DM, PW, (bf16*)(C.ws + WS_WIN) + (size_t)l * PW * DM, r, lane); continue; } r -= 2 * I_IN;
        if (r < 2 * I_OUT) { const int l = r / I_OUT; r -= l * I_OUT; tr_plain(PIN(9) + (size_t)l * DM * DM, DM, DM, DM, (bf16*)(C.ws + WS_WOUT) + (size_t)l * DM * DM, r, lane); continue; } r -= 2 * I_OUT;
        if (r < 2 * I_GLU) { const int l = r / I_GLU; r -= l * I_GLU; tr_plain(PIN(18) + (size_t)l * 512 * 512, 512, 512, 512, (bf16*)(C.ws + WS_WGLU) + (size_t)l * 512 * 512, r, lane); continue; } r -= 2 * I_GLU;
        if (r < 2 * I_F13) { const int half = r / I_F13; r -= half * I_F13;
            if (DENSE_FP8 >= 1) { const int nblk = DFF / 64, kb = r / nblk, n0 = 64 * (r % nblk); tr_tile8(half ? PIN(29) : PIN(28), DFF, (unsigned char*)(C.ws + WS_WUP), DM, 64 * kb, n0, (n0 >> 7) * 256 + half * 128 + (n0 & 127), lane, S8_W13); }
            else tr_inter(half ? PIN(29) : PIN(28), DM, DFF, (bf16*)(C.ws + WS_WUP), half, r, lane);
            continue; } r -= 2 * I_F13;
        if (r < I_F2) { if (DENSE_FP8 >= 2) { const int nblk = DM / 64, kb = r / nblk, n0 = 64 * (r % nblk); tr_tile8(PIN(30), DM, (unsigned char*)(C.ws + WS_WDN), DFF, 64 * kb, n0, n0, lane, S8_W2); }
            else tr_plain(PIN(30), DM, DFF, DM, (bf16*)(C.ws + WS_WDN), r, lane); }
    }
}

constexpr int MOE_CVT_TILES = 16 * (32 * 112) + 8 * (112 * 32), MOE_CVT_CHUNKS = MOE_CVT_TILES / 16;
struct CvtTile { const float* sp; unsigned char* dp; int ld, K; float sc; };
__device__ __forceinline__ void moe_cvt_addr(const Ctx& C, KP P, int r, int lane, CvtTile& t) {
    constexpr int I_M13 = 32 * 112, I_M2 = 112 * 32; const int c4 = lane & 15, rr = lane >> 4;
    if (r < 16 * I_M13) { const int q = r / I_M13, e = q >> 1, half = q & 1; r -= q * I_M13; const int nblk = DFE / 64, kb = 2 * (r / (2 * nblk)) + (r & 1), n0 = 64 * ((r % (2 * nblk)) >> 1);
        t.ld = DFE; t.K = DM; t.sc = S8_W13; t.sp = (half ? PIN(33) : PIN(32)) + (size_t)e * DM * DFE + (size_t)(64 * kb + 16 * rr) * DFE + n0 + 4 * c4;
        t.dp = (unsigned char*)(C.ws + WS_MUP) + (size_t)e * 2 * DFE * DM + (size_t)((n0 >> 7) * 256 + half * 128 + (n0 & 127) + 4 * c4) * DM + 64 * kb + 16 * rr; }
    else { r -= 16 * I_M13; const int e = r / I_M2; r -= e * I_M2; const int nblk = DM / 64, kb = 2 * (r / (2 * nblk)) + (r & 1), n0 = 64 * ((r % (2 * nblk)) >> 1);
        t.ld = DM; t.K = DFE; t.sc = S8_W2; t.sp = PIN(34) + (size_t)e * DFE * DM + (size_t)(64 * kb + 16 * rr) * DM + n0 + 4 * c4;
        t.dp = (unsigned char*)(C.ws + WS_MDN) + (size_t)e * DM * DFE + (size_t)(n0 + 4 * c4) * DFE + 64 * kb + 16 * rr; }
}
__device__ __forceinline__ void cvt_load(const CvtTile& t, f32x4 (&x)[16]) {
#pragma unroll
    for (int i = 0; i < 16; ++i) x[i] = __builtin_nontemporal_load((const f32x4*)(t.sp + (size_t)i * t.ld));
}
__device__ __forceinline__ void cvt_store(const CvtTile& t, const f32x4 (&x)[16]) {
    const float sc = t.sc;
#pragma unroll
    for (int q = 0; q < 4; ++q) { v4u o; o.x = pk4_fp8(x[0][q] * sc, x[1][q] * sc, x[2][q] * sc, x[3][q] * sc); o.y = pk4_fp8(x[4][q] * sc, x[5][q] * sc, x[6][q] * sc, x[7][q] * sc);
        o.z = pk4_fp8(x[8][q] * sc, x[9][q] * sc, x[10][q] * sc, x[11][q] * sc); o.w = pk4_fp8(x[12][q] * sc, x[13][q] * sc, x[14][q] * sc, x[15][q] * sc);
        *(GAS v4u*)(t.dp + (size_t)q * t.K) = o; }
}
__device__ __forceinline__ void moe_cvt_fill(const Ctx& C, KP P, int k) {
    gu32* arr = C.ctl + CW_ARR + 64 * k; gu32* head = C.ctl + CW_CVQ;
    if (C.wave == 0 && C.lane == 0) (void)__hip_atomic_fetch_add(arr, 1u, RLX_AGENT);
    for (;;) {
        if (C.wave == 0 && C.lane == 0) { unsigned q = 0xffffffffu; if (__hip_atomic_load(arr, RLX_AGENT) < (unsigned)C.G) q = __hip_atomic_fetch_add(head, 1u, RLX_AGENT); C.MISC[24] = q; }
        __syncthreads();
        const unsigned q = (unsigned)__builtin_amdgcn_readfirstlane((int)C.MISC[24]);
        __syncthreads();
        if (q >= (unsigned)MOE_CVT_CHUNKS) break;
        { const int tb = (MOE_CVT_CHUNKS - 1 - (int)q) * 16 + C.wave * 2;
          CvtTile a, b; moe_cvt_addr(C, P, tb, C.lane, a); moe_cvt_addr(C, P, tb + 1, C.lane, b); f32x4 xa[16], xb[16]; cvt_load(a, xa); cvt_load(b, xb); cvt_store(a, xa); cvt_store(b, xb); }
    }
}
__device__ __forceinline__ void moe_cvt_drain(const Ctx& C, KP P) {
    unsigned h = __hip_atomic_load(C.ctl + CW_CVQ, RLX_AGENT); h = (unsigned)__builtin_amdgcn_readfirstlane((int)h); if (h > (unsigned)MOE_CVT_CHUNKS) h = MOE_CVT_CHUNKS;
    const int s0 = (int)h * 16, npair = (MOE_CVT_TILES - s0) / 2, step = C.G * NWAVES; int p = C.blk * NWAVES + C.wave;
    if (p >= npair) return;
    CvtTile a, b; f32x4 xa[16], xb[16];
    moe_cvt_addr(C, P, MOE_CVT_TILES - 1 - (s0 + 2 * p), C.lane, a); moe_cvt_addr(C, P, MOE_CVT_TILES - 2 - (s0 + 2 * p), C.lane, b); cvt_load(a, xa); cvt_load(b, xb);
#pragma unroll 1
    for (;;) { const int pn = p + step; const bool more = pn < npair;
        cvt_store(a, xa); if (more) { moe_cvt_addr(C, P, MOE_CVT_TILES - 1 - (s0 + 2 * pn), C.lane, a); cvt_load(a, xa); }
        cvt_store(b, xb); if (!more) break; moe_cvt_addr(C, P, MOE_CVT_TILES - 2 - (s0 + 2 * pn), C.lane, b); cvt_load(b, xb);
        p = pn; }
}

template <bool WITH_GAB, bool OUT8 = false>
__device__ __forceinline__ void norm_phase(const Ctx& C, const float* __restrict__ src, const float* __restrict__ nw, const float* __restrict__ mod_shift, const float* __restrict__ mod_scale, const float* __restrict__ w12  ) {
    LAS float* W12T = (LAS float*)C.lds;
    if (WITH_GAB) { for (int idx = C.tid; idx < DM * 12; idx += NTHR) { const int k = idx / 12, j = idx % 12; W12T[j * DM + k] = w12[(size_t)k * INW + C_GA + j]; } __syncthreads(); }
    bf16* HN = (bf16*)(C.ws + WS_HN); float* GAB = (float*)(C.ws + WS_GAB);
    const int lane = C.lane;
    f32x4 nwv[8];
#pragma unroll
    for (int j = 0; j < 8; ++j) nwv[j] = *(const f32x4*)(nw + 4 * lane + 256 * j);
    f32x4 vn[2][8];
#pragma unroll
    for (int u = 0; u < 2; ++u)
#pragma unroll
        for (int j = 0; j < 8; ++j) vn[u][j] = *(const f32x4*)(src + (size_t)(C.blk * 64 + C.wave * 8 + u) * DM + 4 * lane + 256 * j);
    int nlim = 4; asm volatile("" : "+s"(nlim));
#pragma unroll 1
    for (int i = 0; i < nlim; ++i) { const int t0 = C.blk * 64 + C.wave * 8 + 2 * i; const int b = t0 >> 12;
        f32x4 v[2][8]; float ss0 = 0.f, ss1 = 0.f;
#pragma unroll
        for (int j = 0; j < 8; ++j) { v[0][j] = vn[0][j]; v[1][j] = vn[1][j];
            ss0 += (v[0][j].x * v[0][j].x + v[0][j].y * v[0][j].y) + (v[0][j].z * v[0][j].z + v[0][j].w * v[0][j].w); ss1 += (v[1][j].x * v[1][j].x + v[1][j].y * v[1][j].y) + (v[1][j].z * v[1][j].z + v[1][j].w * v[1][j].w); }
        if (i + 1 < nlim) {
#pragma unroll
            for (int u = 0; u < 2; ++u)
#pragma unroll
                for (int j = 0; j < 8; ++j) vn[u][j] = *(const f32x4*)(src + (size_t)(t0 + 2 + u) * DM + 4 * lane + 256 * j); }
        const float r0 = rsqrtf(wave_sum(ss0) * (1.f / DM) + EPS), r1 = rsqrtf(wave_sum(ss1) * (1.f / DM) + EPS);
        const float* sh = mod_shift + (size_t)b * 6 * DM; const float* scp = mod_scale + (size_t)b * 6 * DM;
#pragma unroll
        for (int j = 0; j < 8; ++j) { const f32x4 s1 = *(const f32x4*)(scp + 4 * lane + 256 * j), s0 = *(const f32x4*)(sh + 4 * lane + 256 * j); const f32x4 m1 = nwv[j] * (s1 + 1.f);
            v[0][j] = v[0][j] * r0 * m1 + s0; v[1][j] = v[1][j] * r1 * m1 + s0;
#pragma unroll
            for (int u = 0; u < 2; ++u) {
                if (OUT8) *(GAS unsigned*)((unsigned char*)HN + (size_t)(t0 + u) * DM + 4 * lane + 256 * j) = pk4_fp8(v[u][j].x * S8_HN, v[u][j].y * S8_HN, v[u][j].z * S8_HN, v[u][j].w * S8_HN);
                else { u32x2_t o; o.x = pk2(v[u][j].x, v[u][j].y); o.y = pk2(v[u][j].z, v[u][j].w); *(GAS u32x2_t*)(HN + (size_t)(t0 + u) * DM + 4 * lane + 256 * j) = o; } } }
        if (WITH_GAB) { unsigned wb = 16u * (unsigned)lane; asm volatile("" : "+v"(wb));
            const LAS float* W12L = (const LAS float*)(size_t)wb;
#pragma unroll
            for (int jj = 0; jj < 12; ++jj) { float a0 = 0.f, a1 = 0.f;
#pragma unroll
                for (int j = 0; j < 8; ++j) { const f32x4 wv = *(const LAS f32x4*)(W12L + jj * DM + 256 * j);
                    a0 += (v[0][j].x * wv.x + v[0][j].y * wv.y) + (v[0][j].z * wv.z + v[0][j].w * wv.w); a1 += (v[1][j].x * wv.x + v[1][j].y * wv.y) + (v[1][j].z * wv.z + v[1][j].w * wv.w); }
                a0 = wave_sum(a0); a1 = wave_sum(a1); if (lane == 0) { GAB[(size_t)t0 * 12 + jj] = a0; GAB[(size_t)(t0 + 1) * 12 + jj] = a1; } } }
    }
    __syncthreads();
}

__device__ __forceinline__ void rope_pass(const Ctx& C) {
    bf16* PROJ = (bf16*)(C.ws + WS_PROJ); const float* rope = (const float*)(C.ws + WS_ROPE);
    for (int idx = C.blk * NTHR + C.tid; idx < TOK * 24; idx += C.G * NTHR) { const int t = idx / 24, v = idx % 24;
        bf16* p = PROJ + (size_t)t * PW + (v < 12 ? C_DQ + v * 64 : C_DK + (v - 12) * 64);
        const u32x4_t a = *(const u32x4_t*)p, b = *(const u32x4_t*)(p + 8);
        const f32x4 c0 = *(const f32x4*)(rope + t * 16), c1 = *(const f32x4*)(rope + t * 16 + 4), s0 = *(const f32x4*)(rope + t * 16 + 8), s1 = *(const f32x4*)(rope + t * 16 + 12);
        const float t1[8] = {bflo(a.x), bfhi(a.x), bflo(a.y), bfhi(a.y), bflo(a.z), bfhi(a.z), bflo(a.w), bfhi(a.w)};
        const float t2[8] = {bflo(b.x), bfhi(b.x), bflo(b.y), bfhi(b.y), bflo(b.z), bfhi(b.z), bflo(b.w), bfhi(b.w)};
        const float cs[8] = {c0.x, c0.y, c0.z, c0.w, c1.x, c1.y, c1.z, c1.w}, sn[8] = {s0.x, s0.y, s0.z, s0.w, s1.x, s1.y, s1.z, s1.w};
        float o1[8], o2[8];
#pragma unroll
        for (int i = 0; i < 8; ++i) { o1[i] = t1[i] * cs[i] - t2[i] * sn[i]; o2[i] = t2[i] * cs[i] + t1[i] * sn[i]; }
        u32x4_t oa, ob; oa.x = pk2(o1[0], o1[1]); oa.y = pk2(o1[2], o1[3]); oa.z = pk2(o1[4], o1[5]); oa.w = pk2(o1[6], o1[7]);
        ob.x = pk2(o2[0], o2[1]); ob.y = pk2(o2[2], o2[3]); ob.z = pk2(o2[4], o2[5]); ob.w = pk2(o2[6], o2[7]);
        *(u32x4_t*)p = oa; *(u32x4_t*)(p + 8) = ob; }
}

#define SSM_BAR() asm volatile("s_waitcnt lgkmcnt(0)\n\ts_barrier" ::: "memory")
__device__ __forceinline__ void ssm_gemm_a(const Ctx& C, int l) {
    const bf16* PROJ = (const bf16*)(C.ws + WS_PROJ); float* XC = (float*)(C.ws + WS_XC);
    const int lane = C.lane, fr = lane & 15, quad = lane >> 4, tid = C.tid;
    for (int bu = C.blk; bu < 256; bu += C.G) { const int g = bu >> 3, rt = (bu & 7) * 8 + C.wave, r = 16 * rt + fr, tok = (r >> 8) * SQ + (r & 255) * 16;
        const bf16* arow = PROJ + (size_t)(tok + (quad >> 1)) * PW + C_U + g * 16 + 8 * (quad & 1);
        const bf16* bsrc = (const bf16*)(C.ws + WS_M2) + ((size_t)(l * 32 + g) * 128 + 16 * (tid >> 6) + fr) * 256 + 8 * quad;
        f32x4 acc[8];
#pragma unroll
        for (int nt = 0; nt < 8; ++nt) acc[nt] = (f32x4){0.f, 0.f, 0.f, 0.f};
        u32x4_t rb = *(const u32x4_t*)bsrc; bf16x8 an = *(const bf16x8*)arow;
        *(LAS u32x4_t*)(C.lds + tid * 16) = rb;
        SSM_BAR();
#pragma unroll 1
        for (int ks = 0; ks < 8; ++ks) { const bf16x8 a = an; const LAS unsigned char* cur = C.lds + (ks & 1) * 8192;
            if (ks + 1 < 8) { rb = *(const u32x4_t*)(bsrc + 32 * (ks + 1)); an = *(const bf16x8*)(arow + (size_t)(2 * (ks + 1)) * PW); }
#pragma unroll
            for (int nt = 0; nt < 8; ++nt) { const bf16x8 b = *(const LAS bf16x8*)(cur + (nt * 64 + lane) * 16); acc[nt] = __builtin_amdgcn_mfma_f32_16x16x32_bf16(a, b, acc[nt], 0, 0, 0); }
            if (ks + 1 < 8) *(LAS u32x4_t*)(C.lds + ((ks + 1) & 1) * 8192 + tid * 16) = rb;
            SSM_BAR(); }
#pragma unroll
        for (int nt = 0; nt < 8; ++nt)
#pragma unroll
            for (int j = 0; j < 4; ++j) XC[((size_t)(16 * rt + 4 * quad + j) * 32 + g) * 128 + 16 * nt + fr] = acc[nt][j];
    }
}

__device__ __forceinline__ void ssm_gemm_b(const Ctx& C, int l) {
    const bf16* PROJ = (const bf16*)(C.ws + WS_PROJ); const bf16* XS = (const bf16*)(C.ws + WS_XS); bf16* YG = (bf16*)(C.ws + WS_YGELU);
    const int lane = C.lane, fr = lane & 15, quad = lane >> 4, tid = C.tid;
    for (int bu = C.blk; bu < 256; bu += C.G) { const int g = bu >> 3, rt = (bu & 7) * 8 + C.wave, r = 16 * rt + fr, tok = (r >> 8) * SQ + (r & 255) * 16;
        const bf16* arow = PROJ + (size_t)(tok + (quad >> 1)) * PW + C_U + g * 16 + 8 * (quad & 1);
        const bf16* xrow = XS + ((size_t)r * 32 + g) * 128 + 8 * quad;
        const bf16* bsrc = (const bf16*)(C.ws + WS_M13) + ((size_t)(l * 32 + g) * 256 + 16 * (tid >> 6) + fr) * 384 + 8 * quad;
        f32x4 acc[16];
#pragma unroll
        for (int nt = 0; nt < 16; ++nt) acc[nt] = (f32x4){0.f, 0.f, 0.f, 0.f};
        u32x4_t rb0 = *(const u32x4_t*)bsrc, rb1 = *(const u32x4_t*)(bsrc + 128 * 384); bf16x8 an = *(const bf16x8*)arow;
        *(LAS u32x4_t*)(C.lds + tid * 16) = rb0; *(LAS u32x4_t*)(C.lds + 8192 + tid * 16) = rb1;
        SSM_BAR();
#pragma unroll 1
        for (int ks = 0; ks < 12; ++ks) { const bf16x8 a = an; const LAS unsigned char* cur = C.lds + (ks & 1) * 16384;
            if (ks + 1 < 12) { rb0 = *(const u32x4_t*)(bsrc + 32 * (ks + 1)); rb1 = *(const u32x4_t*)(bsrc + 128 * 384 + 32 * (ks + 1));
                an = (ks + 1 < 8) ? *(const bf16x8*)(arow + (size_t)(2 * (ks + 1)) * PW) : *(const bf16x8*)(xrow + 32 * (ks + 1 - 8)); }
#pragma unroll
            for (int nt = 0; nt < 16; ++nt) { const bf16x8 b = *(const LAS bf16x8*)(cur + (nt * 64 + lane) * 16); acc[nt] = __builtin_amdgcn_mfma_f32_16x16x32_bf16(a, b, acc[nt], 0, 0, 0); }
            if (ks + 1 < 12) { *(LAS u32x4_t*)(C.lds + ((ks + 1) & 1) * 16384 + tid * 16) = rb0; *(LAS u32x4_t*)(C.lds + ((ks + 1) & 1) * 16384 + 8192 + tid * 16) = rb1; }
            SSM_BAR(); }
#pragma unroll
        for (int j = 0; j < 4; ++j) { const int rr = 16 * rt + 4 * quad + j; const size_t tb = (size_t)((rr >> 8) * SQ + (rr & 255) * 16);
#pragma unroll
            for (int nt = 0; nt < 16; ++nt) YG[(tb + nt) * 512 + g * 16 + fr] = (bf16)f2bf(gelu_tanh_f(acc[nt][j])); }
    }
}

__device__ __forceinline__ void ssm_scan(const Ctx& C, int l, int sblk  ) {
    const int idx = sblk * NTHR + C.tid, b = idx >> 11, g = (idx >> 6) & 31, p = idx & 63;
    const f32x2_t a = ((const f32x2_t*)(C.ws + WS_A16))[(l * 32 + g) * 64 + p];
    const f32x2_t* xc = (const f32x2_t*)(C.ws + WS_XC) + ((size_t)(b * 256) * 32 + g) * 64 + p; unsigned* xs = (unsigned*)(C.ws + WS_XS) + ((size_t)(b * 256) * 32 + g) * 64 + p;
    float xr = 0.f, xi = 0.f;
    for (int c0 = 0; c0 < 256; c0 += 8) { f32x2_t in[8];
#pragma unroll
        for (int q = 0; q < 8; ++q) in[q] = xc[(size_t)(c0 + q) * 2048];
#pragma unroll
        for (int q = 0; q < 8; ++q) { xs[(size_t)(c0 + q) * 2048] = pk2(xr, xi); const float nr = a.x * xr - a.y * xi + in[q].x, ni = a.x * xi + a.y * xr + in[q].y; xr = nr; xi = ni; } }
}

constexpr int GL_QT = 0, GL_KT = 33792, GL_VT = 67584, GL_AM = 101376, GL_QK = 118784, GL_SM = 136192;
__device__ __forceinline__ void gdn_prep_unit(const Ctx& C, KP P, int l, int unit) {
    const int b = unit / 384, h = (unit / 64) % 6, ch = unit & 63, tok0 = b * SQ + ch * 64, tid = C.tid, lane = C.lane, wave = C.wave;
    LAS float* QT = (LAS float*)(C.lds + GL_QT); LAS float* KT = (LAS float*)(C.lds + GL_KT); LAS float* VT = (LAS float*)(C.lds + GL_VT);
    LAS float* AM = (LAS float*)(C.lds + GL_AM); LAS float* QKM = (LAS float*)(C.lds + GL_QK);
    unsigned smb = GL_SM; asm volatile("" : "+v"(smb));
    LAS float* gc = (LAS float*)(size_t)smb; LAS float* beta = gc + 64; LAS float* eg = gc + 128; LAS float* ek = gc + 192;
    const bf16* PROJ = (const bf16*)(C.ws + WS_PROJ); const float* convw = PIN(24) + (size_t)l * 4 * 2304;
    GAS unsigned char* UB = C.ws + WS_GU + (size_t)unit * GDN_UNIT_BYTES;
    PSPAN_BEGIN(C, 110);
    if (tid < 384) { const int cg = tid % 48, seg = tid / 48, which = cg >> 4, d0 = (cg & 15) * 8, chn = which * 768 + h * 128 + d0, sp0 = ch * 64 + 8 * seg - 3;
        const bf16* src = PROJ + ((size_t)(b * SQ) + sp0) * PW + C_GQ + chn;
        u32x4_t raw[11];
#pragma unroll
        for (int r = 0; r < 11; ++r) raw[r] = (r >= 3 || sp0 + r >= 0) ? *(const u32x4_t*)(src + (ptrdiff_t)r * PW) : (u32x4_t){0u, 0u, 0u, 0u};
        f32x4 wv[4][2];
#pragma unroll
        for (int tap = 0; tap < 4; ++tap) { wv[tap][0] = *(const f32x4*)(convw + tap * 2304 + chn); wv[tap][1] = *(const f32x4*)(convw + tap * 2304 + chn + 4); }
        LAS float* T = (LAS float*)(C.lds + which * 33792) + (8 * seg) * 132 + d0;
#pragma unroll
        for (int i = 0; i < 8; ++i) { f32x4 a0 = (f32x4){0.f, 0.f, 0.f, 0.f}, a1 = a0;
#pragma unroll
            for (int tap = 0; tap < 4; ++tap) { const u32x4_t w = raw[i + tap];
                a0 += wv[tap][0] * (f32x4){bflo(w.x), bfhi(w.x), bflo(w.y), bfhi(w.y)}; a1 += wv[tap][1] * (f32x4){bflo(w.z), bfhi(w.z), bflo(w.w), bfhi(w.w)}; }
            *(LAS f32x4*)(T + i * 132) = (f32x4){silu_f(a0.x), silu_f(a0.y), silu_f(a0.z), silu_f(a0.w)}; *(LAS f32x4*)(T + i * 132 + 4) = (f32x4){silu_f(a1.x), silu_f(a1.y), silu_f(a1.z), silu_f(a1.w)}; } }
    __syncthreads();
    PSPAN_END(C, 110); PSPAN_BEGIN(C, 111);
#pragma unroll
    for (int ii = 0; ii < 8; ++ii) { const int i = wave * 8 + ii;
        { const float a = QT[i * 132 + lane], c = QT[i * 132 + 64 + lane]; const float sc = rsqrtf(wave_sum(a * a + c * c) + EPS) * 0.08838834764831845f; QT[i * 132 + lane] = a * sc; QT[i * 132 + 64 + lane] = c * sc; }
        { const float a = KT[i * 132 + lane], c = KT[i * 132 + 64 + lane]; const float sc = rsqrtf(wave_sum(a * a + c * c) + EPS); KT[i * 132 + lane] = a * sc; KT[i * 132 + 64 + lane] = c * sc; } }
    if (wave == 0) { const float* GAB = (const float*)(C.ws + WS_GAB) + (size_t)(tok0 + lane) * 12;
        const float av = GAB[h], bv = GAB[6 + h]; const float x = av + PIN(26)[l * 6 + h]; const float sp = (x > 20.f) ? x : log1pf(__expf(x));
        float g = -__expf(PIN(25)[l * 6 + h]) * sp;
#pragma unroll
        for (int o = 1; o < 64; o <<= 1) { const float t = __shfl_up(g, o); if (lane >= o) g += t; }
        const float glast = __shfl(g, 63);
        gc[lane] = g; beta[lane] = sigmoid_f(bv); eg[lane] = __expf(g); ek[lane] = __expf(glast - g);
        if (lane == 0) *(float*)(UB + 57344 + 32768) = __expf(glast); }
    __syncthreads();
    PSPAN_END(C, 111); PSPAN_BEGIN(C, 112);
    for (int z = tid; z < 6 * 256; z += NTHR) { const int t = z >> 8, e = z & 255, ti = (t >= 3) ? (t >= 5 ? 2 : 1) : 0, tj = (t >= 3) ? (t >= 5 ? 3 : t - 1) : t + 1;
        QKM[(16 * ti + (e >> 4)) * 68 + 16 * tj + (e & 15)] = 0.f; }
    { const int fr = lane & 15, quad = lane >> 4;
#pragma unroll 1
      for (int job = wave; job < 20; job += NWAVES) { const int mat = job / 10, t = job % 10, ti = (t >= 6) ? 3 : (t >= 3) ? 2 : (t >= 1) ? 1 : 0, tj = t - ti * (ti + 1) / 2; LAS float* OUT = mat ? QKM : AM;
          const LAS float* ap = (mat ? QT : KT) + (16 * ti + fr) * 132 + quad; const LAS float* bp = KT + (16 * tj + fr) * 132 + quad;
          f32x4 a0 = (f32x4){0.f, 0.f, 0.f, 0.f}, a1 = a0, a2 = a0, a3 = a0;
#pragma unroll
          for (int kk = 0; kk < 32; kk += 4) { a0 = __builtin_amdgcn_mfma_f32_16x16x4f32(ap[4 * kk], bp[4 * kk], a0, 0, 0, 0); a1 = __builtin_amdgcn_mfma_f32_16x16x4f32(ap[4 * kk + 4], bp[4 * kk + 4], a1, 0, 0, 0);
              a2 = __builtin_amdgcn_mfma_f32_16x16x4f32(ap[4 * kk + 8], bp[4 * kk + 8], a2, 0, 0, 0); a3 = __builtin_amdgcn_mfma_f32_16x16x4f32(ap[4 * kk + 12], bp[4 * kk + 12], a3, 0, 0, 0); }
          const f32x4 acc = (a0 + a1) + (a2 + a3);
#pragma unroll
          for (int j = 0; j < 4; ++j) { const int i = 16 * ti + 4 * quad + j, jj = 16 * tj + fr; float v = 0.f;
              if (mat == 0) { if (i > jj) v = beta[i] * acc[j] * __expf(gc[i] - gc[jj]); } else { if (i >= jj) v = acc[j] * __expf(gc[i] - gc[jj]); }
              OUT[i * 68 + jj] = v; } } }
    __syncthreads();
    PSPAN_END(C, 112); PSPAN_BEGIN(C, 113);
    { LAS float* TM = (LAS float*)(C.lds + GL_SM + 1024);
      const int fr = lane & 15, quad = lane >> 4;
      f32x4 acc[2][4];
#pragma unroll
      for (int r = 0; r < 4; ++r)
#pragma unroll
          for (int jq = 0; jq < 4; ++jq) { const int i = 16 * r + 4 * quad + jq; const float bi = beta[i];
              acc[0][r][jq] = VT[i * 132 + 16 * wave + fr] * bi; acc[1][r][jq] = KT[i * 132 + 16 * wave + fr] * bi * eg[i]; }
      if (wave == 0) { const int r = lane >> 4, c = lane & 15; const LAS float* Ar = AM + (16 * r) * 68 + 16 * r; float t[16];
#pragma unroll
          for (int i2 = 0; i2 < 16; ++i2) { float sacc = (i2 == c) ? 1.f : 0.f;
#pragma unroll
              for (int j2 = 0; j2 < i2; ++j2) sacc -= Ar[i2 * 68 + j2] * t[j2];
              t[i2] = sacc; TM[(r * 16 + i2) * 16 + c] = sacc; } }
      __syncthreads();
      f32x4 X[2][4];
#pragma unroll
      for (int r = 0; r < 4; ++r) {
#pragma unroll
          for (int q = 0; q < r; ++q) { const f32x4 a = *(const LAS f32x4*)(AM + (16 * r + fr) * 68 + 16 * q + 4 * quad);
#pragma unroll
              for (int jq = 0; jq < 4; ++jq) { acc[0][r] = __builtin_amdgcn_mfma_f32_16x16x4f32(-a[jq], X[0][q][jq], acc[0][r], 0, 0, 0); acc[1][r] = __builtin_amdgcn_mfma_f32_16x16x4f32(-a[jq], X[1][q][jq], acc[1][r], 0, 0, 0); } }
          const f32x4 tt = *(const LAS f32x4*)(TM + (r * 16 + fr) * 16 + 4 * quad);
          X[0][r] = (f32x4){0.f, 0.f, 0.f, 0.f}; X[1][r] = X[0][r];
#pragma unroll
          for (int jq = 0; jq < 4; ++jq) { X[0][r] = __builtin_amdgcn_mfma_f32_16x16x4f32(tt[jq], acc[0][r][jq], X[0][r], 0, 0, 0); X[1][r] = __builtin_amdgcn_mfma_f32_16x16x4f32(tt[jq], acc[1][r][jq], X[1][r], 0, 0, 0); }
          *(f32x4*)((float*)(UB + 57344) + ((((wave * 4 + r) * 4 + quad) * 16 + fr) * 4)) = X[0][r];
#pragma unroll
          for (int jq = 0; jq < 4; ++jq) VT[(16 * r + 4 * quad + jq) * 132 + 16 * wave + fr] = X[1][r][jq]; } }
    __syncthreads();
    PSPAN_END(C, 113); PSPAN_BEGIN(C, 114);
    for (int pc = tid; pc < 3584; pc += NTHR) { const int ln = pc & 63, row = ln & 15, quad = ln >> 4; float v[8];
        if (pc < 2048) { const int tile = (pc >> 6) & 15, mt = tile >> 2, s = tile & 3, i = 16 * mt + row, cb = 32 * s + 4 * quad; const LAS float* src = (pc < 1024 ? VT : QT) + i * 132 + cb; const float sc = (pc < 1024) ? 1.f : eg[i];
            const f32x4 a = *(const LAS f32x4*)src, c = *(const LAS f32x4*)(src + 16);
            v[0] = a.x * sc; v[1] = a.y * sc; v[2] = a.z * sc; v[3] = a.w * sc; v[4] = c.x * sc; v[5] = c.y * sc; v[6] = c.z * sc; v[7] = c.w * sc; }
        else if (pc < 3072) { const int tile = (pc - 2048) >> 6, dt = tile >> 1, s2 = tile & 1, d = 16 * dt + row;
#pragma unroll
            for (int j = 0; j < 8; ++j) { const int jj = 32 * s2 + 4 * quad + (j & 3) + 16 * (j >> 2); v[j] = KT[jj * 132 + d] * ek[jj]; } }
        else { const int tile = (pc - 3072) >> 6, mt = tile >> 1, s2 = tile & 1, i = 16 * mt + row; const LAS float* src = QKM + i * 68 + 32 * s2 + 4 * quad;
            const f32x4 a = *(const LAS f32x4*)src, c = *(const LAS f32x4*)(src + 16);
            v[0] = a.x; v[1] = a.y; v[2] = a.z; v[3] = a.w; v[4] = c.x; v[5] = c.y; v[6] = c.z; v[7] = c.w; }
        v4u o; o.x = pk2(v[0], v[1]); o.y = pk2(v[2], v[3]); o.z = pk2(v[4], v[5]); o.w = pk2(v[6], v[7]); *(GAS v4u*)(UB + (size_t)pc * 16) = o; }
    __syncthreads();
    PSPAN_END(C, 114);
}

#define GDN_BAR() asm volatile("s_waitcnt lgkmcnt(0)\n\ts_barrier" ::: "memory")
template <int PAR>
__device__ __forceinline__ void gdn_step_c(const Ctx& C, int n, const GAS unsigned char* UB, float* OG, int slice, f32x4 (&S)[8], f32x4 (&uu)[4], float& ue) {
    const int lane = C.lane, col = lane & 15, quad = lane >> 4;
    const LAS unsigned char* cur = C.lds + PAR * 57344;
    f32x4 u4[4];
#pragma unroll
    for (int mt = 0; mt < 4; ++mt) u4[mt] = uu[mt];
    const float egl = ue;
    if (n + 2 < 64) { const GAS unsigned char* un = UB + (size_t)(n + 2) * GDN_UNIT_BYTES + 57344;
#pragma unroll
        for (int mt = 0; mt < 4; ++mt) uu[mt] = *(const GAS f32x4*)(un + (size_t)((((slice * 4 + mt) * 4 + quad) * 16 + col) * 16));
        ue = *(const GAS float*)(un + 32768); }
    bf16x8 sb[4];
#pragma unroll
    for (int s = 0; s < 4; ++s) sb[s] = pack8(S[2 * s], S[2 * s + 1]);
    f32x4 vn[4];
#pragma unroll
    for (int mt = 0; mt < 4; ++mt) { f32x4 ws = (f32x4){0.f, 0.f, 0.f, 0.f};
#pragma unroll
        for (int s = 0; s < 4; ++s) { const bf16x8 a = *(const LAS bf16x8*)(cur + ((mt * 4 + s) * 64 + lane) * 16); ws = __builtin_amdgcn_mfma_f32_16x16x32_bf16(a, sb[s], ws, 0, 0, 0); }
        vn[mt] = u4[mt] - ws; }
    bf16x8 vb[2]; vb[0] = pack8(vn[0], vn[1]); vb[1] = pack8(vn[2], vn[3]);
#pragma unroll
    for (int d = 0; d < 8; ++d) { f32x4 sd = S[d] * egl;
#pragma unroll
        for (int s2 = 0; s2 < 2; ++s2) { const bf16x8 a = *(const LAS bf16x8*)(cur + 32768 + ((d * 2 + s2) * 64 + lane) * 16); sd = __builtin_amdgcn_mfma_f32_16x16x32_bf16(a, vb[s2], sd, 0, 0, 0); }
        S[d] = sd; }
#pragma unroll
    for (int mt = 0; mt < 4; ++mt) { f32x4 o = (f32x4){0.f, 0.f, 0.f, 0.f};
#pragma unroll
        for (int s = 0; s < 4; ++s) { const bf16x8 a = *(const LAS bf16x8*)(cur + 16384 + ((mt * 4 + s) * 64 + lane) * 16); o = __builtin_amdgcn_mfma_f32_16x16x32_bf16(a, sb[s], o, 0, 0, 0); }
#pragma unroll
        for (int s2 = 0; s2 < 2; ++s2) { const bf16x8 a = *(const LAS bf16x8*)(cur + 49152 + ((mt * 2 + s2) * 64 + lane) * 16); o = __builtin_amdgcn_mfma_f32_16x16x32_bf16(a, vb[s2], o, 0, 0, 0); }
#pragma unroll
        for (int j = 0; j < 4; ++j) OG[(size_t)(n * 64 + 16 * mt + 4 * quad + j) * 768] = o[j]; }
}
template <int PAR>
__device__ __forceinline__ void gdn_step_l(const Ctx& C, int n, const GAS unsigned char* UB, int lt, u32x4_t (&rr)[14]) {
    if (n + 1 < 64) {
#pragma unroll
        for (int k = 0; k < 14; ++k) *(LAS u32x4_t*)(C.lds + (1 - PAR) * 57344 + (size_t)(lt + 256 * k) * 16) = rr[k]; }
    if (n + 3 < 64) { const GAS unsigned char* un = UB + (size_t)(n + 3) * GDN_UNIT_BYTES;
#pragma unroll
        for (int k = 0; k < 14; ++k) rr[k] = *(const GAS u32x4_t*)(un + (size_t)(lt + 256 * k) * 16); }
}
__device__ __forceinline__ void gdn_seq(const Ctx& C, int gi) {
    const int bh = gi >> 1, b = bh / 6, h = bh % 6, lane = C.lane, col = lane & 15, quad = lane >> 4;
    const GAS unsigned char* UB = C.ws + WS_GU + (size_t)(bh * 64) * GDN_UNIT_BYTES;
    if (C.wave < 4) {
        const int slice = (gi & 1) * 4 + C.wave;
        float* OG = (float*)(C.ws + WS_OGDN) + (size_t)(b * SQ) * 768 + h * 128 + slice * 16 + col;
        f32x4 S[8], uu0[4], uu1[4]; float ue0, ue1;
#pragma unroll
        for (int d = 0; d < 8; ++d) S[d] = (f32x4){0.f, 0.f, 0.f, 0.f};
#pragma unroll
        for (int mt = 0; mt < 4; ++mt) { uu0[mt] = *(const GAS f32x4*)(UB + 57344 + (size_t)((((slice * 4 + mt) * 4 + quad) * 16 + col) * 16)); uu1[mt] = *(const GAS f32x4*)(UB + GDN_UNIT_BYTES + 57344 + (size_t)((((slice * 4 + mt) * 4 + quad) * 16 + col) * 16)); }
        ue0 = *(const GAS float*)(UB + 57344 + 32768); ue1 = *(const GAS float*)(UB + GDN_UNIT_BYTES + 57344 + 32768);
        GDN_BAR();
#pragma unroll 1
        for (int n = 0; n < 64; n += 2) {
            gdn_step_c<0>(C, n, UB, OG, slice, S, uu0, ue0); GDN_BAR();
            gdn_step_c<1>(C, n + 1, UB, OG, slice, S, uu1, ue1); GDN_BAR();
        }
    } else {
        const int lt = C.tid - 256; u32x4_t ra[14], rb[14];
#pragma unroll
        for (int k = 0; k < 14; ++k) { const u32x4_t v = *(const GAS u32x4_t*)(UB + (size_t)(lt + 256 * k) * 16); *(LAS u32x4_t*)(C.lds + (size_t)(lt + 256 * k) * 16) = v; }
#pragma unroll
        for (int k = 0; k < 14; ++k) { ra[k] = *(const GAS u32x4_t*)(UB + GDN_UNIT_BYTES + (size_t)(lt + 256 * k) * 16); rb[k] = *(const GAS u32x4_t*)(UB + 2 * (size_t)GDN_UNIT_BYTES + (size_t)(lt + 256 * k) * 16); }
        GDN_BAR();
#pragma unroll 1
        for (int n = 0; n < 64; n += 2) {
            gdn_step_l<0>(C, n, UB, lt, ra); GDN_BAR();
            gdn_step_l<1>(C, n + 1, UB, lt, rb); GDN_BAR();
        }
    }
}

__device__ __forceinline__ void attn_queue(const Ctx& C, int l) {
    const attn_body::bf16* PROJ = (const attn_body::bf16*)(C.ws + WS_PROJ); attn_body::bf16* ATTO = (attn_body::bf16*)(C.ws + WS_ATTO);
    if (C.tid == 0) C.MISC[18] = 0u;
    for (;;) {
        if (C.tid == 0) { unsigned d = C.MISC[18], q = 0xffffffffu; const unsigned x0 = xb_xcc_id() & 7u;
            for (; d < 8u; ++d) { const unsigned x = (x0 + d) & 7u; const unsigned t = __hip_atomic_fetch_add(C.ctl + CW_QUEUE + 64 * (l * 8 + (int)x), 1u, RLX_AGENT); if (t < 192u) { q = (x << 8) | t; break; } }
            C.MISC[18] = d; C.MISC[16] = q; }
        __syncthreads();
        const unsigned q = (unsigned)__builtin_amdgcn_readfirstlane((int)C.MISC[16]);
        __syncthreads();
        if (q == 0xffffffffu) break;
        const int x = (int)(q >> 8), t = (int)(q & 255u), g = t >> 6, r = t & 63, qb = 15 - (r >> 2), bh = x * 3 + g, b = bh / 6, vh = (bh % 6) * 4 + (r & 3);
        const attn_body::bf16* base = PROJ + (size_t)(b * SQ) * PW;
        attn_body::attn_unit<8>(qb, base + C_DQ + (vh >> 1) * 64, base + C_DK + (vh >> 1) * 64, base + C_DV + (vh >> 2) * 128 + (vh & 1) * 64, ATTO + (size_t)(b * SQ) * 1536 + vh * 64, (char*)C.lds, C.wave);
    }
}

__device__ __forceinline__ volatile LAS unsigned* misc_at(int i) { unsigned a = (unsigned)(MISC_OFF + 4 * i); asm volatile("" : "+v"(a)); return (volatile LAS unsigned*)(size_t)a; }
__device__ __forceinline__ void attn_queue128(const Ctx& C, int l) {
    const attn_body::bf16* PROJ = (const attn_body::bf16*)(C.ws + WS_PROJ); attn_body::bf16* ATTO = (attn_body::bf16*)(C.ws + WS_ATTO);
    if (C.tid == 0) *misc_at(18) = 0u;
    for (;;) {
        if (C.tid == 0) { unsigned d = *misc_at(18), q = 0xffffffffu; const unsigned x0 = xb_xcc_id() & 7u;
            for (; d < 8u; ++d) { const unsigned x = (x0 + d) & 7u; const unsigned t = __hip_atomic_fetch_add(C.ctl + CW_QUEUE + 64 * (l * 8 + (int)x), 1u, RLX_AGENT); if (t < 96u) { q = (x << 8) | t; break; } }
            *misc_at(18) = d; *misc_at(16) = q; }
        __syncthreads();
        const unsigned q = (unsigned)__builtin_amdgcn_readfirstlane((int)*misc_at(16));
        __syncthreads();
        if (q == 0xffffffffu) break;
        const int x = (int)(q >> 8), t = (int)(q & 255u), g = t >> 5, r = t & 31, qb = 15 - (r >> 1), bh = x * 3 + g, b = bh / 6, hm = (bh % 6) * 2 + (r & 1);
        const attn_body::bf16* base = PROJ + (size_t)(b * SQ) * PW;
        attn_body::attn_unit128<8>(qb, base + C_DQ + hm * 64, base + C_DK + hm * 64, base + C_DV + (hm >> 1) * 128, ATTO + (size_t)(b * SQ) * 1536 + hm * 128, (char*)C.lds, C.wave);
    }
}

__device__ __forceinline__ void scan_publish(const Ctx& C, int l) {
    asm volatile("s_waitcnt vmcnt(0)" ::: "memory"); __syncthreads();
    if (C.tid == 0) { __builtin_amdgcn_fence(__ATOMIC_RELEASE, "agent"); asm volatile("s_waitcnt vmcnt(0)" ::: "memory"); (void)__hip_atomic_fetch_add(C.ctl + CW_SCAN + 64 * l, 1u, RLX_AGENT); }
}
__device__ __forceinline__ void scan_wait(const Ctx& C, int l) {
    if (C.tid == 0) { unsigned sp = 0; while (__hip_atomic_load(C.ctl + CW_SCAN + 64 * l, RLX_AGENT) < 16u && ++sp < (1u << 22)) __builtin_amdgcn_s_sleep(2);
        __builtin_amdgcn_fence(__ATOMIC_ACQUIRE, "agent"); asm volatile("s_waitcnt vmcnt(0)" ::: "memory"); }
    __syncthreads();
}

__device__ __forceinline__ void post_mix(const Ctx& C, KP P, int l) {
    const int lane = C.lane; const bf16* ATTO = (const bf16*)(C.ws + WS_ATTO); const float* OG = (const float*)(C.ws + WS_OGDN); const bf16* PROJ = (const bf16*)(C.ws + WS_PROJ); bf16* YCAT = (bf16*)(C.ws + WS_YCAT);
    const float linit = 0.8f - 0.6f * expf(-0.3f * (float)l);
    const float lam = expf(wave_sum(PIN(19)[l * 64 + lane] * PIN(20)[l * 64 + lane])) - expf(wave_sum(PIN(21)[l * 64 + lane] * PIN(22)[l * 64 + lane])) + linit;
    const float sl0 = PIN(23)[l * 128 + 2 * lane] * (1.f - linit), sl1 = PIN(23)[l * 128 + 2 * lane + 1] * (1.f - linit);
    const float gn0 = PIN(27)[l * 128 + 2 * lane], gn1 = PIN(27)[l * 128 + 2 * lane + 1];
    const int tb = (C.blk < 128) ? 48 * C.blk : 6144 + 80 * (C.blk - 128), tn = (C.blk < 128) ? 48 : 80;
    for (int t0 = tb + 2 * C.wave; t0 < tb + tn; t0 += 2 * NWAVES) {
        unsigned o1[2][6], o2[2][6], zz[2][6]; f32x2_t og[2][6];
#pragma unroll
        for (int u = 0; u < 2; ++u)
#pragma unroll
            for (int h = 0; h < 6; ++h) { const int t = t0 + u; o1[u][h] = *(const unsigned*)(ATTO + (size_t)t * 1536 + (2 * h) * 128 + 2 * lane); o2[u][h] = *(const unsigned*)(ATTO + (size_t)t * 1536 + (2 * h + 1) * 128 + 2 * lane);
                og[u][h] = *(const f32x2_t*)(OG + (size_t)t * 768 + h * 128 + 2 * lane); zz[u][h] = *(const unsigned*)(PROJ + (size_t)t * PW + C_GZ + h * 128 + 2 * lane); }
#pragma unroll
        for (int u = 0; u < 2; ++u)
#pragma unroll
            for (int h = 0; h < 6; ++h) { const int t = t0 + u;
                { const float a = bflo(o1[u][h]) - lam * bflo(o2[u][h]), c = bfhi(o1[u][h]) - lam * bfhi(o2[u][h]); const float r = rsqrtf(wave_sum(a * a + c * c) * (1.f / 128.f) + EPS);
                  *(unsigned*)(YCAT + (size_t)t * DM + 512 + h * 128 + 2 * lane) = pk2(a * r * sl0, c * r * sl1); }
                { const f32x2_t o = og[u][h]; const float r = rsqrtf(wave_sum(o.x * o.x + o.y * o.y) * (1.f / 128.f) + EPS);
                  *(unsigned*)(YCAT + (size_t)t * DM + 1280 + h * 128 + 2 * lane) = pk2(o.x * r * gn0 * silu_f(bflo(zz[u][h])), o.y * r * gn1 * silu_f(bfhi(zz[u][h]))); } } }
}

__device__ __forceinline__ void norm_router_phase(const Ctx& C, KP P, const float* __restrict__ nw, const float* __restrict__ mod_shift, const float* __restrict__ mod_scale) {
    LAS float* WRT = (LAS float*)C.lds;
    LAS int* esel = (LAS int*)(C.lds + 65536); LAS int* rankl = esel + 128;
    const float* wr = PIN(31);
    for (int idx = C.tid; idx < DM * 8; idx += NTHR) { const int k = idx >> 3, e = idx & 7; WRT[e * DM + k] = wr[idx]; }
    __syncthreads();
    const float* src = (const float*)(C.ws + WS_HRES); unsigned char* HN8 = (unsigned char*)(C.ws + WS_HN); const int lane = C.lane;
    f32x4 nwv[8];
#pragma unroll
    for (int j = 0; j < 8; ++j) nwv[j] = *(const f32x4*)(nw + 4 * lane + 256 * j);
    f32x4 vn[8];
#pragma unroll
    for (int j = 0; j < 8; ++j) vn[j] = *(const f32x4*)(src + (size_t)(C.blk * 64 + C.wave * 8) * DM + 4 * lane + 256 * j);
    int nlim = 8; asm volatile("" : "+s"(nlim));
#pragma unroll 1
    for (int i = 0; i < nlim; ++i) { const int tl = C.wave * 8 + i, t = C.blk * 64 + tl, b = t >> 12;
        f32x4 v[8]; float ss = 0.f;
#pragma unroll
        for (int j = 0; j < 8; ++j) { v[j] = vn[j]; ss += (v[j].x * v[j].x + v[j].y * v[j].y) + (v[j].z * v[j].z + v[j].w * v[j].w); }
        if (i + 1 < nlim) {
#pragma unroll
            for (int j = 0; j < 8; ++j) vn[j] = *(const f32x4*)(src + (size_t)(t + 1) * DM + 4 * lane + 256 * j); }
        const float r = rsqrtf(wave_sum(ss) * (1.f / DM) + EPS);
        const float* sh = mod_shift + (size_t)b * 6 * DM; const float* scp = mod_scale + (size_t)b * 6 * DM;
#pragma unroll
        for (int j = 0; j < 8; ++j) { const f32x4 s1 = *(const f32x4*)(scp + 4 * lane + 256 * j), s0 = *(const f32x4*)(sh + 4 * lane + 256 * j);
            v[j] = v[j] * r * nwv[j] * (s1 + 1.f) + s0;
            *(GAS unsigned*)(HN8 + (size_t)t * DM + 4 * lane + 256 * j) = pk4_fp8(v[j].x * S8_HN, v[j].y * S8_HN, v[j].z * S8_HN, v[j].w * S8_HN); }
        float lg[8];
        unsigned wb = 16u * (unsigned)lane; asm volatile("" : "+v"(wb)); const LAS float* WRL = (const LAS float*)(size_t)wb;
#pragma unroll
        for (int e = 0; e < 8; ++e) { float a = 0.f;
#pragma unroll
            for (int j = 0; j < 8; ++j) { const f32x4 wv = *(const LAS f32x4*)(WRL + e * DM + 256 * j); a += (v[j].x * wv.x + v[j].y * wv.y) + (v[j].z * wv.z + v[j].w * wv.w); }
            lg[e] = wave_sum(a); }
        int e0 = 0; float v0 = lg[0];
#pragma unroll
        for (int e = 1; e < 8; ++e) if (lg[e] > v0) { v0 = lg[e]; e0 = e; }
        int e1 = -1; float v1 = -INFINITY;
#pragma unroll
        for (int e = 0; e < 8; ++e) if (e != e0 && lg[e] > v1) { v1 = lg[e]; e1 = e; }
        const float g0 = 1.f / (1.f + __expf(v1 - v0)), g1 = 1.f - g0;
        if (lane == 0) { esel[2 * tl] = e0; esel[2 * tl + 1] = e1; ((int*)(C.ws + WS_TOKE))[2 * t] = e0; ((int*)(C.ws + WS_TOKE))[2 * t + 1] = e1; ((float*)(C.ws + WS_TOKG))[2 * t] = g0; ((float*)(C.ws + WS_TOKG))[2 * t + 1] = g1; }
    }
    __syncthreads();
    if (C.tid < 8) { int cnt = 0; for (int i = 0; i < 128; ++i) if (esel[i] == C.tid) rankl[i] = cnt++; ((int*)(C.ws + WS_CNT))[C.blk * 8 + C.tid] = cnt; }
    __syncthreads();
    if (C.tid < 128) ((int*)(C.ws + WS_RANK))[(size_t)C.blk * 128 + C.tid] = rankl[C.tid];
    __syncthreads();
}

__device__ __forceinline__ void route_phase(const Ctx& C) {
    LAS int* tot = (LAS int*)C.lds; LAS int* pre = tot + 8; LAS int* base = tot + 16;
    const int* CNT = (const int*)(C.ws + WS_CNT);
    LAS int* part = tot + 32;
    if (C.tid < 256) { const int bb = C.tid; const int4 ca = *(const int4*)(CNT + bb * 8), cb = *(const int4*)(CNT + bb * 8 + 4); const int cv[8] = {ca.x, ca.y, ca.z, ca.w, cb.x, cb.y, cb.z, cb.w};
#pragma unroll
        for (int e = 0; e < 8; ++e) { int s = cv[e], m = (bb < C.blk) ? cv[e] : 0;
#pragma unroll
            for (int o = 1; o < 64; o <<= 1) { s += __shfl_xor(s, o); m += __shfl_xor(m, o); }
            if (C.lane == 0) { part[C.wave * 16 + e] = s; part[C.wave * 16 + 8 + e] = m; } } }
    __syncthreads();
    if (C.tid < 8) { tot[C.tid] = part[C.tid] + part[16 + C.tid] + part[32 + C.tid] + part[48 + C.tid]; pre[C.tid] = part[8 + C.tid] + part[24 + C.tid] + part[40 + C.tid] + part[56 + C.tid]; }
    __syncthreads();
    if (C.tid == 0) { int run = 0; int* TILE = (int*)(C.ws + WS_TILE);
        for (int e = 0; e < 8; ++e) { base[e] = run; const int nt = (tot[e] + 255) >> 8; if (C.blk == 0) for (int q = 0; q < nt; ++q) TILE[1 + (run >> 8) + q] = e; run += nt << 8; }
        if (C.blk == 0) TILE[0] = run >> 8; }
    __syncthreads();
    const int* TOKE = (const int*)(C.ws + WS_TOKE); const float* TOKG = (const float*)(C.ws + WS_TOKG); const int* RANK = (const int*)(C.ws + WS_RANK);
    int* POS = (int*)(C.ws + WS_POS); float* GW = (float*)(C.ws + WS_GW); const unsigned char* HN8 = (const unsigned char*)(C.ws + WS_HN); unsigned char* AS8 = (unsigned char*)(C.ws + WS_AS);
    for (int i = 0; i < 8; ++i) { const int t = C.blk * 64 + C.wave * 8 + i;
        const int e0 = TOKE[2 * t], e1 = TOKE[2 * t + 1]; const int p0 = base[e0] + pre[e0] + RANK[2 * t], p1 = base[e1] + pre[e1] + RANK[2 * t + 1];
        if (C.lane == 0) { POS[2 * t] = p0; POS[2 * t + 1] = p1; GW[p0] = TOKG[2 * t]; GW[p1] = TOKG[2 * t + 1]; }
#pragma unroll
        for (int j = 0; j < 2; ++j) { const u32x4_t v = *(const u32x4_t*)(HN8 + (size_t)t * DM + 16 * C.lane + 1024 * j); *(u32x4_t*)(AS8 + (size_t)p0 * DM + 16 * C.lane + 1024 * j) = v; *(u32x4_t*)(AS8 + (size_t)p1 * DM + 16 * C.lane + 1024 * j) = v; } }
    __syncthreads();
}

__device__ __forceinline__ void ctr_wait(const Ctx& C, gu32* w, unsigned n) {
    if (C.tid == 0) { unsigned sp = 0; while (__hip_atomic_load(w, RLX_AGENT) < n && ++sp < (1u << 22)) __builtin_amdgcn_s_sleep(2);
        __builtin_amdgcn_fence(__ATOMIC_ACQUIRE, "agent"); asm volatile("s_waitcnt vmcnt(0)" ::: "memory"); }
    __syncthreads();
}
constexpr int FIN_W1 = 4;
template <int LATE>
__device__ __forceinline__ void final_pass(const Ctx& C, KP P, int late_row, int first, int step) {
    const float* HR = (const float*)(C.ws + WS_HRES); const bf16* YS = (const bf16*)(C.ws + WS_AS); const int* POS = (const int*)(C.ws + WS_POS);
    const float* gate2 = (const float*)(C.ws + WS_MOD) + (size_t)(1 * 4) * 6 * DM + 5 * DM; const float* nf = PIN(7); const int lane = C.lane;
    for (int it = first; it < TOK / 2; it += step) {
        const int t0 = 2 * (int)it; const int b = t0 >> 12; const int4 pp = *(const int4*)(POS + 2 * t0);
        const int pmin = __builtin_amdgcn_readfirstlane(min(min(pp.x, pp.y), min(pp.z, pp.w)));
        if ((pmin < late_row) == (LATE == 1)) {
        f32x4 v[2][8]; float ss0 = 0.f, ss1 = 0.f;
#pragma unroll
        for (int j = 0; j < 8; ++j) { const int c = 4 * lane + 256 * j; const f32x4 g = *(const f32x4*)(gate2 + (size_t)b * 6 * DM + c);
            const f32x4 ha = *(const f32x4*)(HR + (size_t)t0 * DM + c), hb = *(const f32x4*)(HR + (size_t)(t0 + 1) * DM + c);
            const u32x2_t a0 = *(const u32x2_t*)(YS + (size_t)pp.x * DM + c), a1 = *(const u32x2_t*)(YS + (size_t)pp.y * DM + c), b0 = *(const u32x2_t*)(YS + (size_t)pp.z * DM + c), b1 = *(const u32x2_t*)(YS + (size_t)pp.w * DM + c);
            const f32x4 ya = (f32x4){bflo(a0.x) + bflo(a1.x), bfhi(a0.x) + bfhi(a1.x), bflo(a0.y) + bflo(a1.y), bfhi(a0.y) + bfhi(a1.y)};
            const f32x4 yb = (f32x4){bflo(b0.x) + bflo(b1.x), bfhi(b0.x) + bfhi(b1.x), bflo(b0.y) + bflo(b1.y), bfhi(b0.y) + bfhi(b1.y)};
            v[0][j] = ha + g * ya; v[1][j] = hb + g * yb;
            ss0 += (v[0][j].x * v[0][j].x + v[0][j].y * v[0][j].y) + (v[0][j].z * v[0][j].z + v[0][j].w * v[0][j].w); ss1 += (v[1][j].x * v[1][j].x + v[1][j].y * v[1][j].y) + (v[1][j].z * v[1][j].z + v[1][j].w * v[1][j].w); }
        const float r0 = rsqrtf(wave_sum(ss0) * (1.f / DM) + EPS), r1 = rsqrtf(wave_sum(ss1) * (1.f / DM) + EPS);
#pragma unroll
        for (int j = 0; j < 8; ++j) { const int c = 4 * lane + 256 * j; const f32x4 w = *(const f32x4*)(nf + c); *(f32x4*)(POUT + (size_t)t0 * DM + c) = v[0][j] * r0 * w; *(f32x4*)(POUT + (size_t)(t0 + 1) * DM + c) = v[1][j] * r1 * w; } }
    }
}
__device__ __forceinline__ void final_phase(const Ctx& C, KP P) {
    const int late_row = (__builtin_amdgcn_readfirstlane(((const int*)(C.ws + WS_TILE))[0]) & 31) * 256;
    const int nb = late_row >> 4;
    if (C.blk >= nb) { ctr_wait(C, C.ctl + CW_FIN, (unsigned)C.G);
        if (C.wave < FIN_W1) final_pass<0>(C, P, late_row, (C.blk - nb) * FIN_W1 + C.wave, (C.G - nb) * FIN_W1); }
    else { ctr_wait(C, C.ctl + CW_FIN + 64, (unsigned)C.G); final_pass<1>(C, P, late_row, C.blk * NWAVES + C.wave, nb * NWAVES); }
}

#ifndef MK_N_LAUNCHES
#define MK_N_LAUNCHES 1
#endif
constexpr int N_PHASES = 24;

#if defined(PROBE_LO)
#define PROBE_BEGIN(k) do { if ((k) == PROBE_LO && blockIdx.x == 0 && C0.wave == 0 && mk_lane() == 0) { const unsigned long long t_ = __builtin_amdgcn_s_memrealtime(); C0.MISC[20] = (unsigned)t_; C0.MISC[21] = (unsigned)(t_ >> 32); } } while (0)
#define PROBE_END(k) do { if ((k) == PROBE_HI && blockIdx.x == 0 && C0.wave == 0 && mk_lane() == 0) { const unsigned long long t_ = __builtin_amdgcn_s_memrealtime() - (((unsigned long long)C0.MISC[21] << 32) | C0.MISC[20]); C0.MISC[22] = (unsigned)t_; } } while (0)
#else
#define PROBE_BEGIN(k) do {} while (0)
#define PROBE_END(k) do {} while (0)
#endif
template <int L>
__device__ __forceinline__ void layer_phases(const Ctx& C0, KP P0, int lo, int hi) {
#define IN(k) (lo <= (k) && (k) < hi)
#define SEAM_FILL(k) do { if (IN(k) && IN((k) + 1)) { PHASE_ENV moe_cvt_fill(C, P, (k)); } } while (0)
#define SEAM(k) do { if (IN(k) && IN((k) + 1)) { GAS unsigned char* w_ = C0.ws; asm volatile("" : "+s"(w_)); XcdBarrier b_; b_.bar = (unsigned*)(w_ + WS_CTL) + CW_BAR + (MK_N_LAUNCHES == 1 ? 0 : lo) * XCD_BAR_WORDS; b_.x = xb_xcc_id(); b_.st = C0.MISC + 8; b_.lead = (C0.wave == 0 && mk_lane() == 0); xcd_barrier(b_); } PROBE_END(k); } while (0)
    constexpr int PB = 1 + 11 * L;
#define PHASE_ENV Ctx C = C0; KP P = P0; asm volatile("" : "+s"(C.ws), "+s"(P)); GAS unsigned char* ws = C.ws; C.ctl = (gu32*)(ws + WS_CTL); \
    C.lane = mk_lane(); asm volatile("" : "+v"(C.lane)); C.tid = C.wave * 64 + C.lane; \
    const float* MOD = (const float*)(ws + WS_MOD) + (size_t)(L * 4) * 6 * DM; float* HRES = (float*)(ws + WS_HRES); bf16* HN = (bf16*)(ws + WS_HN); bf16* PROJ = (bf16*)(ws + WS_PROJ); bf16* YCAT = (bf16*)(ws + WS_YCAT); \
    (void)MOD; (void)HRES; (void)HN; (void)PROJ; (void)YCAT; (void)P;
    PROBE_BEGIN(PB + 0); if (IN(PB + 0)) { PHASE_ENV norm_phase<true>(C, L == 0 ? PIN(0) : HRES, PIN(5) + L * DM, MOD + 0 * DM, MOD + 1 * DM, PIN(8) + (size_t)L * DM * INW); }
    SEAM(PB + 0);
    PROBE_BEGIN(PB + 1); if (IN(PB + 1)) { PHASE_ENV pg8::Gemm g{HN, (const bf16*)(ws + WS_WIN) + (size_t)L * PW * DM, TOK, PW, DM}; pg8::StaticOrder S; S.init(TOK, PW, C.G, C.blk); pg8::EpiProj E{PROJ};
        pg8::gemm_phase<pg8::EpiProj, pg8::StaticOrder, true, true>(C.lds, g, S, E, C.wave); }
    SEAM_FILL(PB + 1); SEAM(PB + 1);
    PROBE_BEGIN(PB + 2); if (IN(PB + 2)) { PHASE_ENV rope_pass(C); ssm_gemm_a(C, L);
#pragma unroll 1
        for (int u = C.blk; u < 1536; u += C.G) gdn_prep_unit(C, P, L, u); }
    SEAM(PB + 2);
    PROBE_BEGIN(PB + 3); if (IN(PB + 3)) { PHASE_ENV if (C.blk < 48) { PSPAN_BEGIN(C, 100); gdn_seq(C, C.blk); PSPAN_END(C, 100); __syncthreads(); } else if (C.blk >= C.G - 16) { ssm_scan(C, L, C.blk - (C.G - 16)); scan_publish(C, L); } attn_queue128(C, L); }
    if (IN(PB + 3)) { PHASE_ENV scan_wait(C, L); ssm_gemm_b(C, L); }
    SEAM_FILL(PB + 3); SEAM(PB + 3);
    PROBE_BEGIN(PB + 4); if (IN(PB + 4)) { PHASE_ENV
        { pg8::Gemm g{(const bf16*)(ws + WS_YGELU), (const bf16*)(ws + WS_WGLU) + (size_t)L * 512 * 512, TOK, 512, 512}; pg8::StaticOrder S; S.init(TOK, 512, C.G, C.blk); pg8::EpiGlu E{(const bf16*)(ws + WS_YGELU), YCAT};
          pg8::gemm_phase<pg8::EpiGlu, pg8::StaticOrder, true, true>(C.lds, g, S, E, C.wave); }
        post_mix(C, P, L); }
    SEAM(PB + 4);
    PROBE_BEGIN(PB + 6); if (IN(PB + 6)) { PHASE_ENV pg8::Gemm g{YCAT, (const bf16*)(ws + WS_WOUT) + (size_t)L * DM * DM, TOK, DM, DM}; pg8::StaticOrder S; S.init(TOK, DM, C.G, C.blk); pg8::EpiRes E{L == 0 ? PIN(0) : HRES, HRES, MOD + 2 * DM, 1.f};
        pg8::gemm_phase<pg8::EpiRes, pg8::StaticOrder, true, true>(C.lds, g, S, E, C.wave); }
    SEAM(PB + 6);
    if (L == 0) {
        PROBE_BEGIN(PB + 7); if (IN(PB + 7)) { PHASE_ENV norm_phase<false, (DENSE_FP8 >= 1)>(C, HRES, PIN(6) + L * DM, MOD + 3 * DM, MOD + 4 * DM, nullptr); }
        SEAM(PB + 7);
        SEAM(PB + 8);
        PROBE_BEGIN(PB + 9); if (IN(PB + 9)) { PHASE_ENV pg8::StaticOrder S; S.init(TOK, 2 * DFF, C.G, C.blk);
            if (DENSE_FP8 == 2) { pg8::Gemm g{HN, (const bf16*)(ws + WS_WUP), TOK, 2 * DFF, DM / 2}; pg8::EpiSwiglu8 E{(unsigned char*)(ws + WS_H), DFF, 2 * DFF / 256, 1.f / (S8_HN * S8_W13)}; pg8::gemm_phase<pg8::EpiSwiglu8, pg8::StaticOrder, true, true, true>(C.lds, g, S, E, C.wave); }
            else if (DENSE_FP8 == 1) { pg8::Gemm g{HN, (const bf16*)(ws + WS_WUP), TOK, 2 * DFF, DM / 2}; pg8::EpiSwiglu E{(bf16*)(ws + WS_H), DFF, 2 * DFF / 256, 1.f / (S8_HN * S8_W13)}; pg8::gemm_phase<pg8::EpiSwiglu, pg8::StaticOrder, true, true, true>(C.lds, g, S, E, C.wave); }
            else { pg8::Gemm g{HN, (const bf16*)(ws + WS_WUP), TOK, 2 * DFF, DM}; pg8::EpiSwiglu E{(bf16*)(ws + WS_H), DFF, 2 * DFF / 256, 1.f}; pg8::gemm_phase<pg8::EpiSwiglu, pg8::StaticOrder, true, true>(C.lds, g, S, E, C.wave); } }
        SEAM(PB + 9);
        PROBE_BEGIN(PB + 10); if (IN(PB + 10)) { PHASE_ENV pg8::StaticOrder S; S.init(TOK, DM, C.G, C.blk);
            if (DENSE_FP8 == 2) { pg8::Gemm g{(const bf16*)(ws + WS_H), (const bf16*)(ws + WS_WDN), TOK, DM, DFF / 2}; pg8::EpiRes E{HRES, HRES, MOD + 5 * DM, 1.f / (S8_H * S8_W2)}; pg8::gemm_phase<pg8::EpiRes, pg8::StaticOrder, true, true, true>(C.lds, g, S, E, C.wave); }
            else { pg8::Gemm g{(const bf16*)(ws + WS_H), (const bf16*)(ws + WS_WDN), TOK, DM, DFF}; pg8::EpiRes E{HRES, HRES, MOD + 5 * DM, 1.f}; pg8::gemm_phase<pg8::EpiRes, pg8::StaticOrder, true, true>(C.lds, g, S, E, C.wave); } }
        SEAM(PB + 10);
    } else {
        PROBE_BEGIN(PB + 7); if (IN(PB + 7)) { PHASE_ENV norm_router_phase(C, P, PIN(6) + L * DM, MOD + 3 * DM, MOD + 4 * DM); }
        SEAM(PB + 7);
        PROBE_BEGIN(PB + 8); if (IN(PB + 8)) { PHASE_ENV moe_cvt_drain(C, P); route_phase(C); }
        SEAM(PB + 8);
        PROBE_BEGIN(PB + 9); if (IN(PB + 9)) { PHASE_ENV LAS int* TL = (LAS int*)(C.lds + TILE_OFF); for (int i = C.tid; i <= MOE_TILES_MAX; i += NTHR) TL[i] = ((const int*)(ws + WS_TILE))[i]; __syncthreads(); const int R = __builtin_amdgcn_readfirstlane(TL[0]);
            pg8::Gemm g{(const bf16*)(ws + WS_AS), (const bf16*)(ws + WS_MUP), R * 256, 2 * DFE, DM / 2}; pg8::MoeOrder S; S.so.init(R * 256, 2 * DFE, C.G, C.blk); S.tile_e = TL + 1; S.nct = 2 * DFE / 256;
            pg8::EpiSwiglu8 E{(unsigned char*)(ws + WS_H), DFE, 2 * DFE / 256, 1.f / (S8_HN * S8_W13)};
            pg8::gemm_phase<pg8::EpiSwiglu8, pg8::MoeOrder, true, true, true>(C.lds, g, S, E, C.wave); }
        SEAM(PB + 9);
        PROBE_BEGIN(PB + 10); if (IN(PB + 10)) { PHASE_ENV LAS int* TL = (LAS int*)(C.lds + TILE_OFF); for (int i = C.tid; i <= MOE_TILES_MAX; i += NTHR) TL[i] = ((const int*)(ws + WS_TILE))[i]; __syncthreads(); const int R = __builtin_amdgcn_readfirstlane(TL[0]);
            pg8::Gemm g{(const bf16*)(ws + WS_H), (const bf16*)(ws + WS_MDN), R * 256, DM, DFE / 2}; pg8::MoeDownOrder S; S.nM = R; S.nl = R & 31; S.R = R >> 5; S.c = C.blk; S.so.init((R - S.nl) * 256, DM, C.G, C.blk); S.tile_e = TL + 1; S.nct = DM / 256; S.ntf = DFE / 128;
            S.arr = (gu32*)(ws + WS_CTL) + CW_FIN; S.wc = (LAS unsigned*)(C.lds + MISC_OFF) + 28;
            pg8::EpiMoeDown E{(bf16*)(ws + WS_AS), (const float*)(ws + WS_GW), 1.f / (S8_H * S8_W2), (f32x4*)(ws + WS_XC), (gu32*)(ws + WS_CTL) + CW_FIN + 256, (LAS unsigned*)(C.lds + MISC_OFF) + 29};
            pg8::gemm_phase<pg8::EpiMoeDown, pg8::MoeDownOrder, true, true, true>(C.lds, g, S, E, C.wave);
            asm volatile("s_waitcnt vmcnt(0)" ::: "memory"); __syncthreads();
            if (C.wave == 0 && mk_lane() == 0) { __builtin_amdgcn_fence(__ATOMIC_RELEASE, "agent"); asm volatile("s_waitcnt vmcnt(0)" ::: "memory"); (void)__hip_atomic_fetch_add((gu32*)(ws + WS_CTL) + CW_FIN + 64, 1u, RLX_AGENT); } }
        PROBE_END(PB + 10);
    }
#undef IN
#undef SEAM
#undef PHASE_ENV
}

__global__ void __launch_bounds__(NTHR, 2) mk_fwd(Params P) {
    extern __shared__ __attribute__((aligned(16))) unsigned char lds[];
    KP KPp = (KP)__builtin_amdgcn_kernarg_segment_ptr();
    Ctx C; C.lds = (LAS unsigned char*)lds; C.MISC = (volatile LAS unsigned*)(C.lds + MISC_OFF); C.ws = (GAS unsigned char*)KPp->ws; C.ctl = (gu32*)(C.ws + WS_CTL);
    C.tid = threadIdx.x; C.lane = C.tid & 63; C.wave = __builtin_amdgcn_readfirstlane(C.tid >> 6); C.blk = blockIdx.x; C.G = 256;
    for (int u = C.tid; u < (LDS_BYTES - TILE_OFF) / 4; u += NTHR) ((LAS unsigned*)(C.lds + TILE_OFF))[u] = 0u;
    __syncthreads();
    const int lo = KPp->ph_lo, hi = KPp->ph_hi;
    (void)xcd_barrier_post((unsigned*)(C.ctl + CW_BAR) + (MK_N_LAUNCHES == 1 ? 0 : lo) * XCD_BAR_WORDS, C.MISC + 8);
    { const Ctx& C0 = C; PROBE_BEGIN(0); }
    if (lo <= 0 && 0 < hi) { Ctx Cp = C; KP Pp = KPp; asm volatile("" : "+s"(Cp.ws), "+s"(Pp)); Cp.lane = mk_lane(); asm volatile("" : "+v"(Cp.lane)); Cp.tid = Cp.wave * 64 + Cp.lane; p0_prologue(Cp, Pp); if (1 < hi) { XcdBarrier b_; b_.bar = (unsigned*)(Cp.ws + WS_CTL) + CW_BAR + (MK_N_LAUNCHES == 1 ? 0 : lo) * XCD_BAR_WORDS; b_.x = xb_xcc_id(); b_.st = C.MISC + 8; b_.lead = (C.wave == 0 && mk_lane() == 0); xcd_barrier(b_); } }
    { const Ctx& C0 = C; PROBE_END(0); }
    layer_phases<0>(C, KPp, lo, hi);
    layer_phases<1>(C, KPp, lo, hi);
    { const Ctx& C0 = C; PROBE_BEGIN(23); }
    if (lo <= 23 && 23 < hi) { Ctx Cp = C; KP Pp = KPp; asm volatile("" : "+s"(Cp.ws), "+s"(Pp)); Cp.lane = mk_lane(); asm volatile("" : "+v"(Cp.lane)); Cp.tid = Cp.wave * 64 + Cp.lane; final_phase(Cp, Pp); }
    { const Ctx& C0 = C; PROBE_END(23); }
#if defined(PROBE_LO)
    if (blockIdx.x == 0 && C.wave == 0 && mk_lane() == 0) { const unsigned long long t0_ = __builtin_amdgcn_s_memrealtime(), w_ = (unsigned long long)C.MISC[22] * PROBE_MULT; while (__builtin_amdgcn_s_memrealtime() - t0_ < w_) __builtin_amdgcn_s_sleep(8); }
#endif
}

extern "C" void kernel_launch(void* const* d_in, const int* in_sizes, int n_in, void* d_out, int out_size, void* d_ws, size_t ws_size, hipStream_t stream) {
    static int grid = 0;
    if (grid == 0) {
        if (n_in != 35 || in_sizes[0] != TOK * DM || out_size != TOK * DM || ws_size < WS_END) { fprintf(stderr, "kernel_launch: unexpected problem: n_in %d in0 %d out %d ws %zu (need %zu)\n", n_in, n_in > 0 ? in_sizes[0] : -1, out_size, ws_size, (size_t)WS_END); grid = -1; return; }
        int dev = 0, cus = 0, per_cu = 0;
        if (hipGetDevice(&dev) != hipSuccess || hipDeviceGetAttribute(&cus, hipDeviceAttributeMultiprocessorCount, dev) != hipSuccess) { grid = -1; return; }
        if (hipFuncSetAttribute((const void*)mk_fwd, hipFuncAttributeMaxDynamicSharedMemorySize, LDS_BYTES) != hipSuccess) { fprintf(stderr, "kernel_launch: hipFuncSetAttribute failed\n"); grid = -1; return; }
        if (hipOccupancyMaxActiveBlocksPerMultiprocessor(&per_cu, (const void*)mk_fwd, NTHR, LDS_BYTES) != hipSuccess || per_cu < 1) fprintf(stderr, "kernel_launch: occupancy query says %d\n", per_cu);
        (void)hipGetLastError();
        grid = 256;
        if (cus < 256) { fprintf(stderr, "kernel_launch: device has %d CUs, this kernel needs 256\n", cus); grid = -1; return; }
    }
    if (grid < 0) return;
    if (hipMemsetAsync((char*)d_ws + WS_CTL, 0, CTL_ZERO_BYTES, stream) != hipSuccess) return;
    Params p{};
    for (int i = 0; i < 35; ++i) p.in[i] = (const float*)d_in[i];
    p.out = (float*)d_out; p.ws = (unsigned char*)d_ws;
#if MK_N_LAUNCHES == 1
    p.ph_lo = 0; p.ph_hi = N_PHASES;
    hipLaunchKernelGGL(mk_fwd, dim3(grid), dim3(NTHR), LDS_BYTES, stream, p);
#else
    for (int k = 0; k < N_PHASES; ++k) { p.ph_lo = k; p.ph_hi = k + 1; hipLaunchKernelGGL(mk_fwd, dim3(grid), dim3(NTHR), LDS_BYTES, stream, p); }
#endif
}
```

```cpp
#include <hip/hip_runtime.h>
#include <hip/hip_bf16.h>
#include <cstdio>
#include <cstdint>
#include <cmath>
__device__ __forceinline__ int mk_lane() { int l = (int)__builtin_amdgcn_mbcnt_hi(~0u, __builtin_amdgcn_mbcnt_lo(~0u, 0u)); asm volatile("" : "+v"(l)); return l; }
namespace pg8 {
#define PG8_LAS __attribute__((address_space(3)))
typedef unsigned short bf16_t;
typedef short bf16x8 __attribute__((ext_vector_type(8)));
typedef float f32x4 __attribute__((ext_vector_type(4)));
typedef unsigned u32x4 __attribute__((ext_vector_type(4)));
constexpr int BM = 256, BK = 64, HALF = 128, HTB = HALF * BK * 2  , STAGE_BYTES = 8 * HTB, NXCD = 8, WGM = 8;

__host__ __device__ __forceinline__ int lds_byte(int r, int c) { const int st = (r >> 4) * 2 + (c >> 5), rr = r & 15, cc = c & 31, ob = rr * 64 + cc * 2; return st * 1024 + (ob ^ (((ob >> 9) & 1) << 5)); }
__host__ __device__ __forceinline__ void stage_rc(int b, int& R, int& C) { const int st = b / 1024, sb = b % 1024, swz = sb ^ (((sb >> 9) & 1) << 5); R = (st >> 1) * 16 + swz / 64; C = (st & 1) * 32 + (swz % 64) / 2; }
__host__ __device__ __forceinline__ int perm32(int rho) { const int n = rho >> 4, i = rho & 15; return 8 * (i >> 2) + 4 * n + (i & 3); }

struct Unit { int pm, pn, aux = 0, kt0 = 0, nt = 0, ks = 0, slot = 0; };
struct Gemm { const bf16_t* A; const bf16_t* Bt; int M, N, K; };

struct StaticOrder {
    static constexpr bool SPLITK = false;
    int nM, nN, nwg, G, c;
    __host__ __device__ void init(int M, int N, int G_, int c_) { nM = M / BM; nN = N / BM; nwg = nM * nN; G = G_; c = c_; }
    __host__ __device__ bool next(int i, Unit& u) const {
        const long L = (long)i * G + c; if (L >= nwg) return false;
        int wgid = (int)L; { const int q = nwg / NXCD, r = nwg % NXCD, xcd = wgid % NXCD, off = wgid / NXCD; wgid = (xcd < r ? xcd * (q + 1) : r * (q + 1) + (xcd - r) * q) + off; }
        const int nig = WGM * nN, gid = wgid / nig, fm = gid * WGM, gsz = (nM - fm) < WGM ? (nM - fm) : WGM;
        u.pm = fm + ((wgid % nig) % gsz); u.pn = (wgid % nig) / gsz; return true;
    }
    __device__ __forceinline__ void a_ready(const Unit&) const {}
    __device__ __forceinline__ void done(const Unit&) const {}
};

__device__ __forceinline__ unsigned cvt_pk_bf16(float lo, float hi) { unsigned r; asm volatile("v_cvt_pk_bf16_f32 %0, %1, %2" : "=v"(r) : "v"(lo), "v"(hi)); return r; }
typedef float f32x2 __attribute__((ext_vector_type(2)));
__device__ __forceinline__ f32x2 gelu_pk(f32x2 v) {
    const f32x2 av = __builtin_elementwise_abs(v), d = av * 0.2316418882f + 1.0f;
    f32x2 t; t.x = __builtin_amdgcn_rcpf(d.x); t.y = __builtin_amdgcn_rcpf(d.y);
    f32x2 q = t * 0.5307027145f + (-0.7265760135f); q = q * t + 0.7107068705f; q = q * t + (-0.142248368f); q = q * t + 0.127414796f; q = q * t;
    const f32x2 s = (v * v) * (-0.72134752044f);
    f32x2 e; e.x = __builtin_amdgcn_exp2f(s.x); e.y = __builtin_amdgcn_exp2f(s.y);
    const f32x2 m = v * (q * e), r = v - m;
    f32x2 o; o.x = v.x < 0.f ? m.x : r.x; o.y = v.y < 0.f ? m.y : r.y; return o;
}

template <int ACT  > struct EpiBf16 {
    static constexpr bool PERM = true, AFTER_DRAIN = false; static_assert(ACT == 0 || ACT == 1, "EpiBf16: ACT is 0 (none) or 1 (gelu_pk)");
    bf16_t* O; int ldc; const float* bias; int split_cols; size_t split_stride; float scale0;
    __device__ __forceinline__ void operator()(const f32x4 (&acc)[2][2][4][2], const Unit& u, int wr, int wc, int fr, int fq) const {
        const int row0 = u.pm * BM + wr * 64 + fr; int colt = u.pn * BM; bf16_t* base = O;
        float sc = 1.f; if (split_cols) { const int t = colt / split_cols; base += (size_t)t * split_stride; colt -= t * split_cols; if (t == 0) sc = scale0; }
        const int col0 = colt + wc * 32 + 8 * fq, bcol0 = u.pn * BM + wc * 32 + 8 * fq;
        f32x4 bv[2][2];
#pragma unroll
        for (int bj = 0; bj < 2; ++bj)
#pragma unroll
            for (int n = 0; n < 2; ++n) bv[bj][n] = bias ? *(const f32x4*)(bias + bcol0 + bj * HALF + 4 * n) : (f32x4){0.f, 0.f, 0.f, 0.f};
#pragma unroll
        for (int ai = 0; ai < 2; ++ai)
#pragma unroll
            for (int m = 0; m < 4; ++m) { bf16_t* rowp = base + (size_t)(row0 + ai * HALF + m * 16) * ldc + col0;
#pragma unroll
                for (int bj = 0; bj < 2; ++bj) { f32x4 v0 = acc[ai][bj][m][0] + bv[bj][0], v1 = acc[ai][bj][m][1] + bv[bj][1];
                    if (ACT == 1) { f32x2 a = gelu_pk((f32x2){v0[0], v0[1]}), b = gelu_pk((f32x2){v0[2], v0[3]}), c = gelu_pk((f32x2){v1[0], v1[1]}), d = gelu_pk((f32x2){v1[2], v1[3]});
                        v0 = (f32x4){a.x, a.y, b.x, b.y}; v1 = (f32x4){c.x, c.y, d.x, d.y}; }
                    v0 = v0 * sc; v1 = v1 * sc; u32x4 w; w.x = cvt_pk_bf16(v0[0], v0[1]); w.y = cvt_pk_bf16(v0[2], v0[3]); w.z = cvt_pk_bf16(v1[0], v1[1]); w.w = cvt_pk_bf16(v1[2], v1[3]);
                    *(u32x4*)(rowp + bj * HALF) = w; } }
    }
};

typedef int v8i_t __attribute__((ext_vector_type(8))); typedef int v4i_t __attribute__((ext_vector_type(4)));
__device__ __forceinline__ v8i_t cat8(const bf16x8& a, const bf16x8& b) { return __builtin_shufflevector(__builtin_bit_cast(v4i_t, a), __builtin_bit_cast(v4i_t, b), 0, 1, 2, 3, 4, 5, 6, 7); }
template <class Epi, class Sched, bool ALIGN_EPI = false, bool SP2 = false, bool FP8 = false>
__device__ __forceinline__ void gemm_phase(PG8_LAS unsigned char* lds, const Gemm g, const Sched& S, const Epi& E, const int wv  ) {
    const int lane = mk_lane(), wid = wv, tid = wv * 64 + lane, wr = wid >> 2, wc = wid & 3, fr = lane & 15, fq = lane >> 4;
    const int K = g.K, nt = K / BK;
    unsigned voffA[2], voffB[2];
#pragma unroll
    for (int i = 0; i < 2; ++i) { int R, C; stage_rc(tid * 16 + i * 8192, R, C); const int Rb = Epi::PERM ? ((R & ~31) + perm32(R & 31)) : R;
        voffA[i] = (unsigned)(R * K + C) * 2u; voffB[i] = (unsigned)(Rb * K + C) * 2u; }
    const size_t kstep = (size_t)(BK * 2);
    const size_t hstep = (size_t)HALF * K * 2;
    const size_t tstep = 2 * hstep;
    const unsigned ldsw = (unsigned)wid * 1024u;
    const int aoff = lds_byte(wr * 64 + fr, fq * 8), boff = lds_byte(wc * 32 + fr, fq * 8);
#define PG8_SA(b, h) (((b) * 2 + (h)) * HTB)
#define PG8_SB(b, h) ((4 + (b) * 2 + (h)) * HTB)
#define PG8_STAGE(bufoff, gbase, voff) do { _Pragma("unroll") for (int _i = 0; _i < 2; ++_i) \
        __builtin_amdgcn_global_load_lds((const unsigned*)((const char*)(gbase) + (voff)[_i]), (PG8_LAS unsigned*)(lds + (bufoff) + ldsw + _i * 8192), 16, 0, 0); } while (0)
#define PG8_LDA(dst, b, h) do { _Pragma("unroll") for (int m = 0; m < 4; ++m) _Pragma("unroll") for (int k = 0; k < 2; ++k) dst[m][k] = *(const PG8_LAS bf16x8*)(lds + PG8_SA(b, h) + aoff + m * 2048 + k * 1024); } while (0)
#define PG8_LDB(dst, b, h) do { _Pragma("unroll") for (int n = 0; n < 2; ++n) _Pragma("unroll") for (int k = 0; k < 2; ++k) dst[n][k] = *(const PG8_LAS bf16x8*)(lds + PG8_SB(b, h) + boff + n * 2048 + k * 1024); } while (0)
#define PG8_MMA(ai, bj, At, Bt) do { __builtin_amdgcn_s_setprio(1); \
        if constexpr (FP8) { asm volatile("s_nop 1" ::: ); _Pragma("unroll") for (int m = 0; m < 4; ++m) _Pragma("unroll") for (int n = 0; n < 2; ++n) \
            asm volatile("v_mfma_scale_f32_16x16x128_f8f6f4 %0, %1, %2, %0, %3, %3 op_sel_hi:[0,0,0]" : "+v"(acc[ai][bj][m][n]) : "v"(cat8(Bt[n][0], Bt[n][1])), "v"(cat8(At[m][0], At[m][1])), "v"(sc_one)); } \
        else { _Pragma("unroll") for (int m = 0; m < 4; ++m) _Pragma("unroll") for (int n = 0; n < 2; ++n) _Pragma("unroll") for (int k = 0; k < 2; ++k) \
            acc[ai][bj][m][n] = __builtin_amdgcn_mfma_f32_16x16x32_bf16(Bt[n][k], At[m][k], acc[ai][bj][m][n], 0, 0, 0); } \
        __builtin_amdgcn_s_setprio(0); } while (0)
#define PG8_WAIT_V(n) asm volatile("s_waitcnt vmcnt(" #n ")" ::: "memory")
#define PG8_WAIT_L(n) asm volatile("s_waitcnt lgkmcnt(" #n ")" ::: "memory")
#define PG8_BAR __builtin_amdgcn_s_barrier()
#define PG8_SCHED __builtin_amdgcn_sched_barrier(0)
    Unit cur, nxt; int ui = 0;
    if (!S.next(0, cur)) return;
    unsigned sc_one = 0x7f7f7f7fu; asm volatile("" : "+v"(sc_one));
    (void)sc_one;
    f32x4 acc[2][2][4][2];
#pragma unroll
    for (int a = 0; a < 2; ++a)
#pragma unroll
        for (int b = 0; b < 2; ++b)
#pragma unroll
            for (int m = 0; m < 4; ++m)
#pragma unroll
                for (int n = 0; n < 2; ++n) acc[a][b][m][n] = (f32x4){0.f, 0.f, 0.f, 0.f};
    bf16x8 At[4][2], B0[2][2], B1[2][2];
    const char* cA = (const char*)g.A + (size_t)cur.pm * tstep; const char* cB = (const char*)g.Bt + (size_t)cur.pn * tstep;
    if constexpr (Sched::SPLITK) { cA += (size_t)cur.kt0 * kstep; cB += (size_t)cur.kt0 * kstep; }
    S.a_ready(cur);
    if constexpr (SP2) {
        PG8_STAGE(PG8_SB(0, 0), cB, voffB); PG8_STAGE(PG8_SB(0, 1), cB + hstep, voffB); PG8_STAGE(PG8_SA(0, 0), cA, voffA); PG8_STAGE(PG8_SA(0, 1), cA + hstep, voffA);
        if (wr == 1) PG8_BAR;
        PG8_WAIT_V(2); PG8_BAR;
        PG8_STAGE(PG8_SB(1, 0), cB + kstep, voffB); PG8_STAGE(PG8_SA(1, 0), cA + kstep, voffA); PG8_STAGE(PG8_SB(1, 1), cB + hstep + kstep, voffB);
        PG8_WAIT_V(6); PG8_BAR;
    } else {
        PG8_STAGE(PG8_SB(0, 0), cB, voffB); PG8_STAGE(PG8_SA(0, 0), cA, voffA); PG8_STAGE(PG8_SB(0, 1), cB + hstep, voffB); PG8_STAGE(PG8_SA(0, 1), cA + hstep, voffA);
        if (wr == 1) PG8_BAR;
        PG8_WAIT_V(4); PG8_BAR;
        PG8_STAGE(PG8_SB(1, 0), cB + kstep, voffB); PG8_STAGE(PG8_SA(1, 0), cA + kstep, voffA); PG8_STAGE(PG8_SB(1, 1), cB + hstep + kstep, voffB);
        PG8_WAIT_V(6); PG8_BAR;
    }
    for (;;) {
        const bool has_next = S.next(ui + 1, nxt);
        const char* nA = has_next ? (const char*)g.A + (size_t)nxt.pm * tstep : cA; const char* nB = has_next ? (const char*)g.Bt + (size_t)nxt.pn * tstep : cB;
        if constexpr (Sched::SPLITK) { if (has_next) { nA += (size_t)nxt.kt0 * kstep; nB += (size_t)nxt.kt0 * kstep; } }
        const int cnt = Sched::SPLITK ? cur.nt : nt;
        for (int t = 0; t < cnt; t += 2) {
            const bool last = (t == cnt - 2);
            const char* a1 = cA + (size_t)(t + 1) * kstep;
            const char* a2 = last ? nA : cA + (size_t)(t + 2) * kstep; const char* b2 = last ? nB : cB + (size_t)(t + 2) * kstep;
            const char* a3 = a2 + kstep; const char* b3 = b2 + kstep;
            if (last && has_next) S.a_ready(nxt);
            if constexpr (SP2) {
            PG8_LDB(B0, 0, 0); PG8_LDB(B1, 0, 1); PG8_SCHED; PG8_LDA(At, 0, 0); PG8_STAGE(PG8_SA(1, 1), a1 + hstep, voffA);
            PG8_WAIT_V(8); PG8_WAIT_L(0); PG8_BAR; PG8_MMA(0, 0, At, B0); PG8_MMA(0, 1, At, B1); PG8_BAR; PG8_SCHED;
            PG8_LDA(At, 0, 1); PG8_STAGE(PG8_SB(0, 0), b2, voffB); PG8_STAGE(PG8_SB(0, 1), b2 + hstep, voffB); PG8_STAGE(PG8_SA(0, 0), a2, voffA);
            PG8_WAIT_V(8); PG8_WAIT_L(0); PG8_BAR; PG8_MMA(1, 0, At, B0); PG8_MMA(1, 1, At, B1); PG8_BAR; PG8_SCHED;
            PG8_LDB(B0, 1, 0); PG8_LDB(B1, 1, 1); PG8_SCHED; PG8_LDA(At, 1, 0); PG8_STAGE(PG8_SA(0, 1), a2 + hstep, voffA);
            PG8_WAIT_V(8); PG8_WAIT_L(0); PG8_BAR; PG8_MMA(0, 0, At, B0); PG8_MMA(0, 1, At, B1); PG8_BAR; PG8_SCHED;
            PG8_LDA(At, 1, 1); PG8_STAGE(PG8_SB(1, 0), b3, voffB); PG8_STAGE(PG8_SB(1, 1), b3 + hstep, voffB); PG8_STAGE(PG8_SA(1, 0), a3, voffA);
            PG8_WAIT_V(8); PG8_WAIT_L(0); PG8_BAR; PG8_MMA(1, 0, At, B0); PG8_MMA(1, 1, At, B1); PG8_BAR; PG8_SCHED;
            } else {
            PG8_LDB(B0, 0, 0); PG8_SCHED; PG8_LDA(At, 0, 0); PG8_STAGE(PG8_SA(1, 1), a1 + hstep, voffA);
            PG8_WAIT_L(8); PG8_BAR; PG8_WAIT_L(0); PG8_MMA(0, 0, At, B0); PG8_BAR; PG8_SCHED;
            PG8_LDB(B1, 0, 1); PG8_STAGE(PG8_SB(0, 0), b2, voffB);
            PG8_BAR; PG8_WAIT_L(0); PG8_MMA(0, 1, At, B1); PG8_BAR;
            PG8_LDA(At, 0, 1); PG8_STAGE(PG8_SA(0, 0), a2, voffA);
            PG8_BAR; PG8_WAIT_L(0); PG8_MMA(1, 0, At, B0); PG8_BAR; PG8_SCHED;
            PG8_STAGE(PG8_SB(0, 1), b2 + hstep, voffB);
            PG8_WAIT_V(6); PG8_BAR; PG8_MMA(1, 1, At, B1); PG8_BAR;
            PG8_LDB(B0, 1, 0); PG8_SCHED; PG8_LDA(At, 1, 0); PG8_STAGE(PG8_SA(0, 1), a2 + hstep, voffA);
            PG8_WAIT_L(8); PG8_BAR; PG8_WAIT_L(0); PG8_MMA(0, 0, At, B0); PG8_BAR; PG8_SCHED;
            PG8_LDB(B1, 1, 1); PG8_STAGE(PG8_SB(1, 0), b3, voffB);
            PG8_BAR; PG8_WAIT_L(0); PG8_MMA(0, 1, At, B1); PG8_BAR;
            PG8_LDA(At, 1, 1); PG8_STAGE(PG8_SA(1, 0), a3, voffA);
            PG8_BAR; PG8_WAIT_L(0); PG8_MMA(1, 0, At, B0); PG8_BAR; PG8_SCHED;
            PG8_STAGE(PG8_SB(1, 1), b3 + hstep, voffB);
            PG8_WAIT_V(6); PG8_BAR; PG8_MMA(1, 1, At, B1); PG8_BAR;
            }
        }
        if constexpr (FP8) asm volatile("s_nop 15\n\ts_nop 15" ::: );
        if constexpr (ALIGN_EPI) { if (wr == 0) PG8_BAR; }
        if constexpr (!Epi::AFTER_DRAIN) { E(acc, cur, wr, wc, fr, fq); S.done(cur); }
        if (!has_next) break;
#pragma unroll
        for (int a = 0; a < 2; ++a)
#pragma unroll
            for (int b = 0; b < 2; ++b)
#pragma unroll
                for (int m = 0; m < 4; ++m)
#pragma unroll
                    for (int n = 0; n < 2; ++n) acc[a][b][m][n] = (f32x4){0.f, 0.f, 0.f, 0.f};
        cur = nxt; cA = nA; cB = nB; ++ui;
        if constexpr (ALIGN_EPI) { if (wr == 1) PG8_BAR; }
    }
    PG8_WAIT_V(0);
    if constexpr (!ALIGN_EPI) { if (wr == 0) PG8_BAR; }
    PG8_BAR;
    if constexpr (Epi::AFTER_DRAIN) { E.fused(acc, cur, wr, wc, fr, fq, lds, wid, lane); S.done(cur); }
#undef PG8_SA
#undef PG8_SB
#undef PG8_STAGE
#undef PG8_LDA
#undef PG8_LDB
#undef PG8_MMA
#undef PG8_WAIT_V
#undef PG8_WAIT_L
#undef PG8_BAR
#undef PG8_SCHED
}
}
#include <hip/hip_bf16.h>
#include <cmath>
namespace attn_body {
using bf16=__hip_bfloat16;
using bf16x8=__attribute__((ext_vector_type(8)))short;
using s16x4=__attribute__((ext_vector_type(4)))short;
using f32x16=__attribute__((ext_vector_type(16)))float;
using u32x4=__attribute__((ext_vector_type(4)))unsigned;
constexpr int SEQ=4096,D=64,PITCH=5888,OPITCH=1536;
constexpr int NW=8,QBLK=32,QB=QBLK*NW,KVBLK=64,NQB=SEQ/QB;
constexpr int ATTN_UNIT_ROWS=QB;
__device__ __forceinline__ int crow(int r,int hi){return (r&3)+8*(r>>2)+4*hi;}
#define SBAR() __builtin_amdgcn_sched_barrier(0)
__device__ __forceinline__ void cmask(f32x16&p0,f32x16&p1,int jb,int qrel,int hi){
  const float NEG=-INFINITY; int kb=64*jb+4*hi;
  #pragma unroll
  for(int r=0;r<16;++r){int kv=kb+(r&3)+8*(r>>2); if(kv>qrel)p0[r]=NEG; if(kv+32>qrel)p1[r]=NEG;}
}

constexpr int NSLOT=3, SLOTB=8192;
constexpr int LDS_K=0, LDS_V=NSLOT*SLOTB, LDS_WS=2*NSLOT*SLOTB, LDS_OST=LDS_WS+NW*64*4, LDS_BYTES=LDS_OST+NW*4096;
constexpr float C2=0.125f*1.4426950408889634f;
__device__ __forceinline__ void glds16(const void*gsrc,unsigned lds_dst){unsigned keep;
  asm volatile("s_mov_b32 %0, m0\n\ts_mov_b32 m0, %2\n\ts_nop 0\n\tglobal_load_lds_dwordx4 %1, off\n\ts_mov_b32 m0, %0":"=&s"(keep):"v"(gsrc),"s"(lds_dst):"memory");}
__device__ __forceinline__ void glds16s(const void*sbase,unsigned voff,unsigned lds_dst){unsigned keep;
  asm volatile("s_mov_b32 %0, m0\n\ts_mov_b32 m0, %3\n\ts_nop 0\n\tglobal_load_lds_dwordx4 %1, %2\n\ts_mov_b32 m0, %0":"=&s"(keep):"v"(voff),"s"(sbase),"s"(lds_dst):"memory");}
__device__ __forceinline__ float max3f(float a,float b,float c){float r;asm("v_max3_f32 %0, %1, %2, %3":"=v"(r):"v"(a),"v"(b),"v"(c));return r;}
__device__ __forceinline__ float max2f(float a,float b){float r;asm("v_max_f32_e32 %0, %1, %2":"=v"(r):"v"(a),"v"(b));return r;}
__device__ __forceinline__ float fadd_s(float a,float b){float r;asm("v_add_f32_e32 %0, %1, %2":"=v"(r):"v"(a),"v"(b));return r;}
__device__ __forceinline__ float fsub_s(float a,float b){float r;asm("v_sub_f32_e32 %0, %1, %2":"=v"(r):"v"(a),"v"(b));return r;}
typedef float f32x2_t __attribute__((ext_vector_type(2))); typedef __bf16 bf16x2_t __attribute__((ext_vector_type(2)));
__device__ __forceinline__ unsigned cvtpk_s(float lo,float hi){f32x2_t v={lo,hi};bf16x2_t b=__builtin_convertvector(v,bf16x2_t);return __builtin_bit_cast(unsigned,b);}
#define WAIT_BAR(N) asm volatile("s_waitcnt vmcnt(" #N ") lgkmcnt(0)\n\ts_barrier":::"memory")

__device__ __forceinline__ void qkt(f32x16&p0,f32x16&p1,const char*Kslot,const bf16x8*qr,const f32x16&negm,int r32,int hi){
  const char*kb=Kslot+hi*1024+r32*16;
  #pragma unroll
  for(int d0=0;d0<4;++d0){
    const bf16x8 b0=*reinterpret_cast<const bf16x8*>(kb+d0*2048);
    const bf16x8 b1=*reinterpret_cast<const bf16x8*>(kb+d0*2048+512);
    if(d0==0){p0=__builtin_amdgcn_mfma_f32_32x32x16_bf16(b0,qr[0],negm,0,0,0);p1=__builtin_amdgcn_mfma_f32_32x32x16_bf16(b1,qr[0],negm,0,0,0);}
    else{p0=__builtin_amdgcn_mfma_f32_32x32x16_bf16(b0,qr[d0],p0,0,0,0);p1=__builtin_amdgcn_mfma_f32_32x32x16_bf16(b1,qr[d0],p1,0,0,0);}}
}
typedef __attribute__((address_space(3))) const char* lds_cptr;
typedef short v4i16_t __attribute__((ext_vector_type(4)));
__device__ __forceinline__ void kload8(bf16x8*kf,lds_cptr kp){
  kf[0]=*(const __attribute__((address_space(3))) bf16x8*)(kp);      kf[1]=*(const __attribute__((address_space(3))) bf16x8*)(kp+512);
  kf[2]=*(const __attribute__((address_space(3))) bf16x8*)(kp+2048); kf[3]=*(const __attribute__((address_space(3))) bf16x8*)(kp+2560);
  kf[4]=*(const __attribute__((address_space(3))) bf16x8*)(kp+4096); kf[5]=*(const __attribute__((address_space(3))) bf16x8*)(kp+4608);
  kf[6]=*(const __attribute__((address_space(3))) bf16x8*)(kp+6144); kf[7]=*(const __attribute__((address_space(3))) bf16x8*)(kp+6656);
}
__device__ __forceinline__ void kload2(bf16x8*kf,lds_cptr kp,int j){ kf[2*j]=*(const __attribute__((address_space(3))) bf16x8*)(kp+j*2048); kf[2*j+1]=*(const __attribute__((address_space(3))) bf16x8*)(kp+j*2048+512); }
__device__ __forceinline__ s16x4 vtr(lds_cptr p){ return __builtin_bit_cast(s16x4,__builtin_amdgcn_ds_read_tr16_b64_v4i16((__attribute__((address_space(3))) v4i16_t*)p)); }
__device__ __forceinline__ float rowmax(const f32x16&p0,const f32x16&p1){
  float a=max3f(p0[0],p0[1],p1[0]),b=max3f(p0[2],p0[3],p1[1]);a=max3f(a,p1[2],p1[3]);
  #pragma unroll
  for(int r=4;r<16;r+=4){a=max3f(a,p0[r],p0[r+1]);b=max3f(b,p0[r+2],p0[r+3]);a=max3f(a,p1[r],p1[r+1]);b=max3f(b,p1[r+2],p1[r+3]);}
  const float m=max2f(a,b);
  auto rr=__builtin_amdgcn_permlane32_swap(__float_as_uint(m),__float_as_uint(m),false,false);
  return max2f(__uint_as_float(rr[0]),__uint_as_float(rr[1]));
}
__device__ __forceinline__ void pv(f32x16*o,int vb,bf16x8 pa0,bf16x8 pa1,bf16x8 pa2,bf16x8 pa3){
  #pragma unroll
  for(int d0=0;d0<2;++d0){s16x4 lo[4],hi[4];
    #pragma unroll
    for(int ks=0;ks<4;++ks){
      asm volatile("ds_read_b64_tr_b16 %0,%1 offset:%c2":"=&v"(lo[ks]):"v"(vb),"i"(d0*4096+ks*1024):"memory");
      asm volatile("ds_read_b64_tr_b16 %0,%1 offset:%c2":"=&v"(hi[ks]):"v"(vb),"i"(d0*4096+ks*1024+512):"memory");}
    asm volatile("s_waitcnt lgkmcnt(0)":::"memory");SBAR();
    #define PK(k) (bf16x8){lo[k][0],lo[k][1],lo[k][2],lo[k][3],hi[k][0],hi[k][1],hi[k][2],hi[k][3]}
    o[d0]=__builtin_amdgcn_mfma_f32_32x32x16_bf16(pa0,PK(0),o[d0],0,0,0);
    o[d0]=__builtin_amdgcn_mfma_f32_32x32x16_bf16(pa1,PK(1),o[d0],0,0,0);
    o[d0]=__builtin_amdgcn_mfma_f32_32x32x16_bf16(pa2,PK(2),o[d0],0,0,0);
    o[d0]=__builtin_amdgcn_mfma_f32_32x32x16_bf16(pa3,PK(3),o[d0],0,0,0);
    #undef PK
  }
}

#ifndef ATTN_STORE16
#define ATTN_STORE16(p,v) (*(u32x4*)(p)=(v))
#endif
template<int THRL> __device__ __forceinline__ void attn_unit(int qb,const bf16*Qh,const bf16*__restrict__ Kh,const bf16*__restrict__ Vh,bf16*Oh,char*shm,const int wv){
  const int lane=mk_lane(),r32=lane&31,hi=lane>>5; const int wid=wv;
  const int q0=qb*QB;
  const bf16*Qw=Qh+(long)(q0+wid*QBLK)*PITCH;
  const unsigned lds0=(unsigned)(uintptr_t)shm;
  float*wsf=(float*)(shm+LDS_WS)+wid*64;
  const bf16*ksrc=Kh+(long)lane*PITCH+wid*8;
  const bf16*vsrc=Vh+(long)(16*(wid&3)+(lane>>2))*PITCH+(wid>>2)*32+(lane&3)*8;
  const unsigned kdst=lds0+LDS_K+wid*1024, vdst=lds0+LDS_V+wid*1024;
  #define DMA_K(t,slot) glds16(ksrc+(long)(t)*KVBLK*PITCH,(unsigned)__builtin_amdgcn_readfirstlane(kdst+(slot)))
  #define DMA_V(t,slot) glds16(vsrc+(long)(t)*KVBLK*PITCH,(unsigned)__builtin_amdgcn_readfirstlane(vdst+(slot)))
  const int vb0=(int)(lds0+LDS_V)+((lane>>4)&1)*32+(lane&3)*8+(4*hi+((lane&15)>>2))*64;
  const char*Kbase=shm+LDS_K; bf16x8 kf[8];
  const lds_cptr shm3=(lds_cptr)shm; const lds_cptr kp0=shm3+LDS_K+hi*1024+r32*16; const lds_cptr vp0=shm3+LDS_V+((lane>>4)&1)*32+(lane&3)*8+(4*hi+((lane&15)>>2))*64;
  const int NT=(q0+QB)/KVBLK;
  DMA_K(0,0);DMA_V(0,0);DMA_K(1,SLOTB);
  bf16x8 qr[4];
  #pragma unroll
  for(int d0=0;d0<4;++d0)qr[d0]=*reinterpret_cast<const bf16x8*>(&Qw[(long)r32*PITCH+d0*16+hi*8]);
  float mhat=0.f,l_reg=0.f;f32x16 o[2];o[0]=f32x16{};o[1]=f32x16{};f32x16 negm=f32x16{};asm volatile("":"+v"(negm));
  const int qrel=wid*QBLK+r32;
  #define CMASK(P0,P1,t) do{int jb_=(t)-(NT-4); if(jb_>=0)cmask(P0,P1,jb_,qrel,hi);}while(0)
  bool resc=false;
  #define START(P0,P1) do{ const float rm=rowmax(P0,P1); resc=false; \
    { const float dl=rm; mhat=fadd_s(mhat,dl); \
      _Pragma("unroll") for(int r=0;r<16;++r){P0[r]=fsub_s(P0[r],dl);P1[r]=fsub_s(P1[r],dl);} \
      _Pragma("unroll") for(int r=0;r<16;++r)negm[r]=-mhat; asm volatile("":"+v"(negm)); } \
    _Pragma("unroll") for(int r=0;r<16;++r)P0[r]=__builtin_amdgcn_exp2f(P0[r]); }while(0)
  #define RESC() do{ if(resc){ asm volatile("s_waitcnt lgkmcnt(0)":::"memory"); \
      _Pragma("unroll") for(int d_=0;d_<2;++d_) _Pragma("unroll") for(int r=0;r<16;++r)o[d_][r]*=wsf[crow(r,hi)]; } }while(0)
  f32x16 pA0,pA1,pB0,pB1;
  int sl_prev=0,sl_cur=0,sl_next=SLOTB;
  #define ROT() do{sl_prev=sl_cur;sl_cur=sl_next;sl_next=(sl_next==(NSLOT-1)*SLOTB)?0:sl_next+SLOTB;}while(0)
  DMA_K(2,2*SLOTB);
  WAIT_BAR(3);
  qkt(pA0,pA1,Kbase,qr,negm,r32,hi);asm volatile("s_nop 15\n\ts_nop 7":"+v"(pA0),"+v"(pA1));CMASK(pA0,pA1,0);
  START(pA0,pA1);
  _Pragma("unroll") for(int r=0;r<16;++r)pA1[r]=__builtin_amdgcn_exp2f(pA1[r]);
  WAIT_BAR(0);
  DMA_K(3,0);DMA_V(1,SLOTB);
  ROT();
  kload8(kf,kp0+sl_cur);
  WAIT_BAR(2);
  s16x4 vlo[8],vhi[8]; u32x4 pw0,pw1,pw2,pw3;
  #define PKW(P,B) cvtpk_s(P[B],P[B+1])
  #define PAF(k) __builtin_bit_cast(bf16x8,pw##k)
  #define VFR(i) (bf16x8){vlo[i][0],vlo[i][1],vlo[i][2],vlo[i][3],vhi[i][0],vhi[i][1],vhi[i][2],vhi[i][3]}
  #define PIN(x) asm volatile("":"+v"(x))
  #define MX3(a,b,c) __builtin_fmaxf(__builtin_fmaxf((a),(b)),(c))
  #define GAPA(MF,A0,A1,A2,A3,W0,W1,PW) do{ MF; sacc+=A0; sacc+=A1; sacc+=A2; sacc+=A3; PIN(sacc); W0; W1; PIN(PW); SBAR(); }while(0)
  #define EX(v) __builtin_amdgcn_exp2f(v)
  #define GAPB(MF,X,B) do{ MF; X[B]=EX(X[B]); X[B+1]=EX(X[B+1]); X[B+2]=EX(X[B+2]); X[B+3]=EX(X[B+3]); PIN(X); SBAR(); }while(0)
  #define VRD(i) do{ vlo[i]=vtr(vp_+(((i)>>2)*4096+((i)&3)*1024)); vhi[i]=vtr(vp_+(((i)>>2)*4096+((i)&3)*1024+512)); }while(0)
  #define KRD(G,j) do{ if(G){ kload2(kf,kp0+sl_next,j); SBAR(); } }while(0)
  #define STEP(C0,C1,P0,P1,t,GK,GV,GL) do{ SBAR(); \
    const lds_cptr vp_=vp0+sl_prev; \
    VRD(0); SBAR(); float sacc=(P0[0]+P0[1]); \
    GAPA(C0=__builtin_amdgcn_mfma_f32_32x32x16_bf16(kf[0],qr[0],negm,0,0,0), P0[2],P0[3],P0[4],P0[5],     pw0[0]=PKW(P0,0), pw0[1]=PKW(P0,2), pw0); \
    VRD(4); SBAR(); GAPA(C1=__builtin_amdgcn_mfma_f32_32x32x16_bf16(kf[1],qr[0],negm,0,0,0), P0[6],P0[7],P0[8],P0[9],     pw0[2]=PKW(P0,4), pw0[3]=PKW(P0,6), pw0); \
    VRD(1); SBAR(); GAPA(C0=__builtin_amdgcn_mfma_f32_32x32x16_bf16(kf[2],qr[1],C0,0,0,0),   P0[10],P0[11],P0[12],P0[13], pw1[0]=PKW(P0,8), pw1[1]=PKW(P0,10), pw1); \
    VRD(5); SBAR(); GAPA(C1=__builtin_amdgcn_mfma_f32_32x32x16_bf16(kf[3],qr[1],C1,0,0,0),   P0[14],P0[15],P1[0],P1[1],   pw1[2]=PKW(P0,12),pw1[3]=PKW(P0,14), pw1); \
    VRD(2); SBAR(); GAPA(C0=__builtin_amdgcn_mfma_f32_32x32x16_bf16(kf[4],qr[2],C0,0,0,0),   P1[2],P1[3],P1[4],P1[5],     pw2[0]=PKW(P1,0), pw2[1]=PKW(P1,2), pw2); \
    VRD(6); SBAR(); GAPA(C1=__builtin_amdgcn_mfma_f32_32x32x16_bf16(kf[5],qr[2],C1,0,0,0),   P1[6],P1[7],P1[8],P1[9],     pw2[2]=PKW(P1,4), pw2[3]=PKW(P1,6), pw2); \
    VRD(3); SBAR(); GAPA(C0=__builtin_amdgcn_mfma_f32_32x32x16_bf16(kf[6],qr[3],C0,0,0,0),   P1[10],P1[11],P1[12],P1[13], pw3[0]=PKW(P1,8), pw3[1]=PKW(P1,10), pw3); \
    VRD(7); SBAR(); GAPA(C1=__builtin_amdgcn_mfma_f32_32x32x16_bf16(kf[7],qr[3],C1,0,0,0),   P1[14],P1[15],0.f,0.f,       pw3[2]=PKW(P1,12),pw3[3]=PKW(P1,14), pw3); \
    l_reg+=sacc; \
    if(GK){DMA_K((t)+3,sl_cur);} if(GV){DMA_V((t)+1,sl_next);} \
    CMASK(C0,C1,t); \
    { float a=MX3(C0[0],C0[1],C1[0]),b=MX3(C0[2],C0[3],C1[1]); a=MX3(a,C1[2],C1[3]); \
      _Pragma("unroll") for(int r=4;r<16;r+=4){a=MX3(a,C0[r],C0[r+1]);b=MX3(b,C0[r+2],C0[r+3]);a=MX3(a,C1[r],C1[r+1]);b=MX3(b,C1[r+2],C1[r+3]);} \
      float rm=__builtin_fmaxf(a,b); { auto rr=__builtin_amdgcn_permlane32_swap(__float_as_uint(rm),__float_as_uint(rm),false,false); rm=__builtin_fmaxf(__uint_as_float(rr[0]),__uint_as_float(rr[1])); } \
      resc=false; \
      if(__builtin_expect(__any(rm>(float)THRL),0)){ const float dl=__builtin_fmaxf(rm,0.f); mhat+=dl; \
        _Pragma("unroll") for(int r=0;r<16;++r){C0[r]-=dl;C1[r]-=dl;} \
        _Pragma("unroll") for(int r=0;r<16;++r)negm[r]=-mhat; asm volatile("":"+v"(negm)); \
        const float f=__builtin_amdgcn_exp2f(-dl); l_reg*=f; if(hi==0)wsf[r32]=f; resc=true; } } \
    SBAR(); \
    GAPB(o[0]=__builtin_amdgcn_mfma_f32_32x32x16_bf16(PAF(0),VFR(0),o[0],0,0,0), C0,0); \
    GAPB(o[1]=__builtin_amdgcn_mfma_f32_32x32x16_bf16(PAF(0),VFR(4),o[1],0,0,0), C0,4); \
    KRD(GL,0); GAPB(o[0]=__builtin_amdgcn_mfma_f32_32x32x16_bf16(PAF(1),VFR(1),o[0],0,0,0), C0,8); \
    KRD(GL,1); GAPB(o[1]=__builtin_amdgcn_mfma_f32_32x32x16_bf16(PAF(1),VFR(5),o[1],0,0,0), C0,12); \
    KRD(GL,2); GAPB(o[0]=__builtin_amdgcn_mfma_f32_32x32x16_bf16(PAF(2),VFR(2),o[0],0,0,0), C1,0); \
    KRD(GL,3); GAPB(o[1]=__builtin_amdgcn_mfma_f32_32x32x16_bf16(PAF(2),VFR(6),o[1],0,0,0), C1,4); \
    GAPB(o[0]=__builtin_amdgcn_mfma_f32_32x32x16_bf16(PAF(3),VFR(3),o[0],0,0,0), C1,8); \
    GAPB(o[1]=__builtin_amdgcn_mfma_f32_32x32x16_bf16(PAF(3),VFR(7),o[1],0,0,0), C1,12); \
    }while(0)
  int t=1;
  #undef CMASK
  #define CMASK(P0,P1,t) do{}while(0)
  for(;t+5<NT;t+=2){
    STEP(pB0,pB1,pA0,pA1,t,true,true,true);     WAIT_BAR(2); RESC(); ROT();
    STEP(pA0,pA1,pB0,pB1,t+1,true,true,true);   WAIT_BAR(2); RESC(); ROT();
  }
  #undef CMASK
  #define CMASK(P0,P1,t) do{int jb_=(t)-(NT-4); if(jb_>=0)cmask(P0,P1,jb_,qrel,hi);}while(0)
  #define ENDW(tt) do{ if((tt)+3<NT){WAIT_BAR(2);} else if((tt)+2<NT){WAIT_BAR(1);} else {WAIT_BAR(0);} }while(0)
  for(;t+1<NT;t+=2){
    STEP(pB0,pB1,pA0,pA1,t,(t+3<NT),(t+1<NT),(t+1<NT));       ENDW(t);   RESC(); ROT();
    STEP(pA0,pA1,pB0,pB1,t+1,(t+4<NT),(t+2<NT),(t+2<NT));     ENDW(t+1); RESC(); ROT();
  }
  STEP(pB0,pB1,pA0,pA1,NT-1,false,false,false); RESC();
  { float sacc=pB0[0]+pB0[1]; _Pragma("unroll") for(int r=2;r<16;++r)sacc+=pB0[r]; _Pragma("unroll") for(int r=0;r<16;++r)sacc+=pB1[r]; l_reg+=sacc;
    pw0=(u32x4){PKW(pB0,0),PKW(pB0,2),PKW(pB0,4),PKW(pB0,6)};pw1=(u32x4){PKW(pB0,8),PKW(pB0,10),PKW(pB0,12),PKW(pB0,14)};pw2=(u32x4){PKW(pB1,0),PKW(pB1,2),PKW(pB1,4),PKW(pB1,6)};pw3=(u32x4){PKW(pB1,8),PKW(pB1,10),PKW(pB1,12),PKW(pB1,14)};
    SBAR(); pv(o,vb0+sl_cur,PAF(0),PAF(1),PAF(2),PAF(3)); }
  #undef PKW
  #undef PAF
  #undef VFR
  #undef PIN
  #undef MX3
  #undef GAPA
  #undef GAPB
  #undef EX
  #undef VRD
  #undef KRD
  #undef STEP
  #undef ENDW
  {auto rr=__builtin_amdgcn_permlane32_swap(__float_as_uint(l_reg),__float_as_uint(l_reg),false,false);l_reg=__uint_as_float(rr[0])+__uint_as_float(rr[1]);}
  if(hi==0)wsf[32+r32]=l_reg;asm volatile("s_waitcnt lgkmcnt(0)":::"memory");
  float rli[16];
  #pragma unroll
  for(int r=0;r<16;++r)rli[r]=__builtin_amdgcn_rcpf(wsf[32+crow(r,hi)]);
  bf16*Ow=Oh+(long)(q0+wid*QBLK)*OPITCH;
  { bf16*stg=(bf16*)(shm+LDS_OST)+wid*2048;
    #pragma unroll
    for(int r=0;r<16;++r){const int orow=crow(r,hi);
      #pragma unroll
      for(int d0=0;d0<2;++d0)stg[orow*64+d0*32+r32]=__float2bfloat16(o[d0][r]*rli[r]);}
    asm volatile("s_waitcnt lgkmcnt(0)":::"memory");
    #pragma unroll
    for(int i=0;i<4;++i){const int row=i*8+(lane>>3),ch=lane&7; const u32x4 v=*(const u32x4*)(stg+row*64+ch*8); ATTN_STORE16(Ow+(long)row*OPITCH+ch*8,v);} }
  asm volatile("s_waitcnt lgkmcnt(0)\n\ts_barrier":::"memory");
  #undef DMA_K
  #undef DMA_V
  #undef CMASK
  #undef START
  #undef RESC
  #undef ROT
}
constexpr int LV_V=NSLOT*SLOTB, LV_WS=LV_V+NSLOT*2*SLOTB, LV_OST=LV_WS+NW*64*4, LV_BYTES=LV_OST+NW*8192;
__device__ __forceinline__ void pv4(f32x16*o,int vb,bf16x8 pa0,bf16x8 pa1,bf16x8 pa2,bf16x8 pa3){
  #pragma unroll
  for(int d0=0;d0<4;++d0){s16x4 lo[4],hi[4];
    #pragma unroll
    for(int ks=0;ks<4;++ks){
      asm volatile("ds_read_b64_tr_b16 %0,%1 offset:%c2":"=&v"(lo[ks]):"v"(vb),"i"(d0*4096+ks*1024):"memory");
      asm volatile("ds_read_b64_tr_b16 %0,%1 offset:%c2":"=&v"(hi[ks]):"v"(vb),"i"(d0*4096+ks*1024+512):"memory");}
    asm volatile("s_waitcnt lgkmcnt(0)":::"memory");SBAR();
    #define PK(k) (bf16x8){lo[k][0],lo[k][1],lo[k][2],lo[k][3],hi[k][0],hi[k][1],hi[k][2],hi[k][3]}
    o[d0]=__builtin_amdgcn_mfma_f32_32x32x16_bf16(pa0,PK(0),o[d0],0,0,0);
    o[d0]=__builtin_amdgcn_mfma_f32_32x32x16_bf16(pa1,PK(1),o[d0],0,0,0);
    o[d0]=__builtin_amdgcn_mfma_f32_32x32x16_bf16(pa2,PK(2),o[d0],0,0,0);
    o[d0]=__builtin_amdgcn_mfma_f32_32x32x16_bf16(pa3,PK(3),o[d0],0,0,0);
    #undef PK
  }
}
#ifndef ATTN_STORE16
#define ATTN_STORE16(p,v) (*(u32x4*)(p)=(v))
#endif
template<int THRL> __device__ __forceinline__ void attn_unit128(int qb,const bf16*Qh,const bf16*__restrict__ Kh,const bf16*__restrict__ Vh,bf16*Oh,char*shm,const int wv){
  const int lane=mk_lane(),r32=lane&31,hi=lane>>5; const int wid=wv;
  const int q0=qb*QB;
  const bf16*Qw=Qh+(long)(q0+wid*QBLK)*PITCH;
  const unsigned lds0=(unsigned)(uintptr_t)shm;
  float*wsf=(float*)(shm+LV_WS)+wid*64;
  const unsigned koff=(unsigned)((lane*PITCH+wid*8)*2), voff=(unsigned)(((16*(wid&3)+(lane>>2))*PITCH+(wid>>2)*32+(lane&3)*8)*2);
  const unsigned kdst=lds0+LDS_K+wid*1024, vdst=lds0+LV_V+wid*1024;
  #define DMA_K(t,slot) glds16s(Kh+(long)(t)*KVBLK*PITCH,koff,(unsigned)__builtin_amdgcn_readfirstlane(kdst+(slot)))
  #define DMA_V(t,slot) do{ glds16s(Vh+(long)(t)*KVBLK*PITCH,voff,(unsigned)__builtin_amdgcn_readfirstlane(vdst+2*(slot))); glds16s(Vh+64+(long)(t)*KVBLK*PITCH,voff,(unsigned)__builtin_amdgcn_readfirstlane(vdst+2*(slot)+8192)); }while(0)
  const char*Kbase=shm+LDS_K; bf16x8 kf[8];
  const lds_cptr shm3=(lds_cptr)shm; const lds_cptr kp0=shm3+LDS_K+hi*1024+r32*16; const lds_cptr vp0=shm3+LV_V+((lane>>4)&1)*32+(lane&3)*8+(4*hi+((lane&15)>>2))*64;
  const int NT=(q0+QB)/KVBLK;
  DMA_K(0,0);DMA_V(0,0);DMA_K(1,SLOTB);
  bf16x8 qr[4];
  #pragma unroll
  for(int d0=0;d0<4;++d0)qr[d0]=*reinterpret_cast<const bf16x8*>(&Qw[(long)r32*PITCH+d0*16+hi*8]);
  float mhat=0.f,l_reg=0.f;f32x16 o[4];o[0]=f32x16{};o[1]=f32x16{};o[2]=f32x16{};o[3]=f32x16{};const f32x16 zero16=f32x16{};
  const int qrel=wid*QBLK+r32;
  #define CMASK(P0,P1,t) do{int jb_=(t)-(NT-4); if(jb_>=0)cmask(P0,P1,jb_,qrel,hi);}while(0)
  bool resc=false;
  #define START(P0,P1) do{ const float rm=rowmax(P0,P1); resc=false; \
    { const float dl=rm; mhat=fadd_s(mhat,dl); \
      _Pragma("unroll") for(int r=0;r<16;++r){P0[r]=fsub_s(P0[r],dl);P1[r]=fsub_s(P1[r],dl);} \
      } \
    _Pragma("unroll") for(int r=0;r<16;++r)P0[r]=__builtin_amdgcn_exp2f(P0[r]); }while(0)
  #define RESC() do{ if(resc){ asm volatile("s_waitcnt lgkmcnt(0)":::"memory"); \
      _Pragma("unroll") for(int d_=0;d_<4;++d_) _Pragma("unroll") for(int r=0;r<16;++r)o[d_][r]*=wsf[crow(r,hi)]; } }while(0)
  f32x16 pA0,pA1,pB0,pB1;
  int sl_prev=0,sl_cur=0,sl_next=SLOTB;
  #define ROT() do{sl_prev=sl_cur;sl_cur=sl_next;sl_next=(sl_next==(NSLOT-1)*SLOTB)?0:sl_next+SLOTB;}while(0)
  DMA_K(2,2*SLOTB);
  WAIT_BAR(4);
  qkt(pA0,pA1,Kbase,qr,zero16,r32,hi);asm volatile("s_nop 15\n\ts_nop 7":"+v"(pA0),"+v"(pA1));CMASK(pA0,pA1,0);
  START(pA0,pA1);
  _Pragma("unroll") for(int r=0;r<16;++r)pA1[r]=__builtin_amdgcn_exp2f(pA1[r]);
  WAIT_BAR(0);
  DMA_K(3,0);DMA_V(1,SLOTB);
  ROT();
  kload8(kf,kp0+sl_cur);
  WAIT_BAR(3);
  s16x4 vq0lo,vq0hi,vq1lo,vq1hi,vq2lo,vq2hi; u32x4 pw0,pw1,pw2,pw3;
  #define PKW(P,B) cvtpk_s(P[B],P[B+1])
  #define PAF(k) __builtin_bit_cast(bf16x8,pw##k)
  #define VFQ(B) (bf16x8){B##lo[0],B##lo[1],B##lo[2],B##lo[3],B##hi[0],B##hi[1],B##hi[2],B##hi[3]}
  #define PIN(x) asm volatile("":"+v"(x))
  #define MX3(a,b,c) __builtin_fmaxf(__builtin_fmaxf((a),(b)),(c))
  #define GAPA(MF,A0,A1,A2,A3,W0,W1,PW) do{ MF; sacc+=A0; sacc+=A1; sacc+=A2; sacc+=A3; PIN(sacc); W0; W1; PIN(PW); SBAR(); }while(0)
  #define EX(v) __builtin_amdgcn_exp2f(v)
  #define GAPB(MF,X,B) do{ MF; X[B]=EX(X[B]); X[B+1]=EX(X[B+1]); PIN(X); SBAR(); }while(0)
  #define VRD(B,i) do{ B##lo=vtr(vp_+(((i)>>2)*4096+((i)&3)*1024)); B##hi=vtr(vp_+(((i)>>2)*4096+((i)&3)*1024+512)); SBAR(); }while(0)
  #define KRD(G,j) do{ if(G){ kload2(kf,kp0+sl_next,j); SBAR(); } }while(0)
  #define STEP(C0,C1,P0,P1,t,GK,GV,GL) do{ SBAR(); \
    const lds_cptr vp_=vp0+2*sl_prev; \
    float sacc=(P0[0]+P0[1]); \
    GAPA(C0=__builtin_amdgcn_mfma_f32_32x32x16_bf16(kf[0],qr[0],zero16,0,0,0), P0[2],P0[3],P0[4],P0[5],     pw0[0]=PKW(P0,0), pw0[1]=PKW(P0,2), pw0); \
    GAPA(C1=__builtin_amdgcn_mfma_f32_32x32x16_bf16(kf[1],qr[0],zero16,0,0,0), P0[6],P0[7],P0[8],P0[9],     pw0[2]=PKW(P0,4), pw0[3]=PKW(P0,6), pw0); \
    GAPA(C0=__builtin_amdgcn_mfma_f32_32x32x16_bf16(kf[2],qr[1],C0,0,0,0),   P0[10],P0[11],P0[12],P0[13], pw1[0]=PKW(P0,8), pw1[1]=PKW(P0,10), pw1); \
    GAPA(C1=__builtin_amdgcn_mfma_f32_32x32x16_bf16(kf[3],qr[1],C1,0,0,0),   P0[14],P0[15],P1[0],P1[1],   pw1[2]=PKW(P0,12),pw1[3]=PKW(P0,14), pw1); \
    GAPA(C0=__builtin_amdgcn_mfma_f32_32x32x16_bf16(kf[4],qr[2],C0,0,0,0),   P1[2],P1[3],P1[4],P1[5],     pw2[0]=PKW(P1,0), pw2[1]=PKW(P1,2), pw2); \
    GAPA(C1=__builtin_amdgcn_mfma_f32_32x32x16_bf16(kf[5],qr[2],C1,0,0,0),   P1[6],P1[7],P1[8],P1[9],     pw2[2]=PKW(P1,4), pw2[3]=PKW(P1,6), pw2); \
    VRD(vq0,0); GAPA(C0=__builtin_amdgcn_mfma_f32_32x32x16_bf16(kf[6],qr[3],C0,0,0,0),   P1[10],P1[11],P1[12],P1[13], pw3[0]=PKW(P1,8), pw3[1]=PKW(P1,10), pw3); \
    VRD(vq1,4); GAPA(C1=__builtin_amdgcn_mfma_f32_32x32x16_bf16(kf[7],qr[3],C1,0,0,0),   P1[14],P1[15],0.f,0.f,       pw3[2]=PKW(P1,12),pw3[3]=PKW(P1,14), pw3); \
    l_reg+=sacc; \
    _Pragma("unroll") for(int r=0;r<16;++r){C0[r]-=mhat;C1[r]-=mhat;} \
    if(GK){DMA_K((t)+3,sl_cur);} if(GV){DMA_V((t)+1,sl_next);} \
    CMASK(C0,C1,t); \
    { float a=MX3(C0[0],C0[1],C1[0]),b=MX3(C0[2],C0[3],C1[1]); a=MX3(a,C1[2],C1[3]); \
      _Pragma("unroll") for(int r=4;r<16;r+=4){a=MX3(a,C0[r],C0[r+1]);b=MX3(b,C0[r+2],C0[r+3]);a=MX3(a,C1[r],C1[r+1]);b=MX3(b,C1[r+2],C1[r+3]);} \
      float rm=__builtin_fmaxf(a,b); { auto rr=__builtin_amdgcn_permlane32_swap(__float_as_uint(rm),__float_as_uint(rm),false,false); rm=__builtin_fmaxf(__uint_as_float(rr[0]),__uint_as_float(rr[1])); } \
      resc=false; \
      if(__builtin_expect(__any(rm>(float)THRL),0)){ const float dl=__builtin_fmaxf(rm,0.f); mhat+=dl; \
        _Pragma("unroll") for(int r=0;r<16;++r){C0[r]-=dl;C1[r]-=dl;} \
        const float f=__builtin_amdgcn_exp2f(-dl); l_reg*=f; if(hi==0)wsf[r32]=f; resc=true; } } \
    SBAR(); \
    VRD(vq2,8); GAPB(o[0]=__builtin_amdgcn_mfma_f32_32x32x16_bf16(PAF(0),VFQ(vq0),o[0],0,0,0), C0,0); \
    VRD(vq0,12); GAPB(o[1]=__builtin_amdgcn_mfma_f32_32x32x16_bf16(PAF(0),VFQ(vq1),o[1],0,0,0), C0,2); \
    VRD(vq1,1); GAPB(o[2]=__builtin_amdgcn_mfma_f32_32x32x16_bf16(PAF(0),VFQ(vq2),o[2],0,0,0), C0,4); \
    VRD(vq2,5); GAPB(o[3]=__builtin_amdgcn_mfma_f32_32x32x16_bf16(PAF(0),VFQ(vq0),o[3],0,0,0), C0,6); \
    VRD(vq0,9); GAPB(o[0]=__builtin_amdgcn_mfma_f32_32x32x16_bf16(PAF(1),VFQ(vq1),o[0],0,0,0), C0,8); \
    VRD(vq1,13); GAPB(o[1]=__builtin_amdgcn_mfma_f32_32x32x16_bf16(PAF(1),VFQ(vq2),o[1],0,0,0), C0,10); \
    VRD(vq2,2); GAPB(o[2]=__builtin_amdgcn_mfma_f32_32x32x16_bf16(PAF(1),VFQ(vq0),o[2],0,0,0), C0,12); \
    VRD(vq0,6); GAPB(o[3]=__builtin_amdgcn_mfma_f32_32x32x16_bf16(PAF(1),VFQ(vq1),o[3],0,0,0), C0,14); \
    VRD(vq1,10); GAPB(o[0]=__builtin_amdgcn_mfma_f32_32x32x16_bf16(PAF(2),VFQ(vq2),o[0],0,0,0), C1,0); \
    VRD(vq2,14); GAPB(o[1]=__builtin_amdgcn_mfma_f32_32x32x16_bf16(PAF(2),VFQ(vq0),o[1],0,0,0), C1,2); \
    VRD(vq0,3); GAPB(o[2]=__builtin_amdgcn_mfma_f32_32x32x16_bf16(PAF(2),VFQ(vq1),o[2],0,0,0), C1,4); \
    VRD(vq1,7); GAPB(o[3]=__builtin_amdgcn_mfma_f32_32x32x16_bf16(PAF(2),VFQ(vq2),o[3],0,0,0), C1,6); \
    VRD(vq2,11); KRD(GL,0); GAPB(o[0]=__builtin_amdgcn_mfma_f32_32x32x16_bf16(PAF(3),VFQ(vq0),o[0],0,0,0), C1,8); \
    VRD(vq0,15); KRD(GL,1); GAPB(o[1]=__builtin_amdgcn_mfma_f32_32x32x16_bf16(PAF(3),VFQ(vq1),o[1],0,0,0), C1,10); \
    KRD(GL,2); GAPB(o[2]=__builtin_amdgcn_mfma_f32_32x32x16_bf16(PAF(3),VFQ(vq2),o[2],0,0,0), C1,12); \
    KRD(GL,3); GAPB(o[3]=__builtin_amdgcn_mfma_f32_32x32x16_bf16(PAF(3),VFQ(vq0),o[3],0,0,0), C1,14); \
    }while(0)
  int t=1;
  #undef CMASK
  #define CMASK(P0,P1,t) do{}while(0)
  for(;t+5<NT;t+=2){
    STEP(pB0,pB1,pA0,pA1,t,true,true,true);     WAIT_BAR(3); RESC(); ROT();
    STEP(pA0,pA1,pB0,pB1,t+1,true,true,true);   WAIT_BAR(3); RESC(); ROT();
  }
  #undef CMASK
  #define CMASK(P0,P1,t) do{int jb_=(t)-(NT-4); if(jb_>=0)cmask(P0,P1,jb_,qrel,hi);}while(0)
  #define ENDW(tt) do{ if((tt)+3<NT){WAIT_BAR(3);} else if((tt)+2<NT){WAIT_BAR(2);} else {WAIT_BAR(0);} }while(0)
  for(;t+1<NT;t+=2){
    STEP(pB0,pB1,pA0,pA1,t,(t+3<NT),(t+1<NT),(t+1<NT));       ENDW(t);   RESC(); ROT();
    STEP(pA0,pA1,pB0,pB1,t+1,(t+4<NT),(t+2<NT),(t+2<NT));     ENDW(t+1); RESC(); ROT();
  }
  STEP(pB0,pB1,pA0,pA1,NT-1,false,false,false); RESC();
  { float sacc=pB0[0]+pB0[1]; _Pragma("unroll") for(int r=2;r<16;++r)sacc+=pB0[r]; _Pragma("unroll") for(int r=0;r<16;++r)sacc+=pB1[r]; l_reg+=sacc;
    pw0=(u32x4){PKW(pB0,0),PKW(pB0,2),PKW(pB0,4),PKW(pB0,6)};pw1=(u32x4){PKW(pB0,8),PKW(pB0,10),PKW(pB0,12),PKW(pB0,14)};pw2=(u32x4){PKW(pB1,0),PKW(pB1,2),PKW(pB1,4),PKW(pB1,6)};pw3=(u32x4){PKW(pB1,8),PKW(pB1,10),PKW(pB1,12),PKW(pB1,14)};
    SBAR(); pv4(o,(int)(lds0+LV_V)+((lane>>4)&1)*32+(lane&3)*8+(4*hi+((lane&15)>>2))*64+2*sl_cur,PAF(0),PAF(1),PAF(2),PAF(3)); }
  #undef PKW
  #undef PAF
  #undef VFQ
  #undef PIN
  #undef MX3
  #undef GAPA
  #undef GAPB
  #undef EX
  #undef VRD
  #undef KRD
  #undef STEP
  #undef ENDW
  {auto rr=__builtin_amdgcn_permlane32_swap(__float_as_uint(l_reg),__float_as_uint(l_reg),false,false);l_reg=__uint_as_float(rr[0])+__uint_as_float(rr[1]);}
  if(hi==0)wsf[32+r32]=l_reg;asm volatile("s_waitcnt lgkmcnt(0)":::"memory");
  float rli[16];
  #pragma unroll
  for(int r=0;r<16;++r)rli[r]=__builtin_amdgcn_rcpf(wsf[32+crow(r,hi)]);
  bf16*Ow=Oh+(long)(q0+wid*QBLK)*OPITCH;
  { bf16*stg=(bf16*)(shm+LV_OST)+wid*4096;
    #pragma unroll
    for(int r=0;r<16;++r){const int orow=crow(r,hi);
      #pragma unroll
      for(int d0=0;d0<4;++d0)stg[orow*128+d0*32+r32]=__float2bfloat16(o[d0][r]*rli[r]);}
    asm volatile("s_waitcnt lgkmcnt(0)":::"memory");
    #pragma unroll
    for(int i=0;i<8;++i){const int row=i*4+(lane>>4),ch=lane&15; const u32x4 v=*(const u32x4*)(stg+row*128+ch*8); ATTN_STORE16(Ow+(long)row*OPITCH+ch*8,v);} }
  asm volatile("s_waitcnt lgkmcnt(0)\n\ts_barrier":::"memory");
  #undef DMA_K
  #undef DMA_V
  #undef CMASK
  #undef START
  #undef RESC
  #undef ROT
}
constexpr int ATTN_LDS_BYTES=LDS_BYTES;
#undef SBAR
#undef WAIT_BAR
}
#define GAS __attribute__((address_space(1)))
#define LAS __attribute__((address_space(3)))
typedef unsigned short bf16;
typedef unsigned v4u __attribute__((ext_vector_type(4)));
typedef float f32x4 __attribute__((ext_vector_type(4)));
typedef short bf16x8 __attribute__((ext_vector_type(8)));
typedef GAS unsigned gu32;
typedef GAS unsigned long long gu64;
#define RLX_AGENT __ATOMIC_RELAXED, __HIP_MEMORY_SCOPE_AGENT
#define LDS_WAIT() asm volatile("s_waitcnt lgkmcnt(0)" ::: "memory")
#define VM_WAIT() asm volatile("s_waitcnt vmcnt(0)" ::: "memory")
__device__ __forceinline__ unsigned long long rt() { return __builtin_amdgcn_s_memrealtime(); }
__device__ __forceinline__ unsigned f2bf(float f) { unsigned u = __builtin_bit_cast(unsigned, f); return (u + 0x7fffu + ((u >> 16) & 1u)) >> 16; }
__device__ __forceinline__ unsigned pk2(float lo, float hi) { return attn_body::cvtpk_s(lo, hi); }

#define XB_TMO      128
#define XB_XCNT(j)  (256  + 64 * (j))
#define XB_XSUB(j)  (1280 + 64 * (j))
#define XB_XGEN(j)  (2304 + 64 * (j))
#define XB_TOP      3328
#define XB_TOPGEN   3392
#define XCD_BAR_WORDS 3456
#define XB_SPIN_CAP (1u << 18)

__device__ __forceinline__ unsigned xb_ld(unsigned* p)              { return __hip_atomic_load(p, __ATOMIC_RELAXED, __HIP_MEMORY_SCOPE_AGENT); }
__device__ __forceinline__ unsigned xb_add(unsigned* p, unsigned v) { return __hip_atomic_fetch_add(p, v, __ATOMIC_RELAXED, __HIP_MEMORY_SCOPE_AGENT); }
__device__ __forceinline__ unsigned xb_xcc_id() { return (unsigned)__builtin_amdgcn_s_getreg((3 << 11) | 20) & 0xFu; }
#define XB_SPIN(cond, bar) do { unsigned _sp = 0; while (cond) { __builtin_amdgcn_s_sleep(1); \
    if ((++_sp & 255u) == 0u) { if (xb_ld(&(bar)[XB_TMO])) break; if (_sp > XB_SPIN_CAP) { atomicAdd(&(bar)[XB_TMO], 1u); break; } } } } while (0)

struct XcdBarrier {
    unsigned* bar; unsigned x; bool lead;
    volatile LAS unsigned* st;
};

__device__ __forceinline__ XcdBarrier xcd_barrier_post(unsigned* bar, volatile LAS unsigned* st) {
    XcdBarrier b; b.bar = bar; b.x = xb_xcc_id(); b.st = st;
    if (threadIdx.x == 0) (void)xb_add(&bar[XB_XCNT(b.x)], 1u);
    return b;
}
__device__ __forceinline__ void xcd_barrier_complete(unsigned* bar, unsigned x, unsigned& nloc, unsigned& nx) {
    const unsigned G = gridDim.x * gridDim.y * gridDim.z;
    unsigned sum, cnt, mine, sp = 0u;
    for (;;) {
        sum = 0u; cnt = 0u; mine = 0u;
#pragma unroll
        for (unsigned j = 0; j < 16; ++j) { const unsigned c = xb_ld(&bar[XB_XCNT(j)]); sum += c; cnt += (c > 0u) ? 1u : 0u; mine = (j == x) ? c : mine; }
        if (sum == G) break;
        __builtin_amdgcn_s_sleep(1);
        if ((++sp & 255u) == 0u) { if (xb_ld(&bar[XB_TMO])) break; if (sp > XB_SPIN_CAP) { atomicAdd(&bar[XB_TMO], 1u); break; } }
    }
    nloc = mine > 0u ? mine : 1u; nx = cnt > 0u ? cnt : 1u;
}

__device__ __forceinline__ void xcd_barrier(const XcdBarrier& b) {
    asm volatile("s_waitcnt vmcnt(0)" ::: "memory");
    __syncthreads();
    if (b.lead) {
        unsigned* bar = b.bar;
        __builtin_amdgcn_s_waitcnt(0);
        unsigned nloc = b.st[0], nx = b.st[1];
        if (nloc == 0u) { xcd_barrier_complete(bar, b.x, nloc, nx); b.st[0] = nloc; b.st[1] = nx; }
        const unsigned old = xb_add(&bar[XB_XSUB(b.x)], 1u);
        const unsigned gen = old / nloc;
        if (old + 1u == (gen + 1u) * nloc) {
            __builtin_amdgcn_fence(__ATOMIC_RELEASE, "agent");
            asm volatile("s_waitcnt vmcnt(0)" ::: "memory");
            const unsigned og = xb_add(&bar[XB_TOP], 1u);
            const unsigned tg = og / nx;
            if (og + 1u == (tg + 1u) * nx) xb_add(&bar[XB_TOPGEN], 1u);
            else XB_SPIN(xb_ld(&bar[XB_TOPGEN]) == tg, bar);
            __builtin_amdgcn_fence(__ATOMIC_ACQUIRE, "agent");
            xb_add(&bar[XB_XGEN(b.x)], 1u);
            asm volatile("s_waitcnt vmcnt(0)" ::: "memory");
        } else {
            XB_SPIN(xb_ld(&bar[XB_XGEN(b.x)]) == gen, bar);
            __builtin_amdgcn_fence(__ATOMIC_ACQUIRE, "agent");
            asm volatile("s_waitcnt vmcnt(0)" ::: "memory");
        }
    }
    __syncthreads();
}

constexpr int NWAVES = 8, NTHR = 512;
constexpr int DM = 2048, NB = 4, SQ = 4096, TOK = NB * SQ;
constexpr int INW = 5900, PW = 5888;
constexpr int C_U = 0, C_DQ = 512, C_DK = 1280, C_DV = 2048, C_GQ = 2816, C_GZ = 5120, C_GA = 5888;
constexpr int DFF = 5632, DFE = 7168, NE = 8;
constexpr int MOE_ROWS = 2 * TOK + NE * 256, MOE_TILES_MAX = MOE_ROWS / 256;
constexpr float EPS = 1e-6f;
constexpr int GDN_UNIT_BYTES = 57344 + 32768 + 256;

constexpr size_t MiB = 1u << 20;
constexpr size_t WS_CTL = 0, CTL_ZERO_BYTES = 1 * MiB;
constexpr size_t WS_MOD = 1 * MiB;
constexpr size_t WS_ROPE = 2 * MiB;
constexpr size_t WS_GAB = 3 * MiB;
constexpr size_t WS_TOKE = 4 * MiB, WS_TOKG = WS_TOKE + 128 * 1024, WS_RANK = WS_TOKE + 256 * 1024, WS_POS = WS_TOKE + 384 * 1024, WS_CNT = WS_TOKE + 512 * 1024, WS_TILE = WS_TOKE + 640 * 1024;
constexpr size_t WS_GW = 5 * MiB;
constexpr size_t WS_M2 = 6 * MiB;
constexpr size_t WS_M13 = 10 * MiB;
constexpr size_t WS_A16 = 22 * MiB;
constexpr size_t WS_XC = 23 * MiB;
constexpr size_t WS_XS = 39 * MiB;
constexpr size_t WS_YGELU = 47 * MiB;
constexpr size_t WS_WIN = 64 * MiB;
constexpr size_t WS_WOUT = 110 * MiB;
constexpr size_t WS_WGLU = 126 * MiB;
constexpr size_t WS_WUP = 128 * MiB;
constexpr size_t WS_WDN = 172 * MiB;
constexpr size_t WS_MUP = 194 * MiB;
constexpr size_t WS_MDN = 642 * MiB;
constexpr size_t WS_HRES = 866 * MiB;
constexpr size_t WS_HN = 994 * MiB;
constexpr size_t WS_R = 1058 * MiB;
constexpr size_t WS_PROJ = WS_R, WS_YCAT = WS_R + 184 * MiB, WS_ATTO = WS_R + 248 * MiB, WS_OGDN = WS_R + 296 * MiB;
constexpr size_t WS_H = WS_R;
constexpr size_t WS_AS = 1534 * MiB;
constexpr size_t WS_GU = WS_AS;
constexpr size_t WS_END = 1670 * MiB;
static_assert((size_t)MOE_ROWS * DFE * 2 <= 476 * MiB && (size_t)MOE_ROWS * DM * 2 <= 136 * MiB && (size_t)1536 * GDN_UNIT_BYTES <= 136 * MiB, "ws map");
static_assert((size_t)TOK * PW * 2 <= 184 * MiB && (size_t)TOK * 768 * 4 <= 48 * MiB, "ws map 2");
constexpr int CW_BAR = 4096, CW_QUEUE = 8192, CW_CVQ = 9216, CW_ARR = 9280, CW_SCAN = 11008, CW_FIN = 12288, CW_ADA = 12800;

constexpr int LDS_BYTES = 147456;
constexpr int RING_BYTES = 131072;
constexpr int TILE_OFF = 146432, MISC_OFF = 147200;

typedef unsigned u32x4_t __attribute__((ext_vector_type(4)));
typedef unsigned u32x2_t __attribute__((ext_vector_type(2)));
typedef float f32x2_t __attribute__((ext_vector_type(2)));

__device__ __forceinline__ float bf2f(unsigned short u) { return __uint_as_float((unsigned)u << 16); }
__device__ __forceinline__ float bflo(unsigned w) { return __uint_as_float(w << 16); }
__device__ __forceinline__ float bfhi(unsigned w) { return __uint_as_float(w & 0xffff0000u); }
__device__ __forceinline__ float wave_sum(float v) {
    v += __builtin_bit_cast(float, __builtin_amdgcn_update_dpp(0, __builtin_bit_cast(int, v), 0xB1, 0xF, 0xF, false));
    v += __builtin_bit_cast(float, __builtin_amdgcn_update_dpp(0, __builtin_bit_cast(int, v), 0x4E, 0xF, 0xF, false));
    v += __builtin_bit_cast(float, __builtin_amdgcn_update_dpp(0, __builtin_bit_cast(int, v), 0x141, 0xF, 0xF, false));
    v += __builtin_bit_cast(float, __builtin_amdgcn_update_dpp(0, __builtin_bit_cast(int, v), 0x140, 0xF, 0xF, false));
    v += __builtin_bit_cast(float, __builtin_amdgcn_update_dpp(0, __builtin_bit_cast(int, v), 0x142, 0xA, 0xF, false));
    v += __builtin_bit_cast(float, __builtin_amdgcn_update_dpp(0, __builtin_bit_cast(int, v), 0x143, 0xC, 0xF, false));
    return __builtin_bit_cast(float, __builtin_amdgcn_readlane(__builtin_bit_cast(int, v), 63));
}
__device__ __forceinline__ float sigmoid_f(float x) { return __builtin_amdgcn_rcpf(1.f + __expf(-x)); }
__device__ __forceinline__ float silu_f(float x) { return x * __builtin_amdgcn_rcpf(1.f + __expf(-x)); }
__device__ __forceinline__ float gelu_tanh_f(float y) { const float z = 0.7978845608028654f * (y + 0.044715f * y * y * y); const float e = __expf(2.f * z); const float th = 1.f - 2.f * __builtin_amdgcn_rcpf(e + 1.f); return 0.5f * y * (1.f + th); }
__device__ __forceinline__ bf16x8 pack8(const f32x4& a, const f32x4& b) {
    u32x4_t w; w.x = pk2(a[0], a[1]); w.y = pk2(a[2], a[3]); w.z = pk2(b[0], b[1]); w.w = pk2(b[2], b[3]);
    return __builtin_bit_cast(bf16x8, w);
}
__device__ __forceinline__ unsigned pk4_fp8(float a, float b, float c, float d) {
    a = __builtin_amdgcn_fmed3f(a, -448.f, 448.f); b = __builtin_amdgcn_fmed3f(b, -448.f, 448.f); c = __builtin_amdgcn_fmed3f(c, -448.f, 448.f); d = __builtin_amdgcn_fmed3f(d, -448.f, 448.f);
    int w = 0; w = __builtin_amdgcn_cvt_pk_fp8_f32(a, b, w, false); w = __builtin_amdgcn_cvt_pk_fp8_f32(c, d, w, true); return (unsigned)w;
}
#ifndef DENSE_FP8
#define DENSE_FP8 2
#endif
constexpr float S8_HN = 4.f, S8_W13 = 64.f, S8_H = 8.f, S8_W2 = 128.f;
__device__ __forceinline__ void sincos2pi(double r, float& s, float& c) {
    const double x = r * 6.283185307179586476925; const double x2 = x * x;
    double ss = 1.0, cc = 1.0;
#pragma unroll
    for (int k = 12; k >= 1; --k) { ss = 1.0 - x2 * ss / (double)((2 * k) * (2 * k + 1)); cc = 1.0 - x2 * cc / (double)((2 * k - 1) * (2 * k)); }
    s = (float)(x * ss); c = (float)cc;
}

namespace pg8 {
struct EpiProj {
    static constexpr bool PERM = true, AFTER_DRAIN = false;
    bf16_t* O;
    __device__ __forceinline__ void operator()(const f32x4 (&acc)[2][2][4][2], const Unit& u, int wr, int wc, int fr, int fq) const {
        const int row0 = u.pm * BM + wr * 64 + fr, col0 = u.pn * BM + wc * 32 + 8 * fq;
        const float sc = (u.pn >= 2 && u.pn <= 4) ? attn_body::C2 : 1.f;
#pragma unroll
        for (int ai = 0; ai < 2; ++ai)
#pragma unroll
            for (int m = 0; m < 4; ++m) { bf16_t* rowp = O + (size_t)(row0 + ai * HALF + m * 16) * PW + col0;
#pragma unroll
                for (int bj = 0; bj < 2; ++bj) { const f32x4 v0 = acc[ai][bj][m][0] * sc, v1 = acc[ai][bj][m][1] * sc;
                    u32x4 w; w.x = cvt_pk_bf16(v0[0], v0[1]); w.y = cvt_pk_bf16(v0[2], v0[3]); w.z = cvt_pk_bf16(v1[0], v1[1]); w.w = cvt_pk_bf16(v1[2], v1[3]);
                    *(u32x4*)(rowp + bj * HALF) = w; } }
    }
};
struct EpiGlu {
    static constexpr bool PERM = true, AFTER_DRAIN = false;
    const bf16_t* Y; bf16_t* O;
    __device__ __forceinline__ void operator()(const f32x4 (&acc)[2][2][4][2], const Unit& u, int wr, int wc, int fr, int fq) const {
        const int row0 = u.pm * BM + wr * 64 + fr, col0 = u.pn * BM + wc * 32 + 8 * fq;
#pragma unroll
        for (int ai = 0; ai < 2; ++ai)
#pragma unroll
            for (int m = 0; m < 4; ++m) { const int row = row0 + ai * HALF + m * 16;
#pragma unroll
                for (int bj = 0; bj < 2; ++bj) { const int col = col0 + bj * HALF;
                    const u32x4 yv = *(const u32x4*)(Y + (size_t)row * 512 + col);
                    const f32x4 a0 = acc[ai][bj][m][0], a1 = acc[ai][bj][m][1];
                    u32x4 w;
                    w.x = cvt_pk_bf16(bflo(yv.x) * sigmoid_f(a0[0]), bfhi(yv.x) * sigmoid_f(a0[1]));
                    w.y = cvt_pk_bf16(bflo(yv.y) * sigmoid_f(a0[2]), bfhi(yv.y) * sigmoid_f(a0[3]));
                    w.z = cvt_pk_bf16(bflo(yv.z) * sigmoid_f(a1[0]), bfhi(yv.z) * sigmoid_f(a1[1]));
                    w.w = cvt_pk_bf16(bflo(yv.w) * sigmoid_f(a1[2]), bfhi(yv.w) * sigmoid_f(a1[3]));
                    *(u32x4*)(O + (size_t)row * DM + col) = w; } }
    }
};
struct EpiRes {
    static constexpr bool PERM = false, AFTER_DRAIN = false;
    const float* res; float* out; const float* gate; float sin;
    __device__ __forceinline__ void operator()(const f32x4 (&acc)[2][2][4][2], const Unit& u, int wr, int wc, int fr, int fq) const {
        const int col0 = u.pn * BM + wc * 32 + 4 * fq;
#pragma unroll
        for (int ai = 0; ai < 2; ++ai)
#pragma unroll
            for (int m = 0; m < 4; ++m) { const int row = u.pm * BM + ai * HALF + wr * 64 + m * 16 + fr; const float* gp = gate + (size_t)(row >> 12) * (6 * DM); const size_t off = (size_t)row * DM;
#pragma unroll
                for (int bj = 0; bj < 2; ++bj)
#pragma unroll
                    for (int n = 0; n < 2; ++n) { const int col = col0 + bj * HALF + n * 16;
                        const f32x4 g = *(const f32x4*)(gp + col), r = *(const f32x4*)(res + off + col);
                        *(f32x4*)(out + off + col) = r + g * (acc[ai][bj][m][n] * sin); } }
    }
};
struct EpiSwiglu {
    static constexpr bool PERM = true, AFTER_DRAIN = false;
    bf16_t* H; int ldh; int nct; float sin;
    __device__ __forceinline__ void operator()(const f32x4 (&acc)[2][2][4][2], const Unit& u, int wr, int wc, int fr, int fq) const {
        const int pnl = u.pn % nct; const int row0 = u.pm * BM + wr * 64 + fr, col0 = pnl * HALF + wc * 32 + 8 * fq;
#pragma unroll
        for (int ai = 0; ai < 2; ++ai)
#pragma unroll
            for (int m = 0; m < 4; ++m) { const int row = row0 + ai * HALF + m * 16;
                const f32x4 g0 = acc[ai][0][m][0] * sin, g1 = acc[ai][0][m][1] * sin, u0 = acc[ai][1][m][0] * sin, u1 = acc[ai][1][m][1] * sin;
                u32x4 w;
                w.x = cvt_pk_bf16(silu_f(g0[0]) * u0[0], silu_f(g0[1]) * u0[1]); w.y = cvt_pk_bf16(silu_f(g0[2]) * u0[2], silu_f(g0[3]) * u0[3]);
                w.z = cvt_pk_bf16(silu_f(g1[0]) * u1[0], silu_f(g1[1]) * u1[1]); w.w = cvt_pk_bf16(silu_f(g1[2]) * u1[2], silu_f(g1[3]) * u1[3]);
                *(u32x4*)(H + (size_t)row * ldh + col0) = w; }
    }
};
struct EpiSwiglu8 {
    static constexpr bool PERM = true, AFTER_DRAIN = false;
    unsigned char* H; int ldh; int nct; float sin;
    __device__ __forceinline__ void operator()(const f32x4 (&acc)[2][2][4][2], const Unit& u, int wr, int wc, int fr, int fq) const {
        const int pnl = u.pn % nct; const int row0 = u.pm * BM + wr * 64 + fr, col0 = pnl * HALF + wc * 32 + 8 * fq;
#pragma unroll
        for (int ai = 0; ai < 2; ++ai)
#pragma unroll
            for (int m = 0; m < 4; ++m) { const int row = row0 + ai * HALF + m * 16;
                const f32x4 g0 = acc[ai][0][m][0] * sin, g1 = acc[ai][0][m][1] * sin, u0 = acc[ai][1][m][0] * (sin * S8_H), u1 = acc[ai][1][m][1] * (sin * S8_H);
                u32x2_t w; w.x = pk4_fp8(silu_f(g0[0]) * u0[0], silu_f(g0[1]) * u0[1], silu_f(g0[2]) * u0[2], silu_f(g0[3]) * u0[3]);
                w.y = pk4_fp8(silu_f(g1[0]) * u1[0], silu_f(g1[1]) * u1[1], silu_f(g1[2]) * u1[2], silu_f(g1[3]) * u1[3]);
                *(u32x2_t*)(H + (size_t)row * ldh + col0) = w; }
    }
};
struct EpiMoeDown {
    static constexpr bool PERM = true, AFTER_DRAIN = false;
    bf16_t* O; const float* gw; float sin;
    f32x4* part; gu32* flag; PG8_LAS unsigned* wcnt;
    __device__ __forceinline__ void operator()(const f32x4 (&acc)[2][2][4][2], const Unit& u, int wr, int wc, int fr, int fq) const {
        const int row0 = u.pm * BM + wr * 64 + fr, col0 = (u.pn & 7) * BM + wc * 32 + 8 * fq;
        f32x4* pp = part + ((size_t)(u.slot * 8 + wr * 4 + wc) * 32) * 64 + (fq * 16 + fr);
        if (u.ks == 1) {
#pragma unroll
            for (int ai = 0; ai < 2; ++ai)
#pragma unroll
                for (int bj = 0; bj < 2; ++bj)
#pragma unroll
                    for (int m = 0; m < 4; ++m)
#pragma unroll
                        for (int n = 0; n < 2; ++n) pp[(((ai * 2 + bj) * 4 + m) * 2 + n) * 64] = acc[ai][bj][m][n];
            asm volatile("s_waitcnt vmcnt(0)" ::: "memory");
            if (fq * 16 + fr == 0) { const unsigned old = __hip_atomic_fetch_add(wcnt, 1u, __ATOMIC_RELAXED, __HIP_MEMORY_SCOPE_WORKGROUP);
                if (old == 7u) { __builtin_amdgcn_fence(__ATOMIC_RELEASE, "agent"); asm volatile("s_waitcnt vmcnt(0)" ::: "memory"); __hip_atomic_store(flag + u.slot, 1u, RLX_AGENT); } }
            return; }
        if (u.ks == 2) {
            if (fq * 16 + fr == 0) { unsigned sp = 0; while (__hip_atomic_load(flag + u.slot, RLX_AGENT) == 0u && ++sp < (1u << 22)) __builtin_amdgcn_s_sleep(1); }
            __builtin_amdgcn_fence(__ATOMIC_ACQUIRE, "agent"); asm volatile("s_waitcnt vmcnt(0)" ::: "memory");
#pragma unroll
            for (int ai = 0; ai < 2; ++ai)
#pragma unroll
                for (int m = 0; m < 4; ++m) { const int row = row0 + ai * HALF + m * 16; const float s = gw[row] * sin; bf16_t* rowp = O + (size_t)row * DM + col0;
#pragma unroll
                    for (int bj = 0; bj < 2; ++bj) { const f32x4 v0 = (acc[ai][bj][m][0] + pp[(((ai * 2 + bj) * 4 + m) * 2 + 0) * 64]) * s, v1 = (acc[ai][bj][m][1] + pp[(((ai * 2 + bj) * 4 + m) * 2 + 1) * 64]) * s;
                        u32x4 w; w.x = cvt_pk_bf16(v0[0], v0[1]); w.y = cvt_pk_bf16(v0[2], v0[3]); w.z = cvt_pk_bf16(v1[0], v1[1]); w.w = cvt_pk_bf16(v1[2], v1[3]);
                        *(u32x4*)(rowp + bj * HALF) = w; }
                    asm volatile("" ::: "memory"); }
            return; }
#pragma unroll
        for (int ai = 0; ai < 2; ++ai)
#pragma unroll
            for (int m = 0; m < 4; ++m) { const int row = row0 + ai * HALF + m * 16; const float s = gw[row] * sin; bf16_t* rowp = O + (size_t)row * DM + col0;
#pragma unroll
                for (int bj = 0; bj < 2; ++bj) { const f32x4 v0 = acc[ai][bj][m][0] * s, v1 = acc[ai][bj][m][1] * s;
                    u32x4 w; w.x = cvt_pk_bf16(v0[0], v0[1]); w.y = cvt_pk_bf16(v0[2], v0[3]); w.z = cvt_pk_bf16(v1[0], v1[1]); w.w = cvt_pk_bf16(v1[2], v1[3]);
                    *(u32x4*)(rowp + bj * HALF) = w; } }
    }
};
struct MoeOrder {
    static constexpr bool SPLITK = false;
    StaticOrder so; const PG8_LAS int* tile_e; int nct; int rev = 0;
    __device__ __forceinline__ bool next(int i, Unit& u) const { if (!so.next(i, u)) return false; if (rev) u.pm = so.nM - 1 - u.pm; u.pn += __builtin_amdgcn_readfirstlane(tile_e[u.pm]) * nct; return true; }
    __device__ __forceinline__ void a_ready(const Unit&) const {}
    __device__ __forceinline__ void done(const Unit&) const {}
};
struct MoeDownOrder {
    static constexpr bool SPLITK = true;
    StaticOrder so; const PG8_LAS int* tile_e; int nct, nM, nl, R, c, ntf; gu32* arr; LAS unsigned* wc;
    __device__ __forceinline__ bool next(int i, Unit& u) const {
        if (i < R) { (void)so.next(i, u); u.pm = nM - 1 - u.pm; }
        else if (i == R && c < nl * 16) { u.pm = c >> 4; u.pn = c & 7; const int h = (c >> 3) & 1; u.kt0 = h * (ntf >> 1); u.nt = ntf >> 1; u.ks = 1 + h; u.slot = (c >> 4) * 8 + (c & 7); }
        else return false;
        if (i < R) { u.kt0 = 0; u.nt = ntf; u.ks = 0; }
        u.aux = i; u.pn += __builtin_amdgcn_readfirstlane(tile_e[u.pm]) * nct; return true; }
    __device__ __forceinline__ void a_ready(const Unit&) const {}
    __device__ __forceinline__ void done(const Unit& u) const {
        if (u.aux == R - 1) { asm volatile("s_waitcnt vmcnt(0)" ::: "memory");
            if (mk_lane() == 0) { const unsigned old = __hip_atomic_fetch_add(wc, 1u, __ATOMIC_RELAXED, __HIP_MEMORY_SCOPE_WORKGROUP);
                if (old == 7u) { __builtin_amdgcn_fence(__ATOMIC_RELEASE, "agent"); asm volatile("s_waitcnt vmcnt(0)" ::: "memory"); (void)__hip_atomic_fetch_add(arr, 1u, RLX_AGENT); } } } }
};
}

#if defined(PROBE_LO)
#define PSPAN_BEGIN(C, id) do { if ((id) == PROBE_LO && blockIdx.x == 0 && (C).wave == 0 && mk_lane() == 0) { const unsigned long long t_ = __builtin_amdgcn_s_memrealtime(); (C).MISC[20] = (unsigned)t_; (C).MISC[21] = (unsigned)(t_ >> 32); } } while (0)
#define PSPAN_END(C, id) do { if ((id) == PROBE_LO && blockIdx.x == 0 && (C).wave == 0 && mk_lane() == 0) { const unsigned long long t_ = __builtin_amdgcn_s_memrealtime() - (((unsigned long long)(C).MISC[21] << 32) | (C).MISC[20]); (C).MISC[22] += (unsigned)t_; } } while (0)
#else
#define PSPAN_BEGIN(C, id) do {} while (0)
#define PSPAN_END(C, id) do {} while (0)
#endif
struct Params { const float* in[35]; float* out; unsigned char* ws; int ph_lo, ph_hi; };
typedef const __attribute__((address_space(4))) Params* KP;

#define PIN(i) ((const float*)(const GAS float*)(P->in[i]))
#define POUT ((float*)(GAS float*)(P->out))
struct Ctx {
    LAS unsigned char* lds; volatile LAS unsigned* MISC; GAS unsigned char* ws; gu32* ctl;
    int tid, lane, wave, blk, G;
};

__device__ __forceinline__ void tr_tile(const float* __restrict__ src, int ld, bf16* dst, int K, int k0, int n0, int drow0, int lane) {
    const int c4 = lane & 15, r = lane >> 4;
    const float* sp = src + (size_t)(k0 + 16 * r) * ld + n0 + 4 * c4;
    f32x4 x[16];
#pragma unroll
    for (int i = 0; i < 16; ++i) x[i] = __builtin_nontemporal_load((const f32x4*)(sp + (size_t)i * ld));
    bf16* dp = dst + (size_t)(drow0 + 4 * c4) * K + k0 + 16 * r;
#pragma unroll
    for (int q = 0; q < 4; ++q)
#pragma unroll
        for (int hf = 0; hf < 2; ++hf) { v4u o; o.x = pk2(x[8 * hf + 0][q], x[8 * hf + 1][q]); o.y = pk2(x[8 * hf + 2][q], x[8 * hf + 3][q]); o.z = pk2(x[8 * hf + 4][q], x[8 * hf + 5][q]); o.w = pk2(x[8 * hf + 6][q], x[8 * hf + 7][q]);
            *(GAS v4u*)(dp + (size_t)q * K + 8 * hf) = o; }
}
__device__ __forceinline__ void tr_tile8(const float* __restrict__ src, int ld, unsigned char* dst, int K, int k0, int n0, int drow0, int lane, float sc) {
    const int c4 = lane & 15, r = lane >> 4;
    const float* sp = src + (size_t)(k0 + 16 * r) * ld + n0 + 4 * c4;
    f32x4 x[16];
#pragma unroll
    for (int i = 0; i < 16; ++i) x[i] = __builtin_nontemporal_load((const f32x4*)(sp + (size_t)i * ld)) * sc;
    unsigned char* dp = dst + (size_t)(drow0 + 4 * c4) * K + k0 + 16 * r;
#pragma unroll
    for (int q = 0; q < 4; ++q) { v4u o; o.x = pk4_fp8(x[0][q], x[1][q], x[2][q], x[3][q]); o.y = pk4_fp8(x[4][q], x[5][q], x[6][q], x[7][q]); o.z = pk4_fp8(x[8][q], x[9][q], x[10][q], x[11][q]); o.w = pk4_fp8(x[12][q], x[13][q], x[14][q], x[15][q]);
        *(GAS v4u*)(dp + (size_t)q * K) = o; }
}
__device__ __forceinline__ void tr_plain(const float* src, int ld, int K, int N, bf16* dst, int item, int lane) {
    const int nblk = N / 64, kb = item / nblk, nb = item % nblk;
    tr_tile(src, ld, dst, K, 64 * kb, 64 * nb, 64 * nb, lane);
}
__device__ __forceinline__ void tr_inter(const float* src, int K, int N, bf16* dst, int half, int item, int lane) {
    const int nblk = N / 64, kb = item / nblk, nb = item % nblk, n0 = 64 * nb;
    tr_tile(src, N, dst, K, 64 * kb, n0, (n0 >> 7) * 256 + half * 128 + (n0 & 127), lane);
}

__device__ __forceinline__ void p0_ada(const Ctx& C, KP P) {
    const int u = C.blk, l = u / 96, ks = (u % 96) / 12, slab = (u % 96) % 12, n0 = slab * 1024, k0 = ks * 256, lane = C.lane, w = C.wave;
    LAS float* sc = (LAS float*)C.lds; LAS float* part = (LAS float*)(C.lds + 4096);
    const float* cin = PIN(1);
    for (int i = C.tid; i < 4 * 256; i += NTHR) sc[i] = silu_f(cin[(i >> 8) * DM + k0 + (i & 255)]);
    __syncthreads();
    const float* Wp = PIN(3) + ((size_t)l * DM + k0 + 32 * w) * (6 * DM) + n0 + 4 * lane;
    f32x4 acc[4][4];
#pragma unroll
    for (int b = 0; b < 4; ++b)
#pragma unroll
        for (int g = 0; g < 4; ++g) acc[b][g] = (f32x4){0.f, 0.f, 0.f, 0.f};
#pragma unroll 4
    for (int i = 0; i < 32; ++i) { f32x4 wv[4];
#pragma unroll
        for (int g = 0; g < 4; ++g) wv[g] = __builtin_nontemporal_load((const f32x4*)(Wp + (size_t)i * (6 * DM) + 256 * g));
#pragma unroll
        for (int b = 0; b < 4; ++b) { const float sv = sc[b * 256 + 32 * w + i];
#pragma unroll
            for (int g = 0; g < 4; ++g) acc[b][g] += wv[g] * sv; } }
#pragma unroll
    for (int b = 0; b < 4; ++b)
#pragma unroll
        for (int g = 0; g < 4; ++g) *(LAS f32x4*)(part + (w * 4 + b) * 1024 + 256 * g + 4 * lane) = acc[b][g];
    __syncthreads();
    float* PART = (float*)(C.ws + WS_XC);
    { float* dst = PART + ((size_t)((l * 12 + slab) * 8 + ks)) * 4096;
      for (int idx = C.tid; idx < 4096; idx += NTHR) { float sum = 0.f;
#pragma unroll
          for (int ww = 0; ww < 8; ++ww) sum += part[ww * 4096 + idx];
          dst[idx] = sum; } }
    asm volatile("s_waitcnt vmcnt(0)" ::: "memory"); __syncthreads();
    if (C.tid == 0) { __builtin_amdgcn_fence(__ATOMIC_RELEASE, "agent"); asm volatile("s_waitcnt vmcnt(0)" ::: "memory");
        const unsigned old = __hip_atomic_fetch_add(C.ctl + CW_ADA + (l * 12 + slab), 1u, RLX_AGENT);
        if (old == 7u) { __builtin_amdgcn_fence(__ATOMIC_ACQUIRE, "agent"); asm volatile("s_waitcnt vmcnt(0)" ::: "memory"); }
        C.MISC[24] = old; }
    __syncthreads();
    const unsigned old = (unsigned)__builtin_amdgcn_readfirstlane((int)C.MISC[24]);
    __syncthreads();
    if (old == 7u) { const float* src = PART + ((size_t)((l * 12 + slab) * 8)) * 4096; const float* bias = PIN(4) + l * (6 * DM) + n0;
        for (int idx = C.tid; idx < 4096; idx += NTHR) { const int b = idx >> 10, n = idx & 1023; float sum = bias[n];
#pragma unroll
            for (int q = 0; q < 8; ++q) sum += src[(size_t)q * 4096 + idx];
            ((float*)(C.ws + WS_MOD))[(size_t)(l * 4 + b) * (6 * DM) + n0 + n] = sum; } }
    __syncthreads();
}

__device__ __forceinline__ void p0_ssm(const Ctx& C, KP P) {
    const int u = C.blk - 192, l = u >> 5, g = u & 31, lg = l * 32 + g;
    LAS f32x2_t* Pw = (LAS f32x2_t*)C.lds;
    LAS f32x2_t* Bb = (LAS f32x2_t*)(C.lds + 8704);
    LAS f32x2_t* Cc = (LAS f32x2_t*)(C.lds + 8704 + 8192);
    LAS float* Kl = (LAS float*)(C.lds + 8704 + 16384);
    const float dt = expf(PIN(12)[lg]);
    if (C.tid < 64) { const int p = C.tid; const float ar = PIN(10)[lg * 64 + p], ai = PIN(11)[lg * 64 + p];
        for (int j = 0; j <= 16; ++j) { const float mag = expf(ar * dt * (float)j); double rev = (double)ai * (double)dt * (double)j * 0.15915494309189533577; rev -= rint(rev);
            float s, c; sincos2pi(rev, s, c); Pw[j * 64 + p] = (f32x2_t){mag * c, mag * s}; }
        const f32x2_t lb = Pw[64 + p]; const float nx = lb.x - 1.f, ny = lb.y, den = ar * ar + ai * ai;
        const float cx = (nx * ar + ny * ai) / den, cy = (ny * ar - nx * ai) / den;
        for (int h = 0; h < 16; ++h) { const float br = PIN(13)[(lg * 64 + p) * 16 + h], bi = PIN(14)[(lg * 64 + p) * 16 + h]; Bb[p * 16 + h] = (f32x2_t){cx * br - cy * bi, cx * bi + cy * br}; }
        ((f32x2_t*)(C.ws + WS_A16))[lg * 64 + p] = Pw[16 * 64 + p]; }
    for (int i = C.tid; i < 1024; i += NTHR) Cc[i] = (f32x2_t){PIN(15)[lg * 1024 + i], PIN(16)[lg * 1024 + i]};
    __syncthreads();
    for (int e = C.tid; e < 4096; e += NTHR) { const int j = e >> 8, hp = (e >> 4) & 15, h = e & 15; float s = 0.f;
        for (int p = 0; p < 64; ++p) { const f32x2_t c = Cc[hp * 64 + p], pw = Pw[j * 64 + p], bb = Bb[p * 16 + h]; const float zx = c.x * pw.x - c.y * pw.y, zy = c.x * pw.y + c.y * pw.x; s += zx * bb.x - zy * bb.y; }
        if (j == 0 && hp == h) s += PIN(17)[l * 512 + g * 16 + h];
        Kl[e] = s; }
    __syncthreads();
    bf16* M2 = (bf16*)(C.ws + WS_M2) + (size_t)lg * 128 * 256;
    for (int pc = C.tid; pc < 4096; pc += NTHR) { const int n = pc >> 5, k0 = (pc & 31) * 8, p = n >> 1, ri = n & 1, s = k0 >> 4, h0 = k0 & 15; const f32x2_t pw = Pw[(15 - s) * 64 + p]; float v[8];
#pragma unroll
        for (int j = 0; j < 8; ++j) { const f32x2_t bb = Bb[p * 16 + h0 + j]; v[j] = ri ? (pw.x * bb.y + pw.y * bb.x) : (pw.x * bb.x - pw.y * bb.y); }
        v4u o; o.x = pk2(v[0], v[1]); o.y = pk2(v[2], v[3]); o.z = pk2(v[4], v[5]); o.w = pk2(v[6], v[7]); *(GAS v4u*)(M2 + (size_t)n * 256 + k0) = o; }
    bf16* M13 = (bf16*)(C.ws + WS_M13) + (size_t)lg * 256 * 384;
    for (int pc = C.tid; pc < 12288; pc += NTHR) { const int n = pc / 48, k0 = (pc % 48) * 8, i = n >> 4, hp = n & 15; float v[8];
        if (k0 < 256) { const int s = k0 >> 4, h0 = k0 & 15;
#pragma unroll
            for (int j = 0; j < 8; ++j) v[j] = (i >= s) ? Kl[((i - s) * 16 + hp) * 16 + h0 + j] : 0.f; }
        else {
#pragma unroll
            for (int j = 0; j < 8; ++j) { const int kk = k0 - 256 + j, p = kk >> 1, ri = kk & 1; const f32x2_t c = Cc[hp * 64 + p], pw = Pw[(i + 1) * 64 + p]; const float zx = c.x * pw.x - c.y * pw.y, zy = c.x * pw.y + c.y * pw.x; v[j] = ri ? -zy : zx; } }
        v4u o; o.x = pk2(v[0], v[1]); o.y = pk2(v[2], v[3]); o.z = pk2(v[4], v[5]); o.w = pk2(v[6], v[7]); *(GAS v4u*)(M13 + (size_t)n * 384 + k0) = o; }
    __syncthreads();
}

__device__ __forceinline__ void p0_prologue(const Ctx& C, KP P) {
    if (C.blk < 192) p0_ada(C, P); else p0_ssm(C, P);
    { const int* pos = (const int*)PIN(2); float* rope = (float*)(C.ws + WS_ROPE);
      for (int idx = C.blk * NTHR + C.tid; idx < TOK * 8; idx += C.G * NTHR) { const int t = idx >> 3, i = idx & 7;
          const double invf = exp(-(double)i * (13.122363377404328 / 8.0)); double rev = (double)pos[t] * invf * 0.15915494309189533577; rev -= rint(rev);
          float s, c; sincos2pi(rev, s, c); rope[t * 16 + i] = c; rope[t * 16 + 8 + i] = s; } }
    const int gw = C.blk * NWAVES + C.wave, NGW = C.G * NWAVES, lane = C.lane;
    constexpr int I_IN = 32 * 92, I_OUT = 32 * 32, I_GLU = 8 * 8, I_F13 = 32 * 88, I_F2 = 88 * 32, I_M13 = 32 * 112, I_M2 = 112 * 32;
    constexpr int NITEMS = 2 * I_IN + 2 * I_OUT + 2 * I_GLU + 2 * I_F13 + I_F2;
#pragma unroll 1
    for (int it = gw; it < NITEMS; it += NGW) {
        int r = it;
        if (r < 2 * I_IN) { const int l = r / I_IN; r -= l * I_IN; tr_plain(PIN(8) + (size_t)l * DM * INW, INW, DM, PW, (bf16*)(C.ws + WS_WIN) + (size_t)l * PW * DM, r, lane); continue; } r -= 2 * I_IN;
        if (r < 2 * I_OUT) { const int l = r / I_OUT; r -= l * I_OUT; tr_plain(PIN(9) + (size_t)l * DM * DM, DM, DM, DM, (bf16*)(C.ws + WS_WOUT) + (size_t)l * DM * DM, r, lane); continue; } r -= 2 * I_OUT;
        if (r < 2 * I_GLU) { const int l = r / I_GLU; r -= l * I_GLU; tr_plain(PIN(18) + (size_t)l * 512 * 512, 512, 512, 512, (bf16*)(C.ws + WS_WGLU) + (size_t)l * 512 * 512, r, lane); continue; } r -= 2 * I_GLU;
        if (r < 2 * I_F13) { const int half = r / I_F13; r -= half * I_F13;
            if (DENSE_FP8 >= 1) { const int nblk = DFF / 64, kb = r / nblk, n0 = 64 * (r % nblk); tr_tile8(half ? PIN(29) : PIN(28), DFF, (unsigned char*)(C.ws + WS_WUP), DM, 64 * kb, n0, (n0 >> 7) * 256 + half * 128 + (n0 & 127), lane, S8_W13); }
            else tr_inter(half ? PIN(29) : PIN(28), DM, DFF, (bf16*)(C.ws + WS_WUP), half, r, lane);
            continue; } r -= 2 * I_F13;
        if (r < I_F2) { if (DENSE_FP8 >= 2) { const int nblk = DM / 64, kb = r / nblk, n0 = 64 * (r % nblk); tr_tile8(PIN(30), DM, (unsigned char*)(C.ws + WS_WDN), DFF, 64 * kb, n0, n0, lane, S8_W2); }
            else tr_plain(PIN(30), DM, DFF, DM, (bf16*)(C.ws + WS_WDN), r, lane); }
    }
}

constexpr int MOE_CVT_TILES = 16 * (32 * 112) + 8 * (112 * 32), MOE_CVT_CHUNKS = MOE_CVT_TILES / 16;
struct CvtTile { const float* sp; unsigned char* dp; int ld, K; float sc; };
__device__ __forceinline__ void moe_cvt_addr(const Ctx& C, KP P, int r, int lane, CvtTile& t) {
    constexpr int I_M13 = 32 * 112, I_M2 = 112 * 32; const int c4 = lane & 15, rr = lane >> 4;
    if (r < 16 * I_M13) { const int q = r / I_M13, e = q >> 1, half = q & 1; r -= q * I_M13; const int nblk = DFE / 64, kb = 2 * (r / (2 * nblk)) + (r & 1), n0 = 64 * ((r % (2 * nblk)) >> 1);
        t.ld = DFE; t.K = DM; t.sc = S8_W13; t.sp = (half ? PIN(33) : PIN(32)) + (size_t)e * DM * DFE + (size_t)(64 * kb + 16 * rr) * DFE + n0 + 4 * c4;
        t.dp = (unsigned char*)(C.ws + WS_MUP) + (size_t)e * 2 * DFE * DM + (size_t)((n0 >> 7) * 256 + half * 128 + (n0 & 127) + 4 * c4) * DM + 64 * kb + 16 * rr; }
    else { r -= 16 * I_M13; const int e = r / I_M2; r -= e * I_M2; const int nblk = DM / 64, kb = 2 * (r / (2 * nblk)) + (r & 1), n0 = 64 * ((r % (2 * nblk)) >> 1);
        t.ld = DM; t.K = DFE; t.sc = S8_W2; t.sp = PIN(34) + (size_t)e * DFE * DM + (size_t)(64 * kb + 16 * rr) * DM + n0 + 4 * c4;
        t.dp = (unsigned char*)(C.ws + WS_MDN) + (size_t)e * DM * DFE + (size_t)(n0 + 4 * c4) * DFE + 64 * kb + 16 * rr; }
}
__device__ __forceinline__ void cvt_load(const CvtTile& t, f32x4 (&x)[16]) {
#pragma unroll
    for (int i = 0; i < 16; ++i) x[i] = __builtin_nontemporal_load((const f32x4*)(t.sp + (size_t)i * t.ld));
}
__device__ __forceinline__ void cvt_store(const CvtTile& t, const f32x4 (&x)[16]) {
    const float sc = t.sc;
#pragma unroll
    for (int q = 0; q < 4; ++q) { v4u o; o.x = pk4_fp8(x[0][q] * sc, x[1][q] * sc, x[2][q] * sc, x[3][q] * sc); o.y = pk4_fp8(x[4][q] * sc, x[5][q] * sc, x[6][q] * sc, x[7][q] * sc);
        o.z = pk4_fp8(x[8][q] * sc, x[9][q] * sc, x[10][q] * sc, x[11][q] * sc); o.w = pk4_fp8(x[12][q] * sc, x[13][q] * sc, x[14][q] * sc, x[15][q] * sc);
        *(GAS v4u*)(t.dp + (size_t)q * t.K) = o; }
}
__device__ __forceinline__ void moe_cvt_fill(const Ctx& C, KP P, int k) {
    gu32* arr = C.ctl + CW_ARR + 64 * k; gu32* head = C.ctl + CW_CVQ;
    if (C.wave == 0 && C.lane == 0) (void)__hip_atomic_fetch_add(arr, 1u, RLX_AGENT);
    for (;;) {
        if (C.wave == 0 && C.lane == 0) { unsigned q = 0xffffffffu; if (__hip_atomic_load(arr, RLX_AGENT) < (unsigned)C.G) q = __hip_atomic_fetch_add(head, 1u, RLX_AGENT); C.MISC[24] = q; }
        __syncthreads();
        const unsigned q = (unsigned)__builtin_amdgcn_readfirstlane((int)C.MISC[24]);
        __syncthreads();
        if (q >= (unsigned)MOE_CVT_CHUNKS) break;
        { const int tb = (MOE_CVT_CHUNKS - 1 - (int)q) * 16 + C.wave * 2;
          CvtTile a, b; moe_cvt_addr(C, P, tb, C.lane, a); moe_cvt_addr(C, P, tb + 1, C.lane, b); f32x4 xa[16], xb[16]; cvt_load(a, xa); cvt_load(b, xb); cvt_store(a, xa); cvt_store(b, xb); }
    }
}
__device__ __forceinline__ void moe_cvt_mix(const Ctx& C, KP P, int l) {
    gu32* head = C.ctl + CW_CVQ; gu32* aq = C.ctl + CW_QUEUE + 64 * (l * 8 + (int)(xb_xcc_id() & 7u));
    for (;;) {
        if (C.wave == 0 && C.lane == 0) { unsigned q = 0xffffffffu; if (__hip_atomic_load(aq, RLX_AGENT) < 96u) q = __hip_atomic_fetch_add(head, 1u, RLX_AGENT); C.MISC[24] = q; }
        __syncthreads();
        const unsigned q = (unsigned)__builtin_amdgcn_readfirstlane((int)C.MISC[24]);
        __syncthreads();
        if (q >= (unsigned)MOE_CVT_CHUNKS) break;
        { const int tb = (MOE_CVT_CHUNKS - 1 - (int)q) * 16 + C.wave * 2;
          CvtTile a, b; moe_cvt_addr(C, P, tb, C.lane, a); moe_cvt_addr(C, P, tb + 1, C.lane, b); f32x4 xa[16], xb[16]; cvt_load(a, xa); cvt_load(b, xb); cvt_store(a, xa); cvt_store(b, xb); }
    }
}
__device__ __forceinline__ void moe_cvt_drain(const Ctx& C, KP P) {
    unsigned h = __hip_atomic_load(C.ctl + CW_CVQ, RLX_AGENT); h = (unsigned)__builtin_amdgcn_readfirstlane((int)h); if (h > (unsigned)MOE_CVT_CHUNKS) h = MOE_CVT_CHUNKS;
    const int s0 = (int)h * 16, npair = (MOE_CVT_TILES - s0) / 2, step = C.G * NWAVES; int p = C.blk * NWAVES + C.wave;
    if (p >= npair) return;
    CvtTile a, b; f32x4 xa[16], xb[16];
    moe_cvt_addr(C, P, MOE_CVT_TILES - 1 - (s0 + 2 * p), C.lane, a); moe_cvt_addr(C, P, MOE_CVT_TILES - 2 - (s0 + 2 * p), C.lane, b); cvt_load(a, xa); cvt_load(b, xb);
#pragma unroll 1
    for (;;) { const int pn = p + step; const bool more = pn < npair;
        cvt_store(a, xa); if (more) { moe_cvt_addr(C, P, MOE_CVT_TILES - 1 - (s0 + 2 * pn), C.lane, a); cvt_load(a, xa); }
        cvt_store(b, xb); if (!more) break; moe_cvt_addr(C, P, MOE_CVT_TILES - 2 - (s0 + 2 * pn), C.lane, b); cvt_load(b, xb);
        p = pn; }
}

template <bool WITH_GAB, bool OUT8 = false>
__device__ __forceinline__ void norm_phase(const Ctx& C, const float* __restrict__ src, const float* __restrict__ nw, const float* __restrict__ mod_shift, const float* __restrict__ mod_scale, const float* __restrict__ w12  ) {
    LAS float* W12T = (LAS float*)C.lds;
    if (WITH_GAB) { for (int idx = C.tid; idx < DM * 12; idx += NTHR) { const int k = idx / 12, j = idx % 12; W12T[j * DM + k] = w12[(size_t)k * INW + C_GA + j]; } __syncthreads(); }
    bf16* HN = (bf16*)(C.ws + WS_HN); float* GAB = (float*)(C.ws + WS_GAB);
    const int lane = C.lane;
    f32x4 nwv[8];
#pragma unroll
    for (int j = 0; j < 8; ++j) nwv[j] = *(const f32x4*)(nw + 4 * lane + 256 * j);
    f32x4 vn[2][8];
#pragma unroll
    for (int u = 0; u < 2; ++u)
#pragma unroll
        for (int j = 0; j < 8; ++j) vn[u][j] = *(const f32x4*)(src + (size_t)(C.blk * 64 + C.wave * 8 + u) * DM + 4 * lane + 256 * j);
    int nlim = 4; asm volatile("" : "+s"(nlim));
#pragma unroll 1
    for (int i = 0; i < nlim; ++i) { const int t0 = C.blk * 64 + C.wave * 8 + 2 * i; const int b = t0 >> 12;
        f32x4 v[2][8]; float ss0 = 0.f, ss1 = 0.f;
#pragma unroll
        for (int j = 0; j < 8; ++j) { v[0][j] = vn[0][j]; v[1][j] = vn[1][j];
            ss0 += (v[0][j].x * v[0][j].x + v[0][j].y * v[0][j].y) + (v[0][j].z * v[0][j].z + v[0][j].w * v[0][j].w); ss1 += (v[1][j].x * v[1][j].x + v[1][j].y * v[1][j].y) + (v[1][j].z * v[1][j].z + v[1][j].w * v[1][j].w); }
        if (i + 1 < nlim) {
#pragma unroll
            for (int u = 0; u < 2; ++u)
#pragma unroll
                for (int j = 0; j < 8; ++j) vn[u][j] = *(const f32x4*)(src + (size_t)(t0 + 2 + u) * DM + 4 * lane + 256 * j); }
        const float r0 = rsqrtf(wave_sum(ss0) * (1.f / DM) + EPS), r1 = rsqrtf(wave_sum(ss1) * (1.f / DM) + EPS);
        const float* sh = mod_shift + (size_t)b * 6 * DM; const float* scp = mod_scale + (size_t)b * 6 * DM;
#pragma unroll
        for (int j = 0; j < 8; ++j) { const f32x4 s1 = *(const f32x4*)(scp + 4 * lane + 256 * j), s0 = *(const f32x4*)(sh + 4 * lane + 256 * j); const f32x4 m1 = nwv[j] * (s1 + 1.f);
            v[0][j] = v[0][j] * r0 * m1 + s0; v[1][j] = v[1][j] * r1 * m1 + s0;
#pragma unroll
            for (int u = 0; u < 2; ++u) {
                if (OUT8) *(GAS unsigned*)((unsigned char*)HN + (size_t)(t0 + u) * DM + 4 * lane + 256 * j) = pk4_fp8(v[u][j].x * S8_HN, v[u][j].y * S8_HN, v[u][j].z * S8_HN, v[u][j].w * S8_HN);
                else { u32x2_t o; o.x = pk2(v[u][j].x, v[u][j].y); o.y = pk2(v[u][j].z, v[u][j].w); *(GAS u32x2_t*)(HN + (size_t)(t0 + u) * DM + 4 * lane + 256 * j) = o; } } }
        if (WITH_GAB) { unsigned wb = 16u * (unsigned)lane; asm volatile("" : "+v"(wb));
            const LAS float* W12L = (const LAS float*)(size_t)wb;
#pragma unroll
            for (int jj = 0; jj < 12; ++jj) { float a0 = 0.f, a1 = 0.f;
#pragma unroll
                for (int j = 0; j < 8; ++j) { const f32x4 wv = *(const LAS f32x4*)(W12L + jj * DM + 256 * j);
                    a0 += (v[0][j].x * wv.x + v[0][j].y * wv.y) + (v[0][j].z * wv.z + v[0][j].w * wv.w); a1 += (v[1][j].x * wv.x + v[1][j].y * wv.y) + (v[1][j].z * wv.z + v[1][j].w * wv.w); }
                a0 = wave_sum(a0); a1 = wave_sum(a1); if (lane == 0) { GAB[(size_t)t0 * 12 + jj] = a0; GAB[(size_t)(t0 + 1) * 12 + jj] = a1; } } }
    }
    __syncthreads();
}

__device__ __forceinline__ void rope_pass(const Ctx& C) {
    bf16* PROJ = (bf16*)(C.ws + WS_PROJ); const float* rope = (const float*)(C.ws + WS_ROPE);
    for (int idx = C.blk * NTHR + C.tid; idx < TOK * 24; idx += C.G * NTHR) { const int t = idx / 24, v = idx % 24;
        bf16* p = PROJ + (size_t)t * PW + (v < 12 ? C_DQ + v * 64 : C_DK + (v - 12) * 64);
        const u32x4_t a = *(const u32x4_t*)p, b = *(const u32x4_t*)(p + 8);
        const f32x4 c0 = *(const f32x4*)(rope + t * 16), c1 = *(const f32x4*)(rope + t * 16 + 4), s0 = *(const f32x4*)(rope + t * 16 + 8), s1 = *(const f32x4*)(rope + t * 16 + 12);
        const float t1[8] = {bflo(a.x), bfhi(a.x), bflo(a.y), bfhi(a.y), bflo(a.z), bfhi(a.z), bflo(a.w), bfhi(a.w)};
        const float t2[8] = {bflo(b.x), bfhi(b.x), bflo(b.y), bfhi(b.y), bflo(b.z), bfhi(b.z), bflo(b.w), bfhi(b.w)};
        const float cs[8] = {c0.x, c0.y, c0.z, c0.w, c1.x, c1.y, c1.z, c1.w}, sn[8] = {s0.x, s0.y, s0.z, s0.w, s1.x, s1.y, s1.z, s1.w};
        float o1[8], o2[8];
#pragma unroll
        for (int i = 0; i < 8; ++i) { o1[i] = t1[i] * cs[i] - t2[i] * sn[i]; o2[i] = t2[i] * cs[i] + t1[i] * sn[i]; }
        u32x4_t oa, ob; oa.x = pk2(o1[0], o1[1]); oa.y = pk2(o1[2], o1[3]); oa.z = pk2(o1[4], o1[5]); oa.w = pk2(o1[6], o1[7]);
        ob.x = pk2(o2[0], o2[1]); ob.y = pk2(o2[2], o2[3]); ob.z = pk2(o2[4], o2[5]); ob.w = pk2(o2[6], o2[7]);
        *(u32x4_t*)p = oa; *(u32x4_t*)(p + 8) = ob; }
}

#define SSM_BAR() asm volatile("s_waitcnt lgkmcnt(0)\n\ts_barrier" ::: "memory")
__device__ __forceinline__ void ssm_gemm_a(const Ctx& C, int l) {
    const bf16* PROJ = (const bf16*)(C.ws + WS_PROJ); float* XC = (float*)(C.ws + WS_XC);
    const int lane = C.lane, fr = lane & 15, quad = lane >> 4, tid = C.tid;
    for (int bu = C.blk; bu < 256; bu += C.G) { const int g = bu >> 3, rt = (bu & 7) * 8 + C.wave, r = 16 * rt + fr, tok = (r >> 8) * SQ + (r & 255) * 16;
        const bf16* arow = PROJ + (size_t)(tok + (quad >> 1)) * PW + C_U + g * 16 + 8 * (quad & 1);
        const bf16* bsrc = (const bf16*)(C.ws + WS_M2) + ((size_t)(l * 32 + g) * 128 + 16 * (tid >> 6) + fr) * 256 + 8 * quad;
        f32x4 acc[8];
#pragma unroll
        for (int nt = 0; nt < 8; ++nt) acc[nt] = (f32x4){0.f, 0.f, 0.f, 0.f};
        u32x4_t rb = *(const u32x4_t*)bsrc; bf16x8 an = *(const bf16x8*)arow;
        *(LAS u32x4_t*)(C.lds + tid * 16) = rb;
        SSM_BAR();
#pragma unroll 1
        for (int ks = 0; ks < 8; ++ks) { const bf16x8 a = an; const LAS unsigned char* cur = C.lds + (ks & 1) * 8192;
            if (ks + 1 < 8) { rb = *(const u32x4_t*)(bsrc + 32 * (ks + 1)); an = *(const bf16x8*)(arow + (size_t)(2 * (ks + 1)) * PW); }
#pragma unroll
            for (int nt = 0; nt < 8; ++nt) { const bf16x8 b = *(const LAS bf16x8*)(cur + (nt * 64 + lane) * 16); acc[nt] = __builtin_amdgcn_mfma_f32_16x16x32_bf16(a, b, acc[nt], 0, 0, 0); }
            if (ks + 1 < 8) *(LAS u32x4_t*)(C.lds + ((ks + 1) & 1) * 8192 + tid * 16) = rb;
            SSM_BAR(); }
#pragma unroll
        for (int nt = 0; nt < 8; ++nt)
#pragma unroll
            for (int j = 0; j < 4; ++j) XC[((size_t)(16 * rt + 4 * quad + j) * 32 + g) * 128 + 16 * nt + fr] = acc[nt][j];
    }
}

__device__ __forceinline__ void ssm_gemm_b(const Ctx& C, int l) {
    const bf16* PROJ = (const bf16*)(C.ws + WS_PROJ); const bf16* XS = (const bf16*)(C.ws + WS_XS); bf16* YG = (bf16*)(C.ws + WS_YGELU);
    const int lane = C.lane, fr = lane & 15, quad = lane >> 4, tid = C.tid;
    for (int bu = C.blk; bu < 256; bu += C.G) { const int g = bu >> 3, rt = (bu & 7) * 8 + C.wave, r = 16 * rt + fr, tok = (r >> 8) * SQ + (r & 255) * 16;
        const bf16* arow = PROJ + (size_t)(tok + (quad >> 1)) * PW + C_U + g * 16 + 8 * (quad & 1);
        const bf16* xrow = XS + ((size_t)r * 32 + g) * 128 + 8 * quad;
        const bf16* bsrc = (const bf16*)(C.ws + WS_M13) + ((size_t)(l * 32 + g) * 256 + 16 * (tid >> 6) + fr) * 384 + 8 * quad;
        f32x4 acc[16];
#pragma unroll
        for (int nt = 0; nt < 16; ++nt) acc[nt] = (f32x4){0.f, 0.f, 0.f, 0.f};
        u32x4_t rb0 = *(const u32x4_t*)bsrc, rb1 = *(const u32x4_t*)(bsrc + 128 * 384); bf16x8 an = *(const bf16x8*)arow;
        *(LAS u32x4_t*)(C.lds + tid * 16) = rb0; *(LAS u32x4_t*)(C.lds + 8192 + tid * 16) = rb1;
        SSM_BAR();
#pragma unroll 1
        for (int ks = 0; ks < 12; ++ks) { const bf16x8 a = an; const LAS unsigned char* cur = C.lds + (ks & 1) * 16384;
            if (ks + 1 < 12) { rb0 = *(const u32x4_t*)(bsrc + 32 * (ks + 1)); rb1 = *(const u32x4_t*)(bsrc + 128 * 384 + 32 * (ks + 1));
                an = (ks + 1 < 8) ? *(const bf16x8*)(arow + (size_t)(2 * (ks + 1)) * PW) : *(const bf16x8*)(xrow + 32 * (ks + 1 - 8)); }
#pragma unroll
            for (int nt = 0; nt < 16; ++nt) { const bf16x8 b = *(const LAS bf16x8*)(cur + (nt * 64 + lane) * 16); acc[nt] = __builtin_amdgcn_mfma_f32_16x16x32_bf16(a, b, acc[nt], 0, 0, 0); }
            if (ks + 1 < 12) { *(LAS u32x4_t*)(C.lds + ((ks + 1) & 1) * 16384 + tid * 16) = rb0; *(LAS u32x4_t*)(C.lds + ((ks + 1) & 1) * 16384 + 8192 + tid * 16) = rb1; }
            SSM_BAR(); }
#pragma unroll
        for (int j = 0; j < 4; ++j) { const int rr = 16 * rt + 4 * quad + j; const size_t tb = (size_t)((rr >> 8) * SQ + (rr & 255) * 16);
#pragma unroll
            for (int nt = 0; nt < 16; ++nt) YG[(tb + nt) * 512 + g * 16 + fr] = (bf16)f2bf(gelu_tanh_f(acc[nt][j])); }
    }
}

__device__ __forceinline__ void ssm_scan(const Ctx& C, int l, int sblk  ) {
    const int idx = sblk * NTHR + C.tid, b = idx >> 11, g = (idx >> 6) & 31, p = idx & 63;
    const f32x2_t a = ((const f32x2_t*)(C.ws + WS_A16))[(l * 32 + g) * 64 + p];
    const f32x2_t* xc = (const f32x2_t*)(C.ws + WS_XC) + ((size_t)(b * 256) * 32 + g) * 64 + p; unsigned* xs = (unsigned*)(C.ws + WS_XS) + ((size_t)(b * 256) * 32 + g) * 64 + p;
    float xr = 0.f, xi = 0.f;
    for (int c0 = 0; c0 < 256; c0 += 8) { f32x2_t in[8];
#pragma unroll
        for (int q = 0; q < 8; ++q) in[q] = xc[(size_t)(c0 + q) * 2048];
#pragma unroll
        for (int q = 0; q < 8; ++q) { xs[(size_t)(c0 + q) * 2048] = pk2(xr, xi); const float nr = a.x * xr - a.y * xi + in[q].x, ni = a.x * xi + a.y * xr + in[q].y; xr = nr; xi = ni; } }
}

constexpr int GL_QT = 0, GL_KT = 33792, GL_VT = 67584, GL_AM = 101376, GL_QK = 118784, GL_SM = 136192;
__device__ __forceinline__ void gdn_prep_unit(const Ctx& C, KP P, int l, int unit) {
    const int b = unit / 384, h = (unit / 64) % 6, ch = unit & 63, tok0 = b * SQ + ch * 64, tid = C.tid, lane = C.lane, wave = C.wave;
    LAS float* QT = (LAS float*)(C.lds + GL_QT); LAS float* KT = (LAS float*)(C.lds + GL_KT); LAS float* VT = (LAS float*)(C.lds + GL_VT);
    LAS float* AM = (LAS float*)(C.lds + GL_AM); LAS float* QKM = (LAS float*)(C.lds + GL_QK);
    unsigned smb = GL_SM; asm volatile("" : "+v"(smb));
    LAS float* gc = (LAS float*)(size_t)smb; LAS float* beta = gc + 64; LAS float* eg = gc + 128; LAS float* ek = gc + 192;
    const bf16* PROJ = (const bf16*)(C.ws + WS_PROJ); const float* convw = PIN(24) + (size_t)l * 4 * 2304;
    GAS unsigned char* UB = C.ws + WS_GU + (size_t)unit * GDN_UNIT_BYTES;
    PSPAN_BEGIN(C, 110);
    if (tid < 384) { const int cg = tid % 48, seg = tid / 48, which = cg >> 4, d0 = (cg & 15) * 8, chn = which * 768 + h * 128 + d0, sp0 = ch * 64 + 8 * seg - 3;
        const bf16* src = PROJ + ((size_t)(b * SQ) + sp0) * PW + C_GQ + chn;
        u32x4_t raw[11];
#pragma unroll
        for (int r = 0; r < 11; ++r) raw[r] = (r >= 3 || sp0 + r >= 0) ? *(const u32x4_t*)(src + (ptrdiff_t)r * PW) : (u32x4_t){0u, 0u, 0u, 0u};
        f32x4 wv[4][2];
#pragma unroll
        for (int tap = 0; tap < 4; ++tap) { wv[tap][0] = *(const f32x4*)(convw + tap * 2304 + chn); wv[tap][1] = *(const f32x4*)(convw + tap * 2304 + chn + 4); }
        LAS float* T = (LAS float*)(C.lds + which * 33792) + (8 * seg) * 132 + d0;
#pragma unroll
        for (int i = 0; i < 8; ++i) { f32x4 a0 = (f32x4){0.f, 0.f, 0.f, 0.f}, a1 = a0;
#pragma unroll
            for (int tap = 0; tap < 4; ++tap) { const u32x4_t w = raw[i + tap];
                a0 += wv[tap][0] * (f32x4){bflo(w.x), bfhi(w.x), bflo(w.y), bfhi(w.y)}; a1 += wv[tap][1] * (f32x4){bflo(w.z), bfhi(w.z), bflo(w.w), bfhi(w.w)}; }
            *(LAS f32x4*)(T + i * 132) = (f32x4){silu_f(a0.x), silu_f(a0.y), silu_f(a0.z), silu_f(a0.w)}; *(LAS f32x4*)(T + i * 132 + 4) = (f32x4){silu_f(a1.x), silu_f(a1.y), silu_f(a1.z), silu_f(a1.w)}; } }
    __syncthreads();
    PSPAN_END(C, 110); PSPAN_BEGIN(C, 111);
#pragma unroll
    for (int ii = 0; ii < 8; ++ii) { const int i = wave * 8 + ii;
        { const float a = QT[i * 132 + lane], c = QT[i * 132 + 64 + lane]; const float sc = rsqrtf(wave_sum(a * a + c * c) + EPS) * 0.08838834764831845f; QT[i * 132 + lane] = a * sc; QT[i * 132 + 64 + lane] = c * sc; }
        { const float a = KT[i * 132 + lane], c = KT[i * 132 + 64 + lane]; const float sc = rsqrtf(wave_sum(a * a + c * c) + EPS); KT[i * 132 + lane] = a * sc; KT[i * 132 + 64 + lane] = c * sc; } }
    if (wave == 0) { const float* GAB = (const float*)(C.ws + WS_GAB) + (size_t)(tok0 + lane) * 12;
        const float av = GAB[h], bv = GAB[6 + h]; const float x = av + PIN(26)[l * 6 + h]; const float sp = (x > 20.f) ? x : log1pf(__expf(x));
        float g = -__expf(PIN(25)[l * 6 + h]) * sp;
#pragma unroll
        for (int o = 1; o < 64; o <<= 1) { const float t = __shfl_up(g, o); if (lane >= o) g += t; }
        const float glast = __shfl(g, 63);
        gc[lane] = g; beta[lane] = sigmoid_f(bv); eg[lane] = __expf(g); ek[lane] = __expf(glast - g);
        if (lane == 0) *(float*)(UB + 57344 + 32768) = __expf(glast); }
    __syncthreads();
    PSPAN_END(C, 111); PSPAN_BEGIN(C, 112);
    for (int z = tid; z < 6 * 256; z += NTHR) { const int t = z >> 8, e = z & 255, ti = (t >= 3) ? (t >= 5 ? 2 : 1) : 0, tj = (t >= 3) ? (t >= 5 ? 3 : t - 1) : t + 1;
        QKM[(16 * ti + (e >> 4)) * 68 + 16 * tj + (e & 15)] = 0.f; }
    { const int fr = lane & 15, quad = lane >> 4;
#pragma unroll 1
      for (int job = wave; job < 20; job += NWAVES) { const int mat = job / 10, t = job % 10, ti = (t >= 6) ? 3 : (t >= 3) ? 2 : (t >= 1) ? 1 : 0, tj = t - ti * (ti + 1) / 2; LAS float* OUT = mat ? QKM : AM;
          const LAS float* ap = (mat ? QT : KT) + (16 * ti + fr) * 132 + quad; const LAS float* bp = KT + (16 * tj + fr) * 132 + quad;
          f32x4 a0 = (f32x4){0.f, 0.f, 0.f, 0.f}, a1 = a0, a2 = a0, a3 = a0;
#pragma unroll
          for (int kk = 0; kk < 32; kk += 4) { a0 = __builtin_amdgcn_mfma_f32_16x16x4f32(ap[4 * kk], bp[4 * kk], a0, 0, 0, 0); a1 = __builtin_amdgcn_mfma_f32_16x16x4f32(ap[4 * kk + 4], bp[4 * kk + 4], a1, 0, 0, 0);
              a2 = __builtin_amdgcn_mfma_f32_16x16x4f32(ap[4 * kk + 8], bp[4 * kk + 8], a2, 0, 0, 0); a3 = __builtin_amdgcn_mfma_f32_16x16x4f32(ap[4 * kk + 12], bp[4 * kk + 12], a3, 0, 0, 0); }
          const f32x4 acc = (a0 + a1) + (a2 + a3);
#pragma unroll
          for (int j = 0; j < 4; ++j) { const int i = 16 * ti + 4 * quad + j, jj = 16 * tj + fr; float v = 0.f;
              if (mat == 0) { if (i > jj) v = beta[i] * acc[j] * __expf(gc[i] - gc[jj]); } else { if (i >= jj) v = acc[j] * __expf(gc[i] - gc[jj]); }
              OUT[i * 68 + jj] = v; } } }
    __syncthreads();
    PSPAN_END(C, 112); PSPAN_BEGIN(C, 113);
    { LAS float* TM = (LAS float*)(C.lds + GL_SM + 1024);
      const int fr = lane & 15, quad = lane >> 4;
      f32x4 acc[2][4];
#pragma unroll
      for (int r = 0; r < 4; ++r)
#pragma unroll
          for (int jq = 0; jq < 4; ++jq) { const int i = 16 * r + 4 * quad + jq; const float bi = beta[i];
              acc[0][r][jq] = VT[i * 132 + 16 * wave + fr] * bi; acc[1][r][jq] = KT[i * 132 + 16 * wave + fr] * bi * eg[i]; }
      if (wave == 0) { const int r = lane >> 4, c = lane & 15; const LAS float* Ar = AM + (16 * r) * 68 + 16 * r; float t[16];
#pragma unroll
          for (int i2 = 0; i2 < 16; ++i2) { float sacc = (i2 == c) ? 1.f : 0.f;
#pragma unroll
              for (int j2 = 0; j2 < i2; ++j2) sacc -= Ar[i2 * 68 + j2] * t[j2];
              t[i2] = sacc; TM[(r * 16 + i2) * 16 + c] = sacc; } }
      __syncthreads();
      f32x4 X[2][4];
#pragma unroll
      for (int r = 0; r < 4; ++r) {
#pragma unroll
          for (int q = 0; q < r; ++q) { const f32x4 a = *(const LAS f32x4*)(AM + (16 * r + fr) * 68 + 16 * q + 4 * quad);
#pragma unroll
              for (int jq = 0; jq < 4; ++jq) { acc[0][r] = __builtin_amdgcn_mfma_f32_16x16x4f32(-a[jq], X[0][q][jq], acc[0][r], 0, 0, 0); acc[1][r] = __builtin_amdgcn_mfma_f32_16x16x4f32(-a[jq], X[1][q][jq], acc[1][r], 0, 0, 0); } }
          const f32x4 tt = *(const LAS f32x4*)(TM + (r * 16 + fr) * 16 + 4 * quad);
          X[0][r] = (f32x4){0.f, 0.f, 0.f, 0.f}; X[1][r] = X[0][r];
#pragma unroll
          for (int jq = 0; jq < 4; ++jq) { X[0][r] = __builtin_amdgcn_mfma_f32_16x16x4f32(tt[jq], acc[0][r][jq], X[0][r], 0, 0, 0); X[1][r] = __builtin_amdgcn_mfma_f32_16x16x4f32(tt[jq], acc[1][r][jq], X[1][r], 0, 0, 0); }
          *(f32x4*)((float*)(UB + 57344) + ((((wave * 4 + r) * 4 + quad) * 16 + fr) * 4)) = X[0][r];
#pragma unroll
          for (int jq = 0; jq < 4; ++jq) VT[(16 * r + 4 * quad + jq) * 132 + 16 * wave + fr] = X[1][r][jq]; } }
    __syncthreads();
    PSPAN_END(C, 113); PSPAN_BEGIN(C, 114);
    for (int pc = tid; pc < 3584; pc += NTHR) { const int ln = pc & 63, row = ln & 15, quad = ln >> 4; float v[8];
        if (pc < 2048) { const int tile = (pc >> 6) & 15, mt = tile >> 2, s = tile & 3, i = 16 * mt + row, cb = 32 * s + 4 * quad; const LAS float* src = (pc < 1024 ? VT : QT) + i * 132 + cb; const float sc = (pc < 1024) ? 1.f : eg[i];
            const f32x4 a = *(const LAS f32x4*)src, c = *(const LAS f32x4*)(src + 16);
            v[0] = a.x * sc; v[1] = a.y * sc; v[2] = a.z * sc; v[3] = a.w * sc; v[4] = c.x * sc; v[5] = c.y * sc; v[6] = c.z * sc; v[7] = c.w * sc; }
        else if (pc < 3072) { const int tile = (pc - 2048) >> 6, dt = tile >> 1, s2 = tile & 1, d = 16 * dt + row;
#pragma unroll
            for (int j = 0; j < 8; ++j) { const int jj = 32 * s2 + 4 * quad + (j & 3) + 16 * (j >> 2); v[j] = KT[jj * 132 + d] * ek[jj]; } }
        else { const int tile = (pc - 3072) >> 6, mt = tile >> 1, s2 = tile & 1, i = 16 * mt + row; const LAS float* src = QKM + i * 68 + 32 * s2 + 4 * quad;
            const f32x4 a = *(const LAS f32x4*)src, c = *(const LAS f32x4*)(src + 16);
            v[0] = a.x; v[1] = a.y; v[2] = a.z; v[3] = a.w; v[4] = c.x; v[5] = c.y; v[6] = c.z; v[7] = c.w; }
        v4u o; o.x = pk2(v[0], v[1]); o.y = pk2(v[2], v[3]); o.z = pk2(v[4], v[5]); o.w = pk2(v[6], v[7]); *(GAS v4u*)(UB + (size_t)pc * 16) = o; }
    __syncthreads();
    PSPAN_END(C, 114);
}

#define GDN_BAR() asm volatile("s_waitcnt lgkmcnt(0)\n\ts_barrier" ::: "memory")
template <int PAR>
__device__ __forceinline__ void gdn_step_c(const Ctx& C, int n, const GAS unsigned char* UB, float* OG, int slice, f32x4 (&S)[8], f32x4 (&uu)[4], float& ue) {
    const int lane = C.lane, col = lane & 15, quad = lane >> 4;
    const LAS unsigned char* cur = C.lds + PAR * 57344;
    f32x4 u4[4];
#pragma unroll
    for (int mt = 0; mt < 4; ++mt) u4[mt] = uu[mt];
    const float egl = ue;
    if (n + 2 < 64) { const GAS unsigned char* un = UB + (size_t)(n + 2) * GDN_UNIT_BYTES + 57344;
#pragma unroll
        for (int mt = 0; mt < 4; ++mt) uu[mt] = *(const GAS f32x4*)(un + (size_t)((((slice * 4 + mt) * 4 + quad) * 16 + col) * 16));
        ue = *(const GAS float*)(un + 32768); }
    bf16x8 sb[4];
#pragma unroll
    for (int s = 0; s < 4; ++s) sb[s] = pack8(S[2 * s], S[2 * s + 1]);
    f32x4 vn[4];
#pragma unroll
    for (int mt = 0; mt < 4; ++mt) { f32x4 ws = (f32x4){0.f, 0.f, 0.f, 0.f};
#pragma unroll
        for (int s = 0; s < 4; ++s) { const bf16x8 a = *(const LAS bf16x8*)(cur + ((mt * 4 + s) * 64 + lane) * 16); ws = __builtin_amdgcn_mfma_f32_16x16x32_bf16(a, sb[s], ws, 0, 0, 0); }
        vn[mt] = u4[mt] - ws; }
    bf16x8 vb[2]; vb[0] = pack8(vn[0], vn[1]); vb[1] = pack8(vn[2], vn[3]);
#pragma unroll
    for (int d = 0; d < 8; ++d) { f32x4 sd = S[d] * egl;
#pragma unroll
        for (int s2 = 0; s2 < 2; ++s2) { const bf16x8 a = *(const LAS bf16x8*)(cur + 32768 + ((d * 2 + s2) * 64 + lane) * 16); sd = __builtin_amdgcn_mfma_f32_16x16x32_bf16(a, vb[s2], sd, 0, 0, 0); }
        S[d] = sd; }
#pragma unroll
    for (int mt = 0; mt < 4; ++mt) { f32x4 o = (f32x4){0.f, 0.f, 0.f, 0.f};
#pragma unroll
        for (int s = 0; s < 4; ++s) { const bf16x8 a = *(const LAS bf16x8*)(cur + 16384 + ((mt * 4 + s) * 64 + lane) * 16); o = __builtin_amdgcn_mfma_f32_16x16x32_bf16(a, sb[s], o, 0, 0, 0); }
#pragma unroll
        for (int s2 = 0; s2 < 2; ++s2) { const bf16x8 a = *(const LAS bf16x8*)(cur + 49152 + ((mt * 2 + s2) * 64 + lane) * 16); o = __builtin_amdgcn_mfma_f32_16x16x32_bf16(a, vb[s2], o, 0, 0, 0); }
#pragma unroll
        for (int j = 0; j < 4; ++j) OG[(size_t)(n * 64 + 16 * mt + 4 * quad + j) * 768] = o[j]; }
}
template <int PAR>
__device__ __forceinline__ void gdn_step_l(const Ctx& C, int n, const GAS unsigned char* UB, int lt, u32x4_t (&rr)[14]) {
    if (n + 1 < 64) {
#pragma unroll
        for (int k = 0; k < 14; ++k) *(LAS u32x4_t*)(C.lds + (1 - PAR) * 57344 + (size_t)(lt + 256 * k) * 16) = rr[k]; }
    if (n + 3 < 64) { const GAS unsigned char* un = UB + (size_t)(n + 3) * GDN_UNIT_BYTES;
#pragma unroll
        for (int k = 0; k < 14; ++k) rr[k] = *(const GAS u32x4_t*)(un + (size_t)(lt + 256 * k) * 16); }
}
__device__ __forceinline__ void gdn_seq(const Ctx& C, int gi) {
    const int bh = gi >> 1, b = bh / 6, h = bh % 6, lane = C.lane, col = lane & 15, quad = lane >> 4;
    const GAS unsigned char* UB = C.ws + WS_GU + (size_t)(bh * 64) * GDN_UNIT_BYTES;
    if (C.wave < 4) {
        const int slice = (gi & 1) * 4 + C.wave;
        float* OG = (float*)(C.ws + WS_OGDN) + (size_t)(b * SQ) * 768 + h * 128 + slice * 16 + col;
        f32x4 S[8], uu0[4], uu1[4]; float ue0, ue1;
#pragma unroll
        for (int d = 0; d < 8; ++d) S[d] = (f32x4){0.f, 0.f, 0.f, 0.f};
#pragma unroll
        for (int mt = 0; mt < 4; ++mt) { uu0[mt] = *(const GAS f32x4*)(UB + 57344 + (size_t)((((slice * 4 + mt) * 4 + quad) * 16 + col) * 16)); uu1[mt] = *(const GAS f32x4*)(UB + GDN_UNIT_BYTES + 57344 + (size_t)((((slice * 4 + mt) * 4 + quad) * 16 + col) * 16)); }
        ue0 = *(const GAS float*)(UB + 57344 + 32768); ue1 = *(const GAS float*)(UB + GDN_UNIT_BYTES + 57344 + 32768);
        GDN_BAR();
#pragma unroll 1
        for (int n = 0; n < 64; n += 2) {
            gdn_step_c<0>(C, n, UB, OG, slice, S, uu0, ue0); GDN_BAR();
            gdn_step_c<1>(C, n + 1, UB, OG, slice, S, uu1, ue1); GDN_BAR();
        }
    } else {
        const int lt = C.tid - 256; u32x4_t ra[14], rb[14];
#pragma unroll
        for (int k = 0; k < 14; ++k) { const u32x4_t v = *(const GAS u32x4_t*)(UB + (size_t)(lt + 256 * k) * 16); *(LAS u32x4_t*)(C.lds + (size_t)(lt + 256 * k) * 16) = v; }
#pragma unroll
        for (int k = 0; k < 14; ++k) { ra[k] = *(const GAS u32x4_t*)(UB + GDN_UNIT_BYTES + (size_t)(lt + 256 * k) * 16); rb[k] = *(const GAS u32x4_t*)(UB + 2 * (size_t)GDN_UNIT_BYTES + (size_t)(lt + 256 * k) * 16); }
        GDN_BAR();
#pragma unroll 1
        for (int n = 0; n < 64; n += 2) {
            gdn_step_l<0>(C, n, UB, lt, ra); GDN_BAR();
            gdn_step_l<1>(C, n + 1, UB, lt, rb); GDN_BAR();
        }
    }
}

__device__ __forceinline__ void attn_queue(const Ctx& C, int l) {
    const attn_body::bf16* PROJ = (const attn_body::bf16*)(C.ws + WS_PROJ); attn_body::bf16* ATTO = (attn_body::bf16*)(C.ws + WS_ATTO);
    if (C.tid == 0) C.MISC[18] = 0u;
    for (;;) {
        if (C.tid == 0) { unsigned d = C.MISC[18], q = 0xffffffffu; const unsigned x0 = xb_xcc_id() & 7u;
            for (; d < 8u; ++d) { const unsigned x = (x0 + d) & 7u; const unsigned t = __hip_atomic_fetch_add(C.ctl + CW_QUEUE + 64 * (l * 8 + (int)x), 1u, RLX_AGENT); if (t < 192u) { q = (x << 8) | t; break; } }
            C.MISC[18] = d; C.MISC[16] = q; }
        __syncthreads();
        const unsigned q = (unsigned)__builtin_amdgcn_readfirstlane((int)C.MISC[16]);
        __syncthreads();
        if (q == 0xffffffffu) break;
        const int x = (int)(q >> 8), t = (int)(q & 255u), g = t >> 6, r = t & 63, qb = 15 - (r >> 2), bh = x * 3 + g, b = bh / 6, vh = (bh % 6) * 4 + (r & 3);
        const attn_body::bf16* base = PROJ + (size_t)(b * SQ) * PW;
        attn_body::attn_unit<8>(qb, base + C_DQ + (vh >> 1) * 64, base + C_DK + (vh >> 1) * 64, base + C_DV + (vh >> 2) * 128 + (vh & 1) * 64, ATTO + (size_t)(b * SQ) * 1536 + vh * 64, (char*)C.lds, C.wave);
    }
}

__device__ __forceinline__ volatile LAS unsigned* misc_at(int i) { unsigned a = (unsigned)(MISC_OFF + 4 * i); asm volatile("" : "+v"(a)); return (volatile LAS unsigned*)(size_t)a; }
__device__ __forceinline__ void attn_queue128(const Ctx& C, int l) {
    const attn_body::bf16* PROJ = (const attn_body::bf16*)(C.ws + WS_PROJ); attn_body::bf16* ATTO = (attn_body::bf16*)(C.ws + WS_ATTO);
    if (C.tid == 0) *misc_at(18) = 0u;
    for (;;) {
        if (C.tid == 0) { unsigned d = *misc_at(18), q = 0xffffffffu; const unsigned x0 = xb_xcc_id() & 7u;
            for (; d < 8u; ++d) { const unsigned x = (x0 + d) & 7u; const unsigned t = __hip_atomic_fetch_add(C.ctl + CW_QUEUE + 64 * (l * 8 + (int)x), 1u, RLX_AGENT); if (t < 96u) { q = (x << 8) | t; break; } }
            *misc_at(18) = d; *misc_at(16) = q; }
        __syncthreads();
        const unsigned q = (unsigned)__builtin_amdgcn_readfirstlane((int)*misc_at(16));
        __syncthreads();
        if (q == 0xffffffffu) break;
        const int x = (int)(q >> 8), t = (int)(q & 255u), g = t >> 5, r = t & 31, qb = 15 - (r >> 1), bh = x * 3 + g, b = bh / 6, hm = (bh % 6) * 2 + (r & 1);
        const attn_body::bf16* base = PROJ + (size_t)(b * SQ) * PW;
        attn_body::attn_unit128<8>(qb, base + C_DQ + hm * 64, base + C_DK + hm * 64, base + C_DV + (hm >> 1) * 128, ATTO + (size_t)(b * SQ) * 1536 + hm * 128, (char*)C.lds, C.wave);
    }
}

__device__ __forceinline__ void scan_publish(const Ctx& C, int l) {
    asm volatile("s_waitcnt vmcnt(0)" ::: "memory"); __syncthreads();
    if (C.tid == 0) { __builtin_amdgcn_fence(__ATOMIC_RELEASE, "agent"); asm volatile("s_waitcnt vmcnt(0)" ::: "memory"); (void)__hip_atomic_fetch_add(C.ctl + CW_SCAN + 64 * l, 1u, RLX_AGENT); }
}
__device__ __forceinline__ void scan_wait(const Ctx& C, int l) {
    if (C.tid == 0) { unsigned sp = 0; while (__hip_atomic_load(C.ctl + CW_SCAN + 64 * l, RLX_AGENT) < 16u && ++sp < (1u << 22)) __builtin_amdgcn_s_sleep(2);
        __builtin_amdgcn_fence(__ATOMIC_ACQUIRE, "agent"); asm volatile("s_waitcnt vmcnt(0)" ::: "memory"); }
    __syncthreads();
}

__device__ __forceinline__ void post_mix(const Ctx& C, KP P, int l) {
    const int lane = C.lane; const bf16* ATTO = (const bf16*)(C.ws + WS_ATTO); const float* OG = (const float*)(C.ws + WS_OGDN); const bf16* PROJ = (const bf16*)(C.ws + WS_PROJ); bf16* YCAT = (bf16*)(C.ws + WS_YCAT);
    const float linit = 0.8f - 0.6f * expf(-0.3f * (float)l);
    const float lam = expf(wave_sum(PIN(19)[l * 64 + lane] * PIN(20)[l * 64 + lane])) - expf(wave_sum(PIN(21)[l * 64 + lane] * PIN(22)[l * 64 + lane])) + linit;
    const float sl0 = PIN(23)[l * 128 + 2 * lane] * (1.f - linit), sl1 = PIN(23)[l * 128 + 2 * lane + 1] * (1.f - linit);
    const float gn0 = PIN(27)[l * 128 + 2 * lane], gn1 = PIN(27)[l * 128 + 2 * lane + 1];
    const int tb = (C.blk < 128) ? 48 * C.blk : 6144 + 80 * (C.blk - 128), tn = (C.blk < 128) ? 48 : 80;
    for (int t0 = tb + 2 * C.wave; t0 < tb + tn; t0 += 2 * NWAVES) {
        unsigned o1[2][6], o2[2][6], zz[2][6]; f32x2_t og[2][6];
#pragma unroll
        for (int u = 0; u < 2; ++u)
#pragma unroll
            for (int h = 0; h < 6; ++h) { const int t = t0 + u; o1[u][h] = *(const unsigned*)(ATTO + (size_t)t * 1536 + (2 * h) * 128 + 2 * lane); o2[u][h] = *(const unsigned*)(ATTO + (size_t)t * 1536 + (2 * h + 1) * 128 + 2 * lane);
                og[u][h] = *(const f32x2_t*)(OG + (size_t)t * 768 + h * 128 + 2 * lane); zz[u][h] = *(const unsigned*)(PROJ + (size_t)t * PW + C_GZ + h * 128 + 2 * lane); }
#pragma unroll
        for (int u = 0; u < 2; ++u)
#pragma unroll
            for (int h = 0; h < 6; ++h) { const int t = t0 + u;
                { const float a = bflo(o1[u][h]) - lam * bflo(o2[u][h]), c = bfhi(o1[u][h]) - lam * bfhi(o2[u][h]); const float r = rsqrtf(wave_sum(a * a + c * c) * (1.f / 128.f) + EPS);
                  *(unsigned*)(YCAT + (size_t)t * DM + 512 + h * 128 + 2 * lane) = pk2(a * r * sl0, c * r * sl1); }
                { const f32x2_t o = og[u][h]; const float r = rsqrtf(wave_sum(o.x * o.x + o.y * o.y) * (1.f / 128.f) + EPS);
                  *(unsigned*)(YCAT + (size_t)t * DM + 1280 + h * 128 + 2 * lane) = pk2(o.x * r * gn0 * silu_f(bflo(zz[u][h])), o.y * r * gn1 * silu_f(bfhi(zz[u][h]))); } } }
}

__device__ __forceinline__ void norm_router_phase(const Ctx& C, KP P, const float* __restrict__ nw, const float* __restrict__ mod_shift, const float* __restrict__ mod_scale) {
    LAS float* WRT = (LAS float*)C.lds;
    LAS int* esel = (LAS int*)(C.lds + 65536); LAS int* rankl = esel + 128;
    const float* wr = PIN(31);
    for (int idx = C.tid; idx < DM * 8; idx += NTHR) { const int k = idx >> 3, e = idx & 7; WRT[e * DM + k] = wr[idx]; }
    __syncthreads();
    const float* src = (const float*)(C.ws + WS_HRES); unsigned char* HN8 = (unsigned char*)(C.ws + WS_HN); const int lane = C.lane;
    f32x4 nwv[8];
#pragma unroll
    for (int j = 0; j < 8; ++j) nwv[j] = *(const f32x4*)(nw + 4 * lane + 256 * j);
    f32x4 vn[8];
#pragma unroll
    for (int j = 0; j < 8; ++j) vn[j] = *(const f32x4*)(src + (size_t)(C.blk * 64 + C.wave * 8) * DM + 4 * lane + 256 * j);
    int nlim = 8; asm volatile("" : "+s"(nlim));
#pragma unroll 1
    for (int i = 0; i < nlim; ++i) { const int tl = C.wave * 8 + i, t = C.blk * 64 + tl, b = t >> 12;
        f32x4 v[8]; float ss = 0.f;
#pragma unroll
        for (int j = 0; j < 8; ++j) { v[j] = vn[j]; ss += (v[j].x * v[j].x + v[j].y * v[j].y) + (v[j].z * v[j].z + v[j].w * v[j].w); }
        if (i + 1 < nlim) {
#pragma unroll
            for (int j = 0; j < 8; ++j) vn[j] = *(const f32x4*)(src + (size_t)(t + 1) * DM + 4 * lane + 256 * j); }
        const float r = rsqrtf(wave_sum(ss) * (1.f / DM) + EPS);
        const float* sh = mod_shift + (size_t)b * 6 * DM; const float* scp = mod_scale + (size_t)b * 6 * DM;
#pragma unroll
        for (int j = 0; j < 8; ++j) { const f32x4 s1 = *(const f32x4*)(scp + 4 * lane + 256 * j), s0 = *(const f32x4*)(sh + 4 * lane + 256 * j);
            v[j] = v[j] * r * nwv[j] * (s1 + 1.f) + s0;
            *(GAS unsigned*)(HN8 + (size_t)t * DM + 4 * lane + 256 * j) = pk4_fp8(v[j].x * S8_HN, v[j].y * S8_HN, v[j].z * S8_HN, v[j].w * S8_HN); }
        float lg[8];
        unsigned wb = 16u * (unsigned)lane; asm volatile("" : "+v"(wb)); const LAS float* WRL = (const LAS float*)(size_t)wb;
#pragma unroll
        for (int e = 0; e < 8; ++e) { float a = 0.f;
#pragma unroll
            for (int j = 0; j < 8; ++j) { const f32x4 wv = *(const LAS f32x4*)(WRL + e * DM + 256 * j); a += (v[j].x * wv.x + v[j].y * wv.y) + (v[j].z * wv.z + v[j].w * wv.w); }
            lg[e] = wave_sum(a); }
        int e0 = 0; float v0 = lg[0];
#pragma unroll
        for (int e = 1; e < 8; ++e) if (lg[e] > v0) { v0 = lg[e]; e0 = e; }
        int e1 = -1; float v1 = -INFINITY;
#pragma unroll
        for (int e = 0; e < 8; ++e) if (e != e0 && lg[e] > v1) { v1 = lg[e]; e1 = e; }
        const float g0 = 1.f / (1.f + __expf(v1 - v0)), g1 = 1.f - g0;
        if (lane == 0) { esel[2 * tl] = e0; esel[2 * tl + 1] = e1; ((int*)(C.ws + WS_TOKE))[2 * t] = e0; ((int*)(C.ws + WS_TOKE))[2 * t + 1] = e1; ((float*)(C.ws + WS_TOKG))[2 * t] = g0; ((float*)(C.ws + WS_TOKG))[2 * t + 1] = g1; }
    }
    __syncthreads();
    if (C.tid < 8) { int cnt = 0; for (int i = 0; i < 128; ++i) if (esel[i] == C.tid) rankl[i] = cnt++; ((int*)(C.ws + WS_CNT))[C.blk * 8 + C.tid] = cnt; }
    __syncthreads();
    if (C.tid < 128) ((int*)(C.ws + WS_RANK))[(size_t)C.blk * 128 + C.tid] = rankl[C.tid];
    __syncthreads();
}

__device__ __forceinline__ void route_phase(const Ctx& C) {
    LAS int* tot = (LAS int*)C.lds; LAS int* pre = tot + 8; LAS int* base = tot + 16;
    const int* CNT = (const int*)(C.ws + WS_CNT);
    LAS int* part = tot + 32;
    if (C.tid < 256) { const int bb = C.tid; const int4 ca = *(const int4*)(CNT + bb * 8), cb = *(const int4*)(CNT + bb * 8 + 4); const int cv[8] = {ca.x, ca.y, ca.z, ca.w, cb.x, cb.y, cb.z, cb.w};
#pragma unroll
        for (int e = 0; e < 8; ++e) { int s = cv[e], m = (bb < C.blk) ? cv[e] : 0;
#pragma unroll
            for (int o = 1; o < 64; o <<= 1) { s += __shfl_xor(s, o); m += __shfl_xor(m, o); }
            if (C.lane == 0) { part[C.wave * 16 + e] = s; part[C.wave * 16 + 8 + e] = m; } } }
    __syncthreads();
    if (C.tid < 8) { tot[C.tid] = part[C.tid] + part[16 + C.tid] + part[32 + C.tid] + part[48 + C.tid]; pre[C.tid] = part[8 + C.tid] + part[24 + C.tid] + part[40 + C.tid] + part[56 + C.tid]; }
    __syncthreads();
    if (C.tid == 0) { int run = 0; int* TILE = (int*)(C.ws + WS_TILE);
        for (int e = 0; e < 8; ++e) { base[e] = run; const int nt = (tot[e] + 255) >> 8; if (C.blk == 0) for (int q = 0; q < nt; ++q) TILE[1 + (run >> 8) + q] = e; run += nt << 8; }
        if (C.blk == 0) TILE[0] = run >> 8; }
    __syncthreads();
    const int* TOKE = (const int*)(C.ws + WS_TOKE); const float* TOKG = (const float*)(C.ws + WS_TOKG); const int* RANK = (const int*)(C.ws + WS_RANK);
    int* POS = (int*)(C.ws + WS_POS); float* GW = (float*)(C.ws + WS_GW); const unsigned char* HN8 = (const unsigned char*)(C.ws + WS_HN); unsigned char* AS8 = (unsigned char*)(C.ws + WS_AS);
    for (int i = 0; i < 8; ++i) { const int t = C.blk * 64 + C.wave * 8 + i;
        const int e0 = TOKE[2 * t], e1 = TOKE[2 * t + 1]; const int p0 = base[e0] + pre[e0] + RANK[2 * t], p1 = base[e1] + pre[e1] + RANK[2 * t + 1];
        if (C.lane == 0) { POS[2 * t] = p0; POS[2 * t + 1] = p1; GW[p0] = TOKG[2 * t]; GW[p1] = TOKG[2 * t + 1]; }
#pragma unroll
        for (int j = 0; j < 2; ++j) { const u32x4_t v = *(const u32x4_t*)(HN8 + (size_t)t * DM + 16 * C.lane + 1024 * j); *(u32x4_t*)(AS8 + (size_t)p0 * DM + 16 * C.lane + 1024 * j) = v; *(u32x4_t*)(AS8 + (size_t)p1 * DM + 16 * C.lane + 1024 * j) = v; } }
    __syncthreads();
}

__device__ __forceinline__ void ctr_wait(const Ctx& C, gu32* w, unsigned n) {
    if (C.tid == 0) { unsigned sp = 0; while (__hip_atomic_load(w, RLX_AGENT) < n && ++sp < (1u << 22)) __builtin_amdgcn_s_sleep(2);
        __builtin_amdgcn_fence(__ATOMIC_ACQUIRE, "agent"); asm volatile("s_waitcnt vmcnt(0)" ::: "memory"); }
    __syncthreads();
}
constexpr int FIN_W1 = 4;
template <int LATE>
__device__ __forceinline__ void final_pass(const Ctx& C, KP P, int late_row, int first, int step) {
    const float* HR = (const float*)(C.ws + WS_HRES); const bf16* YS = (const bf16*)(C.ws + WS_AS); const int* POS = (const int*)(C.ws + WS_POS);
    const float* gate2 = (const float*)(C.ws + WS_MOD) + (size_t)(1 * 4) * 6 * DM + 5 * DM; const float* nf = PIN(7); const int lane = C.lane;
    for (int it = first; it < TOK / 2; it += step) {
        const int t0 = 2 * (int)it; const int b = t0 >> 12; const int4 pp = *(const int4*)(POS + 2 * t0);
        const int pmin = __builtin_amdgcn_readfirstlane(min(min(pp.x, pp.y), min(pp.z, pp.w)));
        if ((pmin < late_row) == (LATE == 1)) {
        f32x4 v[2][8]; float ss0 = 0.f, ss1 = 0.f;
#pragma unroll
        for (int j = 0; j < 8; ++j) { const int c = 4 * lane + 256 * j; const f32x4 g = *(const f32x4*)(gate2 + (size_t)b * 6 * DM + c);
            const f32x4 ha = *(const f32x4*)(HR + (size_t)t0 * DM + c), hb = *(const f32x4*)(HR + (size_t)(t0 + 1) * DM + c);
            const u32x2_t a0 = *(const u32x2_t*)(YS + (size_t)pp.x * DM + c), a1 = *(const u32x2_t*)(YS + (size_t)pp.y * DM + c), b0 = *(const u32x2_t*)(YS + (size_t)pp.z * DM + c), b1 = *(const u32x2_t*)(YS + (size_t)pp.w * DM + c);
            const f32x4 ya = (f32x4){bflo(a0.x) + bflo(a1.x), bfhi(a0.x) + bfhi(a1.x), bflo(a0.y) + bflo(a1.y), bfhi(a0.y) + bfhi(a1.y)};
            const f32x4 yb = (f32x4){bflo(b0.x) + bflo(b1.x), bfhi(b0.x) + bfhi(b1.x), bflo(b0.y) + bflo(b1.y), bfhi(b0.y) + bfhi(b1.y)};
            v[0][j] = ha + g * ya; v[1][j] = hb + g * yb;
            ss0 += (v[0][j].x * v[0][j].x + v[0][j].y * v[0][j].y) + (v[0][j].z * v[0][j].z + v[0][j].w * v[0][j].w); ss1 += (v[1][j].x * v[1][j].x + v[1][j].y * v[1][j].y) + (v[1][j].z * v[1][j].z + v[1][j].w * v[1][j].w); }
        const float r0 = rsqrtf(wave_sum(ss0) * (1.f / DM) + EPS), r1 = rsqrtf(wave_sum(ss1) * (1.f / DM) + EPS);
#pragma unroll
        for (int j = 0; j < 8; ++j) { const int c = 4 * lane + 256 * j; const f32x4 w = *(const f32x4*)(nf + c); *(f32x4*)(POUT + (size_t)t0 * DM + c) = v[0][j] * r0 * w; *(f32x4*)(POUT + (size_t)(t0 + 1) * DM + c) = v[1][j] * r1 * w; } }
    }
}
__device__ __forceinline__ void final_phase(const Ctx& C, KP P) {
    const int late_row = (__builtin_amdgcn_readfirstlane(((const int*)(C.ws + WS_TILE))[0]) & 31) * 256;
    const int nb = late_row >> 4;
    if (C.blk >= nb) { ctr_wait(C, C.ctl + CW_FIN, (unsigned)C.G);
        if (C.wave < FIN_W1) final_pass<0>(C, P, late_row, (C.blk - nb) * FIN_W1 + C.wave, (C.G - nb) * FIN_W1); }
    else { ctr_wait(C, C.ctl + CW_FIN + 64, (unsigned)C.G); final_pass<1>(C, P, late_row, C.blk * NWAVES + C.wave, nb * NWAVES); }
}

#ifndef MK_N_LAUNCHES
#define MK_N_LAUNCHES 1
#endif
constexpr int N_PHASES = 24;
constexpr int MIX_CVT_WG = 16;

#if defined(PROBE_LO)
#define PROBE_BEGIN(k) do { if ((k) == PROBE_LO && blockIdx.x == 0 && C0.wave == 0 && mk_lane() == 0) { const unsigned long long t_ = __builtin_amdgcn_s_memrealtime(); C0.MISC[20] = (unsigned)t_; C0.MISC[21] = (unsigned)(t_ >> 32); } } while (0)
#define PROBE_END(k) do { if ((k) == PROBE_HI && blockIdx.x == 0 && C0.wave == 0 && mk_lane() == 0) { const unsigned long long t_ = __builtin_amdgcn_s_memrealtime() - (((unsigned long long)C0.MISC[21] << 32) | C0.MISC[20]); C0.MISC[22] = (unsigned)t_; } } while (0)
#else
#define PROBE_BEGIN(k) do {} while (0)
#define PROBE_END(k) do {} while (0)
#endif
template <int L>
__device__ __forceinline__ void layer_phases(const Ctx& C0, KP P0, int lo, int hi) {
#define IN(k) (lo <= (k) && (k) < hi)
#define SEAM_FILL(k) do { if (IN(k) && IN((k) + 1)) { PHASE_ENV moe_cvt_fill(C, P, (k)); } } while (0)
#define SEAM(k) do { if (IN(k) && IN((k) + 1)) { GAS unsigned char* w_ = C0.ws; asm volatile("" : "+s"(w_)); XcdBarrier b_; b_.bar = (unsigned*)(w_ + WS_CTL) + CW_BAR + (MK_N_LAUNCHES == 1 ? 0 : lo) * XCD_BAR_WORDS; b_.x = xb_xcc_id(); b_.st = C0.MISC + 8; b_.lead = (C0.wave == 0 && mk_lane() == 0); xcd_barrier(b_); } PROBE_END(k); } while (0)
    constexpr int PB = 1 + 11 * L;
#define PHASE_ENV Ctx C = C0; KP P = P0; asm volatile("" : "+s"(C.ws), "+s"(P)); GAS unsigned char* ws = C.ws; C.ctl = (gu32*)(ws + WS_CTL); \
    C.lane = mk_lane(); asm volatile("" : "+v"(C.lane)); C.tid = C.wave * 64 + C.lane; \
    const float* MOD = (const float*)(ws + WS_MOD) + (size_t)(L * 4) * 6 * DM; float* HRES = (float*)(ws + WS_HRES); bf16* HN = (bf16*)(ws + WS_HN); bf16* PROJ = (bf16*)(ws + WS_PROJ); bf16* YCAT = (bf16*)(ws + WS_YCAT); \
    (void)MOD; (void)HRES; (void)HN; (void)PROJ; (void)YCAT; (void)P;
    PROBE_BEGIN(PB + 0); if (IN(PB + 0)) { PHASE_ENV norm_phase<true>(C, L == 0 ? PIN(0) : HRES, PIN(5) + L * DM, MOD + 0 * DM, MOD + 1 * DM, PIN(8) + (size_t)L * DM * INW); }
    SEAM(PB + 0);
    PROBE_BEGIN(PB + 1); if (IN(PB + 1)) { PHASE_ENV pg8::Gemm g{HN, (const bf16*)(ws + WS_WIN) + (size_t)L * PW * DM, TOK, PW, DM}; pg8::StaticOrder S; S.init(TOK, PW, C.G, C.blk); pg8::EpiProj E{PROJ};
        pg8::gemm_phase<pg8::EpiProj, pg8::StaticOrder, true, true>(C.lds, g, S, E, C.wave); }
    SEAM_FILL(PB + 1); SEAM(PB + 1);
    PROBE_BEGIN(PB + 2); if (IN(PB + 2)) { PHASE_ENV rope_pass(C); ssm_gemm_a(C, L);
#pragma unroll 1
        for (int u = C.blk; u < 1536; u += C.G) gdn_prep_unit(C, P, L, u); }
    SEAM(PB + 2);
    PROBE_BEGIN(PB + 3); if (IN(PB + 3)) { PHASE_ENV if (C.blk < 48) { PSPAN_BEGIN(C, 100); gdn_seq(C, C.blk); PSPAN_END(C, 100); __syncthreads(); } else if (C.blk >= C.G - 16) { ssm_scan(C, L, C.blk - (C.G - 16)); scan_publish(C, L); } else if (C.blk < 48 + MIX_CVT_WG) { moe_cvt_mix(C, P, L); } attn_queue128(C, L); }
    if (IN(PB + 3)) { PHASE_ENV scan_wait(C, L); ssm_gemm_b(C, L); }
    SEAM_FILL(PB + 3); SEAM(PB + 3);
    PROBE_BEGIN(PB + 4); if (IN(PB + 4)) { PHASE_ENV
        { pg8::Gemm g{(const bf16*)(ws + WS_YGELU), (const bf16*)(ws + WS_WGLU) + (size_t)L * 512 * 512, TOK, 512, 512}; pg8::StaticOrder S; S.init(TOK, 512, C.G, C.blk); pg8::EpiGlu E{(const bf16*)(ws + WS_YGELU), YCAT};
          pg8::gemm_phase<pg8::EpiGlu, pg8::StaticOrder, true, true>(C.lds, g, S, E, C.wave); }
        post_mix(C, P, L); }
    SEAM(PB + 4);
    PROBE_BEGIN(PB + 6); if (IN(PB + 6)) { PHASE_ENV pg8::Gemm g{YCAT, (const bf16*)(ws + WS_WOUT) + (size_t)L * DM * DM, TOK, DM, DM}; pg8::StaticOrder S; S.init(TOK, DM, C.G, C.blk); pg8::EpiRes E{L == 0 ? PIN(0) : HRES, HRES, MOD + 2 * DM, 1.f};
        pg8::gemm_phase<pg8::EpiRes, pg8::StaticOrder, true, true>(C.lds, g, S, E, C.wave); }
    SEAM(PB + 6);
    if (L == 0) {
        PROBE_BEGIN(PB + 7); if (IN(PB + 7)) { PHASE_ENV norm_phase<false, (DENSE_FP8 >= 1)>(C, HRES, PIN(6) + L * DM, MOD + 3 * DM, MOD + 4 * DM, nullptr); }
        SEAM(PB + 7);
        SEAM(PB + 8);
        PROBE_BEGIN(PB + 9); if (IN(PB + 9)) { PHASE_ENV pg8::StaticOrder S; S.init(TOK, 2 * DFF, C.G, C.blk);
            if (DENSE_FP8 == 2) { pg8::Gemm g{HN, (const bf16*)(ws + WS_WUP), TOK, 2 * DFF, DM / 2}; pg8::EpiSwiglu8 E{(unsigned char*)(ws + WS_H), DFF, 2 * DFF / 256, 1.f / (S8_HN * S8_W13)}; pg8::gemm_phase<pg8::EpiSwiglu8, pg8::StaticOrder, true, true, true>(C.lds, g, S, E, C.wave); }
            else if (DENSE_FP8 == 1) { pg8::Gemm g{HN, (const bf16*)(ws + WS_WUP), TOK, 2 * DFF, DM / 2}; pg8::EpiSwiglu E{(bf16*)(ws + WS_H), DFF, 2 * DFF / 256, 1.f / (S8_HN * S8_W13)}; pg8::gemm_phase<pg8::EpiSwiglu, pg8::StaticOrder, true, true, true>(C.lds, g, S, E, C.wave); }
            else { pg8::Gemm g{HN, (const bf16*)(ws + WS_WUP), TOK, 2 * DFF, DM}; pg8::EpiSwiglu E{(bf16*)(ws + WS_H), DFF, 2 * DFF / 256, 1.f}; pg8::gemm_phase<pg8::EpiSwiglu, pg8::StaticOrder, true, true>(C.lds, g, S, E, C.wave); } }
        SEAM(PB + 9);
        PROBE_BEGIN(PB + 10); if (IN(PB + 10)) { PHASE_ENV pg8::StaticOrder S; S.init(TOK, DM, C.G, C.blk);
            if (DENSE_FP8 == 2) { pg8::Gemm g{(const bf16*)(ws + WS_H), (const bf16*)(ws + WS_WDN), TOK, DM, DFF / 2}; pg8::EpiRes E{HRES, HRES, MOD + 5 * DM, 1.f / (S8_H * S8_W2)}; pg8::gemm_phase<pg8::EpiRes, pg8::StaticOrder, true, true, true>(C.lds, g, S, E, C.wave); }
            else { pg8::Gemm g{(const bf16*)(ws + WS_H), (const bf16*)(ws + WS_WDN), TOK, DM, DFF}; pg8::EpiRes E{HRES, HRES, MOD + 5 * DM, 1.f}; pg8::gemm_phase<pg8::EpiRes, pg8::StaticOrder, true, true>(C.lds, g, S, E, C.wave); } }
        SEAM(PB + 10);
    } else {
        PROBE_BEGIN(PB + 7); if (IN(PB + 7)) { PHASE_ENV norm_router_phase(C, P, PIN(6) + L * DM, MOD + 3 * DM, MOD + 4 * DM); }
        SEAM(PB + 7);
        PROBE_BEGIN(PB + 8); if (IN(PB + 8)) { PHASE_ENV moe_cvt_drain(C, P); route_phase(C); }
        SEAM(PB + 8);
        PROBE_BEGIN(PB + 9); if (IN(PB + 9)) { PHASE_ENV LAS int* TL = (LAS int*)(C.lds + TILE_OFF); for (int i = C.tid; i <= MOE_TILES_MAX; i += NTHR) TL[i] = ((const int*)(ws + WS_TILE))[i]; __syncthreads(); const int R = __builtin_amdgcn_readfirstlane(TL[0]);
            pg8::Gemm g{(const bf16*)(ws + WS_AS), (const bf16*)(ws + WS_MUP), R * 256, 2 * DFE, DM / 2}; pg8::MoeOrder S; S.so.init(R * 256, 2 * DFE, C.G, C.blk); S.tile_e = TL + 1; S.nct = 2 * DFE / 256;
            pg8::EpiSwiglu8 E{(unsigned char*)(ws + WS_H), DFE, 2 * DFE / 256, 1.f / (S8_HN * S8_W13)};
            pg8::gemm_phase<pg8::EpiSwiglu8, pg8::MoeOrder, true, true, true>(C.lds, g, S, E, C.wave); }
        SEAM(PB + 9);
        PROBE_BEGIN(PB + 10); if (IN(PB + 10)) { PHASE_ENV LAS int* TL = (LAS int*)(C.lds + TILE_OFF); for (int i = C.tid; i <= MOE_TILES_MAX; i += NTHR) TL[i] = ((const int*)(ws + WS_TILE))[i]; __syncthreads(); const int R = __builtin_amdgcn_readfirstlane(TL[0]);
            pg8::Gemm g{(const bf16*)(ws + WS_H), (const bf16*)(ws + WS_MDN), R * 256, DM, DFE / 2}; pg8::MoeDownOrder S; S.nM = R; S.nl = R & 31; S.R = R >> 5; S.c = C.blk; S.so.init((R - S.nl) * 256, DM, C.G, C.blk); S.tile_e = TL + 1; S.nct = DM / 256; S.ntf = DFE / 128;
            S.arr = (gu32*)(ws + WS_CTL) + CW_FIN; S.wc = (LAS unsigned*)(C.lds + MISC_OFF) + 28;
            pg8::EpiMoeDown E{(bf16*)(ws + WS_AS), (const float*)(ws + WS_GW), 1.f / (S8_H * S8_W2), (f32x4*)(ws + WS_XC), (gu32*)(ws + WS_CTL) + CW_FIN + 256, (LAS unsigned*)(C.lds + MISC_OFF) + 29};
            pg8::gemm_phase<pg8::EpiMoeDown, pg8::MoeDownOrder, true, true, true>(C.lds, g, S, E, C.wave);
            asm volatile("s_waitcnt vmcnt(0)" ::: "memory"); __syncthreads();
            if (C.wave == 0 && mk_lane() == 0) { __builtin_amdgcn_fence(__ATOMIC_RELEASE, "agent"); asm volatile("s_waitcnt vmcnt(0)" ::: "memory"); (void)__hip_atomic_fetch_add((gu32*)(ws + WS_CTL) + CW_FIN + 64, 1u, RLX_AGENT); } }
        PROBE_END(PB + 10);
    }
#undef IN
#undef SEAM
#undef PHASE_ENV
}

__global__ void __launch_bounds__(NTHR, 2) mk_fwd(Params P) {
    extern __shared__ __attribute__((aligned(16))) unsigned char lds[];
    KP KPp = (KP)__builtin_amdgcn_kernarg_segment_ptr();
    Ctx C; C.lds = (LAS unsigned char*)lds; C.MISC = (volatile LAS unsigned*)(C.lds + MISC_OFF); C.ws = (GAS unsigned char*)KPp->ws; C.ctl = (gu32*)(C.ws + WS_CTL);
    C.tid = threadIdx.x; C.lane = C.tid & 63; C.wave = __builtin_amdgcn_readfirstlane(C.tid >> 6); C.blk = blockIdx.x; C.G = 256;
    for (int u = C.tid; u < (LDS_BYTES - TILE_OFF) / 4; u += NTHR) ((LAS unsigned*)(C.lds + TILE_OFF))[u] = 0u;
    __syncthreads();
    const int lo = KPp->ph_lo, hi = KPp->ph_hi;
    (void)xcd_barrier_post((unsigned*)(C.ctl + CW_BAR) + (MK_N_LAUNCHES == 1 ? 0 : lo) * XCD_BAR_WORDS, C.MISC + 8);
    { const Ctx& C0 = C; PROBE_BEGIN(0); }
    if (lo <= 0 && 0 < hi) { Ctx Cp = C; KP Pp = KPp; asm volatile("" : "+s"(Cp.ws), "+s"(Pp)); Cp.lane = mk_lane(); asm volatile("" : "+v"(Cp.lane)); Cp.tid = Cp.wave * 64 + Cp.lane; p0_prologue(Cp, Pp); if (1 < hi) { XcdBarrier b_; b_.bar = (unsigned*)(Cp.ws + WS_CTL) + CW_BAR + (MK_N_LAUNCHES == 1 ? 0 : lo) * XCD_BAR_WORDS; b_.x = xb_xcc_id(); b_.st = C.MISC + 8; b_.lead = (C.wave == 0 && mk_lane() == 0); xcd_barrier(b_); } }
    { const Ctx& C0 = C; PROBE_END(0); }
    layer_phases<0>(C, KPp, lo, hi);
    layer_phases<1>(C, KPp, lo, hi);
    { const Ctx& C0 = C; PROBE_BEGIN(23); }
    if (lo <= 23 && 23 < hi) { Ctx Cp = C; KP Pp = KPp; asm volatile("" : "+s"(Cp.ws), "+s"(Pp)); Cp.lane = mk_lane(); asm volatile("" : "+v"(Cp.lane)); Cp.tid = Cp.wave * 64 + Cp.lane; final_phase(Cp, Pp); }
    { const Ctx& C0 = C; PROBE_END(23); }
#if defined(PROBE_LO)
    if (blockIdx.x == 0 && C.wave == 0 && mk_lane() == 0) { const unsigned long long t0_ = __builtin_amdgcn_s_memrealtime(), w_ = (unsigned long long)C.MISC[22] * PROBE_MULT; while (__builtin_amdgcn_s_memrealtime() - t0_ < w_) __builtin_amdgcn_s_sleep(8); }
#endif
}

extern "C" void kernel_launch(void* const* d_in, const int* in_sizes, int n_in, void* d_out, int out_size, void* d_ws, size_t ws_size, hipStream_t stream) {
    static int grid = 0;
    if (grid == 0) {
        if (n_in != 35 || in_sizes[0] != TOK * DM || out_size != TOK * DM || ws_size < WS_END) { fprintf(stderr, "kernel_launch: unexpected problem: n_in %d in0 %d out %d ws %zu (need %zu)\n", n_in, n_in > 0 ? in_sizes[0] : -1, out_size, ws_size, (size_t)WS_END); grid = -1; return; }
        int dev = 0, cus = 0, per_cu = 0;
        if (hipGetDevice(&dev) != hipSuccess || hipDeviceGetAttribute(&cus, hipDeviceAttributeMultiprocessorCount, dev) != hipSuccess) { grid = -1; return; }
        if (hipFuncSetAttribute((const void*)mk_fwd, hipFuncAttributeMaxDynamicSharedMemorySize, LDS_BYTES) != hipSuccess) { fprintf(stderr, "kernel_launch: hipFuncSetAttribute failed\n"); grid = -1; return; }
        if (hipOccupancyMaxActiveBlocksPerMultiprocessor(&per_cu, (const void*)mk_fwd, NTHR, LDS_BYTES) != hipSuccess || per_cu < 1) fprintf(stderr, "kernel_launch: occupancy query says %d\n", per_cu);
        (void)hipGetLastError();
        grid = 256;
        if (cus < 256) { fprintf(stderr, "kernel_launch: device has %d CUs, this kernel needs 256\n", cus); grid = -1; return; }
    }
    if (grid < 0) return;
    if (hipMemsetAsync((char*)d_ws + WS_CTL, 0, CTL_ZERO_BYTES, stream) != hipSuccess) return;
    Params p{};
    for (int i = 0; i < 35; ++i) p.in[i] = (const float*)d_in[i];
    p.out = (float*)d_out; p.ws = (unsigned char*)d_ws;
#if MK_N_LAUNCHES == 1
    p.ph_lo = 0; p.ph_hi = N_PHASES;
    hipLaunchKernelGGL(mk_fwd, dim3(grid), dim3(NTHR), LDS_BYTES, stream, p);
#else
    for (int k = 0; k < N_PHASES; ++k) { p.ph_lo = k; p.ph_hi = k + 1; hipLaunchKernelGGL(mk_fwd, dim3(grid), dim3(NTHR), LDS_BYTES, stream, p); }
#endif
}
```
